# Optimizing an MI355X kernel written in HIP

```python
import math
import jax, jax.numpy as jnp
from jax import lax
import numpy as np

D_MODEL = 1024
BATCH = 4
SEQ = 4096
DEPTH = 2

PLE_DIM = 256
N_NORMS = 6
EPS = 1e-6
D_RNN = 1024
N_RNN_BLOCKS = 16
RNN_BLOCK = D_RNN // N_RNN_BLOCKS
CONV_WIDTH = 4
LRU_C = 8.0
N_DIFF_HEADS = 8
DIFF_HEAD_DIM = 64
DIFF_V_DIM = 2 * DIFF_HEAD_DIM
D_QK = N_DIFF_HEADS * 2 * DIFF_HEAD_DIM
D_ATTN = N_DIFF_HEADS * DIFF_V_DIM
ROPE_THETA = 10000.0
Q_BLOCK = 128
D_FF = 3584
N_EXPERTS = 8
TOP_K = 2
N_DENSE_LAYERS = (DEPTH + 1) // 2
N_MOE_LAYERS = DEPTH // 2
D_IN = 2 * D_RNN + 2 * D_QK + D_ATTN + 2 * D_MODEL
SPLIT_POINTS = (D_RNN, 2 * D_RNN, 2 * D_RNN + D_QK, 2 * D_RNN + 2 * D_QK,
                2 * D_RNN + 2 * D_QK + D_ATTN, 2 * D_RNN + 2 * D_QK + D_ATTN + D_MODEL)

kernel_name = 'hybrid_rglru_diffattn_moe_block'


def rmsnorm(x, g):
    xf = x.astype(jnp.float32)
    xf = xf * lax.rsqrt(jnp.mean(xf * xf, axis=-1, keepdims=True) + EPS)
    return (xf * g.astype(jnp.float32)).astype(x.dtype)


def rope_tables(positions):
    inv_freq = ROPE_THETA ** (-jnp.arange(0, DIFF_HEAD_DIM, 2, dtype=jnp.float32) / DIFF_HEAD_DIM)
    ang = positions.astype(jnp.float32)[..., None] * inv_freq
    ang = jnp.concatenate([ang, ang], axis=-1)
    return jnp.cos(ang), jnp.sin(ang)


def apply_rope(t, cos, sin):
    half = DIFF_HEAD_DIM // 2
    tf = t.astype(jnp.float32)
    rot = jnp.concatenate([-tf[..., half:], tf[..., :half]], axis=-1)
    c = cos[:, :, None, None, :]
    s = sin[:, :, None, None, :]
    return (tf * c + rot * s).astype(t.dtype)


def causal_depthwise_conv(u, w, b):
    y = lax.conv_general_dilated(u, w[:, None, :].astype(u.dtype), window_strides=(1,),
                                 padding=[(CONV_WIDTH - 1, 0)],
                                 dimension_numbers=('NWC', 'WIO', 'NWC'),
                                 feature_group_count=D_RNN)
    return y + b


def rg_lru(u, w_a, b_a, w_x, b_x, lam):
    bsz, seq, _ = u.shape
    ub = u.reshape(bsz, seq, N_RNN_BLOCKS, RNN_BLOCK)
    r = jax.nn.sigmoid(jnp.einsum('bsnc,ncd->bsnd', ub, w_a).reshape(bsz, seq, D_RNN) + b_a)
    i_gate = jax.nn.sigmoid(jnp.einsum('bsnc,ncd->bsnd', ub, w_x).reshape(bsz, seq, D_RNN) + b_x)
    log_a = -LRU_C * r.astype(jnp.float32) * jax.nn.softplus(-lam.astype(jnp.float32))
    a = jnp.exp(log_a)
    beta = jnp.sqrt(-jnp.expm1(2.0 * log_a))
    b = beta * (i_gate * u).astype(jnp.float32)

    def combine(left, right):
        a_l, b_l = left
        a_r, b_r = right
        return a_l * a_r, a_r * b_l + b_r

    _, h = lax.associative_scan(combine, (a, b), axis=1)
    return h.astype(u.dtype)


def diff_attention(q, k, v, lam, lambda_init, g_sub):
    seq = q.shape[2]
    scale = DIFF_HEAD_DIM ** -0.5
    outs = []
    for j in range(seq // Q_BLOCK):
        q0 = j * Q_BLOCK
        kv_len = q0 + Q_BLOCK
        s = jnp.einsum('bhqmd,bhkmd->bhmqk', q[:, :, q0:kv_len], k[:, :, :kv_len]).astype(jnp.float32) * scale
        causal = (q0 + jnp.arange(Q_BLOCK))[:, None] >= jnp.arange(kv_len)[None, :]
        s = jnp.where(causal, s, -1e30)
        prob = jax.nn.softmax(s, axis=-1)
        w = prob[:, :, 0] - lam * prob[:, :, 1]
        outs.append(jnp.einsum('bhqk,bhkd->bhqd', w.astype(v.dtype), v[:, :, :kv_len]))
    o = jnp.concatenate(outs, axis=2)
    o = rmsnorm(o, g_sub) * (1.0 - lambda_init)
    bsz = o.shape[0]
    return o.transpose(0, 2, 1, 3).reshape(bsz, seq, D_ATTN)


def swiglu(h, w_gate, w_up, w_down):
    return (jax.nn.silu(h @ w_gate) * (h @ w_up)) @ w_down


def moe_swiglu(h, router_w, w_gate, w_up, w_down):
    bsz, seq, d = h.shape
    t = h.reshape(bsz * seq, d)
    logits = (t @ router_w).astype(jnp.float32)
    top_val, top_idx = lax.top_k(logits, TOP_K)
    top_w = jax.nn.softmax(top_val, axis=-1)
    combine = jnp.sum(jax.nn.one_hot(top_idx, N_EXPERTS, dtype=jnp.float32) * top_w[..., None], axis=1)
    out = jnp.zeros_like(t)
    for e in range(N_EXPERTS):
        out = out + combine[:, e:e + 1].astype(t.dtype) * swiglu(t, w_gate[e], w_up[e], w_down[e])
    return out.reshape(bsz, seq, d)


def setup_inputs(seed: int = 0) -> dict:
    key = jax.random.key(seed)
    ks = jax.random.split(key, 28)
    f32 = jnp.float32

    def nrm(k, shape, scale):
        return jax.random.normal(k, shape, f32) * scale

    x = nrm(ks[0], (BATCH, SEQ, D_MODEL), 1.0)
    p = nrm(ks[1], (DEPTH, BATCH, SEQ, PLE_DIM), 1.0)
    offsets = jax.random.randint(ks[2], (BATCH, 1), 0, 1024, dtype=jnp.int32)
    positions = offsets + jnp.arange(SEQ, dtype=jnp.int32)[None, :]
    norm_g = 1.0 + nrm(ks[3], (DEPTH, N_NORMS, D_MODEL), 0.01)
    w_in = nrm(ks[4], (DEPTH, D_MODEL, D_IN), D_MODEL ** -0.5)
    conv_w = nrm(ks[5], (DEPTH, CONV_WIDTH, D_RNN), CONV_WIDTH ** -0.5)
    conv_b = nrm(ks[6], (DEPTH, D_RNN), 0.01)
    lru_wa = nrm(ks[7], (DEPTH, N_RNN_BLOCKS, RNN_BLOCK, RNN_BLOCK), RNN_BLOCK ** -0.5)
    lru_ba = nrm(ks[8], (DEPTH, D_RNN), 0.01)
    lru_wx = nrm(ks[9], (DEPTH, N_RNN_BLOCKS, RNN_BLOCK, RNN_BLOCK), RNN_BLOCK ** -0.5)
    lru_bx = nrm(ks[10], (DEPTH, D_RNN), 0.01)
    a0 = jax.random.uniform(ks[11], (DEPTH, D_RNN), f32, 0.9, 0.999)
    a_root = a0 ** (1.0 / LRU_C)
    lru_lam = jnp.log(a_root) - jnp.log1p(-a_root)
    diff_lambda = nrm(ks[12], (DEPTH, 4, DIFF_HEAD_DIM), 0.1)
    subln_g = 1.0 + nrm(ks[13], (DEPTH, DIFF_V_DIM), 0.01)
    w_proj_a = nrm(ks[14], (DEPTH, D_RNN, D_MODEL), D_RNN ** -0.5)
    w_proj_b = nrm(ks[15], (DEPTH, D_ATTN, D_MODEL), D_ATTN ** -0.5)
    w_out = nrm(ks[16], (DEPTH, D_MODEL, D_MODEL), D_MODEL ** -0.5)
    ffn_w_gate = nrm(ks[17], (N_DENSE_LAYERS, D_MODEL, D_FF), D_MODEL ** -0.5)
    ffn_w_up = nrm(ks[18], (N_DENSE_LAYERS, D_MODEL, D_FF), D_MODEL ** -0.5)
    ffn_w_down = nrm(ks[19], (N_DENSE_LAYERS, D_FF, D_MODEL), D_FF ** -0.5)
    router_w = nrm(ks[20], (N_MOE_LAYERS, D_MODEL, N_EXPERTS), D_MODEL ** -0.5)
    moe_w_gate = nrm(ks[21], (N_MOE_LAYERS, N_EXPERTS, D_MODEL, D_FF), D_MODEL ** -0.5)
    moe_w_up = nrm(ks[22], (N_MOE_LAYERS, N_EXPERTS, D_MODEL, D_FF), D_MODEL ** -0.5)
    moe_w_down = nrm(ks[23], (N_MOE_LAYERS, N_EXPERTS, D_FF, D_MODEL), D_FF ** -0.5)
    ple_w_proj = nrm(ks[24], (DEPTH, PLE_DIM, D_MODEL), PLE_DIM ** -0.5)
    ple_w_gate = nrm(ks[25], (DEPTH, D_MODEL, D_MODEL), D_MODEL ** -0.5)
    return {'x': x, 'p': p, 'positions': positions, 'norm_g': norm_g, 'w_in': w_in,
            'conv_w': conv_w, 'conv_b': conv_b, 'lru_wa': lru_wa, 'lru_ba': lru_ba,
            'lru_wx': lru_wx, 'lru_bx': lru_bx, 'lru_lam': lru_lam,
            'diff_lambda': diff_lambda, 'subln_g': subln_g, 'w_proj_a': w_proj_a,
            'w_proj_b': w_proj_b, 'w_out': w_out, 'ffn_w_gate': ffn_w_gate,
            'ffn_w_up': ffn_w_up, 'ffn_w_down': ffn_w_down, 'router_w': router_w,
            'moe_w_gate': moe_w_gate, 'moe_w_up': moe_w_up, 'moe_w_down': moe_w_down,
            'ple_w_proj': ple_w_proj, 'ple_w_gate': ple_w_gate}


def reference(x, p, positions, norm_g, w_in, conv_w, conv_b, lru_wa, lru_ba, lru_wx, lru_bx,
              lru_lam, diff_lambda, subln_g, w_proj_a, w_proj_b, w_out, ffn_w_gate, ffn_w_up,
              ffn_w_down, router_w, moe_w_gate, moe_w_up, moe_w_down, ple_w_proj, ple_w_gate):
    bsz, seq, _ = x.shape
    cos, sin = rope_tables(positions)
    for i in range(DEPTH):
        lambda_init = 0.8 - 0.6 * math.exp(-0.3 * i)
        h = rmsnorm(x, norm_g[i, 0])
        proj = h @ w_in[i]
        rnn_gate, rnn_in, q, k, v, g_a, g_b = jnp.split(proj, SPLIT_POINTS, axis=-1)
        u = causal_depthwise_conv(rnn_in, conv_w[i], conv_b[i])
        y_a = rg_lru(u, lru_wa[i], lru_ba[i], lru_wx[i], lru_bx[i], lru_lam[i]) * jax.nn.gelu(rnn_gate)
        q = apply_rope(q.reshape(bsz, seq, N_DIFF_HEADS, 2, DIFF_HEAD_DIM), cos, sin).transpose(0, 2, 1, 3, 4)
        k = apply_rope(k.reshape(bsz, seq, N_DIFF_HEADS, 2, DIFF_HEAD_DIM), cos, sin).transpose(0, 2, 1, 3, 4)
        v = v.reshape(bsz, seq, N_DIFF_HEADS, DIFF_V_DIM).transpose(0, 2, 1, 3)
        lq1, lk1, lq2, lk2 = diff_lambda[i].astype(jnp.float32)
        lam = jnp.exp(jnp.sum(lq1 * lk1)) - jnp.exp(jnp.sum(lq2 * lk2)) + lambda_init
        y_b = diff_attention(q, k, v, lam, lambda_init, subln_g[i])
        merged = jax.nn.sigmoid(g_a) * (y_a @ w_proj_a[i]) + jax.nn.sigmoid(g_b) * (y_b @ w_proj_b[i])
        x = x + rmsnorm(merged @ w_out[i], norm_g[i, 1])
        h = rmsnorm(x, norm_g[i, 2])
        if i % 2 == 0:
            f = swiglu(h, ffn_w_gate[i // 2], ffn_w_up[i // 2], ffn_w_down[i // 2])
        else:
            f = moe_swiglu(h, router_w[i // 2], moe_w_gate[i // 2], moe_w_up[i // 2], moe_w_down[i // 2])
        x = x + rmsnorm(f, norm_g[i, 3])
        gate = jax.nn.sigmoid(rmsnorm(x, norm_g[i, 4]) @ ple_w_gate[i])
        x = x + rmsnorm(gate * (p[i] @ ple_w_proj[i]), norm_g[i, 5])
    return x
```

```cpp
#define MK_MULTI 1
#include <hip/hip_runtime.h>
#include <hip/hip_bf16.h>
#include <cstdio>
#include <cstdint>
#include <cmath>
namespace pg8 {
#define PG8_LAS __attribute__((address_space(3)))
typedef unsigned short bf16_t;
typedef short bf16x8 __attribute__((ext_vector_type(8)));
typedef float f32x4 __attribute__((ext_vector_type(4)));
typedef unsigned u32x4 __attribute__((ext_vector_type(4)));
constexpr int BM = 256, BK = 64, HALF = 128, HTB = HALF * BK * 2  , STAGE_BYTES = 8 * HTB, NXCD = 8, WGM = 8;

__host__ __device__ __forceinline__ int lds_byte(int r, int c) { const int st = (r >> 4) * 2 + (c >> 5), rr = r & 15, cc = c & 31, ob = rr * 64 + cc * 2; return st * 1024 + (ob ^ (((ob >> 9) & 1) << 5)); }
__host__ __device__ __forceinline__ void stage_rc(int b, int& R, int& C) { const int st = b / 1024, sb = b % 1024, swz = sb ^ (((sb >> 9) & 1) << 5); R = (st >> 1) * 16 + swz / 64; C = (st & 1) * 32 + (swz % 64) / 2; }
__host__ __device__ __forceinline__ int perm32(int rho) { const int n = rho >> 4, i = rho & 15; return 8 * (i >> 2) + 4 * n + (i & 3); }

struct Unit { int pm, pn; };
struct Gemm { const bf16_t* A; const bf16_t* Bt; int M, N, K; };

struct StaticOrder {
    int nM, nN, nwg, G, c;
    __host__ __device__ void init(int M, int N, int G_, int c_) { nM = M / BM; nN = N / BM; nwg = nM * nN; G = G_; c = c_; }
    __host__ __device__ bool next(int i, Unit& u) const {
        const long L = (long)i * G + c; if (L >= nwg) return false;
        int wgid = (int)L; { const int q = nwg / NXCD, r = nwg % NXCD, xcd = wgid % NXCD, off = wgid / NXCD; wgid = (xcd < r ? xcd * (q + 1) : r * (q + 1) + (xcd - r) * q) + off; }
        const int nig = WGM * nN, gid = wgid / nig, fm = gid * WGM, gsz = (nM - fm) < WGM ? (nM - fm) : WGM;
        u.pm = fm + ((wgid % nig) % gsz); u.pn = (wgid % nig) / gsz; return true;
    }
    __device__ __forceinline__ void a_ready(const Unit&) const {}
    __device__ __forceinline__ void done(const Unit&) const {}
};

__device__ __forceinline__ unsigned cvt_pk_bf16(float lo, float hi) { unsigned r; asm volatile("v_cvt_pk_bf16_f32 %0, %1, %2" : "=v"(r) : "v"(lo), "v"(hi)); return r; }
typedef float f32x2 __attribute__((ext_vector_type(2)));
__device__ __forceinline__ f32x2 gelu_pk(f32x2 v) {
    const f32x2 av = __builtin_elementwise_abs(v), d = av * 0.2316418882f + 1.0f;
    f32x2 t; t.x = __builtin_amdgcn_rcpf(d.x); t.y = __builtin_amdgcn_rcpf(d.y);
    f32x2 q = t * 0.5307027145f + (-0.7265760135f); q = q * t + 0.7107068705f; q = q * t + (-0.142248368f); q = q * t + 0.127414796f; q = q * t;
    const f32x2 s = (v * v) * (-0.72134752044f);
    f32x2 e; e.x = __builtin_amdgcn_exp2f(s.x); e.y = __builtin_amdgcn_exp2f(s.y);
    const f32x2 m = v * (q * e), r = v - m;
    f32x2 o; o.x = v.x < 0.f ? m.x : r.x; o.y = v.y < 0.f ? m.y : r.y; return o;
}

typedef unsigned u32x2 __attribute__((ext_vector_type(2)));
__device__ __forceinline__ float sigm(float v) { return __builtin_amdgcn_rcpf(1.0f + __builtin_amdgcn_exp2f(-1.4426950408889634f * v)); }
__device__ __forceinline__ f32x4 sigm4(f32x4 v) { return (f32x4){sigm(v[0]), sigm(v[1]), sigm(v[2]), sigm(v[3])}; }
__device__ __forceinline__ float gelu_tanh1(float v) { return v * sigm(1.5957691216057308f * v * (1.0f + 0.044715f * v * v)); }
__device__ __forceinline__ f32x4 gelu_tanh4(f32x4 v) { return (f32x4){gelu_tanh1(v[0]), gelu_tanh1(v[1]), gelu_tanh1(v[2]), gelu_tanh1(v[3])}; }
__device__ __forceinline__ u32x4 pack8(f32x4 a, f32x4 b) { u32x4 w; w.x = cvt_pk_bf16(a[0], a[1]); w.y = cvt_pk_bf16(a[2], a[3]); w.z = cvt_pk_bf16(b[0], b[1]); w.w = cvt_pk_bf16(b[2], b[3]); return w; }
__device__ __forceinline__ f32x4 bf_lo4(u32x4 w) { return (f32x4){__uint_as_float(w.x << 16), __uint_as_float(w.x & 0xffff0000u), __uint_as_float(w.y << 16), __uint_as_float(w.y & 0xffff0000u)}; }
__device__ __forceinline__ f32x4 bf_hi4(u32x4 w) { return (f32x4){__uint_as_float(w.z << 16), __uint_as_float(w.z & 0xffff0000u), __uint_as_float(w.w << 16), __uint_as_float(w.w & 0xffff0000u)}; }

struct EpiF32 {
    static constexpr bool PERM = false, AFTER_DRAIN = false;
    float* C; int ldc;
    __device__ __forceinline__ void operator()(const f32x4 (&acc)[2][2][4][2], const Unit& u, int wr, int wc, int fr, int fq) const {
        const int row0 = u.pm * BM + wr * 64 + fr, col0 = u.pn * BM + wc * 32 + 4 * fq;
#pragma unroll
        for (int ai = 0; ai < 2; ++ai)
#pragma unroll
            for (int m = 0; m < 4; ++m) { float* rowp = C + (size_t)(row0 + ai * HALF + m * 16) * ldc + col0;
#pragma unroll
                for (int bj = 0; bj < 2; ++bj)
#pragma unroll
                    for (int n = 0; n < 2; ++n) *(f32x4*)(rowp + bj * HALF + n * 16) = acc[ai][bj][m][n]; }
    }
};

struct EpiInProj {
    static constexpr bool PERM = true, AFTER_DRAIN = false;
    bf16_t* out; size_t slot_stride; const float* cs; const float* sn; float qscale;
    __device__ __forceinline__ void operator()(const f32x4 (&acc)[2][2][4][2], const Unit& u, int wr, int wc, int fr, int fq) const {
        const int type = u.pn >> 2, sub = u.pn & 3;
        bf16_t* base = out + (size_t)type * slot_stride;
        const int row0 = u.pm * BM + wr * 64 + fr;
        if (type == 2 || type == 3) {
            const float sc = (type == 2) ? qscale : 1.0f;
            const int colb = sub * 256 + wc * 64 + 8 * fq;
#pragma unroll
            for (int ai = 0; ai < 2; ++ai)
#pragma unroll
                for (int m = 0; m < 4; ++m) { const int r = row0 + ai * HALF + m * 16;
                    const f32x4 c0 = *(const f32x4*)(cs + (size_t)r * 32 + 8 * fq), c1 = *(const f32x4*)(cs + (size_t)r * 32 + 8 * fq + 4);
                    const f32x4 s0 = *(const f32x4*)(sn + (size_t)r * 32 + 8 * fq), s1 = *(const f32x4*)(sn + (size_t)r * 32 + 8 * fq + 4);
                    const f32x4 x0a = acc[ai][0][m][0], x0b = acc[ai][0][m][1], x1a = acc[ai][1][m][0], x1b = acc[ai][1][m][1];
                    const f32x4 y0a = (x0a * c0 - x1a * s0) * sc, y0b = (x0b * c1 - x1b * s1) * sc, y1a = (x1a * c0 + x0a * s0) * sc, y1b = (x1b * c1 + x0b * s1) * sc;
                    bf16_t* rowp = base + (size_t)r * 1024 + colb;
                    *(u32x4*)(rowp) = pack8(y0a, y0b); *(u32x4*)(rowp + 32) = pack8(y1a, y1b); }
        } else {
            const int colb = sub * 256 + wc * 32 + 8 * fq;
#pragma unroll
            for (int ai = 0; ai < 2; ++ai)
#pragma unroll
                for (int m = 0; m < 4; ++m) { bf16_t* rowp = base + (size_t)(row0 + ai * HALF + m * 16) * 1024 + colb;
#pragma unroll
                    for (int bj = 0; bj < 2; ++bj) { f32x4 v0 = acc[ai][bj][m][0], v1 = acc[ai][bj][m][1];
                        if (type == 0) { v0 = gelu_tanh4(v0); v1 = gelu_tanh4(v1); }
                        else if (type >= 5) { v0 = sigm4(v0); v1 = sigm4(v1); }
                        *(u32x4*)(rowp + bj * HALF) = pack8(v0, v1); } }
        }
    }
};

struct EpiMerge {
    static constexpr bool PERM = true, AFTER_DRAIN = false;
    const bf16_t* sga; const bf16_t* sgb; float* t1; bf16_t* merged; int nM;
    __device__ __forceinline__ void operator()(const f32x4 (&acc)[2][2][4][2], const Unit& u, int wr, int wc, int fr, int fq) const {
        const bool sel = u.pm >= nM; const int pm = sel ? u.pm - nM : u.pm, pn = u.pn & 3;
        const bf16_t* sg = sel ? sgb : sga;
        const int row0 = pm * BM + wr * 64 + fr, col0 = pn * BM + wc * 32 + 8 * fq;
#pragma unroll
        for (int ai = 0; ai < 2; ++ai)
#pragma unroll
            for (int m = 0; m < 4; ++m)
#pragma unroll
                for (int bj = 0; bj < 2; ++bj) { const size_t off = (size_t)(row0 + ai * HALF + m * 16) * 1024 + col0 + bj * HALF;
                    const u32x4 g = *(const u32x4*)(sg + off);
                    f32x4 v0 = acc[ai][bj][m][0] * bf_lo4(g), v1 = acc[ai][bj][m][1] * bf_hi4(g);
                    if (!sel) { *(f32x4*)(t1 + off) = v0; *(f32x4*)(t1 + off + 4) = v1; }
                    else { v0 = v0 + *(const f32x4*)(t1 + off); v1 = v1 + *(const f32x4*)(t1 + off + 4); *(u32x4*)(merged + off) = pack8(v0, v1); } }
    }
};

struct EpiSwiGLU {
    static constexpr bool PERM = true, AFTER_DRAIN = false;
    bf16_t* O; int ldc; int nper; int pm_sub;
    __device__ __forceinline__ void operator()(const f32x4 (&acc)[2][2][4][2], const Unit& u, int wr, int wc, int fr, int fq) const {
        const int pn = u.pn % nper;
        const int row0 = (u.pm - pm_sub) * BM + wr * 64 + fr, col0 = pn * HALF + wc * 32 + 8 * fq;
#pragma unroll
        for (int ai = 0; ai < 2; ++ai)
#pragma unroll
            for (int m = 0; m < 4; ++m) { const f32x4 g0 = acc[ai][0][m][0], g1 = acc[ai][0][m][1], u0 = acc[ai][1][m][0], u1 = acc[ai][1][m][1];
                const f32x4 a0 = g0 * sigm4(g0) * u0, a1 = g1 * sigm4(g1) * u1;
                *(u32x4*)(O + (size_t)(row0 + ai * HALF + m * 16) * ldc + col0) = pack8(a0, a1); }
    }
};

struct EpiPlainBf16 {
    static constexpr bool PERM = true, AFTER_DRAIN = false;
    bf16_t* O; int ldc; int pn_mask;
    __device__ __forceinline__ void operator()(const f32x4 (&acc)[2][2][4][2], const Unit& u, int wr, int wc, int fr, int fq) const {
        const int row0 = u.pm * BM + wr * 64 + fr, col0 = (u.pn & pn_mask) * BM + wc * 32 + 8 * fq;
#pragma unroll
        for (int ai = 0; ai < 2; ++ai)
#pragma unroll
            for (int m = 0; m < 4; ++m) { bf16_t* rowp = O + (size_t)(row0 + ai * HALF + m * 16) * ldc + col0;
#pragma unroll
                for (int bj = 0; bj < 2; ++bj) *(u32x4*)(rowp + bj * HALF) = pack8(acc[ai][bj][m][0], acc[ai][bj][m][1]); }
    }
};

struct EpiPleGate {
    static constexpr bool PERM = false, AFTER_DRAIN = false;
    float* C; const float* PP; int ldc;
    __device__ __forceinline__ void operator()(const f32x4 (&acc)[2][2][4][2], const Unit& u, int wr, int wc, int fr, int fq) const {
        const int row0 = u.pm * BM + wr * 64 + fr, col0 = u.pn * BM + wc * 32 + 4 * fq;
#pragma unroll
        for (int ai = 0; ai < 2; ++ai)
#pragma unroll
            for (int m = 0; m < 4; ++m) { const size_t ro = (size_t)(row0 + ai * HALF + m * 16) * ldc + col0;
#pragma unroll
                for (int bj = 0; bj < 2; ++bj)
#pragma unroll
                    for (int n = 0; n < 2; ++n) { const size_t o = ro + bj * HALF + n * 16; *(f32x4*)(C + o) = sigm4(acc[ai][bj][m][n]) * *(const f32x4*)(PP + o); } }
    }
};

struct PairOrder {
    StaticOrder base;
    __device__ __forceinline__ bool next(int i, Unit& u) const { if (!base.next(i >> 1, u)) return false; if (i & 1) { u.pm += base.nM; u.pn += base.nN; } return true; }
    __device__ __forceinline__ void a_ready(const Unit&) const {}
    __device__ __forceinline__ void done(const Unit&) const {}
};
struct MoeOrder {
    StaticOrder base; int plo; int ps1, ps2, ps3, ps4, ps5, ps6, ps7;
    __device__ __forceinline__ bool next(int i, Unit& u) const {
        if (!base.next(i, u)) return false;
        const int p = u.pm + plo;
        const int e = (p >= ps1) + (p >= ps2) + (p >= ps3) + (p >= ps4) + (p >= ps5) + (p >= ps6) + (p >= ps7);
        u.pm = p; u.pn += e * base.nN; return true;
    }
    __device__ __forceinline__ void a_ready(const Unit&) const {}
    __device__ __forceinline__ void done(const Unit&) const {}
};
template <class Epi, class Sched, bool ALIGN_EPI = false, bool SP2 = false>
__device__ __forceinline__ void gemm_phase(PG8_LAS unsigned char* lds, const Gemm g, const Sched& S, const Epi& E) {
    int tid_ = threadIdx.x; asm volatile("" : "+v"(tid_));
    const int tid = tid_, wid = __builtin_amdgcn_readfirstlane(tid >> 6), lane = tid & 63, wr = wid >> 2, wc = wid & 3, fr = lane & 15, fq = lane >> 4;
    const int K = g.K, nt = K / BK;
    unsigned voffA[2], voffB[2];
#pragma unroll
    for (int i = 0; i < 2; ++i) { int R, C; stage_rc(tid * 16 + i * 8192, R, C); const int Rb = Epi::PERM ? ((R & ~31) + perm32(R & 31)) : R;
        voffA[i] = (unsigned)(R * K + C) * 2u; voffB[i] = (unsigned)(Rb * K + C) * 2u; }
    const size_t kstep = (size_t)(BK * 2);
    const size_t hstep = (size_t)HALF * K * 2;
    const size_t tstep = 2 * hstep;
    const unsigned ldsw = (unsigned)wid * 1024u;
    const int aoff = lds_byte(wr * 64 + fr, fq * 8), boff = lds_byte(wc * 32 + fr, fq * 8);
#define PG8_SA(b, h) (((b) * 2 + (h)) * HTB)
#define PG8_SB(b, h) ((4 + (b) * 2 + (h)) * HTB)
#define PG8_STAGE(bufoff, gbase, voff) do { _Pragma("unroll") for (int _i = 0; _i < 2; ++_i) \
        __builtin_amdgcn_global_load_lds((const unsigned*)((const char*)(gbase) + (voff)[_i]), (PG8_LAS unsigned*)(lds + (bufoff) + ldsw + _i * 8192), 16, 0, 0); } while (0)
#define PG8_LDA(dst, b, h) do { _Pragma("unroll") for (int m = 0; m < 4; ++m) _Pragma("unroll") for (int k = 0; k < 2; ++k) dst[m][k] = *(const PG8_LAS bf16x8*)(lds + PG8_SA(b, h) + aoff + m * 2048 + k * 1024); } while (0)
#define PG8_LDB(dst, b, h) do { _Pragma("unroll") for (int n = 0; n < 2; ++n) _Pragma("unroll") for (int k = 0; k < 2; ++k) dst[n][k] = *(const PG8_LAS bf16x8*)(lds + PG8_SB(b, h) + boff + n * 2048 + k * 1024); } while (0)
#define PG8_MMA(ai, bj, At, Bt) do { __builtin_amdgcn_s_setprio(1); _Pragma("unroll") for (int m = 0; m < 4; ++m) _Pragma("unroll") for (int n = 0; n < 2; ++n) _Pragma("unroll") for (int k = 0; k < 2; ++k) \
        acc[ai][bj][m][n] = __builtin_amdgcn_mfma_f32_16x16x32_bf16(Bt[n][k], At[m][k], acc[ai][bj][m][n], 0, 0, 0); __builtin_amdgcn_s_setprio(0); } while (0)
#define PG8_WAIT_V(n) asm volatile("s_waitcnt vmcnt(" #n ")" ::: "memory")
#define PG8_WAIT_L(n) asm volatile("s_waitcnt lgkmcnt(" #n ")" ::: "memory")
#define PG8_BAR __builtin_amdgcn_s_barrier()
#define PG8_SCHED __builtin_amdgcn_sched_barrier(0)
    Unit cur, nxt; int ui = 0;
    if (!S.next(0, cur)) return;
    f32x4 acc[2][2][4][2];
#pragma unroll
    for (int a = 0; a < 2; ++a)
#pragma unroll
        for (int b = 0; b < 2; ++b)
#pragma unroll
            for (int m = 0; m < 4; ++m)
#pragma unroll
                for (int n = 0; n < 2; ++n) acc[a][b][m][n] = (f32x4){0.f, 0.f, 0.f, 0.f};
    bf16x8 At[4][2], B0[2][2], B1[2][2];
    const char* cA = (const char*)g.A + (size_t)cur.pm * tstep; const char* cB = (const char*)g.Bt + (size_t)cur.pn * tstep;
    S.a_ready(cur);
    if constexpr (SP2) {
        PG8_STAGE(PG8_SB(0, 0), cB, voffB); PG8_STAGE(PG8_SB(0, 1), cB + hstep, voffB); PG8_STAGE(PG8_SA(0, 0), cA, voffA); PG8_STAGE(PG8_SA(0, 1), cA + hstep, voffA);
        if (wr == 1) PG8_BAR;
        PG8_WAIT_V(2); PG8_BAR;
        PG8_STAGE(PG8_SB(1, 0), cB + kstep, voffB); PG8_STAGE(PG8_SA(1, 0), cA + kstep, voffA); PG8_STAGE(PG8_SB(1, 1), cB + hstep + kstep, voffB);
        PG8_WAIT_V(6); PG8_BAR;
    } else {
        PG8_STAGE(PG8_SB(0, 0), cB, voffB); PG8_STAGE(PG8_SA(0, 0), cA, voffA); PG8_STAGE(PG8_SB(0, 1), cB + hstep, voffB); PG8_STAGE(PG8_SA(0, 1), cA + hstep, voffA);
        if (wr == 1) PG8_BAR;
        PG8_WAIT_V(4); PG8_BAR;
        PG8_STAGE(PG8_SB(1, 0), cB + kstep, voffB); PG8_STAGE(PG8_SA(1, 0), cA + kstep, voffA); PG8_STAGE(PG8_SB(1, 1), cB + hstep + kstep, voffB);
        PG8_WAIT_V(6); PG8_BAR;
    }
    for (;;) {
        const bool has_next = S.next(ui + 1, nxt);
        const char* nA = has_next ? (const char*)g.A + (size_t)nxt.pm * tstep : cA; const char* nB = has_next ? (const char*)g.Bt + (size_t)nxt.pn * tstep : cB;
        for (int t = 0; t < nt; t += 2) {
            const bool last = (t == nt - 2);
            const char* a1 = cA + (size_t)(t + 1) * kstep;
            const char* a2 = last ? nA : cA + (size_t)(t + 2) * kstep; const char* b2 = last ? nB : cB + (size_t)(t + 2) * kstep;
            const char* a3 = a2 + kstep; const char* b3 = b2 + kstep;
            if (last && has_next) S.a_ready(nxt);
            if constexpr (SP2) {
            PG8_LDB(B0, 0, 0); PG8_LDB(B1, 0, 1); PG8_SCHED; PG8_LDA(At, 0, 0); PG8_STAGE(PG8_SA(1, 1), a1 + hstep, voffA);
            PG8_WAIT_V(8); PG8_WAIT_L(0); PG8_BAR; PG8_MMA(0, 0, At, B0); PG8_MMA(0, 1, At, B1); PG8_BAR; PG8_SCHED;
            PG8_LDA(At, 0, 1); PG8_STAGE(PG8_SB(0, 0), b2, voffB); PG8_STAGE(PG8_SB(0, 1), b2 + hstep, voffB); PG8_STAGE(PG8_SA(0, 0), a2, voffA);
            PG8_WAIT_V(8); PG8_WAIT_L(0); PG8_BAR; PG8_MMA(1, 0, At, B0); PG8_MMA(1, 1, At, B1); PG8_BAR; PG8_SCHED;
            PG8_LDB(B0, 1, 0); PG8_LDB(B1, 1, 1); PG8_SCHED; PG8_LDA(At, 1, 0); PG8_STAGE(PG8_SA(0, 1), a2 + hstep, voffA);
            PG8_WAIT_V(8); PG8_WAIT_L(0); PG8_BAR; PG8_MMA(0, 0, At, B0); PG8_MMA(0, 1, At, B1); PG8_BAR; PG8_SCHED;
            PG8_LDA(At, 1, 1); PG8_STAGE(PG8_SB(1, 0), b3, voffB); PG8_STAGE(PG8_SB(1, 1), b3 + hstep, voffB); PG8_STAGE(PG8_SA(1, 0), a3, voffA);
            PG8_WAIT_V(8); PG8_WAIT_L(0); PG8_BAR; PG8_MMA(1, 0, At, B0); PG8_MMA(1, 1, At, B1); PG8_BAR; PG8_SCHED;
            } else {
            PG8_LDB(B0, 0, 0); PG8_SCHED; PG8_LDA(At, 0, 0); PG8_STAGE(PG8_SA(1, 1), a1 + hstep, voffA);
            PG8_WAIT_L(8); PG8_BAR; PG8_WAIT_L(0); PG8_MMA(0, 0, At, B0); PG8_BAR; PG8_SCHED;
            PG8_LDB(B1, 0, 1); PG8_STAGE(PG8_SB(0, 0), b2, voffB);
            PG8_BAR; PG8_WAIT_L(0); PG8_MMA(0, 1, At, B1); PG8_BAR;
            PG8_LDA(At, 0, 1); PG8_STAGE(PG8_SA(0, 0), a2, voffA);
            PG8_BAR; PG8_WAIT_L(0); PG8_MMA(1, 0, At, B0); PG8_BAR; PG8_SCHED;
            PG8_STAGE(PG8_SB(0, 1), b2 + hstep, voffB);
            PG8_WAIT_V(6); PG8_BAR; PG8_MMA(1, 1, At, B1); PG8_BAR;
            PG8_LDB(B0, 1, 0); PG8_SCHED; PG8_LDA(At, 1, 0); PG8_STAGE(PG8_SA(0, 1), a2 + hstep, voffA);
            PG8_WAIT_L(8); PG8_BAR; PG8_WAIT_L(0); PG8_MMA(0, 0, At, B0); PG8_BAR; PG8_SCHED;
            PG8_LDB(B1, 1, 1); PG8_STAGE(PG8_SB(1, 0), b3, voffB);
            PG8_BAR; PG8_WAIT_L(0); PG8_MMA(0, 1, At, B1); PG8_BAR;
            PG8_LDA(At, 1, 1); PG8_STAGE(PG8_SA(1, 0), a3, voffA);
            PG8_BAR; PG8_WAIT_L(0); PG8_MMA(1, 0, At, B0); PG8_BAR; PG8_SCHED;
            PG8_STAGE(PG8_SB(1, 1), b3 + hstep, voffB);
            PG8_WAIT_V(6); PG8_BAR; PG8_MMA(1, 1, At, B1); PG8_BAR;
            }
        }
        if constexpr (ALIGN_EPI) { if (wr == 0) PG8_BAR; }
        if constexpr (!Epi::AFTER_DRAIN) { E(acc, cur, wr, wc, fr, fq); S.done(cur); }
        if (!has_next) break;
#pragma unroll
        for (int a = 0; a < 2; ++a)
#pragma unroll
            for (int b = 0; b < 2; ++b)
#pragma unroll
                for (int m = 0; m < 4; ++m)
#pragma unroll
                    for (int n = 0; n < 2; ++n) acc[a][b][m][n] = (f32x4){0.f, 0.f, 0.f, 0.f};
        cur = nxt; cA = nA; cB = nB; ++ui;
        if constexpr (ALIGN_EPI) { if (wr == 1) PG8_BAR; }
    }
    PG8_WAIT_V(0);
    if constexpr (!ALIGN_EPI) { if (wr == 0) PG8_BAR; }
    PG8_BAR;
    if constexpr (Epi::AFTER_DRAIN) { E.fused(acc, cur, wr, wc, fr, fq, lds, wid, lane); S.done(cur); }
#undef PG8_SA
#undef PG8_SB
#undef PG8_STAGE
#undef PG8_LDA
#undef PG8_LDB
#undef PG8_MMA
#undef PG8_WAIT_V
#undef PG8_WAIT_L
#undef PG8_BAR
#undef PG8_SCHED
}
}
#include <hip/hip_bf16.h>
#include <hip/hip_bf16.h>
#include <cmath>
namespace attn_body {
using bf16=__hip_bfloat16;
using bf16x8=__attribute__((ext_vector_type(8)))short;
using s16x4=__attribute__((ext_vector_type(4)))short;
using f32x16=__attribute__((ext_vector_type(16)))float;
using u32x4=__attribute__((ext_vector_type(4)))unsigned;
constexpr int BATCH=4,NHEAD=16,SEQ=4096,D=64,DM=NHEAD*D;
constexpr int NW=8,QBLK=32,QB=QBLK*NW,KVBLK=64,NQB=SEQ/QB;
constexpr int ATTN_PITCH=DM, ATTN_UNIT_ROWS=QB;
__device__ __forceinline__ int crow(int r,int hi){return (r&3)+8*(r>>2)+4*hi;}
#define SBAR() __builtin_amdgcn_sched_barrier(0)
__device__ __forceinline__ void cmask(f32x16&p0,f32x16&p1,int jb,int qrel,int hi){
  const float NEG=-INFINITY; int kb=64*jb+4*hi;
  #pragma unroll
  for(int r=0;r<16;++r){int kv=kb+(r&3)+8*(r>>2); if(kv>qrel)p0[r]=NEG; if(kv+32>qrel)p1[r]=NEG;}
}

constexpr int NSLOT=3, SLOTB=8192;
constexpr int LDS_K=0, LDS_V=NSLOT*SLOTB, LDS_WS=2*NSLOT*SLOTB, LDS_OST=LDS_WS+NW*64*4, LDS_BYTES=LDS_OST+NW*4096;
constexpr float C2=0.125f*1.4426950408889634f;
__device__ __forceinline__ void glds16(const void*gsrc,unsigned lds_dst){unsigned keep;
  asm volatile("s_mov_b32 %0, m0\n\ts_mov_b32 m0, %2\n\ts_nop 0\n\tglobal_load_lds_dwordx4 %1, off\n\ts_mov_b32 m0, %0":"=&s"(keep):"v"(gsrc),"s"(lds_dst):"memory");}
__device__ __forceinline__ float max3f(float a,float b,float c){float r;asm("v_max3_f32 %0, %1, %2, %3":"=v"(r):"v"(a),"v"(b),"v"(c));return r;}
__device__ __forceinline__ float max2f(float a,float b){float r;asm("v_max_f32_e32 %0, %1, %2":"=v"(r):"v"(a),"v"(b));return r;}
__device__ __forceinline__ float fadd_s(float a,float b){float r;asm("v_add_f32_e32 %0, %1, %2":"=v"(r):"v"(a),"v"(b));return r;}
__device__ __forceinline__ float fsub_s(float a,float b){float r;asm("v_sub_f32_e32 %0, %1, %2":"=v"(r):"v"(a),"v"(b));return r;}
typedef float f32x2_t __attribute__((ext_vector_type(2))); typedef __bf16 bf16x2_t __attribute__((ext_vector_type(2)));
__device__ __forceinline__ unsigned cvtpk_s(float lo,float hi){f32x2_t v={lo,hi};bf16x2_t b=__builtin_convertvector(v,bf16x2_t);return __builtin_bit_cast(unsigned,b);}
#define WAIT_BAR(N) asm volatile("s_waitcnt vmcnt(" #N ") lgkmcnt(0)\n\ts_barrier":::"memory")

__device__ __forceinline__ void qkt(f32x16&p0,f32x16&p1,const char*Kslot,const bf16x8*qr,int r32,int hi){ const f32x16 negm=f32x16{};
  const char*kb=Kslot+hi*1024+r32*16;
  #pragma unroll
  for(int d0=0;d0<4;++d0){
    const bf16x8 b0=*reinterpret_cast<const bf16x8*>(kb+d0*2048);
    const bf16x8 b1=*reinterpret_cast<const bf16x8*>(kb+d0*2048+512);
    if(d0==0){p0=__builtin_amdgcn_mfma_f32_32x32x16_bf16(b0,qr[0],negm,0,0,0);p1=__builtin_amdgcn_mfma_f32_32x32x16_bf16(b1,qr[0],negm,0,0,0);}
    else{p0=__builtin_amdgcn_mfma_f32_32x32x16_bf16(b0,qr[d0],p0,0,0,0);p1=__builtin_amdgcn_mfma_f32_32x32x16_bf16(b1,qr[d0],p1,0,0,0);}}
}
typedef __attribute__((address_space(3))) const char* lds_cptr;
typedef short v4i16_t __attribute__((ext_vector_type(4)));
__device__ __forceinline__ void kload8(bf16x8*kf,lds_cptr kp){
  kf[0]=*(const __attribute__((address_space(3))) bf16x8*)(kp);      kf[1]=*(const __attribute__((address_space(3))) bf16x8*)(kp+512);
  kf[2]=*(const __attribute__((address_space(3))) bf16x8*)(kp+2048); kf[3]=*(const __attribute__((address_space(3))) bf16x8*)(kp+2560);
  kf[4]=*(const __attribute__((address_space(3))) bf16x8*)(kp+4096); kf[5]=*(const __attribute__((address_space(3))) bf16x8*)(kp+4608);
  kf[6]=*(const __attribute__((address_space(3))) bf16x8*)(kp+6144); kf[7]=*(const __attribute__((address_space(3))) bf16x8*)(kp+6656);
}
__device__ __forceinline__ void kload2(bf16x8*kf,lds_cptr kp,int j){ kf[2*j]=*(const __attribute__((address_space(3))) bf16x8*)(kp+j*2048); kf[2*j+1]=*(const __attribute__((address_space(3))) bf16x8*)(kp+j*2048+512); }
__device__ __forceinline__ s16x4 vtr(lds_cptr p){ return __builtin_bit_cast(s16x4,__builtin_amdgcn_ds_read_tr16_b64_v4i16((__attribute__((address_space(3))) v4i16_t*)p)); }
__device__ __forceinline__ float rowmax(const f32x16&p0,const f32x16&p1){
  float a=max3f(p0[0],p0[1],p1[0]),b=max3f(p0[2],p0[3],p1[1]);a=max3f(a,p1[2],p1[3]);
  #pragma unroll
  for(int r=4;r<16;r+=4){a=max3f(a,p0[r],p0[r+1]);b=max3f(b,p0[r+2],p0[r+3]);a=max3f(a,p1[r],p1[r+1]);b=max3f(b,p1[r+2],p1[r+3]);}
  const float m=max2f(a,b);
  auto rr=__builtin_amdgcn_permlane32_swap(__float_as_uint(m),__float_as_uint(m),false,false);
  return max2f(__uint_as_float(rr[0]),__uint_as_float(rr[1]));
}
__device__ __forceinline__ void pv(f32x16*o,int vb,bf16x8 pa0,bf16x8 pa1,bf16x8 pa2,bf16x8 pa3){
  #pragma unroll
  for(int d0=0;d0<2;++d0){s16x4 lo[4],hi[4];
    #pragma unroll
    for(int ks=0;ks<4;++ks){
      asm volatile("ds_read_b64_tr_b16 %0,%1 offset:%c2":"=&v"(lo[ks]):"v"(vb),"i"(d0*4096+ks*1024):"memory");
      asm volatile("ds_read_b64_tr_b16 %0,%1 offset:%c2":"=&v"(hi[ks]):"v"(vb),"i"(d0*4096+ks*1024+512):"memory");}
    asm volatile("s_waitcnt lgkmcnt(0)":::"memory");SBAR();
    #define PK(k) (bf16x8){lo[k][0],lo[k][1],lo[k][2],lo[k][3],hi[k][0],hi[k][1],hi[k][2],hi[k][3]}
    o[d0]=__builtin_amdgcn_mfma_f32_32x32x16_bf16(pa0,PK(0),o[d0],0,0,0);
    o[d0]=__builtin_amdgcn_mfma_f32_32x32x16_bf16(pa1,PK(1),o[d0],0,0,0);
    o[d0]=__builtin_amdgcn_mfma_f32_32x32x16_bf16(pa2,PK(2),o[d0],0,0,0);
    o[d0]=__builtin_amdgcn_mfma_f32_32x32x16_bf16(pa3,PK(3),o[d0],0,0,0);
    #undef PK
  }
}

#ifndef ATTN_STORE16
#define ATTN_STORE16(p,v) (*(u32x4*)(p)=(v))
#endif
template<int THRL> __device__ __forceinline__ void attn_unit(int b,int h,int hv,int qb,const bf16*Q,const bf16*__restrict__ K,const bf16*__restrict__ V,bf16*O,char*shm){
  int tid_=threadIdx.x; asm volatile("":"+v"(tid_)); const int tid=tid_,lane=tid&63,r32=lane&31,hi=lane>>5; const int wid=__builtin_amdgcn_readfirstlane(tid>>6);
  const long rowbase=(long)b*SEQ; const int q0=qb*QB;
  const bf16*Qw=Q+(rowbase+q0+wid*QBLK)*DM+h*D;
  const bf16*Kh=K+rowbase*DM+h*D,*Vh=V+rowbase*DM+hv*D;
  const unsigned lds0=(unsigned)(uintptr_t)shm;
  float*wsf=(float*)(shm+LDS_WS)+wid*64;
  const bf16*ksrc=Kh+(long)lane*DM+wid*8;
  const bf16*vsrc=Vh+(long)(16*(wid&3)+(lane>>2))*DM+(wid>>2)*32+(lane&3)*8;
  const unsigned kdst=lds0+LDS_K+wid*1024, vdst=lds0+LDS_V+wid*1024;
  #define DMA_K(t,slot) glds16(ksrc+(long)(t)*KVBLK*DM,(unsigned)__builtin_amdgcn_readfirstlane(kdst+(slot)))
  #define DMA_V(t,slot) glds16(vsrc+(long)(t)*KVBLK*DM,(unsigned)__builtin_amdgcn_readfirstlane(vdst+(slot)))
  const int vb0=(int)(lds0+LDS_V)+((lane>>4)&1)*32+(lane&3)*8+(4*hi+((lane&15)>>2))*64;
  const char*Kbase=shm+LDS_K; bf16x8 kf[8];
  const lds_cptr shm3=(lds_cptr)shm; const lds_cptr kp0=shm3+LDS_K+hi*1024+r32*16; const lds_cptr vp0=shm3+LDS_V+((lane>>4)&1)*32+(lane&3)*8+(4*hi+((lane&15)>>2))*64;
  const int NT=(q0+QB)/KVBLK;
  DMA_K(0,0);DMA_V(0,0);DMA_K(1,SLOTB);
  bf16x8 qr[4];
  #pragma unroll
  for(int d0=0;d0<4;++d0)qr[d0]=*reinterpret_cast<const bf16x8*>(&Qw[(long)r32*DM+d0*16+hi*8]);
  float mhat=0.f,l_reg=0.f;f32x16 o[2];o[0]=f32x16{};o[1]=f32x16{};const f32x16 ZERO16=f32x16{};
  const int qrel=wid*QBLK+r32;
  #define CMASK(P0,P1,t) do{int jb_=(t)-(NT-4); if(jb_>=0)cmask(P0,P1,jb_,qrel,hi);}while(0)
  bool resc=false;
  #define START(P0,P1) do{ const float rm=rowmax(P0,P1); resc=false; \
    { const float dl=rm; mhat=fadd_s(mhat,dl); \
      _Pragma("unroll") for(int r=0;r<16;++r){P0[r]=fsub_s(P0[r],dl);P1[r]=fsub_s(P1[r],dl);} \
      } \
    _Pragma("unroll") for(int r=0;r<16;++r)P0[r]=__builtin_amdgcn_exp2f(P0[r]); }while(0)
  #define RESC() do{ if(resc){ asm volatile("s_waitcnt lgkmcnt(0)":::"memory"); \
      _Pragma("unroll") for(int d_=0;d_<2;++d_) _Pragma("unroll") for(int r=0;r<16;++r)o[d_][r]*=wsf[crow(r,hi)]; } }while(0)
  f32x16 pA0,pA1,pB0,pB1;
  int sl_prev=0,sl_cur=0,sl_next=SLOTB;
  #define ROT() do{sl_prev=sl_cur;sl_cur=sl_next;sl_next=(sl_next==(NSLOT-1)*SLOTB)?0:sl_next+SLOTB;}while(0)
  DMA_K(2,2*SLOTB);
  WAIT_BAR(3);
  qkt(pA0,pA1,Kbase,qr,r32,hi);asm volatile("s_nop 15\n\ts_nop 7":"+v"(pA0),"+v"(pA1));CMASK(pA0,pA1,0);
  START(pA0,pA1);
  _Pragma("unroll") for(int r=0;r<16;++r)pA1[r]=__builtin_amdgcn_exp2f(pA1[r]);
  WAIT_BAR(0);
  DMA_K(3,0);DMA_V(1,SLOTB);
  ROT();
  kload8(kf,kp0+sl_cur);
  WAIT_BAR(2);
  s16x4 vlo[8],vhi[8]; u32x4 pw0,pw1,pw2,pw3;
  #define PKW(P,B) cvtpk_s(P[B],P[B+1])
  #define PAF(k) __builtin_bit_cast(bf16x8,pw##k)
  #define VFR(i) (bf16x8){vlo[i][0],vlo[i][1],vlo[i][2],vlo[i][3],vhi[i][0],vhi[i][1],vhi[i][2],vhi[i][3]}
  #define PIN(x) asm volatile("":"+v"(x))
  #define MX3(a,b,c) __builtin_fmaxf(__builtin_fmaxf((a),(b)),(c))
  #define GAPA(MF,A0,A1,A2,A3,W0,W1,PW) do{ MF; sacc+=A0; sacc+=A1; sacc+=A2; sacc+=A3; PIN(sacc); W0; W1; PIN(PW); SBAR(); }while(0)
  #define EX(v) __builtin_amdgcn_exp2f(v)
  #define GAPB(MF,X,B) do{ MF; X[B]=EX(X[B]-mhat); X[B+1]=EX(X[B+1]-mhat); X[B+2]=EX(X[B+2]-mhat); X[B+3]=EX(X[B+3]-mhat); PIN(X); SBAR(); }while(0)
  #define VRD(i) do{ vlo[i]=vtr(vp_+(((i)>>2)*4096+((i)&3)*1024)); vhi[i]=vtr(vp_+(((i)>>2)*4096+((i)&3)*1024+512)); }while(0)
  #define KRD(G,j) do{ if(G){ kload2(kf,kp0+sl_next,j); SBAR(); } }while(0)
  #define STEP(C0,C1,P0,P1,t,GK,GV,GL) do{ SBAR(); \
    const lds_cptr vp_=vp0+sl_prev; \
    VRD(0); SBAR(); float sacc=(P0[0]+P0[1]); \
    GAPA(C0=__builtin_amdgcn_mfma_f32_32x32x16_bf16(kf[0],qr[0],ZERO16,0,0,0), P0[2],P0[3],P0[4],P0[5],     pw0[0]=PKW(P0,0), pw0[1]=PKW(P0,2), pw0); \
    VRD(4); SBAR(); GAPA(C1=__builtin_amdgcn_mfma_f32_32x32x16_bf16(kf[1],qr[0],ZERO16,0,0,0), P0[6],P0[7],P0[8],P0[9],     pw0[2]=PKW(P0,4), pw0[3]=PKW(P0,6), pw0); \
    VRD(1); SBAR(); GAPA(C0=__builtin_amdgcn_mfma_f32_32x32x16_bf16(kf[2],qr[1],C0,0,0,0),   P0[10],P0[11],P0[12],P0[13], pw1[0]=PKW(P0,8), pw1[1]=PKW(P0,10), pw1); \
    VRD(5); SBAR(); GAPA(C1=__builtin_amdgcn_mfma_f32_32x32x16_bf16(kf[3],qr[1],C1,0,0,0),   P0[14],P0[15],P1[0],P1[1],   pw1[2]=PKW(P0,12),pw1[3]=PKW(P0,14), pw1); \
    VRD(2); SBAR(); GAPA(C0=__builtin_amdgcn_mfma_f32_32x32x16_bf16(kf[4],qr[2],C0,0,0,0),   P1[2],P1[3],P1[4],P1[5],     pw2[0]=PKW(P1,0), pw2[1]=PKW(P1,2), pw2); \
    VRD(6); SBAR(); GAPA(C1=__builtin_amdgcn_mfma_f32_32x32x16_bf16(kf[5],qr[2],C1,0,0,0),   P1[6],P1[7],P1[8],P1[9],     pw2[2]=PKW(P1,4), pw2[3]=PKW(P1,6), pw2); \
    VRD(3); SBAR(); GAPA(C0=__builtin_amdgcn_mfma_f32_32x32x16_bf16(kf[6],qr[3],C0,0,0,0),   P1[10],P1[11],P1[12],P1[13], pw3[0]=PKW(P1,8), pw3[1]=PKW(P1,10), pw3); \
    VRD(7); SBAR(); GAPA(C1=__builtin_amdgcn_mfma_f32_32x32x16_bf16(kf[7],qr[3],C1,0,0,0),   P1[14],P1[15],0.f,0.f,       pw3[2]=PKW(P1,12),pw3[3]=PKW(P1,14), pw3); \
    l_reg+=sacc; \
    if(GK){DMA_K((t)+3,sl_cur);} if(GV){DMA_V((t)+1,sl_next);} \
    CMASK(C0,C1,t); \
    { float a=MX3(C0[0],C0[1],C1[0]),b=MX3(C0[2],C0[3],C1[1]); a=MX3(a,C1[2],C1[3]); \
      _Pragma("unroll") for(int r=4;r<16;r+=4){a=MX3(a,C0[r],C0[r+1]);b=MX3(b,C0[r+2],C0[r+3]);a=MX3(a,C1[r],C1[r+1]);b=MX3(b,C1[r+2],C1[r+3]);} \
      float rm=__builtin_fmaxf(a,b); { auto rr=__builtin_amdgcn_permlane32_swap(__float_as_uint(rm),__float_as_uint(rm),false,false); rm=__builtin_fmaxf(__uint_as_float(rr[0]),__uint_as_float(rr[1])); } \
      resc=false; rm-=mhat;   \
      if(__builtin_expect(__any(rm>(float)THRL),0)){ const float dl=__builtin_fmaxf(rm,0.f); mhat+=dl; \
        const float f=__builtin_amdgcn_exp2f(-dl); l_reg*=f; if(hi==0)wsf[r32]=f; resc=true; } } \
    SBAR(); \
    GAPB(o[0]=__builtin_amdgcn_mfma_f32_32x32x16_bf16(PAF(0),VFR(0),o[0],0,0,0), C0,0); \
    GAPB(o[1]=__builtin_amdgcn_mfma_f32_32x32x16_bf16(PAF(0),VFR(4),o[1],0,0,0), C0,4); \
    KRD(GL,0); GAPB(o[0]=__builtin_amdgcn_mfma_f32_32x32x16_bf16(PAF(1),VFR(1),o[0],0,0,0), C0,8); \
    KRD(GL,1); GAPB(o[1]=__builtin_amdgcn_mfma_f32_32x32x16_bf16(PAF(1),VFR(5),o[1],0,0,0), C0,12); \
    KRD(GL,2); GAPB(o[0]=__builtin_amdgcn_mfma_f32_32x32x16_bf16(PAF(2),VFR(2),o[0],0,0,0), C1,0); \
    KRD(GL,3); GAPB(o[1]=__builtin_amdgcn_mfma_f32_32x32x16_bf16(PAF(2),VFR(6),o[1],0,0,0), C1,4); \
    GAPB(o[0]=__builtin_amdgcn_mfma_f32_32x32x16_bf16(PAF(3),VFR(3),o[0],0,0,0), C1,8); \
    GAPB(o[1]=__builtin_amdgcn_mfma_f32_32x32x16_bf16(PAF(3),VFR(7),o[1],0,0,0), C1,12); \
    }while(0)
  int t=1;
  #undef CMASK
  #define CMASK(P0,P1,t) do{}while(0)
  for(;t+5<NT;t+=2){
    STEP(pB0,pB1,pA0,pA1,t,true,true,true);     WAIT_BAR(2); RESC(); ROT();
    STEP(pA0,pA1,pB0,pB1,t+1,true,true,true);   WAIT_BAR(2); RESC(); ROT();
  }
  #undef CMASK
  #define CMASK(P0,P1,t) do{int jb_=(t)-(NT-4); if(jb_>=0)cmask(P0,P1,jb_,qrel,hi);}while(0)
  #define ENDW(tt) do{ if((tt)+3<NT){WAIT_BAR(2);} else if((tt)+2<NT){WAIT_BAR(1);} else {WAIT_BAR(0);} }while(0)
  for(;t+1<NT;t+=2){
    STEP(pB0,pB1,pA0,pA1,t,(t+3<NT),(t+1<NT),(t+1<NT));       ENDW(t);   RESC(); ROT();
    STEP(pA0,pA1,pB0,pB1,t+1,(t+4<NT),(t+2<NT),(t+2<NT));     ENDW(t+1); RESC(); ROT();
  }
  STEP(pB0,pB1,pA0,pA1,NT-1,false,false,false); RESC();
  { float sacc=pB0[0]+pB0[1]; _Pragma("unroll") for(int r=2;r<16;++r)sacc+=pB0[r]; _Pragma("unroll") for(int r=0;r<16;++r)sacc+=pB1[r]; l_reg+=sacc;
    pw0=(u32x4){PKW(pB0,0),PKW(pB0,2),PKW(pB0,4),PKW(pB0,6)};pw1=(u32x4){PKW(pB0,8),PKW(pB0,10),PKW(pB0,12),PKW(pB0,14)};pw2=(u32x4){PKW(pB1,0),PKW(pB1,2),PKW(pB1,4),PKW(pB1,6)};pw3=(u32x4){PKW(pB1,8),PKW(pB1,10),PKW(pB1,12),PKW(pB1,14)};
    SBAR(); pv(o,vb0+sl_cur,PAF(0),PAF(1),PAF(2),PAF(3)); }
  #undef PKW
  #undef PAF
  #undef VFR
  #undef PIN
  #undef MX3
  #undef GAPA
  #undef GAPB
  #undef EX
  #undef VRD
  #undef KRD
  #undef STEP
  #undef ENDW
  {auto rr=__builtin_amdgcn_permlane32_swap(__float_as_uint(l_reg),__float_as_uint(l_reg),false,false);l_reg=__uint_as_float(rr[0])+__uint_as_float(rr[1]);}
  if(hi==0)wsf[32+r32]=l_reg;asm volatile("s_waitcnt lgkmcnt(0)":::"memory");
  float rli[16];
  #pragma unroll
  for(int r=0;r<16;++r)rli[r]=__builtin_amdgcn_rcpf(wsf[32+crow(r,hi)]);
  bf16*Ow=O+(rowbase+q0+wid*QBLK)*DM+hv*D;
  { bf16*stg=(bf16*)(shm+LDS_OST)+wid*2048;
    #pragma unroll
    for(int r=0;r<16;++r){const int orow=crow(r,hi);
      #pragma unroll
      for(int d0=0;d0<2;++d0)stg[orow*64+d0*32+r32]=__float2bfloat16(o[d0][r]*rli[r]);}
    asm volatile("s_waitcnt lgkmcnt(0)":::"memory");
    #pragma unroll
    for(int i=0;i<4;++i){const int row=i*8+(lane>>3),ch=lane&7; const u32x4 v=*(const u32x4*)(stg+row*64+ch*8); ATTN_STORE16(Ow+(long)row*DM+ch*8,v);} }
  asm volatile("s_waitcnt lgkmcnt(0)\n\ts_barrier":::"memory");
  #undef DMA_K
  #undef DMA_V
  #undef CMASK
  #undef START
  #undef RESC
  #undef ROT
}
constexpr int ATTN_LDS_BYTES=LDS_BYTES;
struct AttnTensors { const bf16* Q; const bf16* K; const bf16* V; bf16* O1; bf16* O2; };
template<int THRL=8> __device__ __forceinline__ void attn_phase(char*lds,const AttnTensors&T,int vcu,int ncu){
  const int sidx=(vcu&255)>>3, s=vcu&7;
  for(int i=0;i<8;++i){
    const int st=sidx+32*(i>>1); const int b=st>>5, hq=(st>>1)&15, half=st&1, hv=(hq&~1)+half; const int qb=(i&1)?15-s:s;
    attn_unit<THRL>(b,hq,hv,qb,T.Q,T.K,T.V,(hq&1)?T.O2:T.O1,lds);
  }
}
#undef SBAR
#undef WAIT_BAR
}
constexpr int NWAVES = 8;
#ifndef MK_MULTI
#define MK_MULTI 0
#endif
constexpr int NB = 4, SEQ = 4096, T = NB * SEQ, D = 1024, DIN = 7168, FF = 3584, NEXP = 8, PLE = 256, DEPTH = 2;
constexpr int NPAN = T / 256;
constexpr float EPS = 1e-6f;
constexpr int MOE_ROWS = 2 * T + NEXP * 256;
constexpr int MOE_PANELS = MOE_ROWS / 256, MOE_HALF = MOE_PANELS / 2;
constexpr size_t MiB = 1u << 20;
constexpr size_t WS_CTL = 0, CTL_ZERO_BYTES = 1 * MiB;
constexpr size_t WS_LRUW = 1 * MiB;
constexpr size_t WS_PAR = 1 * MiB + 512 * 1024;
constexpr size_t WS_SUM = 2 * MiB;
constexpr size_t WS_TOK = 4 * MiB;
constexpr size_t WS_LIST = 5 * MiB;
constexpr size_t WS_COS = 6 * MiB, WS_SIN = 8 * MiB;
constexpr size_t WS_WSMALL = 10 * MiB;
constexpr size_t WL_STRIDE = 45 * MiB / 2, WL_WIN = 0, WL_WAB = 14 * MiB, WL_WO = 18 * MiB, WL_WPG = 20 * MiB, WL_WPP = 22 * MiB;
constexpr size_t WS_WGU = WS_WSMALL + 45 * MiB, WS_WD = WS_WGU + 14 * MiB;
constexpr size_t WS_PB = 76 * MiB;
constexpr size_t WS_H = 92 * MiB;
constexpr size_t WS_BIG = 124 * MiB, SLOT = 32 * MiB;
constexpr size_t WS_GG = WS_BIG, WS_RIN = WS_BIG + SLOT, WS_Q = WS_BIG + 2 * SLOT, WS_K = WS_BIG + 3 * SLOT, WS_V = WS_BIG + 4 * SLOT, WS_SGA = WS_BIG + 5 * SLOT, WS_SGB = WS_BIG + 6 * SLOT;
constexpr size_t WS_HL = WS_BIG + 7 * SLOT, WS_LP = WS_BIG + 8 * SLOT, WS_O1 = WS_BIG + 9 * SLOT, WS_O2 = WS_BIG + 10 * SLOT;
constexpr size_t WS_YA = WS_RIN, WS_YB = WS_Q, WS_T1 = WS_K, WS_MERGED = WS_GG, WS_F = WS_SGA;
constexpr size_t WS_ACT = WS_BIG;
constexpr size_t WS_PP = WS_BIG;
constexpr size_t WS_WMGU = WS_BIG, WS_WMD = WS_BIG + 112 * MiB, WS_ACTH = WS_BIG + 168 * MiB, WS_HG = WS_BIG + 288 * MiB;
constexpr size_t WS_END = WS_HG + 68 * MiB;
static_assert(WS_O2 + SLOT <= WS_END && (size_t)MOE_HALF * 256 * FF * 2 <= 120 * MiB && (size_t)MOE_ROWS * D * 2 <= 68 * MiB, "d_ws map");
constexpr int CW_TMO = 0, CW_CODE = 1;
constexpr int CW_CNT = 64;
constexpr int CW_BAR = 4096;
constexpr int RING_OFF = 0, RING_BYTES = 131072;
constexpr int LDSCTL_OFF = RING_BYTES, MISC_OFF = LDSCTL_OFF + 320;
constexpr int LDS_BYTES = 147456;
static_assert(MISC_OFF + 128 <= LDS_BYTES, "LDS map");
#define GAS __attribute__((address_space(1)))
#define LAS __attribute__((address_space(3)))
typedef unsigned short bf16;
typedef unsigned v4u __attribute__((ext_vector_type(4)));
typedef float f32x4 __attribute__((ext_vector_type(4)));
typedef short bf16x8 __attribute__((ext_vector_type(8)));
typedef GAS unsigned gu32;
typedef GAS unsigned long long gu64;
#define RLX_AGENT __ATOMIC_RELAXED, __HIP_MEMORY_SCOPE_AGENT
#define LDS_WAIT() asm volatile("s_waitcnt lgkmcnt(0)" ::: "memory")
#define VM_WAIT() asm volatile("s_waitcnt vmcnt(0)" ::: "memory")
__device__ __forceinline__ unsigned long long rt() { return __builtin_amdgcn_s_memrealtime(); }
__device__ __forceinline__ unsigned f2bf(float f) { unsigned u = __builtin_bit_cast(unsigned, f); return (u + 0x7fffu + ((u >> 16) & 1u)) >> 16; }
__device__ __forceinline__ unsigned pk2(float lo, float hi) { return f2bf(lo) | (f2bf(hi) << 16); }

#define XB_TMO      128
#define XB_XCNT(j)  (256  + 64 * (j))
#define XB_XSUB(j)  (1280 + 64 * (j))
#define XB_XGEN(j)  (2304 + 64 * (j))
#define XB_TOP      3328
#define XB_TOPGEN   3392
#define XCD_BAR_WORDS 3456
#define XB_SPIN_CAP (1u << 18)

__device__ __forceinline__ unsigned xb_ld(unsigned* p)              { return __hip_atomic_load(p, __ATOMIC_RELAXED, __HIP_MEMORY_SCOPE_AGENT); }
__device__ __forceinline__ unsigned xb_add(unsigned* p, unsigned v) { return __hip_atomic_fetch_add(p, v, __ATOMIC_RELAXED, __HIP_MEMORY_SCOPE_AGENT); }
__device__ __forceinline__ unsigned xb_xcc_id() { return (unsigned)__builtin_amdgcn_s_getreg((3 << 11) | 20) & 0xFu; }
#define XB_SPIN(cond, bar) do { unsigned _sp = 0; while (cond) { __builtin_amdgcn_s_sleep(1); \
    if ((++_sp & 255u) == 0u) { if (xb_ld(&(bar)[XB_TMO])) break; if (_sp > XB_SPIN_CAP) { atomicAdd(&(bar)[XB_TMO], 1u); break; } } } } while (0)

struct XcdBarrier {
    unsigned* bar; unsigned x;
    volatile LAS unsigned* st;
};

__device__ __forceinline__ XcdBarrier xcd_barrier_post(unsigned* bar, volatile LAS unsigned* st) {
    XcdBarrier b; b.bar = bar; b.x = xb_xcc_id(); b.st = st;
    if (threadIdx.x == 0) (void)xb_add(&bar[XB_XCNT(b.x)], 1u);
    return b;
}
__device__ __forceinline__ void xcd_barrier_complete(unsigned* bar, unsigned x, unsigned& nloc, unsigned& nx) {
    const unsigned G = gridDim.x * gridDim.y * gridDim.z;
    unsigned sum, cnt, mine, sp = 0u;
    for (;;) {
        sum = 0u; cnt = 0u; mine = 0u;
#pragma unroll
        for (unsigned j = 0; j < 16; ++j) { const unsigned c = xb_ld(&bar[XB_XCNT(j)]); sum += c; cnt += (c > 0u) ? 1u : 0u; mine = (j == x) ? c : mine; }
        if (sum == G) break;
        __builtin_amdgcn_s_sleep(1);
        if ((++sp & 255u) == 0u) { if (xb_ld(&bar[XB_TMO])) break; if (sp > XB_SPIN_CAP) { atomicAdd(&bar[XB_TMO], 1u); break; } }
    }
    nloc = mine > 0u ? mine : 1u; nx = cnt > 0u ? cnt : 1u;
}

__device__ __forceinline__ void xcd_barrier(const XcdBarrier& b) {
    asm volatile("s_waitcnt vmcnt(0)" ::: "memory");
    __syncthreads();
    if (threadIdx.x == 0) {
        unsigned* bar = b.bar; unsigned bx_ = b.x;
        asm volatile("" : "+s"(bar), "+s"(bx_));
        __builtin_amdgcn_s_waitcnt(0);
        unsigned nloc = b.st[0], nx = b.st[1];
        if (nloc == 0u) { xcd_barrier_complete(bar, bx_, nloc, nx); b.st[0] = nloc; b.st[1] = nx; }
        const unsigned old = xb_add(&bar[XB_XSUB(bx_)], 1u);
        const unsigned gen = old / nloc;
        if (old + 1u == (gen + 1u) * nloc) {
            __builtin_amdgcn_fence(__ATOMIC_RELEASE, "agent");
            asm volatile("s_waitcnt vmcnt(0)" ::: "memory");
            const unsigned og = xb_add(&bar[XB_TOP], 1u);
            const unsigned tg = og / nx;
            if (og + 1u == (tg + 1u) * nx) xb_add(&bar[XB_TOPGEN], 1u);
            else XB_SPIN(xb_ld(&bar[XB_TOPGEN]) == tg, bar);
            __builtin_amdgcn_fence(__ATOMIC_ACQUIRE, "agent");
            xb_add(&bar[XB_XGEN(bx_)], 1u);
            asm volatile("s_waitcnt vmcnt(0)" ::: "memory");
        } else {
            XB_SPIN(xb_ld(&bar[XB_XGEN(bx_)]) == gen, bar);
            __builtin_amdgcn_fence(__ATOMIC_ACQUIRE, "agent");
            asm volatile("s_waitcnt vmcnt(0)" ::: "memory");
        }
    }
    __syncthreads();
}
__device__ const float INV_FREQ[32] = {
    1.0f, 0.74989420933f, 0.56234132519f, 0.42169650343f, 0.31622776602f, 0.23713737057f, 0.17782794100f, 0.13335214322f,
    0.1f, 0.074989420933f, 0.056234132519f, 0.042169650343f, 0.031622776602f, 0.023713737057f, 0.017782794100f, 0.013335214322f,
    0.01f, 0.0074989420933f, 0.0056234132519f, 0.0042169650343f, 0.0031622776602f, 0.0023713737057f, 0.0017782794100f, 0.0013335214322f,
    0.001f, 0.00074989420933f, 0.00056234132519f, 0.00042169650343f, 0.00031622776602f, 0.00023713737057f, 0.00017782794100f, 0.00013335214322f };

__device__ __forceinline__ float wave_sum(float v) {
#pragma unroll
    for (int o = 1; o < 64; o <<= 1) v += __shfl_xor(v, o);
    return v;
}
__device__ __forceinline__ float half_sum(float v) {
#pragma unroll
    for (int o = 1; o < 32; o <<= 1) v += __shfl_xor(v, o);
    return v;
}
__device__ __forceinline__ float dot4(f32x4 a, f32x4 b) { return (a.x * b.x + a.y * b.y) + (a.z * b.z + a.w * b.w); }
__device__ __forceinline__ float bf2f(unsigned short v) { return __uint_as_float((unsigned)v << 16); }
typedef unsigned u32x2 __attribute__((ext_vector_type(2)));
__device__ __forceinline__ f32x4 bf4_to_f(u32x2 w) { return (f32x4){__uint_as_float(w.x << 16), __uint_as_float(w.x & 0xffff0000u), __uint_as_float(w.y << 16), __uint_as_float(w.y & 0xffff0000u)}; }
__device__ __forceinline__ u32x2 f_to_bf4(f32x4 v) { u32x2 w; w.x = pk2(v.x, v.y); w.y = pk2(v.z, v.w); return w; }
__device__ __forceinline__ float sigm_f(float v) { return 1.0f / (1.0f + __expf(-v)); }

__device__ __forceinline__ void transpose_item(const float* W, int K, int N, bf16* WT, int dest_row0, int k0, int n0, LAS float* scr, int lane) {
#pragma unroll 8
    for (int i = 0; i < 32; ++i) { const int kk = 2 * i + (lane >> 5); scr[kk * 33 + (lane & 31)] = W[(size_t)(k0 + kk) * N + n0 + (lane & 31)]; }
    LDS_WAIT(); asm volatile("" ::: "memory");
    const int c = lane & 7;
#pragma unroll
    for (int j = 0; j < 4; ++j) { const int n = (lane >> 3) + 8 * j; const LAS float* s = scr + (8 * c) * 33 + n;
        v4u o; o.x = pk2(s[0 * 33], s[1 * 33]); o.y = pk2(s[2 * 33], s[3 * 33]); o.z = pk2(s[4 * 33], s[5 * 33]); o.w = pk2(s[6 * 33], s[7 * 33]);
        *(v4u*)(WT + (size_t)(dest_row0 + n) * K + k0 + 8 * c) = o; }
    LDS_WAIT(); asm volatile("" ::: "memory");
}
template <int MAP> __device__ __forceinline__ int dest_row(int n0) {
    if (MAP == 1) { const int sec = n0 >> 10; if (sec == 2 || sec == 3) { const int tile = n0 >> 8, w = n0 & 255; return tile * 256 + ((w & 63) >> 5) * 128 + (w >> 6) * 32; } return n0; }
    if (MAP == 2) return (n0 >> 7) * 256 + (n0 & 127);
    if (MAP == 3) return (n0 >> 7) * 256 + 128 + (n0 & 127);
    return n0;
}
template <int MAP> __device__ __forceinline__ void transpose_matrix(const float* W, int K, int N, bf16* WT, int row_off, LAS float* scr, int lane, int gw, int ngw, int& rot) {
    const int nblk = N / 32, nitems = (K / 64) * nblk;
    int it = gw - rot; if (it < 0) it += ngw;
    for (; it < nitems; it += ngw) { const int kb = it / nblk, nb = it % nblk; transpose_item(W, K, N, WT, row_off + dest_row<MAP>(32 * nb), 64 * kb, 32 * nb, scr, lane); }
    rot = (rot + nitems) % ngw;
}

__device__ __forceinline__ void row_post_pre(const f32x4 (&f)[4], const float* xin, float* xout, const float* gpost, const float* gpre, bf16* hrow, int lane, f32x4 (&hn)[4]) {
    float s = 0.f;
#pragma unroll
    for (int j = 0; j < 4; ++j) s += dot4(f[j], f[j]);
    const float rs = rsqrtf(wave_sum(s) * (1.f / D) + EPS);
    f32x4 xv[4]; float s2 = 0.f;
#pragma unroll
    for (int j = 0; j < 4; ++j) { xv[j] = ((const f32x4*)xin)[lane + 64 * j] + f[j] * rs * ((const f32x4*)gpost)[lane + 64 * j]; ((f32x4*)xout)[lane + 64 * j] = xv[j]; s2 += dot4(xv[j], xv[j]); }
    if (gpre) {
        const float rs2 = rsqrtf(wave_sum(s2) * (1.f / D) + EPS);
#pragma unroll
        for (int j = 0; j < 4; ++j) { hn[j] = xv[j] * rs2 * ((const f32x4*)gpre)[lane + 64 * j]; ((u32x2*)hrow)[lane + 64 * j] = f_to_bf4(hn[j]); }
    }
}
struct Args { const void* in[26]; float* out; unsigned char* ws; int ph_lo, ph_hi; };
enum { I_X = 0, I_P, I_POS, I_NORMG, I_WIN, I_CONVW, I_CONVB, I_LWA, I_LBA, I_LWX, I_LBX, I_LLAM, I_DLAM, I_SUBG, I_WPA, I_WPB, I_WOUT, I_FG, I_FU, I_FD, I_RW, I_MG, I_MU, I_MD, I_PWP, I_PWG };

constexpr int PO_NORMG = 0, PO_CONVW = PO_NORMG + DEPTH * 6 * D, PO_CONVB = PO_CONVW + DEPTH * 4 * D, PO_LBA = PO_CONVB + DEPTH * D, PO_LBX = PO_LBA + DEPTH * D, PO_LLAM = PO_LBX + DEPTH * D,
              PO_DLAM = PO_LLAM + DEPTH * D, PO_SUBG = PO_DLAM + DEPTH * 256, PO_RW = PO_SUBG + DEPTH * 128, PO_END = PO_RW + D * NEXP;
static_assert((size_t)PO_END * 4 <= 512 * 1024, "parameter block");
__device__ __forceinline__ void p0_prologue(const Args& A, LAS unsigned char* lds, int vcu, int G) {
    int tid_ = threadIdx.x; asm volatile("" : "+v"(tid_)); const int tid = tid_, lane = tid & 63, wave = __builtin_amdgcn_readfirstlane(tid >> 6); (void)tid; (void)lane; (void)wave;
    unsigned char* ws = A.ws;
    LAS float* scr = (LAS float*)(lds + RING_OFF + wave * 16384);
    const int gw = vcu * NWAVES + wave, ngw = G * NWAVES;
    int rot = 0;
    for (int l = 0; l < DEPTH; ++l) {
        unsigned char* wl = ws + WS_WSMALL + (size_t)l * WL_STRIDE;
        transpose_matrix<1>((const float*)A.in[I_WIN] + (size_t)l * D * DIN, D, DIN, (bf16*)(wl + WL_WIN), 0, scr, lane, gw, ngw, rot);
        transpose_matrix<0>((const float*)A.in[I_WPA] + (size_t)l * D * D, D, D, (bf16*)(wl + WL_WAB), 0, scr, lane, gw, ngw, rot);
        transpose_matrix<0>((const float*)A.in[I_WPB] + (size_t)l * D * D, D, D, (bf16*)(wl + WL_WAB), D, scr, lane, gw, ngw, rot);
        transpose_matrix<0>((const float*)A.in[I_WOUT] + (size_t)l * D * D, D, D, (bf16*)(wl + WL_WO), 0, scr, lane, gw, ngw, rot);
        transpose_matrix<0>((const float*)A.in[I_PWG] + (size_t)l * D * D, D, D, (bf16*)(wl + WL_WPG), 0, scr, lane, gw, ngw, rot);
        transpose_matrix<0>((const float*)A.in[I_PWP] + (size_t)l * PLE * D, PLE, D, (bf16*)(wl + WL_WPP), 0, scr, lane, gw, ngw, rot);
    }
    transpose_matrix<2>((const float*)A.in[I_FG], D, FF, (bf16*)(ws + WS_WGU), 0, scr, lane, gw, ngw, rot);
    transpose_matrix<3>((const float*)A.in[I_FU], D, FF, (bf16*)(ws + WS_WGU), 0, scr, lane, gw, ngw, rot);
    transpose_matrix<0>((const float*)A.in[I_FD], FF, D, (bf16*)(ws + WS_WD), 0, scr, lane, gw, ngw, rot);
    const int gt = gw * 64 + lane, ngt = ngw * 64;
    { const int* pos = (const int*)A.in[I_POS]; float* cs = (float*)(ws + WS_COS); float* sn = (float*)(ws + WS_SIN);
      for (int i = gt; i < T * 32; i += ngt) { const int r = i >> 5, d = i & 31; const float ang = (float)pos[r] * INV_FREQ[d];
          double rev = (double)ang * 0.15915494309189535; rev -= floor(rev); const float fr = (float)rev;
          cs[i] = __builtin_amdgcn_cosf(fr); sn[i] = __builtin_amdgcn_sinf(fr); } }
    { const f32x4* p = (const f32x4*)A.in[I_P]; u32x2* pb = (u32x2*)(ws + WS_PB);
      for (int i = gt; i < DEPTH * T * PLE / 4; i += ngt) pb[i] = f_to_bf4(p[i]); }
    { bf16* lw = (bf16*)(ws + WS_LRUW);
      for (int i = gt; i < DEPTH * 16 * 2 * 4096; i += ngt) { const int c = i & 63, d = (i >> 6) & 63, g = (i >> 12) & 1, n = (i >> 13) & 15, l = i >> 17;
          const float* src = (const float*)A.in[g ? I_LWX : I_LWA]; lw[i] = (bf16)f2bf(src[((size_t)(l * 16 + n) * 64 + c) * 64 + d]); } }
    { const float* g0 = (const float*)A.in[I_NORMG];
      for (int m = gw; m < T; m += ngw) { const f32x4* xr = (const f32x4*)((const float*)A.in[I_X] + (size_t)m * D); f32x4 v[4]; float s = 0.f;
#pragma unroll
          for (int j = 0; j < 4; ++j) { v[j] = xr[lane + 64 * j]; s += dot4(v[j], v[j]); }
          const float rs = rsqrtf(wave_sum(s) * (1.f / D) + EPS);
#pragma unroll
          for (int j = 0; j < 4; ++j) { ((f32x4*)(A.out + (size_t)m * D))[lane + 64 * j] = v[j]; ((u32x2*)(ws + WS_H + (size_t)m * D * 2))[lane + 64 * j] = f_to_bf4(v[j] * rs * ((const f32x4*)g0)[lane + 64 * j]); } } }
    { float* par = (float*)(ws + WS_PAR);
      const int srcs[9] = {I_NORMG, I_CONVW, I_CONVB, I_LBA, I_LBX, I_LLAM, I_DLAM, I_SUBG, I_RW};
      const int offs[10] = {PO_NORMG, PO_CONVW, PO_CONVB, PO_LBA, PO_LBX, PO_LLAM, PO_DLAM, PO_SUBG, PO_RW, PO_END};
#pragma unroll
      for (int k = 0; k < 9; ++k) { const float* src = (const float*)A.in[srcs[k]]; const int n = offs[k + 1] - offs[k];
          for (int i = gt; i < n; i += ngt) par[offs[k] + i] = src[i]; } }
}

__device__ __forceinline__ void lru_pass1(unsigned char* ws, LAS unsigned char* lds, int layer, int chunk) {
    int tid_ = threadIdx.x; asm volatile("" : "+v"(tid_)); const int tid = tid_, lane = tid & 63, wave = __builtin_amdgcn_readfirstlane(tid >> 6); (void)tid; (void)lane; (void)wave;
    typedef float f32x16 __attribute__((ext_vector_type(16)));
    const float* par = (const float*)(ws + WS_PAR);
    const int b = chunk >> 6, t0 = (chunk & 63) * 64; const size_t g0 = (size_t)b * SEQ + t0;
    LAS unsigned char* wl = lds + RING_OFF + wave * 16384;
    LAS bf16* U = (LAS bf16*)wl;
    LAS float* Gs = (LAS float*)(wl + 4608);
    const bf16* RIN = (const bf16*)(ws + WS_RIN); bf16* HL = (bf16*)(ws + WS_HL); bf16* LP = (bf16*)(ws + WS_LP);
    const int r32 = lane & 31, hi = lane >> 5;
    for (int nb = 0; nb < 2; ++nb) {
        const int n = 2 * wave + nb, ch = 64 * n + lane;
        const float* cw = par + PO_CONVW + (size_t)layer * 4 * D;
        const float cw0 = cw[ch], cw1 = cw[D + ch], cw2 = cw[2 * D + ch], cw3 = cw[3 * D + ch], cb = par[PO_CONVB + layer * D + ch];
        const float ba = par[PO_LBA + layer * D + ch], bx = par[PO_LBX + layer * D + ch];
        const float lam = par[PO_LLAM + layer * D + ch];
        const float c8sp = -8.0f * log1pf(__expf(-lam));
        const bf16* lw = (const bf16*)(ws + WS_LRUW) + (size_t)((layer * 16 + n) * 2) * 4096;
        float h = 0.f, lpc = 0.f, xm3 = 0.f, xm2 = 0.f, xm1 = 0.f;
        if (t0 > 0) { xm3 = bf2f(RIN[(g0 - 3) * D + ch]); xm2 = bf2f(RIN[(g0 - 2) * D + ch]); xm1 = bf2f(RIN[(g0 - 1) * D + ch]); }
        for (int tg = 0; tg < 2; ++tg) {
            const size_t gr = g0 + tg * 32;
            float u[32];
#pragma unroll
            for (int t = 0; t < 32; ++t) { const float x = bf2f(RIN[(gr + t) * D + ch]); u[t] = cb + cw0 * xm3 + cw1 * xm2 + cw2 * xm1 + cw3 * x; xm3 = xm2; xm2 = xm1; xm1 = x; U[t * 72 + lane] = (bf16)f2bf(u[t]); }
            LDS_WAIT();
            float gp[2][32];
#pragma unroll
            for (int g = 0; g < 2; ++g) {
                f32x16 c0 = {}, c1 = {};
#pragma unroll
                for (int ks = 0; ks < 4; ++ks) { const bf16x8 a = *(const LAS bf16x8*)(U + r32 * 72 + 16 * ks + 8 * hi);
                    const bf16x8 w0 = *(const bf16x8*)(lw + (size_t)g * 4096 + r32 * 64 + 16 * ks + 8 * hi), w1 = *(const bf16x8*)(lw + (size_t)g * 4096 + (32 + r32) * 64 + 16 * ks + 8 * hi);
                    c0 = __builtin_amdgcn_mfma_f32_32x32x16_bf16(a, w0, c0, 0, 0, 0); c1 = __builtin_amdgcn_mfma_f32_32x32x16_bf16(a, w1, c1, 0, 0, 0); }
#pragma unroll
                for (int r = 0; r < 16; ++r) { const int row = (r & 3) + 8 * (r >> 2) + 4 * hi; Gs[row * 64 + r32] = c0[r]; Gs[row * 64 + 32 + r32] = c1[r]; }
                LDS_WAIT();
#pragma unroll
                for (int t = 0; t < 32; ++t) gp[g][t] = Gs[t * 64 + lane];
                LDS_WAIT();
            }
            LAS bf16* S2 = (LAS bf16*)Gs;
#pragma unroll
            for (int t = 0; t < 32; ++t) { const float rr = sigm_f(gp[0][t] + ba), ii = sigm_f(gp[1][t] + bx), la = c8sp * rr, a = __expf(la);
                const float bb = sqrtf(fmaxf(0.f, 1.0f - __expf(2.0f * la))) * ii * u[t];
                h = a * h + bb; lpc += la; U[t * 72 + lane] = (bf16)f2bf(h); S2[t * 72 + lane] = (bf16)f2bf(lpc); }
            LDS_WAIT();
#pragma unroll
            for (int i = 0; i < 4; ++i) { const int row = i * 8 + (lane >> 3), cc = lane & 7;
                const v4u a = *(const LAS v4u*)(U + row * 72 + cc * 8), c = *(const LAS v4u*)(S2 + row * 72 + cc * 8);
                *(v4u*)(HL + (gr + row) * D + 64 * n + cc * 8) = a; *(v4u*)(LP + (gr + row) * D + 64 * n + cc * 8) = c; }
            LDS_WAIT();
        }
        float* sum = (float*)(ws + WS_SUM) + (size_t)chunk * 2 * D;
        sum[ch] = lpc; sum[D + ch] = h;
    }
}

__device__ __forceinline__ void tp_mix(unsigned char* ws, LAS unsigned char* lds, int layer, int chunk) {
    int tid_ = threadIdx.x; asm volatile("" : "+v"(tid_)); const int tid = tid_, lane = tid & 63, wave = __builtin_amdgcn_readfirstlane(tid >> 6); (void)tid; (void)lane; (void)wave;
    const float* par = (const float*)(ws + WS_PAR);
    LAS float* carry = (LAS float*)(lds + RING_OFF);
    { const float* sum = (const float*)(ws + WS_SUM);
      for (int ch = tid; ch < D; ch += NWAVES * 64) { float c = 0.f;
          for (int cc = chunk & ~63; cc < chunk; ++cc) c = __expf(sum[(size_t)cc * 2 * D + ch]) * c + sum[(size_t)cc * 2 * D + D + ch];
          carry[ch] = c; } }
    __syncthreads();
    const float* dl = par + PO_DLAM + layer * 256;
    const float lam_init = 0.8f - 0.6f * expf(-0.3f * (float)layer);
    const float lamv = expf(wave_sum(dl[lane] * dl[64 + lane])) - expf(wave_sum(dl[128 + lane] * dl[192 + lane])) + lam_init;
    const f32x4 gsub = ((const f32x4*)(par + PO_SUBG + layer * 128))[lane & 31] * (1.0f - lam_init);
    const int b = chunk >> 6, t0 = (chunk & 63) * 64; const size_t g0 = (size_t)b * SEQ + t0;
    for (int rr = wave; rr < 64; rr += NWAVES) { const size_t row = g0 + rr;
        const u32x2* hl = (const u32x2*)(ws + WS_HL + row * D * 2); const u32x2* lp = (const u32x2*)(ws + WS_LP + row * D * 2); const u32x2* gg = (const u32x2*)(ws + WS_GG + row * D * 2);
        const u32x2* o1 = (const u32x2*)(ws + WS_O1 + row * D * 2); const u32x2* o2 = (const u32x2*)(ws + WS_O2 + row * D * 2);
        u32x2* ya = (u32x2*)(ws + WS_YA + row * D * 2); u32x2* yb = (u32x2*)(ws + WS_YB + row * D * 2);
#pragma unroll
        for (int j = 0; j < 4; ++j) { const f32x4 h = bf4_to_f(hl[lane + 64 * j]), l = bf4_to_f(lp[lane + 64 * j]), g = bf4_to_f(gg[lane + 64 * j]); const f32x4 c = ((const LAS f32x4*)carry)[lane + 64 * j];
            const f32x4 e = {__expf(l.x), __expf(l.y), __expf(l.z), __expf(l.w)};
            ya[lane + 64 * j] = f_to_bf4((h + e * c) * g);
            const f32x4 o = bf4_to_f(o1[lane + 64 * j]) - bf4_to_f(o2[lane + 64 * j]) * lamv;
            const float rs = rsqrtf(half_sum(dot4(o, o)) * (1.f / 128.f) + EPS);
            yb[lane + 64 * j] = f_to_bf4(o * rs * gsub); }
    }
    __syncthreads();
}

template <int SRC, bool ROUTE> __device__ __forceinline__ void tp_post_pre(unsigned char* ws, float* xres, LAS unsigned char* lds, const float* gpost, const float* gpre, int vcu, int G) {
    int tid_ = threadIdx.x; asm volatile("" : "+v"(tid_)); const int tid = tid_, lane = tid & 63, wave = __builtin_amdgcn_readfirstlane(tid >> 6); (void)tid; (void)lane; (void)wave;
    gu32* ctl = (gu32*)(ws + WS_CTL);
    LAS float* rwT = (LAS float*)(lds + RING_OFF);
    int ps[NEXP];
    if (ROUTE) { const float* rw = (const float*)(ws + WS_PAR) + PO_RW; for (int i = tid; i < D * NEXP; i += NWAVES * 64) rwT[(i & 7) * D + (i >> 3)] = rw[i]; __syncthreads(); }
    if (SRC == 1) { int acc = 0;
#pragma unroll
        for (int e = 0; e < NEXP; ++e) { ps[e] = acc; acc += ((int)__hip_atomic_load(ctl + CW_CNT + 64 * e, RLX_AGENT) + 255) >> 8; } }
    const int gw = vcu * NWAVES + wave, ngw = G * NWAVES;
    for (int m = gw; m < T; m += ngw) {
        f32x4 f[4], hn[4];
        if (SRC == 0) { const f32x4* fr = (const f32x4*)(ws + WS_F + (size_t)m * D * 4);
#pragma unroll
            for (int j = 0; j < 4; ++j) f[j] = fr[lane + 64 * j];
        } else { const int* ti = (const int*)(ws + WS_TOK) + (size_t)m * 8; const int e0 = ti[0], p0 = ti[1], e1 = ti[2], p1 = ti[3]; const float w0 = __int_as_float(ti[4]), w1 = __int_as_float(ti[5]);
            int s0 = 0, s1 = 0;
#pragma unroll
            for (int e = 0; e < NEXP; ++e) { if (e == e0) s0 = ps[e]; if (e == e1) s1 = ps[e]; }
            const u32x2* a = (const u32x2*)(ws + WS_HG + ((size_t)s0 * 256 + p0) * D * 2); const u32x2* c = (const u32x2*)(ws + WS_HG + ((size_t)s1 * 256 + p1) * D * 2);
#pragma unroll
            for (int j = 0; j < 4; ++j) f[j] = bf4_to_f(a[lane + 64 * j]) * w0 + bf4_to_f(c[lane + 64 * j]) * w1; }
        row_post_pre(f, xres + (size_t)m * D, xres + (size_t)m * D, gpost, gpre, (bf16*)(ws + WS_H + (size_t)m * D * 2), lane, hn);
        if (ROUTE) {
            float lg[NEXP];
#pragma unroll
            for (int e = 0; e < NEXP; ++e) { float s = 0.f;
#pragma unroll
                for (int j = 0; j < 4; ++j) s += dot4(hn[j], ((const LAS f32x4*)(rwT + e * D))[lane + 64 * j]);
                lg[e] = wave_sum(s); }
            int e0 = 0; float v0 = lg[0];
#pragma unroll
            for (int e = 1; e < NEXP; ++e) if (lg[e] > v0) { v0 = lg[e]; e0 = e; }
            int e1 = -1; float v1 = -INFINITY;
#pragma unroll
            for (int e = 0; e < NEXP; ++e) if (e != e0 && lg[e] > v1) { v1 = lg[e]; e1 = e; }
            const float w1 = 1.0f / (1.0f + __expf(v0 - v1)), w0 = 1.0f - w1;
            if (lane == 0) { const int p0 = (int)__hip_atomic_fetch_add(ctl + CW_CNT + 64 * e0, 1u, RLX_AGENT), p1 = (int)__hip_atomic_fetch_add(ctl + CW_CNT + 64 * e1, 1u, RLX_AGENT);
                int* lst = (int*)(ws + WS_LIST); lst[e0 * T + p0] = m; lst[e1 * T + p1] = m;
                int* ti = (int*)(ws + WS_TOK) + (size_t)m * 8; ti[0] = e0; ti[1] = p0; ti[2] = e1; ti[3] = p1; ti[4] = __float_as_int(w0); ti[5] = __float_as_int(w1); }
        }
    }
    if (ROUTE) __syncthreads();
}

__device__ __forceinline__ void pm0_moe_setup(unsigned char* ws, const float* mg, const float* mu, const float* md, LAS unsigned char* lds, int vcu, int G) {
    int tid_ = threadIdx.x; asm volatile("" : "+v"(tid_)); const int tid = tid_, lane = tid & 63, wave = __builtin_amdgcn_readfirstlane(tid >> 6); (void)tid; (void)lane; (void)wave;
    gu32* ctl = (gu32*)(ws + WS_CTL);
    LAS float* scr = (LAS float*)(lds + RING_OFF + wave * 16384);
    const int gw = vcu * NWAVES + wave, ngw = G * NWAVES;
    int cs[NEXP + 1], ps[NEXP]; { int a = 0, p = 0;
#pragma unroll
        for (int e = 0; e < NEXP; ++e) { const int c = (int)__hip_atomic_load(ctl + CW_CNT + 64 * e, RLX_AGENT); cs[e] = a; ps[e] = p; a += c; p += (c + 255) >> 8; } cs[NEXP] = a; }
    const int* lst = (const int*)(ws + WS_LIST);
    for (int i = gw; i < cs[NEXP]; i += ngw) { int e = 0, base = 0, pst = 0;
#pragma unroll
        for (int k = 0; k < NEXP; ++k) if (i >= cs[k]) { e = k; base = cs[k]; pst = ps[k]; }
        const int pos = i - base, tok = lst[e * T + pos];
        const v4u* src = (const v4u*)(ws + WS_H + (size_t)tok * D * 2); v4u* dst = (v4u*)(ws + WS_HG + ((size_t)pst * 256 + pos) * D * 2);
        dst[lane] = src[lane]; dst[lane + 64] = src[lane + 64]; }
    int rot = 0;
    for (int e = 0; e < NEXP; ++e) {
        transpose_matrix<2>(mg + (size_t)e * D * FF, D, FF, (bf16*)(ws + WS_WMGU), e * 2 * FF, scr, lane, gw, ngw, rot);
        transpose_matrix<3>(mu + (size_t)e * D * FF, D, FF, (bf16*)(ws + WS_WMGU), e * 2 * FF, scr, lane, gw, ngw, rot);
        transpose_matrix<0>(md + (size_t)e * FF * D, FF, D, (bf16*)(ws + WS_WMD), e * D, scr, lane, gw, ngw, rot);
    }
}
constexpr int NPH_L = 14, NPHASES = 1 + DEPTH * NPH_L;
__host__ __device__ constexpr bool phase_exists(int ph) { return ph == 0 || !(((ph - 1) / NPH_L) % 2 == 0 && (((ph - 1) % NPH_L) == 6 || ((ph - 1) % NPH_L) == 9 || ((ph - 1) % NPH_L) == 10)); }

__global__ void __launch_bounds__(NWAVES * 64, 2) mk_fwd(Args args) {
    extern __shared__ __attribute__((aligned(16))) unsigned char lds_raw[];
    LAS unsigned char* lds = (LAS unsigned char*)lds_raw;
    volatile LAS unsigned* MISC = (volatile LAS unsigned*)(lds + MISC_OFF);
    const int tid = threadIdx.x;
    const int G = gridDim.x; const int bx = blockIdx.x; const int vcu = (G % 8 == 0) ? (bx % 8) * (G / 8) + bx / 8 : bx;
    for (int u = tid; u < (LDS_BYTES - LDSCTL_OFF) / 4; u += NWAVES * 64) ((LAS unsigned*)(lds + LDSCTL_OFF))[u] = 0u;
    __syncthreads();
    XcdBarrier bar; bar.bar = (unsigned*)(args.ws + WS_CTL) + CW_BAR; bar.x = 0; bar.st = nullptr;
    if (!MK_MULTI) bar = xcd_barrier_post((unsigned*)(args.ws + WS_CTL) + CW_BAR, MISC + 8);
    const int lo = args.ph_lo, hi = args.ph_hi;
#ifndef DIS
#define DIS 0
#endif
#define EN(b) (!((DIS >> (b)) & 1))
#define IN(k) (lo <= (k) && (k) < hi)
#define PH_WS unsigned char* ws = args.ws; asm volatile("" : "+s"(ws)); (void)ws
#define SEAM(k) do { if ((k) + 1 < hi) { if (MK_MULTI) { if (tid == 0) __hip_atomic_store((gu32*)(ws + WS_CTL) + CW_TMO, 0xBADBA0u, RLX_AGENT); } else xcd_barrier(bar); } } while (0)

    if (EN(0) && IN(0)) { PH_WS; p0_prologue(args, lds, vcu, G); SEAM(0); }

    for (int l = 0; l < DEPTH; ++l) {
        const int pb = 1 + NPH_L * l;
        if (EN(1) && IN(pb + 0)) { PH_WS; unsigned char* wl = ws + WS_WSMALL + (size_t)l * WL_STRIDE;
            pg8::Gemm g{(const pg8::bf16_t*)(ws + WS_H), (const pg8::bf16_t*)(wl + WL_WIN), T, DIN, D}; pg8::StaticOrder S; S.init(T, DIN, G, bx);
            pg8::EpiInProj E{(pg8::bf16_t*)(ws + WS_BIG), SLOT / 2, (const float*)(ws + WS_COS), (const float*)(ws + WS_SIN), attn_body::C2};
            pg8::gemm_phase<pg8::EpiInProj, pg8::StaticOrder, true, true>(lds + RING_OFF, g, S, E);
            SEAM(pb + 0);
        }
        if (EN(2) && IN(pb + 1)) { PH_WS;
#ifndef NO_LRU
            for (int c = bx; c < 256; c += G) lru_pass1(ws, lds, l, c);
            __syncthreads();
#endif
#ifndef NO_ATT
            const attn_body::AttnTensors AT{(const attn_body::bf16*)(ws + WS_Q), (const attn_body::bf16*)(ws + WS_K), (const attn_body::bf16*)(ws + WS_V), (attn_body::bf16*)(ws + WS_O1), (attn_body::bf16*)(ws + WS_O2)};
            attn_body::attn_phase<8>((char*)lds_raw + RING_OFF, AT, vcu, G);
#endif
            SEAM(pb + 1);
        }
        if (EN(3) && IN(pb + 2)) { PH_WS; for (int c = bx; c < 256; c += G) tp_mix(ws, lds, l, c); SEAM(pb + 2); }
        if (EN(4) && IN(pb + 3)) { PH_WS; unsigned char* wl = ws + WS_WSMALL + (size_t)l * WL_STRIDE;
            pg8::Gemm g{(const pg8::bf16_t*)(ws + WS_YA), (const pg8::bf16_t*)(wl + WL_WAB), T, D, D}; pg8::PairOrder S; S.base.init(T, D, G, bx);
            pg8::EpiMerge E{(const pg8::bf16_t*)(ws + WS_SGA), (const pg8::bf16_t*)(ws + WS_SGB), (float*)(ws + WS_T1), (pg8::bf16_t*)(ws + WS_MERGED), NPAN};
            pg8::gemm_phase<pg8::EpiMerge, pg8::PairOrder, true, true>(lds + RING_OFF, g, S, E);
            SEAM(pb + 3);
        }
        if (EN(5) && IN(pb + 4)) { PH_WS; unsigned char* wl = ws + WS_WSMALL + (size_t)l * WL_STRIDE;
            pg8::Gemm g{(const pg8::bf16_t*)(ws + WS_MERGED), (const pg8::bf16_t*)(wl + WL_WO), T, D, D}; pg8::StaticOrder S; S.init(T, D, G, bx);
            pg8::EpiF32 E{(float*)(ws + WS_F), D};
            pg8::gemm_phase<pg8::EpiF32, pg8::StaticOrder, false, true>(lds + RING_OFF, g, S, E);
            SEAM(pb + 4);
        }
        if (EN(6) && IN(pb + 5)) { PH_WS; const float* ng = (const float*)(ws + WS_PAR) + PO_NORMG + (size_t)l * 6 * D;
            if (l & 1) tp_post_pre<0, true>(ws, args.out, lds, ng + 1 * D, ng + 2 * D, vcu, G);
            else tp_post_pre<0, false>(ws, args.out, lds, ng + 1 * D, ng + 2 * D, vcu, G);
            SEAM(pb + 5);
        }
        if (!(l & 1)) {
            if (EN(7) && IN(pb + 7)) { PH_WS;
                pg8::Gemm g{(const pg8::bf16_t*)(ws + WS_H), (const pg8::bf16_t*)(ws + WS_WGU), T, 2 * FF, D}; pg8::StaticOrder S; S.init(T, 2 * FF, G, bx);
                pg8::EpiSwiGLU E{(pg8::bf16_t*)(ws + WS_ACT), FF, 2 * FF / 256, 0};
                pg8::gemm_phase<pg8::EpiSwiGLU, pg8::StaticOrder, true, true>(lds + RING_OFF, g, S, E);
                SEAM(pb + 7);
            }
            if (EN(8) && IN(pb + 8)) { PH_WS;
                pg8::Gemm g{(const pg8::bf16_t*)(ws + WS_ACT), (const pg8::bf16_t*)(ws + WS_WD), T, D, FF}; pg8::StaticOrder S; S.init(T, D, G, bx);
                pg8::EpiF32 E{(float*)(ws + WS_F), D};
                pg8::gemm_phase<pg8::EpiF32, pg8::StaticOrder, false, true>(lds + RING_OFF, g, S, E);
                SEAM(pb + 8);
            }
            if (EN(9) && IN(pb + 11)) { PH_WS; const float* ng = (const float*)(ws + WS_PAR) + PO_NORMG + (size_t)l * 6 * D;
                tp_post_pre<0, false>(ws, args.out, lds, ng + 3 * D, ng + 4 * D, vcu, G); SEAM(pb + 11); }
        } else {
            if (EN(10) && IN(pb + 6)) { PH_WS; pm0_moe_setup(ws, (const float*)args.in[I_MG], (const float*)args.in[I_MU], (const float*)args.in[I_MD], lds, vcu, G); SEAM(pb + 6); }
            for (int rd = 0; rd < 2; ++rd) {
                if (EN(11) && IN(pb + 7 + 2 * rd)) { PH_WS; gu32* ctl = (gu32*)(ws + WS_CTL);
                    int ps[NEXP + 1]; { int p = 0;
#pragma unroll
                        for (int e = 0; e < NEXP; ++e) { ps[e] = p; p += ((int)__hip_atomic_load(ctl + CW_CNT + 64 * e, RLX_AGENT) + 255) >> 8; } ps[NEXP] = p; }
                    const int np = ps[NEXP], plo = rd ? (np + 1) / 2 : 0, phi = rd ? np : (np + 1) / 2;
                    pg8::Gemm g{(const pg8::bf16_t*)(ws + WS_HG), (const pg8::bf16_t*)(ws + WS_WMGU), (phi - plo) * 256, 2 * FF, D};
                    pg8::MoeOrder S; S.base.init((phi - plo) * 256, 2 * FF, G, bx); S.plo = plo; S.ps1 = ps[1]; S.ps2 = ps[2]; S.ps3 = ps[3]; S.ps4 = ps[4]; S.ps5 = ps[5]; S.ps6 = ps[6]; S.ps7 = ps[7];
                    pg8::EpiSwiGLU E{(pg8::bf16_t*)(ws + WS_ACTH), FF, 2 * FF / 256, plo};
                    pg8::gemm_phase<pg8::EpiSwiGLU, pg8::MoeOrder, true, true>(lds + RING_OFF, g, S, E);
                    SEAM(pb + 7 + 2 * rd);
                }
                if (EN(12) && IN(pb + 8 + 2 * rd)) { PH_WS; gu32* ctl = (gu32*)(ws + WS_CTL);
                    int ps[NEXP + 1]; { int p = 0;
#pragma unroll
                        for (int e = 0; e < NEXP; ++e) { ps[e] = p; p += ((int)__hip_atomic_load(ctl + CW_CNT + 64 * e, RLX_AGENT) + 255) >> 8; } ps[NEXP] = p; }
                    const int np = ps[NEXP], plo = rd ? (np + 1) / 2 : 0, phi = rd ? np : (np + 1) / 2;
                    pg8::Gemm g{(const pg8::bf16_t*)(ws + WS_ACTH) - (size_t)plo * 256 * FF, (const pg8::bf16_t*)(ws + WS_WMD), (phi - plo) * 256, D, FF};
                    pg8::MoeOrder S; S.base.init((phi - plo) * 256, D, G, bx); S.plo = plo; S.ps1 = ps[1]; S.ps2 = ps[2]; S.ps3 = ps[3]; S.ps4 = ps[4]; S.ps5 = ps[5]; S.ps6 = ps[6]; S.ps7 = ps[7];
                    pg8::EpiPlainBf16 E{(pg8::bf16_t*)(ws + WS_HG), D, 3};
                    pg8::gemm_phase<pg8::EpiPlainBf16, pg8::MoeOrder, true, true>(lds + RING_OFF, g, S, E);
                    SEAM(pb + 8 + 2 * rd);
                }
            }
            if (EN(13) && IN(pb + 11)) { PH_WS; const float* ng = (const float*)(ws + WS_PAR) + PO_NORMG + (size_t)l * 6 * D;
                tp_post_pre<1, false>(ws, args.out, lds, ng + 3 * D, ng + 4 * D, vcu, G); SEAM(pb + 11); }
        }
        if (EN(14) && IN(pb + 12)) { PH_WS; unsigned char* wl = ws + WS_WSMALL + (size_t)l * WL_STRIDE;
            { pg8::Gemm g{(const pg8::bf16_t*)(ws + WS_PB) + (size_t)l * T * PLE, (const pg8::bf16_t*)(wl + WL_WPP), T, D, PLE}; pg8::StaticOrder S; S.init(T, D, G, bx);
              pg8::EpiF32 E{(float*)(ws + WS_PP), D};
              pg8::gemm_phase<pg8::EpiF32, pg8::StaticOrder, false, true>(lds + RING_OFF, g, S, E); }
            __syncthreads();
            { pg8::Gemm g{(const pg8::bf16_t*)(ws + WS_H), (const pg8::bf16_t*)(wl + WL_WPG), T, D, D}; pg8::StaticOrder S; S.init(T, D, G, bx);
              pg8::EpiPleGate E{(float*)(ws + WS_F), (const float*)(ws + WS_PP), D};
              pg8::gemm_phase<pg8::EpiPleGate, pg8::StaticOrder, false, true>(lds + RING_OFF, g, S, E); }
            SEAM(pb + 12);
        }
        if (EN(15) && IN(pb + 13)) { PH_WS; const float* ng = (const float*)(ws + WS_PAR) + PO_NORMG + (size_t)l * 6 * D;
            tp_post_pre<0, false>(ws, args.out, lds, ng + 5 * D, (l + 1 < DEPTH) ? ng + 6 * D : nullptr, vcu, G); SEAM(pb + 13); }
    }
#undef IN
#undef SEAM
#undef PH_WS
}

extern "C" void kernel_launch(void* const* d_in, const int* in_sizes, int n_in, void* d_out, int out_size, void* d_ws, size_t ws_size, hipStream_t stream) {
    static int grid = 0;
    if (grid == 0) {
        if (n_in != 26 || in_sizes[0] != T * D || out_size != T * D || ws_size < WS_END) { fprintf(stderr, "kernel_launch: unexpected shapes / workspace (n_in %d, in0 %d, out %d, ws %zu < %zu); nothing launched\n", n_in, n_in > 0 ? in_sizes[0] : -1, out_size, ws_size, (size_t)WS_END); grid = -1; return; }
        int dev = 0, cus = 0, per_cu = 0;
        if (hipGetDevice(&dev) != hipSuccess || hipDeviceGetAttribute(&cus, hipDeviceAttributeMultiprocessorCount, dev) != hipSuccess) { grid = -1; return; }
        if (hipFuncSetAttribute((const void*)mk_fwd, hipFuncAttributeMaxDynamicSharedMemorySize, LDS_BYTES) != hipSuccess) { fprintf(stderr, "kernel_launch: hipFuncSetAttribute failed\n"); grid = -1; return; }
        if (hipOccupancyMaxActiveBlocksPerMultiprocessor(&per_cu, (const void*)mk_fwd, NWAVES * 64, LDS_BYTES) != hipSuccess || per_cu < 1) { fprintf(stderr, "kernel_launch: occupancy query reports %d workgroups per CU\n", per_cu); (void)hipGetLastError(); grid = -1; return; }
        grid = cus;
    }
    if (grid < 0) return;
    if (hipMemsetAsync((char*)d_ws + WS_CTL, 0, CTL_ZERO_BYTES, stream) != hipSuccess) return;
    Args a{};
    for (int i = 0; i < 26; ++i) a.in[i] = d_in[i];
    a.out = (float*)d_out; a.ws = (unsigned char*)d_ws;
#if MK_MULTI
    for (int ph = 0; ph < NPHASES; ++ph) { if (!phase_exists(ph)) continue; a.ph_lo = ph; a.ph_hi = ph + 1; hipLaunchKernelGGL(mk_fwd, dim3(grid), dim3(NWAVES * 64), LDS_BYTES, stream, a); }
#else
    a.ph_lo = 0; a.ph_hi = NPHASES;
    hipLaunchKernelGGL(mk_fwd, dim3(grid), dim3(NWAVES * 64), LDS_BYTES, stream, a);
#endif
}
```

```cpp
#include <hip/hip_runtime.h>
#include <hip/hip_bf16.h>
#include <cstdio>
#include <cstdint>
#include <cmath>
namespace pg8 {
#define PG8_LAS __attribute__((address_space(3)))
typedef unsigned short bf16_t;
typedef short bf16x8 __attribute__((ext_vector_type(8)));
typedef float f32x4 __attribute__((ext_vector_type(4)));
typedef unsigned u32x4 __attribute__((ext_vector_type(4)));
constexpr int BM = 256, BK = 64, HALF = 128, HTB = HALF * BK * 2  , STAGE_BYTES = 8 * HTB, NXCD = 8, WGM = 8;

__host__ __device__ __forceinline__ int lds_byte(int r, int c) { const int st = (r >> 4) * 2 + (c >> 5), rr = r & 15, cc = c & 31, ob = rr * 64 + cc * 2; return st * 1024 + (ob ^ (((ob >> 9) & 1) << 5)); }
__host__ __device__ __forceinline__ void stage_rc(int b, int& R, int& C) { const int st = b / 1024, sb = b % 1024, swz = sb ^ (((sb >> 9) & 1) << 5); R = (st >> 1) * 16 + swz / 64; C = (st & 1) * 32 + (swz % 64) / 2; }
__host__ __device__ __forceinline__ int perm32(int rho) { const int n = rho >> 4, i = rho & 15; return 8 * (i >> 2) + 4 * n + (i & 3); }

struct Unit { int pm, pn; };
typedef int v4i_t __attribute__((ext_vector_type(4)));
typedef int v8i_t __attribute__((ext_vector_type(8)));
struct Gemm { const bf16_t* A; const bf16_t* Bt; int M, N, K; int sa = 0x7f7f7f7f, sb = 0x7f7f7f7f; };

struct StaticOrder {
    int nM, nN, nwg, G, c;
    __host__ __device__ void init(int M, int N, int G_, int c_) { nM = M / BM; nN = N / BM; nwg = nM * nN; G = G_; c = c_; }
    __host__ __device__ bool next(int i, Unit& u) const {
        const long L = (long)i * G + c; if (L >= nwg) return false;
        int wgid = (int)L; { const int q = nwg / NXCD, r = nwg % NXCD, xcd = wgid % NXCD, off = wgid / NXCD; wgid = (xcd < r ? xcd * (q + 1) : r * (q + 1) + (xcd - r) * q) + off; }
        const int nig = WGM * nN, gid = wgid / nig, fm = gid * WGM, gsz = (nM - fm) < WGM ? (nM - fm) : WGM;
        u.pm = fm + ((wgid % nig) % gsz); u.pn = (wgid % nig) / gsz; return true;
    }
    __device__ __forceinline__ void a_ready(const Unit&) const {}
    __device__ __forceinline__ void done(const Unit&) const {}
};

__device__ __forceinline__ unsigned cvt_pk_bf16(float lo, float hi) { unsigned r; asm volatile("v_cvt_pk_bf16_f32 %0, %1, %2" : "=v"(r) : "v"(lo), "v"(hi)); return r; }
typedef float f32x2 __attribute__((ext_vector_type(2)));
__device__ __forceinline__ f32x2 gelu_pk(f32x2 v) {
    const f32x2 av = __builtin_elementwise_abs(v), d = av * 0.2316418882f + 1.0f;
    f32x2 t; t.x = __builtin_amdgcn_rcpf(d.x); t.y = __builtin_amdgcn_rcpf(d.y);
    f32x2 q = t * 0.5307027145f + (-0.7265760135f); q = q * t + 0.7107068705f; q = q * t + (-0.142248368f); q = q * t + 0.127414796f; q = q * t;
    const f32x2 s = (v * v) * (-0.72134752044f);
    f32x2 e; e.x = __builtin_amdgcn_exp2f(s.x); e.y = __builtin_amdgcn_exp2f(s.y);
    const f32x2 m = v * (q * e), r = v - m;
    f32x2 o; o.x = v.x < 0.f ? m.x : r.x; o.y = v.y < 0.f ? m.y : r.y; return o;
}

typedef unsigned u32x2 __attribute__((ext_vector_type(2)));
#ifndef NT_EPI
#define NT_EPI 0
#endif
#if NT_EPI
#define ST16(p, v) __builtin_nontemporal_store((v), (u32x4*)(p))
#define ST8(p, v) __builtin_nontemporal_store((v), (u32x2*)(p))
#else
#define ST16(p, v) (*(u32x4*)(p) = (v))
#define ST8(p, v) (*(u32x2*)(p) = (v))
#endif
__device__ __forceinline__ float sigm(float v) { return __builtin_amdgcn_rcpf(1.0f + __builtin_amdgcn_exp2f(-1.4426950408889634f * v)); }
__device__ __forceinline__ f32x4 sigm4(f32x4 v) { return (f32x4){sigm(v[0]), sigm(v[1]), sigm(v[2]), sigm(v[3])}; }
__device__ __forceinline__ float gelu_tanh1(float v) { return v * sigm(1.5957691216057308f * v * (1.0f + 0.044715f * v * v)); }
__device__ __forceinline__ f32x4 gelu_tanh4(f32x4 v) { return (f32x4){gelu_tanh1(v[0]), gelu_tanh1(v[1]), gelu_tanh1(v[2]), gelu_tanh1(v[3])}; }
__device__ __forceinline__ u32x4 pack8(f32x4 a, f32x4 b) { u32x4 w; w.x = cvt_pk_bf16(a[0], a[1]); w.y = cvt_pk_bf16(a[2], a[3]); w.z = cvt_pk_bf16(b[0], b[1]); w.w = cvt_pk_bf16(b[2], b[3]); return w; }
__device__ __forceinline__ f32x4 bf_lo4(u32x4 w) { return (f32x4){__uint_as_float(w.x << 16), __uint_as_float(w.x & 0xffff0000u), __uint_as_float(w.y << 16), __uint_as_float(w.y & 0xffff0000u)}; }
__device__ __forceinline__ f32x4 bf_hi4(u32x4 w) { return (f32x4){__uint_as_float(w.z << 16), __uint_as_float(w.z & 0xffff0000u), __uint_as_float(w.w << 16), __uint_as_float(w.w & 0xffff0000u)}; }

struct EpiF32 {
    static constexpr bool PERM = false, AFTER_DRAIN = false;
    float* C; int ldc;
    __device__ __forceinline__ void operator()(const f32x4 (&acc)[2][2][4][2], const Unit& u, int wr, int wc, int fr, int fq) const {
        const int row0 = u.pm * BM + wr * 64 + fr, col0 = u.pn * BM + wc * 32 + 4 * fq;
#pragma unroll
        for (int ai = 0; ai < 2; ++ai)
#pragma unroll
            for (int m = 0; m < 4; ++m) { float* rowp = C + (size_t)(row0 + ai * HALF + m * 16) * ldc + col0;
#pragma unroll
                for (int bj = 0; bj < 2; ++bj)
#pragma unroll
                    for (int n = 0; n < 2; ++n) *(f32x4*)(rowp + bj * HALF + n * 16) = acc[ai][bj][m][n]; }
    }
};

__device__ const float ROPE_REV[32] = {
    0.15915494309f, 0.11934937021f, 0.089499401609f, 0.067115083005f, 0.050329212104f, 0.037741584717f, 0.028302195831f, 0.021223652765f,
    0.015915494309f, 0.011934937021f, 0.0089499401609f, 0.0067115083005f, 0.0050329212104f, 0.0037741584717f, 0.0028302195831f, 0.0021223652765f,
    0.0015915494309f, 0.0011934937021f, 0.00089499401609f, 0.00067115083005f, 0.00050329212104f, 0.00037741584717f, 0.00028302195831f, 0.00021223652765f,
    0.00015915494309f, 0.00011934937021f, 8.9499401609e-05f, 6.7115083005e-05f, 5.0329212104e-05f, 3.7741584717e-05f, 2.8302195831e-05f, 2.1223652765e-05f };
__device__ __forceinline__ f32x4 cos_rev4(f32x4 r) { return (f32x4){__builtin_amdgcn_cosf(__builtin_amdgcn_fractf(r[0])), __builtin_amdgcn_cosf(__builtin_amdgcn_fractf(r[1])), __builtin_amdgcn_cosf(__builtin_amdgcn_fractf(r[2])), __builtin_amdgcn_cosf(__builtin_amdgcn_fractf(r[3]))}; }
__device__ __forceinline__ f32x4 sin_rev4(f32x4 r) { return (f32x4){__builtin_amdgcn_sinf(__builtin_amdgcn_fractf(r[0])), __builtin_amdgcn_sinf(__builtin_amdgcn_fractf(r[1])), __builtin_amdgcn_sinf(__builtin_amdgcn_fractf(r[2])), __builtin_amdgcn_sinf(__builtin_amdgcn_fractf(r[3]))}; }
struct EpiInProj {
    static constexpr bool PERM = true, AFTER_DRAIN = false;
    bf16_t* out; size_t slot_stride; const float* posf; float qscale;
    __device__ __forceinline__ void operator()(const f32x4 (&acc)[2][2][4][2], const Unit& u, int wr, int wc, int fr, int fq) const {
        const int type = u.pn >> 2, sub = u.pn & 3;
        bf16_t* base = out + (size_t)type * slot_stride;
        const int row0 = u.pm * BM + wr * 64 + fr;
        if (type == 2 || type == 3) {
            const float sc = (type == 2) ? qscale : 1.0f;
            const int colb = sub * 256 + wc * 64 + 8 * fq;
            const f32x4 cf0 = *(const f32x4*)(ROPE_REV + 8 * fq), cf1 = *(const f32x4*)(ROPE_REV + 8 * fq + 4);
            float pv[2][4];
#pragma unroll
            for (int ai = 0; ai < 2; ++ai)
#pragma unroll
                for (int m = 0; m < 4; ++m) pv[ai][m] = posf[row0 + ai * HALF + m * 16];
#pragma unroll
            for (int ai = 0; ai < 2; ++ai)
#pragma unroll
                for (int m = 0; m < 4; ++m) { const int r = row0 + ai * HALF + m * 16;
                    const float p = pv[ai][m];
                    const f32x4 r0 = cf0 * p, r1 = cf1 * p;
                    const f32x4 c0 = cos_rev4(r0) * sc, c1 = cos_rev4(r1) * sc, s0 = sin_rev4(r0) * sc, s1 = sin_rev4(r1) * sc;
                    const f32x4 x0a = acc[ai][0][m][0], x0b = acc[ai][0][m][1], x1a = acc[ai][1][m][0], x1b = acc[ai][1][m][1];
                    const f32x4 y0a = x0a * c0 - x1a * s0, y0b = x0b * c1 - x1b * s1, y1a = x1a * c0 + x0a * s0, y1b = x1b * c1 + x0b * s1;
                    bf16_t* rowp = base + (size_t)r * 1024 + colb;
                    ST16(rowp, pack8(y0a, y0b)); ST16(rowp + 32, pack8(y1a, y1b)); }
        } else {
            const int colb = sub * 256 + wc * 64 + 8 * fq;
#pragma unroll
            for (int ai = 0; ai < 2; ++ai)
#pragma unroll
                for (int m = 0; m < 4; ++m) { bf16_t* rowp = base + (size_t)(row0 + ai * HALF + m * 16) * 1024 + colb;
#pragma unroll
                    for (int bj = 0; bj < 2; ++bj) { f32x4 v0 = acc[ai][bj][m][0], v1 = acc[ai][bj][m][1];
                        if (type == 0) { v0 = gelu_tanh4(v0); v1 = gelu_tanh4(v1); }
                        else if (type >= 5) { v0 = sigm4(v0); v1 = sigm4(v1); }
                        ST16(rowp + bj * 32, pack8(v0, v1)); } }
        }
    }
};

struct EpiMerge {
    static constexpr bool PERM = true, AFTER_DRAIN = false;
    const bf16_t* sga; const bf16_t* sgb; bf16_t* t1; bf16_t* merged; int nM;
    __device__ __forceinline__ void operator()(const f32x4 (&acc)[2][2][4][2], const Unit& u, int wr, int wc, int fr, int fq) const {
        const bool sel = u.pm >= nM; const int pm = sel ? u.pm - nM : u.pm, pn = u.pn & 3;
        const bf16_t* sg = sel ? sgb : sga;
        const int row0 = pm * BM + wr * 64 + fr, col0 = pn * BM + wc * 32 + 8 * fq;
#pragma unroll
        for (int ai = 0; ai < 2; ++ai) {
            u32x4 g[4][2], t[4][2];
#pragma unroll
            for (int m = 0; m < 4; ++m)
#pragma unroll
                for (int bj = 0; bj < 2; ++bj) { const size_t off = (size_t)(row0 + ai * HALF + m * 16) * 1024 + col0 + bj * HALF;
                    g[m][bj] = *(const u32x4*)(sg + off); if (sel) t[m][bj] = *(const u32x4*)(t1 + off); }
#pragma unroll
            for (int m = 0; m < 4; ++m)
#pragma unroll
                for (int bj = 0; bj < 2; ++bj) { const size_t off = (size_t)(row0 + ai * HALF + m * 16) * 1024 + col0 + bj * HALF;
                    f32x4 v0 = acc[ai][bj][m][0] * bf_lo4(g[m][bj]), v1 = acc[ai][bj][m][1] * bf_hi4(g[m][bj]);
                    if (!sel) *(u32x4*)(t1 + off) = pack8(v0, v1);
                    else { v0 = v0 + bf_lo4(t[m][bj]); v1 = v1 + bf_hi4(t[m][bj]); *(u32x4*)(merged + off) = pack8(v0, v1); } } }
    }
};

struct EpiSwiGLU {
    static constexpr bool PERM = true, AFTER_DRAIN = false;
    bf16_t* O; int ldc; int nper; int pm_sub;
    __device__ __forceinline__ void operator()(const f32x4 (&acc)[2][2][4][2], const Unit& u, int wr, int wc, int fr, int fq) const {
        const int pn = u.pn % nper;
        const int row0 = (u.pm - pm_sub) * BM + wr * 64 + fr, col0 = pn * HALF + wc * 32 + 8 * fq;
#pragma unroll
        for (int ai = 0; ai < 2; ++ai)
#pragma unroll
            for (int m = 0; m < 4; ++m) { const f32x4 g0 = acc[ai][0][m][0], g1 = acc[ai][0][m][1], u0 = acc[ai][1][m][0], u1 = acc[ai][1][m][1];
                const f32x4 a0 = g0 * sigm4(g0) * u0, a1 = g1 * sigm4(g1) * u1;
                ST16(O + (size_t)(row0 + ai * HALF + m * 16) * ldc + col0, pack8(a0, a1)); }
    }
};

__device__ __forceinline__ unsigned pk4_fp8(f32x4 v) { unsigned w = __builtin_amdgcn_cvt_pk_fp8_f32(v[0], v[1], 0u, false); return __builtin_amdgcn_cvt_pk_fp8_f32(v[2], v[3], w, true); }
__device__ __forceinline__ f32x4 clamp448(f32x4 v) { return (f32x4){__builtin_fminf(__builtin_fmaxf(v[0], -448.f), 448.f), __builtin_fminf(__builtin_fmaxf(v[1], -448.f), 448.f), __builtin_fminf(__builtin_fmaxf(v[2], -448.f), 448.f), __builtin_fminf(__builtin_fmaxf(v[3], -448.f), 448.f)}; }
struct EpiSwiGLU8 {
    static constexpr bool PERM = true, AFTER_DRAIN = false;
    unsigned char* O; int ldc; int nper; int pm_sub; float oscale;
    __device__ __forceinline__ void operator()(const f32x4 (&acc)[2][2][4][2], const Unit& u, int wr, int wc, int fr, int fq) const {
        const int pn = u.pn % nper;
        const int row0 = (u.pm - pm_sub) * BM + wr * 64 + fr, col0 = pn * HALF + wc * 32 + 8 * fq;
#pragma unroll
        for (int ai = 0; ai < 2; ++ai)
#pragma unroll
            for (int m = 0; m < 4; ++m) { const f32x4 g0 = acc[ai][0][m][0], g1 = acc[ai][0][m][1], u0 = acc[ai][1][m][0], u1 = acc[ai][1][m][1];
                const f32x4 a0 = clamp448(g0 * sigm4(g0) * u0 * oscale), a1 = clamp448(g1 * sigm4(g1) * u1 * oscale);
                u32x2 w; w.x = pk4_fp8(a0); w.y = pk4_fp8(a1);
                ST8(O + (size_t)(row0 + ai * HALF + m * 16) * ldc + col0, w); }
    }
};

struct EpiPlainBf16 {
    static constexpr bool PERM = true, AFTER_DRAIN = false;
    bf16_t* O; int ldc; int pn_mask;
    __device__ __forceinline__ void operator()(const f32x4 (&acc)[2][2][4][2], const Unit& u, int wr, int wc, int fr, int fq) const {
        const int row0 = u.pm * BM + wr * 64 + fr, col0 = (u.pn & pn_mask) * BM + wc * 32 + 8 * fq;
#pragma unroll
        for (int ai = 0; ai < 2; ++ai)
#pragma unroll
            for (int m = 0; m < 4; ++m) { bf16_t* rowp = O + (size_t)(row0 + ai * HALF + m * 16) * ldc + col0;
#pragma unroll
                for (int bj = 0; bj < 2; ++bj) ST16(rowp + bj * HALF, pack8(acc[ai][bj][m][0], acc[ai][bj][m][1])); }
    }
};

struct EpiPleGate {
    static constexpr bool PERM = true, AFTER_DRAIN = false;
    bf16_t* O; const bf16_t* PP; int ldc;
    __device__ __forceinline__ void operator()(const f32x4 (&acc)[2][2][4][2], const Unit& u, int wr, int wc, int fr, int fq) const {
        const int row0 = u.pm * BM + wr * 64 + fr, col0 = u.pn * BM + wc * 32 + 8 * fq;
#pragma unroll
        for (int ai = 0; ai < 2; ++ai) {
            u32x4 p[4][2];
#pragma unroll
            for (int m = 0; m < 4; ++m)
#pragma unroll
                for (int bj = 0; bj < 2; ++bj) p[m][bj] = *(const u32x4*)(PP + (size_t)(row0 + ai * HALF + m * 16) * ldc + col0 + bj * HALF);
#pragma unroll
            for (int m = 0; m < 4; ++m)
#pragma unroll
                for (int bj = 0; bj < 2; ++bj) { const size_t ro = (size_t)(row0 + ai * HALF + m * 16) * ldc + col0 + bj * HALF;
                    *(u32x4*)(O + ro) = pack8(sigm4(acc[ai][bj][m][0]) * bf_lo4(p[m][bj]), sigm4(acc[ai][bj][m][1]) * bf_hi4(p[m][bj])); } }
    }
};

struct PairOrder {
    StaticOrder base;
    __device__ __forceinline__ bool next(int i, Unit& u) const { if (!base.next(i >> 1, u)) return false; if (i & 1) { u.pm += base.nM; u.pn += base.nN; } return true; }
    __device__ __forceinline__ void a_ready(const Unit&) const {}
    __device__ __forceinline__ void done(const Unit&) const {}
};
struct MoeOrder {
    StaticOrder base; int plo; int ps1, ps2, ps3, ps4, ps5, ps6, ps7;
    __device__ __forceinline__ bool next(int i, Unit& u) const {
        if (!base.next(i, u)) return false;
        const int p = u.pm + plo;
        const int e = (p >= ps1) + (p >= ps2) + (p >= ps3) + (p >= ps4) + (p >= ps5) + (p >= ps6) + (p >= ps7);
        u.pm = p; u.pn += e * base.nN; return true;
    }
    __device__ __forceinline__ void a_ready(const Unit&) const {}
    __device__ __forceinline__ void done(const Unit&) const {}
};
template <class Epi, class Sched, bool ALIGN_EPI = false, bool SP2 = false, bool F8 = false>
__device__ __forceinline__ void gemm_phase(PG8_LAS unsigned char* lds, const Gemm g, const Sched& S, const Epi& E) {
    int tid_ = threadIdx.x; asm volatile("" : "+v"(tid_));
    const int tid = tid_, wid = __builtin_amdgcn_readfirstlane(tid >> 6), lane = tid & 63, wr = wid >> 2, wc = wid & 3, fr = lane & 15, fq = lane >> 4;
    const int K = g.K, nt = K / BK;
    unsigned voffA[2], voffB[2];
#pragma unroll
    for (int i = 0; i < 2; ++i) { int R, C; stage_rc(tid * 16 + i * 8192, R, C); const int Rb = Epi::PERM ? ((R & ~31) + perm32(R & 31)) : R;
        voffA[i] = (unsigned)(R * K + C) * 2u; voffB[i] = (unsigned)(Rb * K + C) * 2u; }
    const size_t kstep = (size_t)(BK * 2);
    const size_t hstep = (size_t)HALF * K * 2;
    const size_t tstep = 2 * hstep;
    const unsigned ldsw = (unsigned)wid * 1024u;
    const int aoff = lds_byte(wr * 64 + fr, fq * 8), boff = lds_byte(wc * 32 + fr, fq * 8);
#define PG8_SA(b, h) (((b) * 2 + (h)) * HTB)
#define PG8_SB(b, h) ((4 + (b) * 2 + (h)) * HTB)
#define PG8_STAGE(bufoff, gbase, voff) do { _Pragma("unroll") for (int _i = 0; _i < 2; ++_i) \
        __builtin_amdgcn_global_load_lds((const unsigned*)((const char*)(gbase) + (voff)[_i]), (PG8_LAS unsigned*)(lds + (bufoff) + ldsw + _i * 8192), 16, 0, 0); } while (0)
#define PG8_CAT(a, b) __builtin_shufflevector(__builtin_bit_cast(v4i_t, a), __builtin_bit_cast(v4i_t, b), 0, 1, 2, 3, 4, 5, 6, 7)
#define PG8_LDA(dst, b, h) do { _Pragma("unroll") for (int m = 0; m < 4; ++m) { const bf16x8 r0_ = *(const PG8_LAS bf16x8*)(lds + PG8_SA(b, h) + aoff + m * 2048), r1_ = *(const PG8_LAS bf16x8*)(lds + PG8_SA(b, h) + aoff + m * 2048 + 1024); \
        if constexpr (F8) dst##8[m] = PG8_CAT(r0_, r1_); else { dst[m][0] = r0_; dst[m][1] = r1_; } } } while (0)
#define PG8_LDB(dst, b, h) do { _Pragma("unroll") for (int n = 0; n < 2; ++n) { const bf16x8 r0_ = *(const PG8_LAS bf16x8*)(lds + PG8_SB(b, h) + boff + n * 2048), r1_ = *(const PG8_LAS bf16x8*)(lds + PG8_SB(b, h) + boff + n * 2048 + 1024); \
        if constexpr (F8) dst##8[n] = PG8_CAT(r0_, r1_); else { dst[n][0] = r0_; dst[n][1] = r1_; } } } while (0)
#define PG8_MMA(ai, bj, At, Bt) do { __builtin_amdgcn_s_setprio(1); _Pragma("unroll") for (int m = 0; m < 4; ++m) _Pragma("unroll") for (int n = 0; n < 2; ++n) { \
        if constexpr (F8) asm volatile("v_mfma_scale_f32_16x16x128_f8f6f4 %0, %1, %2, %0, %3, %4 op_sel_hi:[0,0,0]" : "+v"(acc[ai][bj][m][n]) : "v"(Bt##8[n]), "v"(At##8[m]), "v"(sbv), "v"(sav));   \
        else { _Pragma("unroll") for (int k = 0; k < 2; ++k) acc[ai][bj][m][n] = __builtin_amdgcn_mfma_f32_16x16x32_bf16(Bt[n][k], At[m][k], acc[ai][bj][m][n], 0, 0, 0); } } \
        __builtin_amdgcn_s_setprio(0); } while (0)
#define PG8_WAIT_V(n) asm volatile("s_waitcnt vmcnt(" #n ")" ::: "memory")
#define PG8_WAIT_L(n) asm volatile("s_waitcnt lgkmcnt(" #n ")" ::: "memory")
#define PG8_BAR __builtin_amdgcn_s_barrier()
#define PG8_SCHED __builtin_amdgcn_sched_barrier(0)
    Unit cur, nxt; int ui = 0;
    if (!S.next(0, cur)) return;
    f32x4 acc[2][2][4][2];
#pragma unroll
    for (int a = 0; a < 2; ++a)
#pragma unroll
        for (int b = 0; b < 2; ++b)
#pragma unroll
            for (int m = 0; m < 4; ++m)
#pragma unroll
                for (int n = 0; n < 2; ++n) acc[a][b][m][n] = (f32x4){0.f, 0.f, 0.f, 0.f};
    bf16x8 At[4][2], B0[2][2], B1[2][2];
    v8i_t At8[4], B08[2], B18[2];
    (void)At; (void)B0; (void)B1; (void)At8; (void)B08; (void)B18;
    const int sav = g.sa, sbv = g.sb; (void)sav; (void)sbv;
    const char* cA = (const char*)g.A + (size_t)cur.pm * tstep; const char* cB = (const char*)g.Bt + (size_t)cur.pn * tstep;
    S.a_ready(cur);
    if constexpr (SP2) {
        PG8_STAGE(PG8_SB(0, 0), cB, voffB); PG8_STAGE(PG8_SB(0, 1), cB + hstep, voffB); PG8_STAGE(PG8_SA(0, 0), cA, voffA); PG8_STAGE(PG8_SA(0, 1), cA + hstep, voffA);
        if (wr == 1) PG8_BAR;
        PG8_WAIT_V(2); PG8_BAR;
        PG8_STAGE(PG8_SB(1, 0), cB + kstep, voffB); PG8_STAGE(PG8_SA(1, 0), cA + kstep, voffA); PG8_STAGE(PG8_SB(1, 1), cB + hstep + kstep, voffB);
        PG8_WAIT_V(6); PG8_BAR;
    } else {
        PG8_STAGE(PG8_SB(0, 0), cB, voffB); PG8_STAGE(PG8_SA(0, 0), cA, voffA); PG8_STAGE(PG8_SB(0, 1), cB + hstep, voffB); PG8_STAGE(PG8_SA(0, 1), cA + hstep, voffA);
        if (wr == 1) PG8_BAR;
        PG8_WAIT_V(4); PG8_BAR;
        PG8_STAGE(PG8_SB(1, 0), cB + kstep, voffB); PG8_STAGE(PG8_SA(1, 0), cA + kstep, voffA); PG8_STAGE(PG8_SB(1, 1), cB + hstep + kstep, voffB);
        PG8_WAIT_V(6); PG8_BAR;
    }
    for (;;) {
        const bool has_next = S.next(ui + 1, nxt);
        const char* nA = has_next ? (const char*)g.A + (size_t)nxt.pm * tstep : cA; const char* nB = has_next ? (const char*)g.Bt + (size_t)nxt.pn * tstep : cB;
        for (int t = 0; t < nt; t += 2) {
            const bool last = (t == nt - 2);
            const char* a1 = cA + (size_t)(t + 1) * kstep;
            const char* a2 = last ? nA : cA + (size_t)(t + 2) * kstep; const char* b2 = last ? nB : cB + (size_t)(t + 2) * kstep;
            const char* a3 = a2 + kstep; const char* b3 = b2 + kstep;
            if (last && has_next) S.a_ready(nxt);
            if constexpr (SP2) {
            PG8_LDB(B0, 0, 0); PG8_LDB(B1, 0, 1); PG8_SCHED; PG8_LDA(At, 0, 0); PG8_STAGE(PG8_SA(1, 1), a1 + hstep, voffA);
            PG8_WAIT_V(8); PG8_WAIT_L(0); PG8_BAR; PG8_MMA(0, 0, At, B0); PG8_MMA(0, 1, At, B1); PG8_BAR; PG8_SCHED;
            PG8_LDA(At, 0, 1); PG8_STAGE(PG8_SB(0, 0), b2, voffB); PG8_STAGE(PG8_SB(0, 1), b2 + hstep, voffB); PG8_STAGE(PG8_SA(0, 0), a2, voffA);
            PG8_WAIT_V(8); PG8_WAIT_L(0); PG8_BAR; PG8_MMA(1, 0, At, B0); PG8_MMA(1, 1, At, B1); PG8_BAR; PG8_SCHED;
            PG8_LDB(B0, 1, 0); PG8_LDB(B1, 1, 1); PG8_SCHED; PG8_LDA(At, 1, 0); PG8_STAGE(PG8_SA(0, 1), a2 + hstep, voffA);
            PG8_WAIT_V(8); PG8_WAIT_L(0); PG8_BAR; PG8_MMA(0, 0, At, B0); PG8_MMA(0, 1, At, B1); PG8_BAR; PG8_SCHED;
            PG8_LDA(At, 1, 1); PG8_STAGE(PG8_SB(1, 0), b3, voffB); PG8_STAGE(PG8_SB(1, 1), b3 + hstep, voffB); PG8_STAGE(PG8_SA(1, 0), a3, voffA);
            PG8_WAIT_V(8); PG8_WAIT_L(0); PG8_BAR; PG8_MMA(1, 0, At, B0); PG8_MMA(1, 1, At, B1); PG8_BAR; PG8_SCHED;
            } else {
            PG8_LDB(B0, 0, 0); PG8_SCHED; PG8_LDA(At, 0, 0); PG8_STAGE(PG8_SA(1, 1), a1 + hstep, voffA);
            PG8_WAIT_L(8); PG8_BAR; PG8_WAIT_L(0); PG8_MMA(0, 0, At, B0); PG8_BAR; PG8_SCHED;
            PG8_LDB(B1, 0, 1); PG8_STAGE(PG8_SB(0, 0), b2, voffB);
            PG8_BAR; PG8_WAIT_L(0); PG8_MMA(0, 1, At, B1); PG8_BAR;
            PG8_LDA(At, 0, 1); PG8_STAGE(PG8_SA(0, 0), a2, voffA);
            PG8_BAR; PG8_WAIT_L(0); PG8_MMA(1, 0, At, B0); PG8_BAR; PG8_SCHED;
            PG8_STAGE(PG8_SB(0, 1), b2 + hstep, voffB);
            PG8_WAIT_V(6); PG8_BAR; PG8_MMA(1, 1, At, B1); PG8_BAR;
            PG8_LDB(B0, 1, 0); PG8_SCHED; PG8_LDA(At, 1, 0); PG8_STAGE(PG8_SA(0, 1), a2 + hstep, voffA);
            PG8_WAIT_L(8); PG8_BAR; PG8_WAIT_L(0); PG8_MMA(0, 0, At, B0); PG8_BAR; PG8_SCHED;
            PG8_LDB(B1, 1, 1); PG8_STAGE(PG8_SB(1, 0), b3, voffB);
            PG8_BAR; PG8_WAIT_L(0); PG8_MMA(0, 1, At, B1); PG8_BAR;
            PG8_LDA(At, 1, 1); PG8_STAGE(PG8_SA(1, 0), a3, voffA);
            PG8_BAR; PG8_WAIT_L(0); PG8_MMA(1, 0, At, B0); PG8_BAR; PG8_SCHED;
            PG8_STAGE(PG8_SB(1, 1), b3 + hstep, voffB);
            PG8_WAIT_V(6); PG8_BAR; PG8_MMA(1, 1, At, B1); PG8_BAR;
            }
        }
        if constexpr (ALIGN_EPI) { if (wr == 0) PG8_BAR; }
        if constexpr (!Epi::AFTER_DRAIN) { E(acc, cur, wr, wc, fr, fq); S.done(cur); }
        if (!has_next) break;
#pragma unroll
        for (int a = 0; a < 2; ++a)
#pragma unroll
            for (int b = 0; b < 2; ++b)
#pragma unroll
                for (int m = 0; m < 4; ++m)
#pragma unroll
                    for (int n = 0; n < 2; ++n) acc[a][b][m][n] = (f32x4){0.f, 0.f, 0.f, 0.f};
        cur = nxt; cA = nA; cB = nB; ++ui;
        if constexpr (ALIGN_EPI) { if (wr == 1) PG8_BAR; }
    }
    PG8_WAIT_V(0);
    if constexpr (!ALIGN_EPI) { if (wr == 0) PG8_BAR; }
    PG8_BAR;
    if constexpr (Epi::AFTER_DRAIN) { E.fused(acc, cur, wr, wc, fr, fq, lds, wid, lane); S.done(cur); }
#undef PG8_SA
#undef PG8_SB
#undef PG8_STAGE
#undef PG8_LDA
#undef PG8_LDB
#undef PG8_MMA
#undef PG8_CAT
#undef PG8_WAIT_V
#undef PG8_WAIT_L
#undef PG8_BAR
#undef PG8_SCHED
}
}
#include <hip/hip_bf16.h>
#include <hip/hip_bf16.h>
#include <cmath>
namespace attn_body {
using bf16=__hip_bfloat16;
using bf16x8=__attribute__((ext_vector_type(8)))short;
using s16x4=__attribute__((ext_vector_type(4)))short;
using f32x16=__attribute__((ext_vector_type(16)))float;
using u32x4=__attribute__((ext_vector_type(4)))unsigned;
constexpr int BATCH=4,NHEAD=16,SEQ=4096,D=64,DM=NHEAD*D;
constexpr int NW=8,QBLK=32,QB=QBLK*NW,KVBLK=64,NQB=SEQ/QB;
constexpr int ATTN_PITCH=DM, ATTN_UNIT_ROWS=QB;
__device__ __forceinline__ int crow(int r,int hi){return (r&3)+8*(r>>2)+4*hi;}
#define SBAR() __builtin_amdgcn_sched_barrier(0)
__device__ __forceinline__ void cmask(f32x16&p0,f32x16&p1,int jb,int qrel,int hi){
  const float NEG=-INFINITY; int kb=64*jb+4*hi;
  #pragma unroll
  for(int r=0;r<16;++r){int kv=kb+(r&3)+8*(r>>2); if(kv>qrel)p0[r]=NEG; if(kv+32>qrel)p1[r]=NEG;}
}

constexpr int NSLOT=3, SLOTB=8192, SLOTV=16384;
constexpr int LDS_K=0, LDS_V=NSLOT*SLOTB, LDS_WS=LDS_V+NSLOT*SLOTV, LDS_OST=LDS_WS+NW*64*4, LDS_BYTES=LDS_OST;
constexpr float C2=0.125f*1.4426950408889634f;
__device__ __forceinline__ void glds16(const void*gsrc,unsigned lds_dst){unsigned keep;
  asm volatile("s_mov_b32 %0, m0\n\ts_mov_b32 m0, %2\n\ts_nop 0\n\tglobal_load_lds_dwordx4 %1, off\n\ts_mov_b32 m0, %0":"=&s"(keep):"v"(gsrc),"s"(lds_dst):"memory");}
__device__ __forceinline__ float max3f(float a,float b,float c){float r;asm("v_max3_f32 %0, %1, %2, %3":"=v"(r):"v"(a),"v"(b),"v"(c));return r;}
__device__ __forceinline__ float max2f(float a,float b){float r;asm("v_max_f32_e32 %0, %1, %2":"=v"(r):"v"(a),"v"(b));return r;}
__device__ __forceinline__ float fadd_s(float a,float b){float r;asm("v_add_f32_e32 %0, %1, %2":"=v"(r):"v"(a),"v"(b));return r;}
__device__ __forceinline__ float fsub_s(float a,float b){float r;asm("v_sub_f32_e32 %0, %1, %2":"=v"(r):"v"(a),"v"(b));return r;}
typedef float f32x2_t __attribute__((ext_vector_type(2))); typedef __bf16 bf16x2_t __attribute__((ext_vector_type(2)));
__device__ __forceinline__ unsigned cvtpk_s(float lo,float hi){f32x2_t v={lo,hi};bf16x2_t b=__builtin_convertvector(v,bf16x2_t);return __builtin_bit_cast(unsigned,b);}
#define WAIT_BAR(N) asm volatile("s_waitcnt vmcnt(" #N ") lgkmcnt(0)\n\ts_barrier":::"memory")

__device__ __forceinline__ void qkt(f32x16&p0,f32x16&p1,const char*Kslot,const bf16x8*qr,int r32,int hi){ const f32x16 negm=f32x16{};
  const char*kb=Kslot+hi*1024+r32*16;
  #pragma unroll
  for(int d0=0;d0<4;++d0){
    const bf16x8 b0=*reinterpret_cast<const bf16x8*>(kb+d0*2048);
    const bf16x8 b1=*reinterpret_cast<const bf16x8*>(kb+d0*2048+512);
    if(d0==0){p0=__builtin_amdgcn_mfma_f32_32x32x16_bf16(b0,qr[0],negm,0,0,0);p1=__builtin_amdgcn_mfma_f32_32x32x16_bf16(b1,qr[0],negm,0,0,0);}
    else{p0=__builtin_amdgcn_mfma_f32_32x32x16_bf16(b0,qr[d0],p0,0,0,0);p1=__builtin_amdgcn_mfma_f32_32x32x16_bf16(b1,qr[d0],p1,0,0,0);}}
}
typedef __attribute__((address_space(3))) const char* lds_cptr;
typedef short v4i16_t __attribute__((ext_vector_type(4)));
__device__ __forceinline__ void kload8(bf16x8*kf,lds_cptr kp){
  kf[0]=*(const __attribute__((address_space(3))) bf16x8*)(kp);      kf[1]=*(const __attribute__((address_space(3))) bf16x8*)(kp+512);
  kf[2]=*(const __attribute__((address_space(3))) bf16x8*)(kp+2048); kf[3]=*(const __attribute__((address_space(3))) bf16x8*)(kp+2560);
  kf[4]=*(const __attribute__((address_space(3))) bf16x8*)(kp+4096); kf[5]=*(const __attribute__((address_space(3))) bf16x8*)(kp+4608);
  kf[6]=*(const __attribute__((address_space(3))) bf16x8*)(kp+6144); kf[7]=*(const __attribute__((address_space(3))) bf16x8*)(kp+6656);
}
__device__ __forceinline__ void kload2(bf16x8*kf,lds_cptr kp,int j){ kf[2*j]=*(const __attribute__((address_space(3))) bf16x8*)(kp+j*2048); kf[2*j+1]=*(const __attribute__((address_space(3))) bf16x8*)(kp+j*2048+512); }
__device__ __forceinline__ s16x4 vtr(lds_cptr p){ return __builtin_bit_cast(s16x4,__builtin_amdgcn_ds_read_tr16_b64_v4i16((__attribute__((address_space(3))) v4i16_t*)p)); }
__device__ __forceinline__ float rowmax(const f32x16&p0,const f32x16&p1){
  float a=max3f(p0[0],p0[1],p1[0]),b=max3f(p0[2],p0[3],p1[1]);a=max3f(a,p1[2],p1[3]);
  #pragma unroll
  for(int r=4;r<16;r+=4){a=max3f(a,p0[r],p0[r+1]);b=max3f(b,p0[r+2],p0[r+3]);a=max3f(a,p1[r],p1[r+1]);b=max3f(b,p1[r+2],p1[r+3]);}
  const float m=max2f(a,b);
  auto rr=__builtin_amdgcn_permlane32_swap(__float_as_uint(m),__float_as_uint(m),false,false);
  return max2f(__uint_as_float(rr[0]),__uint_as_float(rr[1]));
}
__device__ __forceinline__ void pv(f32x16*o,int vb,bf16x8 pa0,bf16x8 pa1,bf16x8 pa2,bf16x8 pa3){
  #pragma unroll
  for(int d0=0;d0<4;++d0){s16x4 lo[4],hi[4];
    #pragma unroll
    for(int ks=0;ks<4;++ks){
      asm volatile("ds_read_b64_tr_b16 %0,%1 offset:%c2":"=&v"(lo[ks]):"v"(vb),"i"(d0*4096+ks*1024):"memory");
      asm volatile("ds_read_b64_tr_b16 %0,%1 offset:%c2":"=&v"(hi[ks]):"v"(vb),"i"(d0*4096+ks*1024+512):"memory");}
    asm volatile("s_waitcnt lgkmcnt(0)":::"memory");SBAR();
    #define PK(k) (bf16x8){lo[k][0],lo[k][1],lo[k][2],lo[k][3],hi[k][0],hi[k][1],hi[k][2],hi[k][3]}
    o[d0]=__builtin_amdgcn_mfma_f32_32x32x16_bf16(pa0,PK(0),o[d0],0,0,0);
    o[d0]=__builtin_amdgcn_mfma_f32_32x32x16_bf16(pa1,PK(1),o[d0],0,0,0);
    o[d0]=__builtin_amdgcn_mfma_f32_32x32x16_bf16(pa2,PK(2),o[d0],0,0,0);
    o[d0]=__builtin_amdgcn_mfma_f32_32x32x16_bf16(pa3,PK(3),o[d0],0,0,0);
    #undef PK
  }
}

#ifndef ATTN_STORE16
#define ATTN_STORE16(p,v) (*(u32x4*)(p)=(v))
#endif
template<int THRL> __device__ __forceinline__ void attn_unit(bool FUSE,int b,int h,int hv,int qb,const bf16*Q,const bf16*__restrict__ K,const bf16*__restrict__ V,bf16*O,const bf16*O2,float lam,const float*gsub,char*shm){
  int tid_=threadIdx.x; asm volatile("":"+v"(tid_)); const int tid=tid_,lane=tid&63,r32=lane&31,hi=lane>>5; const int wid=__builtin_amdgcn_readfirstlane(tid>>6);
  const long rowbase=(long)b*SEQ; const int q0=qb*QB;
  const bf16*Qw=Q+(rowbase+q0+wid*QBLK)*DM+h*D;
  const bf16*Kh=K+rowbase*DM+h*D,*Vh=V+rowbase*DM+hv*2*D;
  const unsigned lds0=(unsigned)(uintptr_t)shm;
  float*wsf=(float*)(shm+LDS_WS)+wid*64;
  const bf16*ksrc=Kh+(long)lane*DM+wid*8;
  const bf16*vsrc=Vh+(long)(16*(wid&3)+(lane>>2))*DM+(wid>>2)*32+(lane&3)*8;
  const unsigned kdst=lds0+LDS_K+wid*1024, vdst=lds0+LDS_V+wid*1024;
  #define DMA_K(t,slot) glds16(ksrc+(long)(t)*KVBLK*DM,(unsigned)__builtin_amdgcn_readfirstlane(kdst+(slot)))
  #define DMA_V(t,slot) do{ glds16(vsrc+(long)(t)*KVBLK*DM,(unsigned)__builtin_amdgcn_readfirstlane(vdst+2*(slot))); glds16(vsrc+(long)(t)*KVBLK*DM+64,(unsigned)__builtin_amdgcn_readfirstlane(vdst+2*(slot)+8192)); }while(0)
  const int vb0=(int)(lds0+LDS_V)+((lane>>4)&1)*32+(lane&3)*8+(4*hi+((lane&15)>>2))*64;
  const char*Kbase=shm+LDS_K; bf16x8 kf[8];
  const lds_cptr shm3=(lds_cptr)shm; const lds_cptr kp0=shm3+LDS_K+hi*1024+r32*16; const lds_cptr vp0=shm3+LDS_V+((lane>>4)&1)*32+(lane&3)*8+(4*hi+((lane&15)>>2))*64;
  const int NT=(q0+QB)/KVBLK;
  DMA_K(0,0);DMA_V(0,0);DMA_K(1,SLOTB);
  bf16x8 qr[4];
  #pragma unroll
  for(int d0=0;d0<4;++d0)qr[d0]=*reinterpret_cast<const bf16x8*>(&Qw[(long)r32*DM+d0*16+hi*8]);
  float mhat=0.f,l_reg=0.f;f32x16 o[4];o[0]=f32x16{};o[1]=f32x16{};o[2]=f32x16{};o[3]=f32x16{};const f32x16 ZERO16=f32x16{};
  const int qrel=wid*QBLK+r32;
  #define CMASK(P0,P1,t) do{int jb_=(t)-(NT-4); if(jb_>=0)cmask(P0,P1,jb_,qrel,hi);}while(0)
  bool resc=false;
  #define START(P0,P1) do{ const float rm=rowmax(P0,P1); resc=false; \
    { const float dl=rm; mhat=fadd_s(mhat,dl); \
      _Pragma("unroll") for(int r=0;r<16;++r){P0[r]=fsub_s(P0[r],dl);P1[r]=fsub_s(P1[r],dl);} \
      } \
    _Pragma("unroll") for(int r=0;r<16;++r)P0[r]=__builtin_amdgcn_exp2f(P0[r]); }while(0)
  #define RESC() do{ if(resc){ asm volatile("s_waitcnt lgkmcnt(0)":::"memory"); \
      _Pragma("unroll") for(int d_=0;d_<4;++d_) _Pragma("unroll") for(int r=0;r<16;++r)o[d_][r]*=wsf[crow(r,hi)]; } }while(0)
  f32x16 pA0,pA1,pB0,pB1;
  int sl_prev=0,sl_cur=0,sl_next=SLOTB;
  #define ROT() do{sl_prev=sl_cur;sl_cur=sl_next;sl_next=(sl_next==(NSLOT-1)*SLOTB)?0:sl_next+SLOTB;}while(0)
  DMA_K(2,2*SLOTB);
  WAIT_BAR(3);
  qkt(pA0,pA1,Kbase,qr,r32,hi);asm volatile("s_nop 15\n\ts_nop 7":"+v"(pA0),"+v"(pA1));CMASK(pA0,pA1,0);
  START(pA0,pA1);
  _Pragma("unroll") for(int r=0;r<16;++r)pA1[r]=__builtin_amdgcn_exp2f(pA1[r]);
  WAIT_BAR(0);
  DMA_K(3,0);DMA_V(1,SLOTB);
  ROT();
  kload8(kf,kp0+sl_cur);
  WAIT_BAR(3);
  s16x4 vlo[8],vhi[8]; u32x4 pw0,pw1,pw2,pw3;
  #define PKW(P,B) cvtpk_s(P[B],P[B+1])
  #define PAF(k) __builtin_bit_cast(bf16x8,pw##k)
  #define VFR(i) (bf16x8){vlo[i][0],vlo[i][1],vlo[i][2],vlo[i][3],vhi[i][0],vhi[i][1],vhi[i][2],vhi[i][3]}
  #define PIN(x) asm volatile("":"+v"(x))
  #define MX3(a,b,c) __builtin_fmaxf(__builtin_fmaxf((a),(b)),(c))
  #define GAPA(MF,A0,A1,A2,A3,W0,W1,PW) do{ MF; sacc+=A0; sacc+=A1; sacc+=A2; sacc+=A3; PIN(sacc); W0; W1; PIN(PW); SBAR(); }while(0)
  #define EX(v) __builtin_amdgcn_exp2f(v)
  #define GAPB(MF,RD,X,B) do{ MF; RD; X[B]=EX(X[B]-mhat); X[B+1]=EX(X[B+1]-mhat); PIN(X); SBAR(); }while(0)
  #define VRD(i) do{ vlo[i]=vtr(vp_+(((i)>>2)*4096+((i)&3)*1024)); vhi[i]=vtr(vp_+(((i)>>2)*4096+((i)&3)*1024+512)); }while(0)
  #define VRD2(i) do{ vlo[i]=vtr(vp_+(8192+((i)>>2)*4096+((i)&3)*1024)); vhi[i]=vtr(vp_+(8192+((i)>>2)*4096+((i)&3)*1024+512)); }while(0)
  #define KRD(G,j) do{ if(G){ kload2(kf,kp0+sl_next,j); SBAR(); } }while(0)
  #define STEP(C0,C1,P0,P1,t,GK,GV,GL) do{ SBAR(); \
    const lds_cptr vp_=vp0+2*sl_prev; \
    VRD(0); SBAR(); float sacc=(P0[0]+P0[1]); \
    GAPA(C0=__builtin_amdgcn_mfma_f32_32x32x16_bf16(kf[0],qr[0],ZERO16,0,0,0), P0[2],P0[3],P0[4],P0[5],     pw0[0]=PKW(P0,0), pw0[1]=PKW(P0,2), pw0); \
    VRD(4); SBAR(); GAPA(C1=__builtin_amdgcn_mfma_f32_32x32x16_bf16(kf[1],qr[0],ZERO16,0,0,0), P0[6],P0[7],P0[8],P0[9],     pw0[2]=PKW(P0,4), pw0[3]=PKW(P0,6), pw0); \
    VRD(1); SBAR(); GAPA(C0=__builtin_amdgcn_mfma_f32_32x32x16_bf16(kf[2],qr[1],C0,0,0,0),   P0[10],P0[11],P0[12],P0[13], pw1[0]=PKW(P0,8), pw1[1]=PKW(P0,10), pw1); \
    VRD(5); SBAR(); GAPA(C1=__builtin_amdgcn_mfma_f32_32x32x16_bf16(kf[3],qr[1],C1,0,0,0),   P0[14],P0[15],P1[0],P1[1],   pw1[2]=PKW(P0,12),pw1[3]=PKW(P0,14), pw1); \
    VRD(2); SBAR(); GAPA(C0=__builtin_amdgcn_mfma_f32_32x32x16_bf16(kf[4],qr[2],C0,0,0,0),   P1[2],P1[3],P1[4],P1[5],     pw2[0]=PKW(P1,0), pw2[1]=PKW(P1,2), pw2); \
    VRD(6); SBAR(); GAPA(C1=__builtin_amdgcn_mfma_f32_32x32x16_bf16(kf[5],qr[2],C1,0,0,0),   P1[6],P1[7],P1[8],P1[9],     pw2[2]=PKW(P1,4), pw2[3]=PKW(P1,6), pw2); \
    VRD(3); SBAR(); GAPA(C0=__builtin_amdgcn_mfma_f32_32x32x16_bf16(kf[6],qr[3],C0,0,0,0),   P1[10],P1[11],P1[12],P1[13], pw3[0]=PKW(P1,8), pw3[1]=PKW(P1,10), pw3); \
    VRD(7); SBAR(); GAPA(C1=__builtin_amdgcn_mfma_f32_32x32x16_bf16(kf[7],qr[3],C1,0,0,0),   P1[14],P1[15],0.f,0.f,       pw3[2]=PKW(P1,12),pw3[3]=PKW(P1,14), pw3); \
    l_reg+=sacc; \
    if(GK){DMA_K((t)+3,sl_cur);} if(GV){DMA_V((t)+1,sl_next);} \
    CMASK(C0,C1,t); \
    { float a=MX3(C0[0],C0[1],C1[0]),b=MX3(C0[2],C0[3],C1[1]); a=MX3(a,C1[2],C1[3]); \
      _Pragma("unroll") for(int r=4;r<16;r+=4){a=MX3(a,C0[r],C0[r+1]);b=MX3(b,C0[r+2],C0[r+3]);a=MX3(a,C1[r],C1[r+1]);b=MX3(b,C1[r+2],C1[r+3]);} \
      float rm=__builtin_fmaxf(a,b); { auto rr=__builtin_amdgcn_permlane32_swap(__float_as_uint(rm),__float_as_uint(rm),false,false); rm=__builtin_fmaxf(__uint_as_float(rr[0]),__uint_as_float(rr[1])); } \
      resc=false; rm-=mhat;   \
      if(__builtin_expect(__any(rm>(float)THRL),0)){ const float dl=__builtin_fmaxf(rm,0.f); mhat+=dl; \
        const float f=__builtin_amdgcn_exp2f(-dl); l_reg*=f; if(hi==0)wsf[r32]=f; resc=true; } } \
    SBAR(); \
    GAPB(o[0]=__builtin_amdgcn_mfma_f32_32x32x16_bf16(PAF(0),VFR(0),o[0],0,0,0), VRD2(0), C0,0); \
    GAPB(o[1]=__builtin_amdgcn_mfma_f32_32x32x16_bf16(PAF(0),VFR(4),o[1],0,0,0), VRD2(4), C0,2); \
    GAPB(o[0]=__builtin_amdgcn_mfma_f32_32x32x16_bf16(PAF(1),VFR(1),o[0],0,0,0), VRD2(1), C0,4); \
    GAPB(o[1]=__builtin_amdgcn_mfma_f32_32x32x16_bf16(PAF(1),VFR(5),o[1],0,0,0), VRD2(5), C0,6); \
    GAPB(o[0]=__builtin_amdgcn_mfma_f32_32x32x16_bf16(PAF(2),VFR(2),o[0],0,0,0), VRD2(2), C0,8); \
    GAPB(o[1]=__builtin_amdgcn_mfma_f32_32x32x16_bf16(PAF(2),VFR(6),o[1],0,0,0), VRD2(6), C0,10); \
    GAPB(o[0]=__builtin_amdgcn_mfma_f32_32x32x16_bf16(PAF(3),VFR(3),o[0],0,0,0), VRD2(3), C0,12); \
    GAPB(o[1]=__builtin_amdgcn_mfma_f32_32x32x16_bf16(PAF(3),VFR(7),o[1],0,0,0), VRD2(7), C0,14); \
    KRD(GL,0); GAPB(o[2]=__builtin_amdgcn_mfma_f32_32x32x16_bf16(PAF(0),VFR(0),o[2],0,0,0), (void)0, C1,0); \
    GAPB(o[3]=__builtin_amdgcn_mfma_f32_32x32x16_bf16(PAF(0),VFR(4),o[3],0,0,0), (void)0, C1,2); \
    KRD(GL,1); GAPB(o[2]=__builtin_amdgcn_mfma_f32_32x32x16_bf16(PAF(1),VFR(1),o[2],0,0,0), (void)0, C1,4); \
    GAPB(o[3]=__builtin_amdgcn_mfma_f32_32x32x16_bf16(PAF(1),VFR(5),o[3],0,0,0), (void)0, C1,6); \
    KRD(GL,2); GAPB(o[2]=__builtin_amdgcn_mfma_f32_32x32x16_bf16(PAF(2),VFR(2),o[2],0,0,0), (void)0, C1,8); \
    GAPB(o[3]=__builtin_amdgcn_mfma_f32_32x32x16_bf16(PAF(2),VFR(6),o[3],0,0,0), (void)0, C1,10); \
    KRD(GL,3); GAPB(o[2]=__builtin_amdgcn_mfma_f32_32x32x16_bf16(PAF(3),VFR(3),o[2],0,0,0), (void)0, C1,12); \
    GAPB(o[3]=__builtin_amdgcn_mfma_f32_32x32x16_bf16(PAF(3),VFR(7),o[3],0,0,0), (void)0, C1,14); \
    }while(0)
  int t=1;
  #undef CMASK
  #define CMASK(P0,P1,t) do{}while(0)
  for(;t+5<NT;t+=2){
    STEP(pB0,pB1,pA0,pA1,t,true,true,true);     WAIT_BAR(3); RESC(); ROT();
    STEP(pA0,pA1,pB0,pB1,t+1,true,true,true);   WAIT_BAR(3); RESC(); ROT();
  }
  #undef CMASK
  #define CMASK(P0,P1,t) do{int jb_=(t)-(NT-4); if(jb_>=0)cmask(P0,P1,jb_,qrel,hi);}while(0)
  #define ENDW(tt) do{ if((tt)+3<NT){WAIT_BAR(3);} else if((tt)+2<NT){WAIT_BAR(2);} else {WAIT_BAR(0);} }while(0)
  for(;t+1<NT;t+=2){
    STEP(pB0,pB1,pA0,pA1,t,(t+3<NT),(t+1<NT),(t+1<NT));       ENDW(t);   RESC(); ROT();
    STEP(pA0,pA1,pB0,pB1,t+1,(t+4<NT),(t+2<NT),(t+2<NT));     ENDW(t+1); RESC(); ROT();
  }
  STEP(pB0,pB1,pA0,pA1,NT-1,false,false,false); RESC();
  { float sacc=pB0[0]+pB0[1]; _Pragma("unroll") for(int r=2;r<16;++r)sacc+=pB0[r]; _Pragma("unroll") for(int r=0;r<16;++r)sacc+=pB1[r]; l_reg+=sacc;
    pw0=(u32x4){PKW(pB0,0),PKW(pB0,2),PKW(pB0,4),PKW(pB0,6)};pw1=(u32x4){PKW(pB0,8),PKW(pB0,10),PKW(pB0,12),PKW(pB0,14)};pw2=(u32x4){PKW(pB1,0),PKW(pB1,2),PKW(pB1,4),PKW(pB1,6)};pw3=(u32x4){PKW(pB1,8),PKW(pB1,10),PKW(pB1,12),PKW(pB1,14)};
    SBAR(); pv(o,vb0+2*sl_cur,PAF(0),PAF(1),PAF(2),PAF(3)); }
  #undef PKW
  #undef PAF
  #undef VFR
  #undef PIN
  #undef MX3
  #undef GAPA
  #undef GAPB
  #undef EX
  #undef VRD
  #undef VRD2
  #undef KRD
  #undef STEP
  #undef ENDW
  {auto rr=__builtin_amdgcn_permlane32_swap(__float_as_uint(l_reg),__float_as_uint(l_reg),false,false);l_reg=__uint_as_float(rr[0])+__uint_as_float(rr[1]);}
  if(hi==0)wsf[32+r32]=l_reg;asm volatile("s_waitcnt lgkmcnt(0)":::"memory");
  float rli[16];
  #pragma unroll
  for(int r=0;r<16;++r)rli[r]=__builtin_amdgcn_rcpf(wsf[32+crow(r,hi)]);
  bf16*Ow=O+(rowbase+q0+wid*QBLK)*DM+hv*2*D;
  asm volatile("s_waitcnt lgkmcnt(0)\n\ts_barrier":::"memory");
  { bf16*stg=(bf16*)(shm+LDS_K)+wid*4096;
    const bf16*O2w=O2+(rowbase+q0+wid*QBLK)*DM+hv*2*D;
    #pragma unroll
    for(int r=0;r<16;++r){const int orow=crow(r,hi);
      #pragma unroll
      for(int d0=0;d0<4;++d0)stg[orow*128+d0*32+r32]=__float2bfloat16(o[d0][r]*rli[r]);}
    asm volatile("s_waitcnt lgkmcnt(0)":::"memory");
    #pragma unroll
    for(int i=0;i<4;++i){const int row=i*8+(lane>>3),ch=lane&7;
      const u32x4 v0=*(const u32x4*)(stg+row*128+ch*8), v1=*(const u32x4*)(stg+row*128+64+ch*8);
      if(!FUSE){ ATTN_STORE16(Ow+(long)row*DM+ch*8,v0); ATTN_STORE16(Ow+(long)row*DM+64+ch*8,v1); }
      else{ const u32x4 t0=*(const u32x4*)(O2w+(long)row*DM+ch*8), t1=*(const u32x4*)(O2w+(long)row*DM+64+ch*8);
        float c[16]; float ss=0.f;
        #pragma unroll
        for(int k=0;k<4;++k){ c[2*k]=__uint_as_float(v0[k]<<16)-lam*__uint_as_float(t0[k]<<16); c[2*k+1]=__uint_as_float(v0[k]&0xffff0000u)-lam*__uint_as_float(t0[k]&0xffff0000u);
          c[8+2*k]=__uint_as_float(v1[k]<<16)-lam*__uint_as_float(t1[k]<<16); c[8+2*k+1]=__uint_as_float(v1[k]&0xffff0000u)-lam*__uint_as_float(t1[k]&0xffff0000u); }
        #pragma unroll
        for(int k=0;k<16;++k)ss+=c[k]*c[k];
        ss+=__int_as_float(__builtin_amdgcn_ds_swizzle(__float_as_int(ss),(1<<10)|0x1f)); ss+=__int_as_float(__builtin_amdgcn_ds_swizzle(__float_as_int(ss),(2<<10)|0x1f)); ss+=__int_as_float(__builtin_amdgcn_ds_swizzle(__float_as_int(ss),(4<<10)|0x1f));
        const float rs=__builtin_amdgcn_rsqf(ss*(1.f/128.f)+1e-6f);
        const float4 g0=*(const float4*)(gsub+ch*8), g1=*(const float4*)(gsub+ch*8+4), g2=*(const float4*)(gsub+64+ch*8), g3=*(const float4*)(gsub+64+ch*8+4);
        u32x4 w0,w1;
        w0[0]=cvtpk_s(c[0]*rs*g0.x,c[1]*rs*g0.y); w0[1]=cvtpk_s(c[2]*rs*g0.z,c[3]*rs*g0.w); w0[2]=cvtpk_s(c[4]*rs*g1.x,c[5]*rs*g1.y); w0[3]=cvtpk_s(c[6]*rs*g1.z,c[7]*rs*g1.w);
        w1[0]=cvtpk_s(c[8]*rs*g2.x,c[9]*rs*g2.y); w1[1]=cvtpk_s(c[10]*rs*g2.z,c[11]*rs*g2.w); w1[2]=cvtpk_s(c[12]*rs*g3.x,c[13]*rs*g3.y); w1[3]=cvtpk_s(c[14]*rs*g3.z,c[15]*rs*g3.w);
        ATTN_STORE16(Ow+(long)row*DM+ch*8,w0); ATTN_STORE16(Ow+(long)row*DM+64+ch*8,w1); } } }
  asm volatile("s_waitcnt lgkmcnt(0)\n\ts_barrier":::"memory");
  #undef DMA_K
  #undef DMA_V
  #undef CMASK
  #undef START
  #undef RESC
  #undef ROT
}
constexpr int ATTN_LDS_BYTES=LDS_BYTES;
struct AttnTensors { const bf16* Q; const bf16* K; const bf16* V; bf16* O2; bf16* YB; };
template<int THRL=8> __device__ __forceinline__ void attn_phase(char*lds,const AttnTensors&T,float lam,const float*gsub,int vcu,int ncu){
  const int bh=(vcu&255)>>3, s=vcu&7; const int b=bh>>3, h=bh&7;
  const float lam_u=__uint_as_float(__builtin_amdgcn_readfirstlane(__float_as_uint(lam)));
  for(int i=0;i<4;++i){ const int qb=(i&2)?15-s:s; const bool fuse=(i&1)!=0;
    attn_unit<THRL>(fuse,b,fuse?2*h:2*h+1,h,qb,T.Q,T.K,T.V,fuse?T.YB:T.O2,T.O2,lam_u,gsub,lds);
  }
}
#undef SBAR
#undef WAIT_BAR
}
constexpr int NWAVES = 8;
#ifndef MK_MULTI
#define MK_MULTI 0
#endif
constexpr int NB = 4, SEQ = 4096, T = NB * SEQ, D = 1024, DIN = 7168, FF = 3584, NEXP = 8, PLE = 256, DEPTH = 2;
constexpr int NPAN = T / 256;
constexpr float EPS = 1e-6f;
constexpr int MOE_ROWS = 2 * T + NEXP * 256;
constexpr int MOE_PANELS = MOE_ROWS / 256, MOE_HALF = MOE_PANELS / 2;
constexpr size_t MiB = 1u << 20;
constexpr size_t WS_CTL = 0, CTL_ZERO_BYTES = 1 * MiB;
constexpr size_t WS_LRUW = 1 * MiB;
constexpr size_t WS_PAR = 1 * MiB + 512 * 1024;
constexpr size_t WS_SUM = 2 * MiB;
constexpr size_t WS_TOK = 4 * MiB;
constexpr size_t WS_LIST = 5 * MiB;
constexpr size_t WS_COS = 6 * MiB;
constexpr size_t WS_WSMALL = 10 * MiB;
constexpr size_t WL_STRIDE = 45 * MiB / 2, WL_WIN = 0, WL_WAB = 14 * MiB, WL_WO = 18 * MiB, WL_WPG = 20 * MiB, WL_WPP = 22 * MiB;
constexpr size_t WS_WGU = WS_WSMALL + 45 * MiB, WS_WD = WS_WGU + 14 * MiB;
constexpr size_t WS_PB = 76 * MiB;
constexpr size_t WS_H = 92 * MiB;
constexpr size_t WS_BIG = 124 * MiB, SLOT = 32 * MiB;
constexpr size_t WS_GG = WS_BIG, WS_RIN = WS_BIG + SLOT, WS_Q = WS_BIG + 2 * SLOT, WS_K = WS_BIG + 3 * SLOT, WS_V = WS_BIG + 4 * SLOT, WS_SGA = WS_BIG + 5 * SLOT, WS_SGB = WS_BIG + 6 * SLOT;
constexpr size_t WS_HL = WS_BIG + 7 * SLOT, WS_LP = WS_BIG + 8 * SLOT, WS_O1 = WS_BIG + 9 * SLOT, WS_O2 = WS_BIG + 10 * SLOT;
constexpr size_t WS_YA = WS_RIN, WS_YB = WS_Q, WS_T1 = WS_K, WS_MERGED = WS_GG, WS_F = WS_SGA;
constexpr size_t WS_ACT = WS_BIG;
constexpr size_t WS_PP = WS_BIG;
constexpr size_t WS_WMGU = WS_BIG, WS_WMD = WS_BIG + 56 * MiB, WS_ACT8 = WS_BIG + 84 * MiB, WS_HG = WS_BIG + 204 * MiB, WS_OE = WS_BIG + 240 * MiB;
constexpr size_t WS_XR = WS_O2 + SLOT;
constexpr size_t WS_END = WS_XR + SLOT;
constexpr float SC_H = 8.f, SC_WGU = 32.f, SC_ACT = 8.f, SC_WD = 64.f;
constexpr int E8_H = 0x7c7c7c7c, E8_WGU = 0x7a7a7a7a, E8_ACT = 0x7c7c7c7c, E8_WD = 0x79797979;
static_assert(WS_OE + (size_t)MOE_ROWS * D * 2 <= WS_END && WS_ACT8 + (size_t)MOE_ROWS * FF <= WS_HG && WS_HG + (size_t)MOE_ROWS * D <= WS_OE && WS_WMD + (size_t)NEXP * D * FF <= WS_ACT8, "d_ws map");
constexpr int CW_TMO = 0, CW_CODE = 1;
constexpr int CW_CNT = 64;
constexpr int CW_BAR = 4096;
constexpr int RING_OFF = 0, RING_BYTES = 131072;
constexpr int LDSCTL_OFF = RING_BYTES, MISC_OFF = LDSCTL_OFF + 320;
constexpr int LDS_BYTES = 147456;
static_assert(MISC_OFF + 128 <= LDS_BYTES, "LDS map");
#define GAS __attribute__((address_space(1)))
#define LAS __attribute__((address_space(3)))
typedef unsigned short bf16;
typedef unsigned v4u __attribute__((ext_vector_type(4)));
typedef float f32x4 __attribute__((ext_vector_type(4)));
typedef short bf16x8 __attribute__((ext_vector_type(8)));
typedef GAS unsigned gu32;
typedef GAS unsigned long long gu64;
#define RLX_AGENT __ATOMIC_RELAXED, __HIP_MEMORY_SCOPE_AGENT
#define LDS_WAIT() asm volatile("s_waitcnt lgkmcnt(0)" ::: "memory")
#define VM_WAIT() asm volatile("s_waitcnt vmcnt(0)" ::: "memory")
__device__ __forceinline__ unsigned long long rt() { return __builtin_amdgcn_s_memrealtime(); }
__device__ __forceinline__ unsigned f2bf(float f) { unsigned u = __builtin_bit_cast(unsigned, f); return (u + 0x7fffu + ((u >> 16) & 1u)) >> 16; }
__device__ __forceinline__ unsigned pk2(float lo, float hi) { return f2bf(lo) | (f2bf(hi) << 16); }

#define XB_TMO      128
#define XB_XCNT(j)  (256  + 64 * (j))
#define XB_XSUB(j)  (1280 + 64 * (j))
#define XB_XGEN(j)  (2304 + 64 * (j))
#define XB_TOP      3328
#define XB_TOPGEN   3392
#define XCD_BAR_WORDS 3456
#define XB_SPIN_CAP (1u << 18)

__device__ __forceinline__ unsigned xb_ld(unsigned* p)              { return __hip_atomic_load(p, __ATOMIC_RELAXED, __HIP_MEMORY_SCOPE_AGENT); }
__device__ __forceinline__ unsigned xb_add(unsigned* p, unsigned v) { return __hip_atomic_fetch_add(p, v, __ATOMIC_RELAXED, __HIP_MEMORY_SCOPE_AGENT); }
__device__ __forceinline__ unsigned xb_xcc_id() { return (unsigned)__builtin_amdgcn_s_getreg((3 << 11) | 20) & 0xFu; }
#define XB_SPIN(cond, bar) do { unsigned _sp = 0; while (cond) { __builtin_amdgcn_s_sleep(1); \
    if ((++_sp & 255u) == 0u) { if (xb_ld(&(bar)[XB_TMO])) break; if (_sp > XB_SPIN_CAP) { atomicAdd(&(bar)[XB_TMO], 1u); break; } } } } while (0)

struct XcdBarrier {
    unsigned* bar; unsigned x;
    volatile LAS unsigned* st;
};

__device__ __forceinline__ XcdBarrier xcd_barrier_post(unsigned* bar, volatile LAS unsigned* st) {
    XcdBarrier b; b.bar = bar; b.x = xb_xcc_id(); b.st = st;
    if (threadIdx.x == 0) (void)xb_add(&bar[XB_XCNT(b.x)], 1u);
    return b;
}
__device__ __forceinline__ void xcd_barrier_complete(unsigned* bar, unsigned x, unsigned& nloc, unsigned& nx) {
    const unsigned G = gridDim.x * gridDim.y * gridDim.z;
    unsigned sum, cnt, mine, sp = 0u;
    for (;;) {
        sum = 0u; cnt = 0u; mine = 0u;
#pragma unroll
        for (unsigned j = 0; j < 16; ++j) { const unsigned c = xb_ld(&bar[XB_XCNT(j)]); sum += c; cnt += (c > 0u) ? 1u : 0u; mine = (j == x) ? c : mine; }
        if (sum == G) break;
        __builtin_amdgcn_s_sleep(1);
        if ((++sp & 255u) == 0u) { if (xb_ld(&bar[XB_TMO])) break; if (sp > XB_SPIN_CAP) { atomicAdd(&bar[XB_TMO], 1u); break; } }
    }
    nloc = mine > 0u ? mine : 1u; nx = cnt > 0u ? cnt : 1u;
}

__device__ __forceinline__ void xcd_barrier(const XcdBarrier& b) {
    asm volatile("s_waitcnt vmcnt(0)" ::: "memory");
    __syncthreads();
    if (threadIdx.x == 0) {
        unsigned* bar = b.bar; unsigned bx_ = b.x;
        asm volatile("" : "+s"(bar), "+s"(bx_));
        __builtin_amdgcn_s_waitcnt(0);
        unsigned nloc = b.st[0], nx = b.st[1];
        if (nloc == 0u) { xcd_barrier_complete(bar, bx_, nloc, nx); b.st[0] = nloc; b.st[1] = nx; }
        const unsigned old = xb_add(&bar[XB_XSUB(bx_)], 1u);
        const unsigned gen = old / nloc;
        if (old + 1u == (gen + 1u) * nloc) {
            __builtin_amdgcn_fence(__ATOMIC_RELEASE, "agent");
            asm volatile("s_waitcnt vmcnt(0)" ::: "memory");
            const unsigned og = xb_add(&bar[XB_TOP], 1u);
            const unsigned tg = og / nx;
            if (og + 1u == (tg + 1u) * nx) xb_add(&bar[XB_TOPGEN], 1u);
            else XB_SPIN(xb_ld(&bar[XB_TOPGEN]) == tg, bar);
            __builtin_amdgcn_fence(__ATOMIC_ACQUIRE, "agent");
            xb_add(&bar[XB_XGEN(bx_)], 1u);
            asm volatile("s_waitcnt vmcnt(0)" ::: "memory");
        } else {
            XB_SPIN(xb_ld(&bar[XB_XGEN(bx_)]) == gen, bar);
            __builtin_amdgcn_fence(__ATOMIC_ACQUIRE, "agent");
            asm volatile("s_waitcnt vmcnt(0)" ::: "memory");
        }
    }
    __syncthreads();
}
__device__ const float INV_FREQ[32] = {
    1.0f, 0.74989420933f, 0.56234132519f, 0.42169650343f, 0.31622776602f, 0.23713737057f, 0.17782794100f, 0.13335214322f,
    0.1f, 0.074989420933f, 0.056234132519f, 0.042169650343f, 0.031622776602f, 0.023713737057f, 0.017782794100f, 0.013335214322f,
    0.01f, 0.0074989420933f, 0.0056234132519f, 0.0042169650343f, 0.0031622776602f, 0.0023713737057f, 0.0017782794100f, 0.0013335214322f,
    0.001f, 0.00074989420933f, 0.00056234132519f, 0.00042169650343f, 0.00031622776602f, 0.00023713737057f, 0.00017782794100f, 0.00013335214322f };

#define SWZ_XOR(v, o) __int_as_float(__builtin_amdgcn_ds_swizzle(__float_as_int(v), ((o) << 10) | 0x1f))
__device__ __forceinline__ float half_sum(float v) {
    v += SWZ_XOR(v, 1); v += SWZ_XOR(v, 2); v += SWZ_XOR(v, 4); v += SWZ_XOR(v, 8); v += SWZ_XOR(v, 16);
    return v;
}
__device__ __forceinline__ float wave_sum(float v) {
    v = half_sum(v);
    const auto rr = __builtin_amdgcn_permlane32_swap(__float_as_uint(v), __float_as_uint(v), false, false);
    return __uint_as_float(rr[0]) + __uint_as_float(rr[1]);
}
__device__ __forceinline__ float dot4(f32x4 a, f32x4 b) { return (a.x * b.x + a.y * b.y) + (a.z * b.z + a.w * b.w); }
__device__ __forceinline__ float bf2f(unsigned short v) { return __uint_as_float((unsigned)v << 16); }
typedef unsigned u32x2 __attribute__((ext_vector_type(2)));
__device__ __forceinline__ f32x4 bf4_to_f(u32x2 w) { return (f32x4){__uint_as_float(w.x << 16), __uint_as_float(w.x & 0xffff0000u), __uint_as_float(w.y << 16), __uint_as_float(w.y & 0xffff0000u)}; }
__device__ __forceinline__ u32x2 f_to_bf4(f32x4 v) { u32x2 w; w.x = pk2(v.x, v.y); w.y = pk2(v.z, v.w); return w; }
__device__ __forceinline__ float sigm_f(float v) { return 1.0f / (1.0f + __expf(-v)); }

__device__ __forceinline__ f32x4 bfl4(v4u w) { return (f32x4){__uint_as_float(w.x << 16), __uint_as_float(w.x & 0xffff0000u), __uint_as_float(w.y << 16), __uint_as_float(w.y & 0xffff0000u)}; }
__device__ __forceinline__ f32x4 bfh4(v4u w) { return (f32x4){__uint_as_float(w.z << 16), __uint_as_float(w.z & 0xffff0000u), __uint_as_float(w.w << 16), __uint_as_float(w.w & 0xffff0000u)}; }
__device__ __forceinline__ v4u pk8bf(f32x4 a, f32x4 b) { v4u w; w.x = pk2(a.x, a.y); w.y = pk2(a.z, a.w); w.z = pk2(b.x, b.y); w.w = pk2(b.z, b.w); return w; }
__device__ __forceinline__ void tr_load(float (&r)[32], const float* W, int N, int k0, int n0, int lane) {
#pragma unroll
    for (int i = 0; i < 32; ++i) r[i] = W[(size_t)(k0 + 2 * i + (lane >> 5)) * N + n0 + (lane & 31)];
}
__device__ __forceinline__ void tr_store(const float (&r)[32], int K, bf16* WT, int dest_row0, int k0, LAS float* scr, int lane) {
#pragma unroll
    for (int i = 0; i < 32; ++i) scr[(2 * i + (lane >> 5)) * 33 + (lane & 31)] = r[i];
    LDS_WAIT(); asm volatile("" ::: "memory");
    const int c = lane & 7;
#pragma unroll
    for (int j = 0; j < 4; ++j) { const int n = (lane >> 3) + 8 * j; const LAS float* s = scr + (8 * c) * 33 + n;
        v4u o; o.x = pk2(s[0 * 33], s[1 * 33]); o.y = pk2(s[2 * 33], s[3 * 33]); o.z = pk2(s[4 * 33], s[5 * 33]); o.w = pk2(s[6 * 33], s[7 * 33]);
        *(v4u*)(WT + (size_t)(dest_row0 + n) * K + k0 + 8 * c) = o; }
    LDS_WAIT(); asm volatile("" ::: "memory");
}
template <int MAP> __device__ __forceinline__ int dest_row(int n0) {
    if (MAP == 1) { const int tile = n0 >> 8, w = n0 & 255; return tile * 256 + ((w & 63) >> 5) * 128 + (w >> 6) * 32; }
    if (MAP == 2) return (n0 >> 7) * 256 + (n0 & 127);
    if (MAP == 3) return (n0 >> 7) * 256 + 128 + (n0 & 127);
    return n0;
}
__device__ __forceinline__ float clamp8(float v) { return __builtin_fminf(__builtin_fmaxf(v, -448.f), 448.f); }
__device__ __forceinline__ unsigned pk4f8(float a, float b, float c, float d) { unsigned w = __builtin_amdgcn_cvt_pk_fp8_f32(clamp8(a), clamp8(b), 0u, false); return __builtin_amdgcn_cvt_pk_fp8_f32(clamp8(c), clamp8(d), w, true); }
__device__ __forceinline__ void tr_store8(const float (&r)[32], int K, unsigned char* WT, int dest_row0, int k0, float scale, LAS float* scr, int lane) {
#pragma unroll
    for (int i = 0; i < 32; ++i) scr[(2 * i + (lane >> 5)) * 33 + (lane & 31)] = r[i] * scale;
    LDS_WAIT(); asm volatile("" ::: "memory");
    const int c = lane & 3;
#pragma unroll
    for (int j = 0; j < 2; ++j) { const int n = (lane >> 2) + 16 * j; const LAS float* s = scr + (16 * c) * 33 + n;
        v4u o; o.x = pk4f8(s[0 * 33], s[1 * 33], s[2 * 33], s[3 * 33]); o.y = pk4f8(s[4 * 33], s[5 * 33], s[6 * 33], s[7 * 33]);
        o.z = pk4f8(s[8 * 33], s[9 * 33], s[10 * 33], s[11 * 33]); o.w = pk4f8(s[12 * 33], s[13 * 33], s[14 * 33], s[15 * 33]);
        *(v4u*)(WT + (size_t)(dest_row0 + n) * K + k0 + 16 * c) = o; }
    LDS_WAIT(); asm volatile("" ::: "memory");
}
struct TrItem { const float* W; bf16* WT; int K, N, dest_row0, k0, n0; float s8; };
template <int MAP> __device__ __forceinline__ TrItem tr_item(const float* W, int K, int N, bf16* WT, int row_off, int q, float s8 = 0.f) {
    const int nblk = N / 32, kb = q / nblk, nb = q - kb * nblk; TrItem t; t.W = W; t.WT = WT; t.K = K; t.N = N; t.dest_row0 = row_off + dest_row<MAP>(32 * nb); t.k0 = 64 * kb; t.n0 = 32 * nb; t.s8 = s8; return t;
}
#define TR_STORE(r, t) do { if (F8 && t.s8 != 0.f) tr_store8(r, t.K, (unsigned char*)t.WT, t.dest_row0, t.k0, t.s8, scr, lane); else tr_store(r, t.K, t.WT, t.dest_row0, t.k0, scr, lane); } while (0)
template <bool F8, class Dec> __device__ __forceinline__ void tr_run(const Dec& DEC, int nitems, LAS float* scr, int lane, int gw, int ngw) {
    int it = gw; if (it >= nitems) return;
    float ra[32], rb[32];
    TrItem a = DEC(it), b = a;
    tr_load(ra, a.W, a.N, a.k0, a.n0, lane);
    for (;;) {
        const int it1 = it + ngw; const bool h1 = it1 < nitems;
        if (h1) { b = DEC(it1); tr_load(rb, b.W, b.N, b.k0, b.n0, lane); }
        TR_STORE(ra, a);
        if (!h1) break;
        const int it2 = it1 + ngw; const bool h2 = it2 < nitems;
        if (h2) { a = DEC(it2); tr_load(ra, a.W, a.N, a.k0, a.n0, lane); }
        TR_STORE(rb, b);
        if (!h2) break;
        it = it2;
    }
}

__device__ __forceinline__ void row_post_pre(const f32x4 (&f)[4], const float* xin, float* xout, const float* gpost, const float* gpre, bf16* hrow, int lane, f32x4 (&hn)[4]) {
    float s = 0.f;
#pragma unroll
    for (int j = 0; j < 4; ++j) s += dot4(f[j], f[j]);
    const float rs = rsqrtf(wave_sum(s) * (1.f / D) + EPS);
    f32x4 xv[4]; float s2 = 0.f;
#pragma unroll
    for (int j = 0; j < 4; ++j) { xv[j] = ((const f32x4*)xin)[lane + 64 * j] + f[j] * rs * ((const f32x4*)gpost)[lane + 64 * j]; ((f32x4*)xout)[lane + 64 * j] = xv[j]; s2 += dot4(xv[j], xv[j]); }
    if (gpre) {
        const float rs2 = rsqrtf(wave_sum(s2) * (1.f / D) + EPS);
#pragma unroll
        for (int j = 0; j < 4; ++j) { hn[j] = xv[j] * rs2 * ((const f32x4*)gpre)[lane + 64 * j]; ((u32x2*)hrow)[lane + 64 * j] = f_to_bf4(hn[j]); }
    }
}
struct Args { const void* in[26]; float* out; unsigned char* ws; int ph_lo, ph_hi; };
enum { I_X = 0, I_P, I_POS, I_NORMG, I_WIN, I_CONVW, I_CONVB, I_LWA, I_LBA, I_LWX, I_LBX, I_LLAM, I_DLAM, I_SUBG, I_WPA, I_WPB, I_WOUT, I_FG, I_FU, I_FD, I_RW, I_MG, I_MU, I_MD, I_PWP, I_PWG };

constexpr int PO_NORMG = 0, PO_CONVW = PO_NORMG + DEPTH * 6 * D, PO_CONVB = PO_CONVW + DEPTH * 4 * D, PO_LBA = PO_CONVB + DEPTH * D, PO_LBX = PO_LBA + DEPTH * D, PO_LLAM = PO_LBX + DEPTH * D,
              PO_DLAM = PO_LLAM + DEPTH * D, PO_SUBG = PO_DLAM + DEPTH * 256, PO_RW = PO_SUBG + DEPTH * 128, PO_SUBGS = PO_RW + D * NEXP, PO_END = PO_SUBGS + DEPTH * 128;
static_assert((size_t)PO_END * 4 <= 512 * 1024, "parameter block");
__device__ __forceinline__ void p0_prologue(const Args& A, LAS unsigned char* lds, int vcu, int G) {
#define AIN(k) ((const void*)(const GAS void*)A.in[k])
    int tid_ = threadIdx.x; asm volatile("" : "+v"(tid_)); const int tid = tid_, lane = tid & 63, wave = __builtin_amdgcn_readfirstlane(tid >> 6); (void)tid; (void)lane; (void)wave;
    unsigned char* ws = (unsigned char*)(GAS unsigned char*)A.ws;
    LAS float* scr = (LAS float*)(lds + RING_OFF + wave * 16384);
    const int gw = vcu * NWAVES + wave, ngw = G * NWAVES;
    { struct Dec { const Args& A; unsigned char* ws;
          __device__ __forceinline__ TrItem operator()(int f) const {
              constexpr int I_IN = (D / 64) * (DIN / 32), I_SQ = (D / 64) * (D / 32), I_PP = (PLE / 64) * (D / 32), I_L = I_IN + 4 * I_SQ + I_PP, I_FF = (D / 64) * (FF / 32);
              if (f < DEPTH * I_L) { const int l = f / I_L; int r = f - l * I_L; unsigned char* wl = ws + WS_WSMALL + (size_t)l * WL_STRIDE;
                  if (r < I_IN) return tr_item<1>((const float*)AIN(I_WIN) + (size_t)l * D * DIN, D, DIN, (bf16*)(wl + WL_WIN), 0, r); r -= I_IN;
                  if (r < I_SQ) return tr_item<0>((const float*)AIN(I_WPA) + (size_t)l * D * D, D, D, (bf16*)(wl + WL_WAB), 0, r); r -= I_SQ;
                  if (r < I_SQ) return tr_item<0>((const float*)AIN(I_WPB) + (size_t)l * D * D, D, D, (bf16*)(wl + WL_WAB), D, r); r -= I_SQ;
                  if (r < I_SQ) return tr_item<0>((const float*)AIN(I_WOUT) + (size_t)l * D * D, D, D, (bf16*)(wl + WL_WO), 0, r); r -= I_SQ;
                  if (r < I_SQ) return tr_item<0>((const float*)AIN(I_PWG) + (size_t)l * D * D, D, D, (bf16*)(wl + WL_WPG), 0, r); r -= I_SQ;
                  return tr_item<0>((const float*)AIN(I_PWP) + (size_t)l * PLE * D, PLE, D, (bf16*)(wl + WL_WPP), 0, r); }
              int r = f - DEPTH * I_L;
              if (r < I_FF) return tr_item<2>((const float*)AIN(I_FG), D, FF, (bf16*)(ws + WS_WGU), 0, r); r -= I_FF;
              if (r < I_FF) return tr_item<3>((const float*)AIN(I_FU), D, FF, (bf16*)(ws + WS_WGU), 0, r); r -= I_FF;
              return tr_item<0>((const float*)AIN(I_FD), FF, D, (bf16*)(ws + WS_WD), 0, r); } };
      constexpr int NIT = DEPTH * ((D / 64) * (DIN / 32) + 4 * (D / 64) * (D / 32) + (PLE / 64) * (D / 32)) + 2 * (D / 64) * (FF / 32) + (FF / 64) * (D / 32);
      const Dec dec{A, ws}; tr_run<true>(dec, NIT, scr, lane, gw, ngw); }
    const int gt = gw * 64 + lane, ngt = ngw * 64;
    { const int* pos = (const int*)AIN(I_POS); float* pf = (float*)(ws + WS_COS); for (int i = gt; i < T; i += ngt) pf[i] = (float)pos[i]; }
    { const f32x4* p = (const f32x4*)AIN(I_P); u32x2* pb = (u32x2*)(ws + WS_PB);
      for (int i = gt; i < DEPTH * T * PLE / 4; i += ngt) pb[i] = f_to_bf4(p[i]); }
    { bf16* lw = (bf16*)(ws + WS_LRUW);
      for (int i = gt; i < DEPTH * 16 * 2 * 4096; i += ngt) { const int c = i & 63, d = (i >> 6) & 63, g = (i >> 12) & 1, n = (i >> 13) & 15, l = i >> 17;
          const float* src = (const float*)AIN(g ? I_LWX : I_LWA); lw[i] = (bf16)f2bf(src[((size_t)(l * 16 + n) * 64 + c) * 64 + d]); } }
    { const float* g0 = (const float*)AIN(I_NORMG);
      for (int m = gw; m < T; m += ngw) { const f32x4* xr = (const f32x4*)((const float*)AIN(I_X) + (size_t)m * D); f32x4 v[4]; float s = 0.f;
#pragma unroll
          for (int j = 0; j < 4; ++j) { v[j] = xr[lane + 64 * j]; s += dot4(v[j], v[j]); }
          const float rs = rsqrtf(wave_sum(s) * (1.f / D) + EPS);
#pragma unroll
          for (int j = 0; j < 4; ++j) { ((u32x2*)(ws + WS_XR + (size_t)m * D * 2))[lane + 64 * j] = f_to_bf4(v[j]); ((u32x2*)(ws + WS_H + (size_t)m * D * 2))[lane + 64 * j] = f_to_bf4(v[j] * rs * ((const f32x4*)g0)[lane + 64 * j]); } } }
    { float* par = (float*)(ws + WS_PAR);
      const int srcs[9] = {I_NORMG, I_CONVW, I_CONVB, I_LBA, I_LBX, I_LLAM, I_DLAM, I_SUBG, I_RW};
      const int offs[10] = {PO_NORMG, PO_CONVW, PO_CONVB, PO_LBA, PO_LBX, PO_LLAM, PO_DLAM, PO_SUBG, PO_RW, PO_SUBGS};
#pragma unroll
      for (int k = 0; k < 9; ++k) { const float* src = (const float*)AIN(srcs[k]); const int n = offs[k + 1] - offs[k];
          for (int i = gt; i < n; i += ngt) par[offs[k] + i] = src[i]; }
      for (int i = gt; i < DEPTH * 128; i += ngt) par[PO_SUBGS + i] = ((const float*)AIN(I_SUBG))[i] * (1.0f - (0.8f - 0.6f * expf(-0.3f * (float)(i >> 7)))); }
}

__device__ __forceinline__ unsigned short bf1(float v) { unsigned r; asm("v_cvt_pk_bf16_f32 %0, %1, %1" : "=v"(r) : "v"(v)); return (unsigned short)r; }
__device__ __forceinline__ float sigm_fast(float v) { return __builtin_amdgcn_rcpf(1.0f + __builtin_amdgcn_exp2f(-1.4426950408889634f * v)); }
__device__ __forceinline__ void lru_pass1(unsigned char* ws, LAS unsigned char* lds, int layer, int chunk) {
    int tid_ = threadIdx.x; asm volatile("" : "+v"(tid_)); const int tid = tid_, lane = tid & 63, wave = __builtin_amdgcn_readfirstlane(tid >> 6); (void)tid; (void)lane; (void)wave;
    typedef float f32x16 __attribute__((ext_vector_type(16)));
    const float* par = (const float*)(ws + WS_PAR);
    const int b = chunk >> 6, t0 = (chunk & 63) * 64; const size_t g0 = (size_t)b * SEQ + t0;
    LAS unsigned char* wl = lds + RING_OFF + wave * 16384;
    LAS bf16* U = (LAS bf16*)wl;
    LAS float* Gs = (LAS float*)(wl + 4608);
    const bf16* RIN = (const bf16*)(ws + WS_RIN); bf16* HL = (bf16*)(ws + WS_HL); bf16* LP = (bf16*)(ws + WS_LP);
    const int r32 = lane & 31, hi = lane >> 5;
    float h = 0.f, lpc = 0.f, xm3 = 0.f, xm2 = 0.f, xm1 = 0.f;
    v4u pre[4];
#define LRU_LOAD(nb_, tg_) do { _Pragma("unroll") for (int i = 0; i < 4; ++i) pre[i] = *(const v4u*)(RIN + (g0 + (tg_) * 32 + (lane >> 3) + 8 * i) * D + 64 * (2 * wave + (nb_)) + 8 * (lane & 7)); } while (0)
    LRU_LOAD(0, 0);
    for (int it = 0; it < 4; ++it) { const int nb = it >> 1, tg = it & 1;
        const int n = 2 * wave + nb, ch = 64 * n + lane;
        const float* cw = par + PO_CONVW + (size_t)layer * 4 * D;
        const float cw0 = cw[ch], cw1 = cw[D + ch], cw2 = cw[2 * D + ch], cw3 = cw[3 * D + ch], cb = par[PO_CONVB + layer * D + ch];
        const float ba = par[PO_LBA + layer * D + ch], bx = par[PO_LBX + layer * D + ch];
        const float lam = par[PO_LLAM + layer * D + ch];
        const float c8sp = -8.0f * 1.4426950408889634f * log1pf(__expf(-lam));
        const bf16* lw = (const bf16*)(ws + WS_LRUW) + (size_t)((layer * 16 + n) * 2) * 4096;
        if (tg == 0) { h = 0.f; lpc = 0.f; xm3 = 0.f; xm2 = 0.f; xm1 = 0.f;
            if (t0 > 0) { xm3 = bf2f(RIN[(g0 - 3) * D + ch]); xm2 = bf2f(RIN[(g0 - 2) * D + ch]); xm1 = bf2f(RIN[(g0 - 1) * D + ch]); } }
        const size_t gr = g0 + tg * 32;
        bf16x8 wf[2][2][4];
#pragma unroll
        for (int g = 0; g < 2; ++g)
#pragma unroll
            for (int dh = 0; dh < 2; ++dh)
#pragma unroll
                for (int ks = 0; ks < 4; ++ks) wf[g][dh][ks] = *(const bf16x8*)(lw + (size_t)g * 4096 + (32 * dh + r32) * 64 + 16 * ks + 8 * hi);
#pragma unroll
        for (int i = 0; i < 4; ++i) *(LAS v4u*)(U + ((lane >> 3) + 8 * i) * 72 + 8 * (lane & 7)) = pre[i];
        LDS_WAIT();
        if (it < 3) LRU_LOAD((it + 1) >> 1, (it + 1) & 1);
        float u[32];
#pragma unroll
        for (int t = 0; t < 32; ++t) { const float x = bf2f(U[t * 72 + lane]); u[t] = cb + cw0 * xm3 + cw1 * xm2 + cw2 * xm1 + cw3 * x; xm3 = xm2; xm2 = xm1; xm1 = x; U[t * 72 + lane] = bf1(u[t]); }
        LDS_WAIT();
        float gp[2][32];
#pragma unroll
        for (int g = 0; g < 2; ++g) {
            f32x16 c0 = {}, c1 = {};
#pragma unroll
            for (int ks = 0; ks < 4; ++ks) { const bf16x8 a = *(const LAS bf16x8*)(U + r32 * 72 + 16 * ks + 8 * hi);
                c0 = __builtin_amdgcn_mfma_f32_32x32x16_bf16(a, wf[g][0][ks], c0, 0, 0, 0); c1 = __builtin_amdgcn_mfma_f32_32x32x16_bf16(a, wf[g][1][ks], c1, 0, 0, 0); }
#pragma unroll
            for (int r = 0; r < 16; ++r) { const int row = (r & 3) + 8 * (r >> 2) + 4 * hi; Gs[row * 64 + r32] = c0[r]; Gs[row * 64 + 32 + r32] = c1[r]; }
            LDS_WAIT();
#pragma unroll
            for (int t = 0; t < 32; ++t) gp[g][t] = Gs[t * 64 + lane];
            LDS_WAIT();
        }
        LAS bf16* S2 = (LAS bf16*)Gs;
#pragma unroll
        for (int t = 0; t < 32; ++t) { const float rr = sigm_fast(gp[0][t] + ba), ii = sigm_fast(gp[1][t] + bx), la = c8sp * rr, a = __builtin_amdgcn_exp2f(la);
            const float bb = __builtin_amdgcn_sqrtf(fmaxf(0.f, 1.0f - a * a)) * ii * u[t];
            h = a * h + bb; lpc += la; U[t * 72 + lane] = bf1(h); S2[t * 72 + lane] = bf1(lpc); }
        LDS_WAIT();
#pragma unroll
        for (int i = 0; i < 4; ++i) { const int row = i * 8 + (lane >> 3), cc = lane & 7;
            const v4u a = *(const LAS v4u*)(U + row * 72 + cc * 8), c = *(const LAS v4u*)(S2 + row * 72 + cc * 8);
            *(v4u*)(HL + (gr + row) * D + 64 * n + cc * 8) = a; *(v4u*)(LP + (gr + row) * D + 64 * n + cc * 8) = c; }
        LDS_WAIT();
        if (tg == 1) { float* sum = (float*)(ws + WS_SUM) + (size_t)chunk * 2 * D; sum[ch] = lpc; sum[D + ch] = h; }
    }
#undef LRU_LOAD
}

__device__ __forceinline__ void tp_mix(unsigned char* ws, LAS unsigned char* lds, int layer, int chunk) {
    int tid_ = threadIdx.x; asm volatile("" : "+v"(tid_)); const int tid = tid_, lane = tid & 63, wave = __builtin_amdgcn_readfirstlane(tid >> 6); (void)tid; (void)lane; (void)wave;
    const float* par = (const float*)(ws + WS_PAR);
    LAS float* carry = (LAS float*)(lds + RING_OFF);
    { const float* sum = (const float*)(ws + WS_SUM);
      for (int ch = tid; ch < D; ch += NWAVES * 64) { float c = 0.f;
          const float* sp = sum + (size_t)(chunk & ~63) * 2 * D + ch; const int n = chunk & 63; int cc = 0;
          for (; cc + 8 <= n; cc += 8) { float la[8], bb[8];
#pragma unroll
              for (int k = 0; k < 8; ++k) { la[k] = sp[(size_t)(cc + k) * 2 * D]; bb[k] = sp[(size_t)(cc + k) * 2 * D + D]; }
#pragma unroll
              for (int k = 0; k < 8; ++k) c = __builtin_amdgcn_exp2f(la[k]) * c + bb[k]; }
          for (; cc < n; ++cc) c = __builtin_amdgcn_exp2f(sp[(size_t)cc * 2 * D]) * c + sp[(size_t)cc * 2 * D + D];
          carry[ch] = c; } }
    __syncthreads();
    const int b = chunk >> 6, t0 = (chunk & 63) * 64; const size_t g0 = (size_t)b * SEQ + t0;
    for (int rr = wave; rr < 64; rr += 2 * NWAVES) {
        v4u hl[2][2], lp[2][2], gg[2][2];
#pragma unroll
        for (int q = 0; q < 2; ++q) { const size_t ro = (g0 + rr + q * NWAVES) * D * 2;
#pragma unroll
            for (int j = 0; j < 2; ++j) { hl[q][j] = ((const v4u*)(ws + WS_HL + ro))[lane + 64 * j]; lp[q][j] = ((const v4u*)(ws + WS_LP + ro))[lane + 64 * j]; gg[q][j] = ((const v4u*)(ws + WS_GG + ro))[lane + 64 * j]; } }
#pragma unroll
        for (int q = 0; q < 2; ++q) { const size_t ro = (g0 + rr + q * NWAVES) * D * 2;
#pragma unroll
            for (int j = 0; j < 2; ++j) { const LAS f32x4* c4 = (const LAS f32x4*)carry + 128 * j + 2 * lane;
                const f32x4 l0 = bfl4(lp[q][j]), l1 = bfh4(lp[q][j]);
                const f32x4 e0 = {__builtin_amdgcn_exp2f(l0.x), __builtin_amdgcn_exp2f(l0.y), __builtin_amdgcn_exp2f(l0.z), __builtin_amdgcn_exp2f(l0.w)}, e1 = {__builtin_amdgcn_exp2f(l1.x), __builtin_amdgcn_exp2f(l1.y), __builtin_amdgcn_exp2f(l1.z), __builtin_amdgcn_exp2f(l1.w)};
                ((v4u*)(ws + WS_YA + ro))[lane + 64 * j] = pk8bf((bfl4(hl[q][j]) + e0 * c4[0]) * bfl4(gg[q][j]), (bfh4(hl[q][j]) + e1 * c4[1]) * bfh4(gg[q][j])); } }
    }
    __syncthreads();
}

template <bool DRY> __device__ __forceinline__ void route_row(unsigned char* ws, const LAS float* rwT, const f32x4 (&hn)[2][2], int m, int lane) {
    gu32* ctl = (gu32*)(ws + WS_CTL);
    float lg[NEXP];
#pragma unroll
    for (int e = 0; e < NEXP; ++e) { float s = 0.f;
#pragma unroll
        for (int j = 0; j < 2; ++j) { const LAS f32x4* r4 = (const LAS f32x4*)(rwT + e * D + 512 * j) + 2 * lane; s += dot4(hn[j][0], r4[0]) + dot4(hn[j][1], r4[1]); }
        lg[e] = wave_sum(s); }
    int e0 = 0; float v0 = lg[0];
#pragma unroll
    for (int e = 1; e < NEXP; ++e) if (lg[e] > v0) { v0 = lg[e]; e0 = e; }
    int e1 = -1; float v1 = -INFINITY;
#pragma unroll
    for (int e = 0; e < NEXP; ++e) if (e != e0 && lg[e] > v1) { v1 = lg[e]; e1 = e; }
    const float w1 = 1.0f / (1.0f + __expf(v0 - v1)), w0 = 1.0f - w1;
    if (DRY) { if (w0 + w1 + (float)e0 + (float)e1 == -12345.f) ((float*)(ws + WS_BIG))[m] = w0; }
    if (lane == 0 && !DRY) { const int p0 = (int)__hip_atomic_fetch_add(ctl + CW_CNT + 64 * e0, 1u, RLX_AGENT), p1 = (int)__hip_atomic_fetch_add(ctl + CW_CNT + 64 * e1, 1u, RLX_AGENT);
        int* lst = (int*)(ws + WS_LIST); lst[e0 * T + p0] = m; lst[e1 * T + p1] = m;
        int* ti = (int*)(ws + WS_TOK) + (size_t)m * 8; ti[0] = e0; ti[1] = p0; ti[2] = e1; ti[3] = p1; ti[4] = __float_as_int(w0); ti[5] = __float_as_int(w1); }
}
template <int SRC, bool ROUTE, bool DRY = false, bool H8 = false, bool FINAL = false> __device__ __forceinline__ void tp_post_pre(unsigned char* ws, float* xres, LAS unsigned char* lds, const float* gpost, const float* gpre, int vcu, int G) {
    int tid_ = threadIdx.x; asm volatile("" : "+v"(tid_)); const int tid = tid_, lane = tid & 63, wave = __builtin_amdgcn_readfirstlane(tid >> 6); (void)tid; (void)lane; (void)wave;
    gu32* ctl = (gu32*)(ws + WS_CTL);
    LAS float* rwT = (LAS float*)(lds + RING_OFF);
    int ps[NEXP];
    if (ROUTE) { const float* rw = (const float*)(ws + WS_PAR) + PO_RW; for (int i = tid; i < D * NEXP; i += NWAVES * 64) rwT[(i & 7) * D + (i >> 3)] = rw[i]; __syncthreads(); }
    if (SRC == 1) { int acc = 0;
#pragma unroll
        for (int e = 0; e < NEXP; ++e) { ps[e] = acc; acc += ((int)__hip_atomic_load(ctl + CW_CNT + 64 * e, RLX_AGENT) + 255) >> 8; } }
    const int gw = vcu * NWAVES + wave, ngw = G * NWAVES;
    f32x4 gp[2][2], gq[2][2];
#pragma unroll
    for (int j = 0; j < 2; ++j)
#pragma unroll
        for (int h = 0; h < 2; ++h) { gp[j][h] = ((const f32x4*)gpost)[128 * j + 2 * lane + h]; gq[j][h] = gpre ? ((const f32x4*)gpre)[128 * j + 2 * lane + h] : (f32x4){0.f, 0.f, 0.f, 0.f}; }
    unsigned char* xo = ws + (DRY ? WS_BIG : WS_XR); unsigned char* ho = ws + (DRY ? WS_BIG + 2 * SLOT : WS_H);
    constexpr int NR = (ROUTE || SRC == 1) ? 2 : 8;
    const bool xl = (ngw == 2048);
#define TP_ROW_OF(k) (xl ? ((gw >> 8) << 11) + (gw & 255) + ((k) << 8) : gw + (k) * ngw)
    for (int k0 = 0; TP_ROW_OF(k0) < T && k0 * ngw < T; k0 += NR) {
        v4u fa[NR][2], fc[NR][2], xr[NR][2]; float w0[NR], w1[NR];
#pragma unroll
        for (int r = 0; r < NR; ++r) { const int m = TP_ROW_OF(k0 + r); if ((k0 + r) * ngw < T && m < T) {
            if (SRC == 0) { const v4u* p = (const v4u*)(ws + WS_F + (size_t)m * D * 2) + lane; fa[r][0] = p[0]; fa[r][1] = p[64]; }
            else { const int* ti = (const int*)(ws + WS_TOK) + (size_t)m * 8; const int e0 = ti[0], p0 = ti[1], e1 = ti[2], p1 = ti[3]; w0[r] = __int_as_float(ti[4]); w1[r] = __int_as_float(ti[5]); int s0 = 0, s1 = 0;
#pragma unroll
                for (int e = 0; e < NEXP; ++e) { if (e == e0) s0 = ps[e]; if (e == e1) s1 = ps[e]; }
                const v4u* a = (const v4u*)(ws + WS_OE + ((size_t)s0 * 256 + p0) * D * 2) + lane; const v4u* c = (const v4u*)(ws + WS_OE + ((size_t)s1 * 256 + p1) * D * 2) + lane;
                fa[r][0] = a[0]; fa[r][1] = a[64]; fc[r][0] = c[0]; fc[r][1] = c[64]; }
            const v4u* xp = (const v4u*)(ws + WS_XR + (size_t)m * D * 2) + lane; xr[r][0] = xp[0]; xr[r][1] = xp[64]; } }
#pragma unroll
        for (int r = 0; r < NR; ++r) { const int m = TP_ROW_OF(k0 + r); if ((k0 + r) * ngw < T && m < T) {
            f32x4 f[2][2], xv[2][2]; float s = 0.f;
#pragma unroll
            for (int j = 0; j < 2; ++j) { f[j][0] = bfl4(fa[r][j]); f[j][1] = bfh4(fa[r][j]);
                if (SRC == 1) { f[j][0] = f[j][0] * w0[r] + bfl4(fc[r][j]) * w1[r]; f[j][1] = f[j][1] * w0[r] + bfh4(fc[r][j]) * w1[r]; }
                s += dot4(f[j][0], f[j][0]) + dot4(f[j][1], f[j][1]); }
            const float rs = rsqrtf(wave_sum(s) * (1.f / D) + EPS); float s2 = 0.f;
#pragma unroll
            for (int j = 0; j < 2; ++j) { xv[j][0] = bfl4(xr[r][j]) + f[j][0] * rs * gp[j][0]; xv[j][1] = bfh4(xr[r][j]) + f[j][1] * rs * gp[j][1];
                if (FINAL && !DRY) { f32x4* o = (f32x4*)(xres + (size_t)m * D) + 128 * j + 2 * lane; o[0] = xv[j][0]; o[1] = xv[j][1]; }
                else ((v4u*)(xo + (size_t)m * D * 2))[lane + 64 * j] = pk8bf(xv[j][0], xv[j][1]);
                s2 += dot4(xv[j][0], xv[j][0]) + dot4(xv[j][1], xv[j][1]); }
            if (gpre) { const float rs2 = rsqrtf(wave_sum(s2) * (1.f / D) + EPS);
#pragma unroll
                for (int j = 0; j < 2; ++j) { xv[j][0] = xv[j][0] * rs2 * gq[j][0]; xv[j][1] = xv[j][1] * rs2 * gq[j][1];
                    if (H8) { u32x2 w; w.x = pk4f8(xv[j][0].x * SC_H, xv[j][0].y * SC_H, xv[j][0].z * SC_H, xv[j][0].w * SC_H); w.y = pk4f8(xv[j][1].x * SC_H, xv[j][1].y * SC_H, xv[j][1].z * SC_H, xv[j][1].w * SC_H);
                        ((u32x2*)(ho + (size_t)m * D))[lane + 64 * j] = w; }
                    else ((v4u*)(ho + (size_t)m * D * 2))[lane + 64 * j] = pk8bf(xv[j][0], xv[j][1]); }
                if (ROUTE) route_row<DRY>(ws, rwT, xv, m, lane); } } }
    }
#undef TP_ROW_OF
    if (ROUTE) __syncthreads();
}

__device__ __forceinline__ void pm0_moe_setup(unsigned char* ws, const float* mg, const float* mu, const float* md, LAS unsigned char* lds, int vcu, int G) {
    int tid_ = threadIdx.x; asm volatile("" : "+v"(tid_)); const int tid = tid_, lane = tid & 63, wave = __builtin_amdgcn_readfirstlane(tid >> 6); (void)tid; (void)lane; (void)wave;
    gu32* ctl = (gu32*)(ws + WS_CTL);
    LAS float* scr = (LAS float*)(lds + RING_OFF + wave * 16384);
    const int gw = vcu * NWAVES + wave, ngw = G * NWAVES;
    int cs[NEXP + 1], ps[NEXP]; { int a = 0, p = 0;
#pragma unroll
        for (int e = 0; e < NEXP; ++e) { const int c = (int)__hip_atomic_load(ctl + CW_CNT + 64 * e, RLX_AGENT); cs[e] = a; ps[e] = p; a += c; p += (c + 255) >> 8; } cs[NEXP] = a; }
    const int* lst = (const int*)(ws + WS_LIST);
    for (int i = gw; i < cs[NEXP]; i += ngw) { int e = 0, base = 0, pst = 0;
#pragma unroll
        for (int k = 0; k < NEXP; ++k) if (i >= cs[k]) { e = k; base = cs[k]; pst = ps[k]; }
        const int pos = i - base, tok = lst[e * T + pos];
        ((v4u*)(ws + WS_HG + ((size_t)pst * 256 + pos) * D))[lane] = ((const v4u*)(ws + WS_H + (size_t)tok * D))[lane]; }
    { struct Dec { const float* mg; const float* mu; const float* md; unsigned char* ws;
          __device__ __forceinline__ TrItem operator()(int f) const {
              constexpr int I_FF = (D / 64) * (FF / 32);
              const int e = f / (3 * I_FF); int r = f - e * 3 * I_FF;
              if (r < I_FF) return tr_item<2>(mg + (size_t)e * D * FF, D, FF, (bf16*)(ws + WS_WMGU), e * 2 * FF, r, SC_WGU); r -= I_FF;
              if (r < I_FF) return tr_item<3>(mu + (size_t)e * D * FF, D, FF, (bf16*)(ws + WS_WMGU), e * 2 * FF, r, SC_WGU); r -= I_FF;
              return tr_item<0>(md + (size_t)e * FF * D, FF, D, (bf16*)(ws + WS_WMD), e * D, r, SC_WD); } };
      const Dec dec{mg, mu, md, ws}; tr_run<true>(dec, NEXP * 3 * (D / 64) * (FF / 32), scr, lane, gw, ngw); }
}
constexpr int NPH_L = 14, NPHASES = 1 + DEPTH * NPH_L;
__host__ __device__ constexpr bool phase_exists(int ph) { return ph == 0 || !((((ph - 1) % NPH_L) == 9 || ((ph - 1) % NPH_L) == 10) || (((ph - 1) / NPH_L) % 2 == 0 && ((ph - 1) % NPH_L) == 6)); }

__global__ void __launch_bounds__(NWAVES * 64, 2) mk_fwd(Args args) {
    extern __shared__ __attribute__((aligned(16))) unsigned char lds_raw[];
    LAS unsigned char* lds = (LAS unsigned char*)lds_raw;
    volatile LAS unsigned* MISC = (volatile LAS unsigned*)(lds + MISC_OFF);
    const int tid = threadIdx.x;
    const int Gk = gridDim.x; const int bxk = blockIdx.x; const int vcuk = (Gk % 8 == 0) ? (bxk % 8) * (Gk / 8) + bxk / 8 : bxk;
    for (int u = tid; u < (LDS_BYTES - LDSCTL_OFF) / 4; u += NWAVES * 64) ((LAS unsigned*)(lds + LDSCTL_OFF))[u] = 0u;
    __syncthreads();
    XcdBarrier bar; bar.bar = (unsigned*)(args.ws + WS_CTL) + CW_BAR; bar.x = 0; bar.st = nullptr;
    if (!MK_MULTI) bar = xcd_barrier_post((unsigned*)(args.ws + WS_CTL) + CW_BAR, MISC + 8);
    const int lo = args.ph_lo, hi = args.ph_hi;
#ifndef DIS
#define DIS 0
#endif
#ifndef REPN
#define REPN 1
#endif
#ifndef REP
#define REP 0
#endif
#define EN(b) (!((DIS >> (b)) & 1))
#define IN(k) (lo <= (k) && (k) < hi)
#define PH_WS int z_ = 0, G = Gk, bx = bxk, vcu = vcuk; asm volatile("" : "+s"(z_), "+s"(G), "+s"(bx), "+s"(vcu)); unsigned char* ws = (unsigned char*)((GAS unsigned char*)args.ws + z_); (void)ws; (void)G; (void)bx; (void)vcu
#define XOUT ((float*)((GAS float*)args.out + z_))
#define GIN(k) ((const float*)((const GAS float*)args.in[k] + z_))
#define SEAM(k) do { if ((k) + 1 < hi) { if (MK_MULTI) { if (tid == 0) __hip_atomic_store((gu32*)(ws + WS_CTL) + CW_TMO, 0xBADBA0u, RLX_AGENT); } else xcd_barrier(bar); } } while (0)

    if (EN(0) && IN(0)) { PH_WS;
#if (REP >> 0) & 1
            for (int repn_ = 0; repn_ < REPN; ++repn_)
        { p0_prologue(args, lds, vcu, G); }
        __syncthreads();
#endif
        p0_prologue(args, lds, vcu, G);
        SEAM(0); }

    for (int l = 0; l < DEPTH; ++l) {
        const int pb = 1 + NPH_L * l;
        if (EN(1) && IN(pb + 0)) { PH_WS;
#if (REP >> 1) & 1
            for (int repn_ = 0; repn_ < REPN; ++repn_)
            { unsigned char* wl = ws + WS_WSMALL + (size_t)l * WL_STRIDE;
            pg8::Gemm g{(const pg8::bf16_t*)(ws + WS_H), (const pg8::bf16_t*)(wl + WL_WIN), T, DIN, D}; pg8::StaticOrder S; S.init(T, DIN, G, bx);
            pg8::EpiInProj E{(pg8::bf16_t*)(ws + WS_BIG), SLOT / 2, (const float*)(ws + WS_COS), attn_body::C2};
#ifdef STAGGER_US
            if (bx & 1) { const unsigned long long t0_ = __builtin_amdgcn_s_memrealtime(); while (__builtin_amdgcn_s_memrealtime() - t0_ < (unsigned long long)(STAGGER_US * 100)) __builtin_amdgcn_s_sleep(8); }
#endif
            pg8::gemm_phase<pg8::EpiInProj, pg8::StaticOrder, false, true>(lds + RING_OFF, g, S, E);
            }
            __syncthreads();
#endif
            unsigned char* wl = ws + WS_WSMALL + (size_t)l * WL_STRIDE;
            pg8::Gemm g{(const pg8::bf16_t*)(ws + WS_H), (const pg8::bf16_t*)(wl + WL_WIN), T, DIN, D}; pg8::StaticOrder S; S.init(T, DIN, G, bx);
            pg8::EpiInProj E{(pg8::bf16_t*)(ws + WS_BIG), SLOT / 2, (const float*)(ws + WS_COS), attn_body::C2};
#ifdef STAGGER_US
            if (bx & 1) { const unsigned long long t0_ = __builtin_amdgcn_s_memrealtime(); while (__builtin_amdgcn_s_memrealtime() - t0_ < (unsigned long long)(STAGGER_US * 100)) __builtin_amdgcn_s_sleep(8); }
#endif
            pg8::gemm_phase<pg8::EpiInProj, pg8::StaticOrder, false, true>(lds + RING_OFF, g, S, E);

            SEAM(pb + 0);
        }
        if (EN(2) && IN(pb + 1)) { PH_WS;
#if (REP >> 2) & 1
            for (int repn_ = 0; repn_ < REPN; ++repn_)
            {
#if !defined(NO_LRU) && !defined(DUP_NO_LRU)
            for (int c = vcu; c < 256; c += G) lru_pass1(ws, lds, l, c);
            __syncthreads();
#endif
#if !defined(NO_ATT) && !defined(DUP_NO_ATT)
            const attn_body::AttnTensors AT{(const attn_body::bf16*)(ws + WS_Q), (const attn_body::bf16*)(ws + WS_K), (const attn_body::bf16*)(ws + WS_V), (attn_body::bf16*)(ws + WS_O2), (attn_body::bf16*)(ws + WS_YB)};
            { const float* par = (const float*)(ws + WS_PAR); const float* dl = par + PO_DLAM + l * 256; int t_ = threadIdx.x; asm volatile("" : "+v"(t_)); const int ln_ = t_ & 63;
              const float lamv = expf(wave_sum(dl[ln_] * dl[64 + ln_])) - expf(wave_sum(dl[128 + ln_] * dl[192 + ln_])) + (0.8f - 0.6f * expf(-0.3f * (float)l));
              attn_body::attn_phase<8>((char*)lds_raw + RING_OFF, AT, lamv, par + PO_SUBGS + l * 128, vcu, G); }
#endif
            }
            __syncthreads();
#endif

#ifndef NO_LRU
            for (int c = vcu; c < 256; c += G) lru_pass1(ws, lds, l, c);
            __syncthreads();
#endif
#ifndef NO_ATT
            const attn_body::AttnTensors AT{(const attn_body::bf16*)(ws + WS_Q), (const attn_body::bf16*)(ws + WS_K), (const attn_body::bf16*)(ws + WS_V), (attn_body::bf16*)(ws + WS_O2), (attn_body::bf16*)(ws + WS_YB)};
            { const float* par = (const float*)(ws + WS_PAR); const float* dl = par + PO_DLAM + l * 256; int t_ = threadIdx.x; asm volatile("" : "+v"(t_)); const int ln_ = t_ & 63;
              const float lamv = expf(wave_sum(dl[ln_] * dl[64 + ln_])) - expf(wave_sum(dl[128 + ln_] * dl[192 + ln_])) + (0.8f - 0.6f * expf(-0.3f * (float)l));
              attn_body::attn_phase<8>((char*)lds_raw + RING_OFF, AT, lamv, par + PO_SUBGS + l * 128, vcu, G); }
#endif

            SEAM(pb + 1);
        }
        if (EN(3) && IN(pb + 2)) { PH_WS;
#if (REP >> 3) & 1
            for (int repn_ = 0; repn_ < REPN; ++repn_)
            { for (int c = vcu; c < 256; c += G) tp_mix(ws, lds, l, c); }
            __syncthreads();
#endif
            for (int c = vcu; c < 256; c += G) tp_mix(ws, lds, l, c);
            SEAM(pb + 2); }
        if (EN(4) && IN(pb + 3)) { PH_WS;
#if (REP >> 4) & 1
            for (int repn_ = 0; repn_ < REPN; ++repn_)
            { unsigned char* wl = ws + WS_WSMALL + (size_t)l * WL_STRIDE;
            pg8::Gemm g{(const pg8::bf16_t*)(ws + WS_YA), (const pg8::bf16_t*)(wl + WL_WAB), T, D, D}; pg8::PairOrder S; S.base.init(T, D, G, bx);
            pg8::EpiMerge E{(const pg8::bf16_t*)(ws + WS_SGA), (const pg8::bf16_t*)(ws + WS_SGB), (pg8::bf16_t*)(ws + WS_T1), (pg8::bf16_t*)(ws + WS_MERGED), NPAN};
            pg8::gemm_phase<pg8::EpiMerge, pg8::PairOrder, true, true>(lds + RING_OFF, g, S, E);
            }
            __syncthreads();
#endif
            unsigned char* wl = ws + WS_WSMALL + (size_t)l * WL_STRIDE;
            pg8::Gemm g{(const pg8::bf16_t*)(ws + WS_YA), (const pg8::bf16_t*)(wl + WL_WAB), T, D, D}; pg8::PairOrder S; S.base.init(T, D, G, bx);
            pg8::EpiMerge E{(const pg8::bf16_t*)(ws + WS_SGA), (const pg8::bf16_t*)(ws + WS_SGB), (pg8::bf16_t*)(ws + WS_T1), (pg8::bf16_t*)(ws + WS_MERGED), NPAN};
            pg8::gemm_phase<pg8::EpiMerge, pg8::PairOrder, true, true>(lds + RING_OFF, g, S, E);

            SEAM(pb + 3);
        }
        if (EN(5) && IN(pb + 4)) { PH_WS;
#if (REP >> 5) & 1
            for (int repn_ = 0; repn_ < REPN; ++repn_)
            { unsigned char* wl = ws + WS_WSMALL + (size_t)l * WL_STRIDE;
            pg8::Gemm g{(const pg8::bf16_t*)(ws + WS_MERGED), (const pg8::bf16_t*)(wl + WL_WO), T, D, D}; pg8::StaticOrder S; S.init(T, D, G, bx);
            pg8::EpiPlainBf16 E{(pg8::bf16_t*)(ws + WS_F), D, 3};
            pg8::gemm_phase<pg8::EpiPlainBf16, pg8::StaticOrder, false, true>(lds + RING_OFF, g, S, E);
            }
            __syncthreads();
#endif
            unsigned char* wl = ws + WS_WSMALL + (size_t)l * WL_STRIDE;
            pg8::Gemm g{(const pg8::bf16_t*)(ws + WS_MERGED), (const pg8::bf16_t*)(wl + WL_WO), T, D, D}; pg8::StaticOrder S; S.init(T, D, G, bx);
            pg8::EpiPlainBf16 E{(pg8::bf16_t*)(ws + WS_F), D, 3};
            pg8::gemm_phase<pg8::EpiPlainBf16, pg8::StaticOrder, false, true>(lds + RING_OFF, g, S, E);

            SEAM(pb + 4);
        }
        if (EN(6) && IN(pb + 5)) { PH_WS;
#if (REP >> 6) & 1
            for (int repn_ = 0; repn_ < REPN; ++repn_)
            { const float* ng = (const float*)(ws + WS_PAR) + PO_NORMG + (size_t)l * 6 * D;
            if (l & 1) tp_post_pre<0, true, true, true>(ws, XOUT, lds, ng + 1 * D, ng + 2 * D, vcu, G);
            else tp_post_pre<0, false, true>(ws, XOUT, lds, ng + 1 * D, ng + 2 * D, vcu, G);
            }
            __syncthreads();
#endif
            const float* ng = (const float*)(ws + WS_PAR) + PO_NORMG + (size_t)l * 6 * D;
            if (l & 1) tp_post_pre<0, true, false, true>(ws, XOUT, lds, ng + 1 * D, ng + 2 * D, vcu, G);
            else tp_post_pre<0, false>(ws, XOUT, lds, ng + 1 * D, ng + 2 * D, vcu, G);

            SEAM(pb + 5);
        }
        if (!(l & 1)) {
            if (EN(7) && IN(pb + 7)) { PH_WS;
#if (REP >> 7) & 1
            for (int repn_ = 0; repn_ < REPN; ++repn_)
                {
                pg8::Gemm g{(const pg8::bf16_t*)(ws + WS_H), (const pg8::bf16_t*)(ws + WS_WGU), T, 2 * FF, D}; pg8::StaticOrder S; S.init(T, 2 * FF, G, bx);
                pg8::EpiSwiGLU E{(pg8::bf16_t*)(ws + WS_ACT), FF, 2 * FF / 256, 0};
#ifdef STAGGER_US
            if (bx & 1) { const unsigned long long t0_ = __builtin_amdgcn_s_memrealtime(); while (__builtin_amdgcn_s_memrealtime() - t0_ < (unsigned long long)(STAGGER_US * 100)) __builtin_amdgcn_s_sleep(8); }
#endif
                pg8::gemm_phase<pg8::EpiSwiGLU, pg8::StaticOrder, true, true>(lds + RING_OFF, g, S, E);
                }
                __syncthreads();
#endif

                pg8::Gemm g{(const pg8::bf16_t*)(ws + WS_H), (const pg8::bf16_t*)(ws + WS_WGU), T, 2 * FF, D}; pg8::StaticOrder S; S.init(T, 2 * FF, G, bx);
                pg8::EpiSwiGLU E{(pg8::bf16_t*)(ws + WS_ACT), FF, 2 * FF / 256, 0};
#ifdef STAGGER_US
            if (bx & 1) { const unsigned long long t0_ = __builtin_amdgcn_s_memrealtime(); while (__builtin_amdgcn_s_memrealtime() - t0_ < (unsigned long long)(STAGGER_US * 100)) __builtin_amdgcn_s_sleep(8); }
#endif
                pg8::gemm_phase<pg8::EpiSwiGLU, pg8::StaticOrder, true, true>(lds + RING_OFF, g, S, E);

                SEAM(pb + 7);
            }
            if (EN(8) && IN(pb + 8)) { PH_WS;
#if (REP >> 8) & 1
            for (int repn_ = 0; repn_ < REPN; ++repn_)
                {
                pg8::Gemm g{(const pg8::bf16_t*)(ws + WS_ACT), (const pg8::bf16_t*)(ws + WS_WD), T, D, FF}; pg8::StaticOrder S; S.init(T, D, G, bx);
                pg8::EpiPlainBf16 E{(pg8::bf16_t*)(ws + WS_F), D, 3};
                pg8::gemm_phase<pg8::EpiPlainBf16, pg8::StaticOrder, false, true>(lds + RING_OFF, g, S, E);
                }
                __syncthreads();
#endif

                pg8::Gemm g{(const pg8::bf16_t*)(ws + WS_ACT), (const pg8::bf16_t*)(ws + WS_WD), T, D, FF}; pg8::StaticOrder S; S.init(T, D, G, bx);
                pg8::EpiPlainBf16 E{(pg8::bf16_t*)(ws + WS_F), D, 3};
                pg8::gemm_phase<pg8::EpiPlainBf16, pg8::StaticOrder, false, true>(lds + RING_OFF, g, S, E);

                SEAM(pb + 8);
            }
            if (EN(9) && IN(pb + 11)) { PH_WS;
#if (REP >> 9) & 1
            for (int repn_ = 0; repn_ < REPN; ++repn_)
                { const float* ng = (const float*)(ws + WS_PAR) + PO_NORMG + (size_t)l * 6 * D;
                tp_post_pre<0, false, true>(ws, XOUT, lds, ng + 3 * D, ng + 4 * D, vcu, G); }
                __syncthreads();
#endif
                const float* ng = (const float*)(ws + WS_PAR) + PO_NORMG + (size_t)l * 6 * D;
                tp_post_pre<0, false>(ws, XOUT, lds, ng + 3 * D, ng + 4 * D, vcu, G);
                SEAM(pb + 11); }
        } else {
            if (EN(10) && IN(pb + 6)) { PH_WS;
#if (REP >> 10) & 1
            for (int repn_ = 0; repn_ < REPN; ++repn_)
                { pm0_moe_setup(ws, GIN(I_MG), GIN(I_MU), GIN(I_MD), lds, vcu, G); }
                __syncthreads();
#endif
                pm0_moe_setup(ws, GIN(I_MG), GIN(I_MU), GIN(I_MD), lds, vcu, G);
                SEAM(pb + 6); }
            if (EN(11) && IN(pb + 7)) { PH_WS; gu32* ctl = (gu32*)(ws + WS_CTL);
                int ps[NEXP + 1]; { int p = 0;
#pragma unroll
                    for (int e = 0; e < NEXP; ++e) { ps[e] = p; p += ((int)__hip_atomic_load(ctl + CW_CNT + 64 * e, RLX_AGENT) + 255) >> 8; } ps[NEXP] = p; }
#if (REP >> 11) & 1
                for (int rep_ = 0; rep_ < 2; ++rep_)
#endif
                {
                pg8::Gemm g{(const pg8::bf16_t*)(ws + WS_HG), (const pg8::bf16_t*)(ws + WS_WMGU), ps[NEXP] * 256, 2 * FF, D / 2, E8_H, E8_WGU};
                pg8::MoeOrder S; S.base.init(ps[NEXP] * 256, 2 * FF, G, bx); S.plo = 0; S.ps1 = ps[1]; S.ps2 = ps[2]; S.ps3 = ps[3]; S.ps4 = ps[4]; S.ps5 = ps[5]; S.ps6 = ps[6]; S.ps7 = ps[7];
                pg8::EpiSwiGLU8 E{ws + WS_ACT8, FF, 2 * FF / 256, 0, SC_ACT};
#ifdef STAGGER_US
            if (bx & 1) { const unsigned long long t0_ = __builtin_amdgcn_s_memrealtime(); while (__builtin_amdgcn_s_memrealtime() - t0_ < (unsigned long long)(STAGGER_US * 100)) __builtin_amdgcn_s_sleep(8); }
#endif
                pg8::gemm_phase<pg8::EpiSwiGLU8, pg8::MoeOrder, true, true, true>(lds + RING_OFF, g, S, E);
                }
                SEAM(pb + 7);
            }
            if (EN(12) && IN(pb + 8)) { PH_WS; gu32* ctl = (gu32*)(ws + WS_CTL);
                int ps[NEXP + 1]; { int p = 0;
#pragma unroll
                    for (int e = 0; e < NEXP; ++e) { ps[e] = p; p += ((int)__hip_atomic_load(ctl + CW_CNT + 64 * e, RLX_AGENT) + 255) >> 8; } ps[NEXP] = p; }
#if (REP >> 12) & 1
                for (int rep_ = 0; rep_ < 2; ++rep_)
#endif
                {
                pg8::Gemm g{(const pg8::bf16_t*)(ws + WS_ACT8), (const pg8::bf16_t*)(ws + WS_WMD), ps[NEXP] * 256, D, FF / 2, E8_ACT, E8_WD};
                pg8::MoeOrder S; S.base.init(ps[NEXP] * 256, D, G, bx); S.plo = 0; S.ps1 = ps[1]; S.ps2 = ps[2]; S.ps3 = ps[3]; S.ps4 = ps[4]; S.ps5 = ps[5]; S.ps6 = ps[6]; S.ps7 = ps[7];
                pg8::EpiPlainBf16 E{(pg8::bf16_t*)(ws + WS_OE), D, 3};
                pg8::gemm_phase<pg8::EpiPlainBf16, pg8::MoeOrder, true, true, true>(lds + RING_OFF, g, S, E);
                }
                SEAM(pb + 8);
            }
            if (EN(13) && IN(pb + 11)) { PH_WS;
#if (REP >> 13) & 1
            for (int repn_ = 0; repn_ < REPN; ++repn_)
                { const float* ng = (const float*)(ws + WS_PAR) + PO_NORMG + (size_t)l * 6 * D;
                tp_post_pre<1, false, true>(ws, XOUT, lds, ng + 3 * D, ng + 4 * D, vcu, G); }
                __syncthreads();
#endif
                const float* ng = (const float*)(ws + WS_PAR) + PO_NORMG + (size_t)l * 6 * D;
                tp_post_pre<1, false>(ws, XOUT, lds, ng + 3 * D, ng + 4 * D, vcu, G);
                SEAM(pb + 11); }
        }
        if (EN(14) && IN(pb + 12)) { PH_WS;
#if (REP >> 14) & 1
            for (int repn_ = 0; repn_ < REPN; ++repn_)
            { unsigned char* wl = ws + WS_WSMALL + (size_t)l * WL_STRIDE;
            { pg8::Gemm g{(const pg8::bf16_t*)(ws + WS_PB) + (size_t)l * T * PLE, (const pg8::bf16_t*)(wl + WL_WPP), T, D, PLE}; pg8::StaticOrder S; S.init(T, D, G, bx);
              pg8::EpiPlainBf16 E{(pg8::bf16_t*)(ws + WS_PP), D, 3};
              pg8::gemm_phase<pg8::EpiPlainBf16, pg8::StaticOrder, false, true>(lds + RING_OFF, g, S, E); }
            __syncthreads();
            { pg8::Gemm g{(const pg8::bf16_t*)(ws + WS_H), (const pg8::bf16_t*)(wl + WL_WPG), T, D, D}; pg8::StaticOrder S; S.init(T, D, G, bx);
              pg8::EpiPleGate E{(pg8::bf16_t*)(ws + WS_F), (const pg8::bf16_t*)(ws + WS_PP), D};
              pg8::gemm_phase<pg8::EpiPleGate, pg8::StaticOrder, false, true>(lds + RING_OFF, g, S, E); }
            }
            __syncthreads();
#endif
            unsigned char* wl = ws + WS_WSMALL + (size_t)l * WL_STRIDE;
            { pg8::Gemm g{(const pg8::bf16_t*)(ws + WS_PB) + (size_t)l * T * PLE, (const pg8::bf16_t*)(wl + WL_WPP), T, D, PLE}; pg8::StaticOrder S; S.init(T, D, G, bx);
              pg8::EpiPlainBf16 E{(pg8::bf16_t*)(ws + WS_PP), D, 3};
              pg8::gemm_phase<pg8::EpiPlainBf16, pg8::StaticOrder, false, true>(lds + RING_OFF, g, S, E); }
            __syncthreads();
            { pg8::Gemm g{(const pg8::bf16_t*)(ws + WS_H), (const pg8::bf16_t*)(wl + WL_WPG), T, D, D}; pg8::StaticOrder S; S.init(T, D, G, bx);
              pg8::EpiPleGate E{(pg8::bf16_t*)(ws + WS_F), (const pg8::bf16_t*)(ws + WS_PP), D};
              pg8::gemm_phase<pg8::EpiPleGate, pg8::StaticOrder, false, true>(lds + RING_OFF, g, S, E); }

            SEAM(pb + 12);
        }
        if (EN(15) && IN(pb + 13)) { PH_WS;
#if (REP >> 15) & 1
            for (int repn_ = 0; repn_ < REPN; ++repn_)
            { const float* ng = (const float*)(ws + WS_PAR) + PO_NORMG + (size_t)l * 6 * D;
            tp_post_pre<0, false, true>(ws, XOUT, lds, ng + 5 * D, (l + 1 < DEPTH) ? ng + 6 * D : nullptr, vcu, G); }
            __syncthreads();
#endif
            const float* ng = (const float*)(ws + WS_PAR) + PO_NORMG + (size_t)l * 6 * D;
            if (l + 1 < DEPTH) tp_post_pre<0, false>(ws, XOUT, lds, ng + 5 * D, ng + 6 * D, vcu, G);
            else tp_post_pre<0, false, false, false, true>(ws, XOUT, lds, ng + 5 * D, nullptr, vcu, G);
            SEAM(pb + 13); }
    }
#undef IN
#undef SEAM
#undef PH_WS
}

extern "C" void kernel_launch(void* const* d_in, const int* in_sizes, int n_in, void* d_out, int out_size, void* d_ws, size_t ws_size, hipStream_t stream) {
    static int grid = 0;
    if (grid == 0) {
        if (n_in != 26 || in_sizes[0] != T * D || out_size != T * D || ws_size < WS_END) { fprintf(stderr, "kernel_launch: unexpected shapes / workspace (n_in %d, in0 %d, out %d, ws %zu < %zu); nothing launched\n", n_in, n_in > 0 ? in_sizes[0] : -1, out_size, ws_size, (size_t)WS_END); grid = -1; return; }
        int dev = 0, cus = 0, per_cu = 0;
        if (hipGetDevice(&dev) != hipSuccess || hipDeviceGetAttribute(&cus, hipDeviceAttributeMultiprocessorCount, dev) != hipSuccess) { grid = -1; return; }
        if (hipFuncSetAttribute((const void*)mk_fwd, hipFuncAttributeMaxDynamicSharedMemorySize, LDS_BYTES) != hipSuccess) { fprintf(stderr, "kernel_launch: hipFuncSetAttribute failed\n"); grid = -1; return; }
        if (hipOccupancyMaxActiveBlocksPerMultiprocessor(&per_cu, (const void*)mk_fwd, NWAVES * 64, LDS_BYTES) != hipSuccess || per_cu < 1) { fprintf(stderr, "kernel_launch: occupancy query reports %d workgroups per CU\n", per_cu); (void)hipGetLastError(); grid = -1; return; }
        grid = cus;
    }
    if (grid < 0) return;
    if (hipMemsetAsync((char*)d_ws + WS_CTL, 0, CTL_ZERO_BYTES, stream) != hipSuccess) return;
    Args a{};
    for (int i = 0; i < 26; ++i) a.in[i] = d_in[i];
    a.out = (float*)d_out; a.ws = (unsigned char*)d_ws;
#if MK_MULTI
    for (int ph = 0; ph < NPHASES; ++ph) { if (!phase_exists(ph)) continue; a.ph_lo = ph; a.ph_hi = ph + 1; hipLaunchKernelGGL(mk_fwd, dim3(grid), dim3(NWAVES * 64), LDS_BYTES, stream, a); }
#else
    a.ph_lo = 0; a.ph_hi = NPHASES;
    hipLaunchKernelGGL(mk_fwd, dim3(grid), dim3(NWAVES * 64), LDS_BYTES, stream, a);
#endif
}
```

```cpp
#include <hip/hip_runtime.h>
#include <hip/hip_bf16.h>
#include <cstdio>
#include <cstdint>
#include <cmath>
namespace pg8 {
#define PG8_LAS __attribute__((address_space(3)))
typedef unsigned short bf16_t;
typedef short bf16x8 __attribute__((ext_vector_type(8)));
typedef float f32x4 __attribute__((ext_vector_type(4)));
typedef unsigned u32x4 __attribute__((ext_vector_type(4)));
constexpr int BM = 256, BK = 64, HALF = 128, HTB = HALF * BK * 2  , STAGE_BYTES = 8 * HTB, NXCD = 8, WGM = 8;

__host__ __device__ __forceinline__ int lds_byte(int r, int c) { const int st = (r >> 4) * 2 + (c >> 5), rr = r & 15, cc = c & 31, ob = rr * 64 + cc * 2; return st * 1024 + (ob ^ (((ob >> 9) & 1) << 5)); }
__host__ __device__ __forceinline__ void stage_rc(int b, int& R, int& C) { const int st = b / 1024, sb = b % 1024, swz = sb ^ (((sb >> 9) & 1) << 5); R = (st >> 1) * 16 + swz / 64; C = (st & 1) * 32 + (swz % 64) / 2; }
__host__ __device__ __forceinline__ int perm32(int rho) { const int n = rho >> 4, i = rho & 15; return 8 * (i >> 2) + 4 * n + (i & 3); }

struct Unit { int pm, pn; int ko = 0; };
typedef int v4i_t __attribute__((ext_vector_type(4)));
typedef int v8i_t __attribute__((ext_vector_type(8)));
struct Gemm { const bf16_t* A; const bf16_t* Bt; int M, N, K; int sa = 0x7f7f7f7f, sb = 0x7f7f7f7f; int ld = 0; };

struct StaticOrder {
    int nM, nN, nwg, G, c;
    __host__ __device__ void init(int M, int N, int G_, int c_) { nM = M / BM; nN = N / BM; nwg = nM * nN; G = G_; c = c_; }
    __host__ __device__ bool next(int i, Unit& u) const {
        const long L = (long)i * G + c; if (L >= nwg) return false;
        int wgid = (int)L; { const int q = nwg / NXCD, r = nwg % NXCD, xcd = wgid % NXCD, off = wgid / NXCD; wgid = (xcd < r ? xcd * (q + 1) : r * (q + 1) + (xcd - r) * q) + off; }
        const int nig = WGM * nN, gid = wgid / nig, fm = gid * WGM, gsz = (nM - fm) < WGM ? (nM - fm) : WGM;
        u.pm = fm + ((wgid % nig) % gsz); u.pn = (wgid % nig) / gsz; return true;
    }
    __device__ __forceinline__ void a_ready(const Unit&) const {}
    __device__ __forceinline__ void done(const Unit&) const {}
};

__device__ __forceinline__ unsigned cvt_pk_bf16(float lo, float hi) { unsigned r; asm volatile("v_cvt_pk_bf16_f32 %0, %1, %2" : "=v"(r) : "v"(lo), "v"(hi)); return r; }
typedef float f32x2 __attribute__((ext_vector_type(2)));
__device__ __forceinline__ f32x2 gelu_pk(f32x2 v) {
    const f32x2 av = __builtin_elementwise_abs(v), d = av * 0.2316418882f + 1.0f;
    f32x2 t; t.x = __builtin_amdgcn_rcpf(d.x); t.y = __builtin_amdgcn_rcpf(d.y);
    f32x2 q = t * 0.5307027145f + (-0.7265760135f); q = q * t + 0.7107068705f; q = q * t + (-0.142248368f); q = q * t + 0.127414796f; q = q * t;
    const f32x2 s = (v * v) * (-0.72134752044f);
    f32x2 e; e.x = __builtin_amdgcn_exp2f(s.x); e.y = __builtin_amdgcn_exp2f(s.y);
    const f32x2 m = v * (q * e), r = v - m;
    f32x2 o; o.x = v.x < 0.f ? m.x : r.x; o.y = v.y < 0.f ? m.y : r.y; return o;
}

typedef unsigned u32x2 __attribute__((ext_vector_type(2)));
#ifndef NT_EPI
#define NT_EPI 0
#endif
#if NT_EPI
#define ST16(p, v) __builtin_nontemporal_store((v), (u32x4*)(p))
#define ST8(p, v) __builtin_nontemporal_store((v), (u32x2*)(p))
#else
#define ST16(p, v) (*(u32x4*)(p) = (v))
#define ST8(p, v) (*(u32x2*)(p) = (v))
#endif
__device__ __forceinline__ float sigm(float v) { return __builtin_amdgcn_rcpf(1.0f + __builtin_amdgcn_exp2f(-1.4426950408889634f * v)); }
__device__ __forceinline__ f32x4 sigm4(f32x4 v) { return (f32x4){sigm(v[0]), sigm(v[1]), sigm(v[2]), sigm(v[3])}; }
__device__ __forceinline__ float gelu_tanh1(float v) { return v * sigm(1.5957691216057308f * v * (1.0f + 0.044715f * v * v)); }
__device__ __forceinline__ f32x4 gelu_tanh4(f32x4 v) { return (f32x4){gelu_tanh1(v[0]), gelu_tanh1(v[1]), gelu_tanh1(v[2]), gelu_tanh1(v[3])}; }
__device__ __forceinline__ u32x4 pack8(f32x4 a, f32x4 b) { u32x4 w; w.x = cvt_pk_bf16(a[0], a[1]); w.y = cvt_pk_bf16(a[2], a[3]); w.z = cvt_pk_bf16(b[0], b[1]); w.w = cvt_pk_bf16(b[2], b[3]); return w; }
__device__ __forceinline__ f32x4 bf_lo4(u32x4 w) { return (f32x4){__uint_as_float(w.x << 16), __uint_as_float(w.x & 0xffff0000u), __uint_as_float(w.y << 16), __uint_as_float(w.y & 0xffff0000u)}; }
__device__ __forceinline__ f32x4 bf_hi4(u32x4 w) { return (f32x4){__uint_as_float(w.z << 16), __uint_as_float(w.z & 0xffff0000u), __uint_as_float(w.w << 16), __uint_as_float(w.w & 0xffff0000u)}; }

struct EpiF32 {
    static constexpr bool PERM = false, AFTER_DRAIN = false;
    float* C; int ldc;
    __device__ __forceinline__ void operator()(const f32x4 (&acc)[2][2][4][2], const Unit& u, int wr, int wc, int fr, int fq) const {
        const int row0 = u.pm * BM + wr * 64 + fr, col0 = u.pn * BM + wc * 32 + 4 * fq;
#pragma unroll
        for (int ai = 0; ai < 2; ++ai)
#pragma unroll
            for (int m = 0; m < 4; ++m) { float* rowp = C + (size_t)(row0 + ai * HALF + m * 16) * ldc + col0;
#pragma unroll
                for (int bj = 0; bj < 2; ++bj)
#pragma unroll
                    for (int n = 0; n < 2; ++n) *(f32x4*)(rowp + bj * HALF + n * 16) = acc[ai][bj][m][n]; }
    }
};

__device__ const float ROPE_REV[32] = {
    0.15915494309f, 0.11934937021f, 0.089499401609f, 0.067115083005f, 0.050329212104f, 0.037741584717f, 0.028302195831f, 0.021223652765f,
    0.015915494309f, 0.011934937021f, 0.0089499401609f, 0.0067115083005f, 0.0050329212104f, 0.0037741584717f, 0.0028302195831f, 0.0021223652765f,
    0.0015915494309f, 0.0011934937021f, 0.00089499401609f, 0.00067115083005f, 0.00050329212104f, 0.00037741584717f, 0.00028302195831f, 0.00021223652765f,
    0.00015915494309f, 0.00011934937021f, 8.9499401609e-05f, 6.7115083005e-05f, 5.0329212104e-05f, 3.7741584717e-05f, 2.8302195831e-05f, 2.1223652765e-05f };
__device__ __forceinline__ f32x4 cos_rev4(f32x4 r) { return (f32x4){__builtin_amdgcn_cosf(__builtin_amdgcn_fractf(r[0])), __builtin_amdgcn_cosf(__builtin_amdgcn_fractf(r[1])), __builtin_amdgcn_cosf(__builtin_amdgcn_fractf(r[2])), __builtin_amdgcn_cosf(__builtin_amdgcn_fractf(r[3]))}; }
__device__ __forceinline__ f32x4 sin_rev4(f32x4 r) { return (f32x4){__builtin_amdgcn_sinf(__builtin_amdgcn_fractf(r[0])), __builtin_amdgcn_sinf(__builtin_amdgcn_fractf(r[1])), __builtin_amdgcn_sinf(__builtin_amdgcn_fractf(r[2])), __builtin_amdgcn_sinf(__builtin_amdgcn_fractf(r[3]))}; }
struct EpiInProj {
    static constexpr bool PERM = true, AFTER_DRAIN = false;
    bf16_t* out; size_t slot_stride; const float* posf; float qscale;
    __device__ __forceinline__ void operator()(const f32x4 (&acc)[2][2][4][2], const Unit& u, int wr, int wc, int fr, int fq) const {
        const int type = u.pn >> 2, sub = u.pn & 3;
        bf16_t* base = out + (size_t)type * slot_stride;
        const int row0 = u.pm * BM + wr * 64 + fr;
        if (type == 2 || type == 3) {
            const float sc = (type == 2) ? qscale : 1.0f;
            const int colb = sub * 256 + wc * 64 + 8 * fq;
            const f32x4 cf0 = *(const f32x4*)(ROPE_REV + 8 * fq), cf1 = *(const f32x4*)(ROPE_REV + 8 * fq + 4);
            float pv[2][4];
#pragma unroll
            for (int ai = 0; ai < 2; ++ai)
#pragma unroll
                for (int m = 0; m < 4; ++m) pv[ai][m] = posf[row0 + ai * HALF + m * 16];
#pragma unroll
            for (int ai = 0; ai < 2; ++ai)
#pragma unroll
                for (int m = 0; m < 4; ++m) { const int r = row0 + ai * HALF + m * 16;
                    const float p = pv[ai][m];
                    const f32x4 r0 = cf0 * p, r1 = cf1 * p;
                    const f32x4 c0 = cos_rev4(r0) * sc, c1 = cos_rev4(r1) * sc, s0 = sin_rev4(r0) * sc, s1 = sin_rev4(r1) * sc;
                    const f32x4 x0a = acc[ai][0][m][0], x0b = acc[ai][0][m][1], x1a = acc[ai][1][m][0], x1b = acc[ai][1][m][1];
                    const f32x4 y0a = x0a * c0 - x1a * s0, y0b = x0b * c1 - x1b * s1, y1a = x1a * c0 + x0a * s0, y1b = x1b * c1 + x0b * s1;
                    bf16_t* rowp = base + (size_t)r * 1024 + colb;
                    ST16(rowp, pack8(y0a, y0b)); ST16(rowp + 32, pack8(y1a, y1b)); }
        } else {
            const int colb = sub * 256 + wc * 64 + 8 * fq;
#pragma unroll
            for (int ai = 0; ai < 2; ++ai)
#pragma unroll
                for (int m = 0; m < 4; ++m) { bf16_t* rowp = base + (size_t)(row0 + ai * HALF + m * 16) * 1024 + colb;
#pragma unroll
                    for (int bj = 0; bj < 2; ++bj) { f32x4 v0 = acc[ai][bj][m][0], v1 = acc[ai][bj][m][1];
                        if (type == 0) { v0 = gelu_tanh4(v0); v1 = gelu_tanh4(v1); }
                        else if (type >= 5) { v0 = sigm4(v0); v1 = sigm4(v1); }
                        ST16(rowp + bj * 32, pack8(v0, v1)); } }
        }
    }
};

struct EpiMerge {
    static constexpr bool PERM = true, AFTER_DRAIN = false;
    const bf16_t* sga; const bf16_t* sgb; bf16_t* t1; bf16_t* merged; int nM;
    __device__ __forceinline__ void operator()(const f32x4 (&acc)[2][2][4][2], const Unit& u, int wr, int wc, int fr, int fq) const {
        const bool sel = u.pm >= nM; const int pm = sel ? u.pm - nM : u.pm, pn = u.pn & 3;
        const bf16_t* sg = sel ? sgb : sga;
        const int row0 = pm * BM + wr * 64 + fr, col0 = pn * BM + wc * 32 + 8 * fq;
#pragma unroll
        for (int ai = 0; ai < 2; ++ai) {
            u32x4 g[4][2], t[4][2];
#pragma unroll
            for (int m = 0; m < 4; ++m)
#pragma unroll
                for (int bj = 0; bj < 2; ++bj) { const size_t off = (size_t)(row0 + ai * HALF + m * 16) * 1024 + col0 + bj * HALF;
                    g[m][bj] = *(const u32x4*)(sg + off); if (sel) t[m][bj] = *(const u32x4*)(t1 + off); }
#pragma unroll
            for (int m = 0; m < 4; ++m)
#pragma unroll
                for (int bj = 0; bj < 2; ++bj) { const size_t off = (size_t)(row0 + ai * HALF + m * 16) * 1024 + col0 + bj * HALF;
                    f32x4 v0 = acc[ai][bj][m][0] * bf_lo4(g[m][bj]), v1 = acc[ai][bj][m][1] * bf_hi4(g[m][bj]);
                    if (!sel) *(u32x4*)(t1 + off) = pack8(v0, v1);
                    else { v0 = v0 + bf_lo4(t[m][bj]); v1 = v1 + bf_hi4(t[m][bj]); *(u32x4*)(merged + off) = pack8(v0, v1); } } }
    }
};

struct EpiSwiGLU {
    static constexpr bool PERM = true, AFTER_DRAIN = false;
    bf16_t* O; int ldc; int nper; int pm_sub;
    __device__ __forceinline__ void operator()(const f32x4 (&acc)[2][2][4][2], const Unit& u, int wr, int wc, int fr, int fq) const {
        const int pn = u.pn % nper;
        const int row0 = (u.pm - pm_sub) * BM + wr * 64 + fr, col0 = pn * HALF + wc * 32 + 8 * fq;
#pragma unroll
        for (int ai = 0; ai < 2; ++ai)
#pragma unroll
            for (int m = 0; m < 4; ++m) { const f32x4 g0 = acc[ai][0][m][0], g1 = acc[ai][0][m][1], u0 = acc[ai][1][m][0], u1 = acc[ai][1][m][1];
                const f32x4 a0 = g0 * sigm4(g0) * u0, a1 = g1 * sigm4(g1) * u1;
                ST16(O + (size_t)(row0 + ai * HALF + m * 16) * ldc + col0, pack8(a0, a1)); }
    }
};

__device__ __forceinline__ unsigned pk4_fp8(f32x4 v) { unsigned w = __builtin_amdgcn_cvt_pk_fp8_f32(v[0], v[1], 0u, false); return __builtin_amdgcn_cvt_pk_fp8_f32(v[2], v[3], w, true); }
__device__ __forceinline__ f32x4 clamp448(f32x4 v) { return (f32x4){__builtin_fminf(__builtin_fmaxf(v[0], -448.f), 448.f), __builtin_fminf(__builtin_fmaxf(v[1], -448.f), 448.f), __builtin_fminf(__builtin_fmaxf(v[2], -448.f), 448.f), __builtin_fminf(__builtin_fmaxf(v[3], -448.f), 448.f)}; }
struct EpiSwiGLU8 {
    static constexpr bool PERM = true, AFTER_DRAIN = false;
    unsigned char* O; int ldc; int nper; int pm_sub; float oscale;
    __device__ __forceinline__ void operator()(const f32x4 (&acc)[2][2][4][2], const Unit& u, int wr, int wc, int fr, int fq) const {
        const int pn = u.pn % nper;
        const int row0 = (u.pm - pm_sub) * BM + wr * 64 + fr, col0 = pn * HALF + wc * 32 + 8 * fq;
#pragma unroll
        for (int ai = 0; ai < 2; ++ai)
#pragma unroll
            for (int m = 0; m < 4; ++m) { const f32x4 g0 = acc[ai][0][m][0], g1 = acc[ai][0][m][1], u0 = acc[ai][1][m][0], u1 = acc[ai][1][m][1];
                const f32x4 a0 = clamp448(g0 * sigm4(g0) * u0 * oscale), a1 = clamp448(g1 * sigm4(g1) * u1 * oscale);
                u32x2 w; w.x = pk4_fp8(a0); w.y = pk4_fp8(a1);
                ST8(O + (size_t)(row0 + ai * HALF + m * 16) * ldc + col0, w); }
    }
};

struct EpiPlainBf16 {
    static constexpr bool PERM = true, AFTER_DRAIN = false;
    bf16_t* O; int ldc; int pn_mask;
    __device__ __forceinline__ void operator()(const f32x4 (&acc)[2][2][4][2], const Unit& u, int wr, int wc, int fr, int fq) const {
        const int row0 = u.pm * BM + wr * 64 + fr, col0 = (u.pn & pn_mask) * BM + wc * 32 + 8 * fq;
#pragma unroll
        for (int ai = 0; ai < 2; ++ai)
#pragma unroll
            for (int m = 0; m < 4; ++m) { bf16_t* rowp = O + (size_t)(row0 + ai * HALF + m * 16) * ldc + col0;
#pragma unroll
                for (int bj = 0; bj < 2; ++bj) ST16(rowp + bj * HALF, pack8(acc[ai][bj][m][0], acc[ai][bj][m][1])); }
    }
};

struct EpiPleGate {
    static constexpr bool PERM = true, AFTER_DRAIN = false;
    bf16_t* O; const bf16_t* PP; int ldc;
    __device__ __forceinline__ void operator()(const f32x4 (&acc)[2][2][4][2], const Unit& u, int wr, int wc, int fr, int fq) const {
        const int row0 = u.pm * BM + wr * 64 + fr, col0 = u.pn * BM + wc * 32 + 8 * fq;
#pragma unroll
        for (int ai = 0; ai < 2; ++ai) {
            u32x4 p[4][2];
#pragma unroll
            for (int m = 0; m < 4; ++m)
#pragma unroll
                for (int bj = 0; bj < 2; ++bj) p[m][bj] = *(const u32x4*)(PP + (size_t)(row0 + ai * HALF + m * 16) * ldc + col0 + bj * HALF);
#pragma unroll
            for (int m = 0; m < 4; ++m)
#pragma unroll
                for (int bj = 0; bj < 2; ++bj) { const size_t ro = (size_t)(row0 + ai * HALF + m * 16) * ldc + col0 + bj * HALF;
                    *(u32x4*)(O + ro) = pack8(sigm4(acc[ai][bj][m][0]) * bf_lo4(p[m][bj]), sigm4(acc[ai][bj][m][1]) * bf_hi4(p[m][bj])); } }
    }
};

struct MoeKSplitOrder {
    int G, c, p0, npan, nN, S, kbytes; int ps1, ps2, ps3, ps4, ps5, ps6, ps7;
    __device__ __forceinline__ bool next(int i, Unit& u) const {
        const int L = i * G + c; if (L >= npan * nN * S) return false;
        const int ks = L % S, r = L / S, pn = r % nN, p = p0 + r / nN;
        const int e = (p >= ps1) + (p >= ps2) + (p >= ps3) + (p >= ps4) + (p >= ps5) + (p >= ps6) + (p >= ps7);
        u.pm = p; u.pn = e * nN + pn; u.ko = ks * kbytes; return true;
    }
    __device__ __forceinline__ void a_ready(const Unit&) const {}
    __device__ __forceinline__ void done(const Unit&) const {}
};
struct EpiSliceBf16 {
    static constexpr bool PERM = true, AFTER_DRAIN = false;
    bf16_t* O; int ldc; int pn_mask; int p0; int kbytes; size_t slice_stride;
    __device__ __forceinline__ void operator()(const f32x4 (&acc)[2][2][4][2], const Unit& u, int wr, int wc, int fr, int fq) const {
        bf16_t* Ob = O + (size_t)(u.ko / kbytes) * slice_stride;
        const int row0 = (u.pm - p0) * BM + wr * 64 + fr, col0 = (u.pn & pn_mask) * BM + wc * 32 + 8 * fq;
#pragma unroll
        for (int ai = 0; ai < 2; ++ai)
#pragma unroll
            for (int m = 0; m < 4; ++m) { bf16_t* rowp = Ob + (size_t)(row0 + ai * HALF + m * 16) * ldc + col0;
#pragma unroll
                for (int bj = 0; bj < 2; ++bj) ST16(rowp + bj * HALF, pack8(acc[ai][bj][m][0], acc[ai][bj][m][1])); }
    }
};
struct PairOrder {
    StaticOrder base;
    __device__ __forceinline__ bool next(int i, Unit& u) const { if (!base.next(i >> 1, u)) return false; if (i & 1) { u.pm += base.nM; u.pn += base.nN; } return true; }
    __device__ __forceinline__ void a_ready(const Unit&) const {}
    __device__ __forceinline__ void done(const Unit&) const {}
};
struct MoeOrder {
    StaticOrder base; int plo; int ps1, ps2, ps3, ps4, ps5, ps6, ps7;
    __device__ __forceinline__ bool next(int i, Unit& u) const {
        if (!base.next(i, u)) return false;
        const int p = u.pm + plo;
        const int e = (p >= ps1) + (p >= ps2) + (p >= ps3) + (p >= ps4) + (p >= ps5) + (p >= ps6) + (p >= ps7);
        u.pm = p; u.pn += e * base.nN; return true;
    }
    __device__ __forceinline__ void a_ready(const Unit&) const {}
    __device__ __forceinline__ void done(const Unit&) const {}
};
template <class Epi, class Sched, bool ALIGN_EPI = false, bool SP2 = false, bool F8 = false>
__device__ __forceinline__ void gemm_phase(PG8_LAS unsigned char* lds, const Gemm g, const Sched& S, const Epi& E) {
    int tid_ = threadIdx.x; asm volatile("" : "+v"(tid_));
    const int tid = tid_, wid = __builtin_amdgcn_readfirstlane(tid >> 6), lane = tid & 63, wr = wid >> 2, wc = wid & 3, fr = lane & 15, fq = lane >> 4;
    const int K = g.K, nt = K / BK, LD = g.ld ? g.ld : K;
    unsigned voffA[2], voffB[2];
#pragma unroll
    for (int i = 0; i < 2; ++i) { int R, C; stage_rc(tid * 16 + i * 8192, R, C); const int Rb = Epi::PERM ? ((R & ~31) + perm32(R & 31)) : R;
        voffA[i] = (unsigned)(R * LD + C) * 2u; voffB[i] = (unsigned)(Rb * LD + C) * 2u; }
    const size_t kstep = (size_t)(BK * 2);
    const size_t hstep = (size_t)HALF * LD * 2;
    const size_t tstep = 2 * hstep;
    const unsigned ldsw = (unsigned)wid * 1024u;
    const int aoff = lds_byte(wr * 64 + fr, fq * 8), boff = lds_byte(wc * 32 + fr, fq * 8);
#define PG8_SA(b, h) (((b) * 2 + (h)) * HTB)
#define PG8_SB(b, h) ((4 + (b) * 2 + (h)) * HTB)
#define PG8_STAGE(bufoff, gbase, voff) do { _Pragma("unroll") for (int _i = 0; _i < 2; ++_i) \
        __builtin_amdgcn_global_load_lds((const unsigned*)((const char*)(gbase) + (voff)[_i]), (PG8_LAS unsigned*)(lds + (bufoff) + ldsw + _i * 8192), 16, 0, 0); } while (0)
#define PG8_CAT(a, b) __builtin_shufflevector(__builtin_bit_cast(v4i_t, a), __builtin_bit_cast(v4i_t, b), 0, 1, 2, 3, 4, 5, 6, 7)
#define PG8_LDA(dst, b, h) do { _Pragma("unroll") for (int m = 0; m < 4; ++m) { const bf16x8 r0_ = *(const PG8_LAS bf16x8*)(lds + PG8_SA(b, h) + aoff + m * 2048), r1_ = *(const PG8_LAS bf16x8*)(lds + PG8_SA(b, h) + aoff + m * 2048 + 1024); \
        if constexpr (F8) dst##8[m] = PG8_CAT(r0_, r1_); else { dst[m][0] = r0_; dst[m][1] = r1_; } } } while (0)
#define PG8_LDB(dst, b, h) do { _Pragma("unroll") for (int n = 0; n < 2; ++n) { const bf16x8 r0_ = *(const PG8_LAS bf16x8*)(lds + PG8_SB(b, h) + boff + n * 2048), r1_ = *(const PG8_LAS bf16x8*)(lds + PG8_SB(b, h) + boff + n * 2048 + 1024); \
        if constexpr (F8) dst##8[n] = PG8_CAT(r0_, r1_); else { dst[n][0] = r0_; dst[n][1] = r1_; } } } while (0)
#define PG8_MMA(ai, bj, At, Bt) do { __builtin_amdgcn_s_setprio(1); _Pragma("unroll") for (int m = 0; m < 4; ++m) _Pragma("unroll") for (int n = 0; n < 2; ++n) { \
        if constexpr (F8) asm volatile("v_mfma_scale_f32_16x16x128_f8f6f4 %0, %1, %2, %0, %3, %4 op_sel_hi:[0,0,0]" : "+v"(acc[ai][bj][m][n]) : "v"(Bt##8[n]), "v"(At##8[m]), "v"(sbv), "v"(sav));   \
        else { _Pragma("unroll") for (int k = 0; k < 2; ++k) acc[ai][bj][m][n] = __builtin_amdgcn_mfma_f32_16x16x32_bf16(Bt[n][k], At[m][k], acc[ai][bj][m][n], 0, 0, 0); } } \
        __builtin_amdgcn_s_setprio(0); } while (0)
#define PG8_WAIT_V(n) asm volatile("s_waitcnt vmcnt(" #n ")" ::: "memory")
#define PG8_WAIT_L(n) asm volatile("s_waitcnt lgkmcnt(" #n ")" ::: "memory")
#define PG8_BAR __builtin_amdgcn_s_barrier()
#define PG8_SCHED __builtin_amdgcn_sched_barrier(0)
    Unit cur, nxt; int ui = 0;
    if (!S.next(0, cur)) return;
    f32x4 acc[2][2][4][2];
#pragma unroll
    for (int a = 0; a < 2; ++a)
#pragma unroll
        for (int b = 0; b < 2; ++b)
#pragma unroll
            for (int m = 0; m < 4; ++m)
#pragma unroll
                for (int n = 0; n < 2; ++n) acc[a][b][m][n] = (f32x4){0.f, 0.f, 0.f, 0.f};
    bf16x8 At[4][2], B0[2][2], B1[2][2];
    v8i_t At8[4], B08[2], B18[2];
    (void)At; (void)B0; (void)B1; (void)At8; (void)B08; (void)B18;
    const int sav = g.sa, sbv = g.sb; (void)sav; (void)sbv;
    const char* cA = (const char*)g.A + (size_t)cur.pm * tstep + cur.ko; const char* cB = (const char*)g.Bt + (size_t)cur.pn * tstep + cur.ko;
    S.a_ready(cur);
    if constexpr (SP2) {
        PG8_STAGE(PG8_SB(0, 0), cB, voffB); PG8_STAGE(PG8_SB(0, 1), cB + hstep, voffB); PG8_STAGE(PG8_SA(0, 0), cA, voffA); PG8_STAGE(PG8_SA(0, 1), cA + hstep, voffA);
        if (wr == 1) PG8_BAR;
        PG8_WAIT_V(2); PG8_BAR;
        PG8_STAGE(PG8_SB(1, 0), cB + kstep, voffB); PG8_STAGE(PG8_SA(1, 0), cA + kstep, voffA); PG8_STAGE(PG8_SB(1, 1), cB + hstep + kstep, voffB);
        PG8_WAIT_V(6); PG8_BAR;
    } else {
        PG8_STAGE(PG8_SB(0, 0), cB, voffB); PG8_STAGE(PG8_SA(0, 0), cA, voffA); PG8_STAGE(PG8_SB(0, 1), cB + hstep, voffB); PG8_STAGE(PG8_SA(0, 1), cA + hstep, voffA);
        if (wr == 1) PG8_BAR;
        PG8_WAIT_V(4); PG8_BAR;
        PG8_STAGE(PG8_SB(1, 0), cB + kstep, voffB); PG8_STAGE(PG8_SA(1, 0), cA + kstep, voffA); PG8_STAGE(PG8_SB(1, 1), cB + hstep + kstep, voffB);
        PG8_WAIT_V(6); PG8_BAR;
    }
    for (;;) {
        const bool has_next = S.next(ui + 1, nxt);
        const char* nA = has_next ? (const char*)g.A + (size_t)nxt.pm * tstep + nxt.ko : cA; const char* nB = has_next ? (const char*)g.Bt + (size_t)nxt.pn * tstep + nxt.ko : cB;
        for (int t = 0; t < nt; t += 2) {
            const bool last = (t == nt - 2);
            const char* a1 = cA + (size_t)(t + 1) * kstep;
            const char* a2 = last ? nA : cA + (size_t)(t + 2) * kstep; const char* b2 = last ? nB : cB + (size_t)(t + 2) * kstep;
            const char* a3 = a2 + kstep; const char* b3 = b2 + kstep;
            if (last && has_next) S.a_ready(nxt);
            if constexpr (SP2) {
            PG8_LDB(B0, 0, 0); PG8_LDB(B1, 0, 1); PG8_SCHED; PG8_LDA(At, 0, 0); PG8_STAGE(PG8_SA(1, 1), a1 + hstep, voffA);
            PG8_WAIT_V(8); PG8_WAIT_L(0); PG8_BAR; PG8_MMA(0, 0, At, B0); PG8_MMA(0, 1, At, B1); PG8_BAR; PG8_SCHED;
            PG8_LDA(At, 0, 1); PG8_STAGE(PG8_SB(0, 0), b2, voffB); PG8_STAGE(PG8_SB(0, 1), b2 + hstep, voffB); PG8_STAGE(PG8_SA(0, 0), a2, voffA);
            PG8_WAIT_V(8); PG8_WAIT_L(0); PG8_BAR; PG8_MMA(1, 0, At, B0); PG8_MMA(1, 1, At, B1); PG8_BAR; PG8_SCHED;
            PG8_LDB(B0, 1, 0); PG8_LDB(B1, 1, 1); PG8_SCHED; PG8_LDA(At, 1, 0); PG8_STAGE(PG8_SA(0, 1), a2 + hstep, voffA);
            PG8_WAIT_V(8); PG8_WAIT_L(0); PG8_BAR; PG8_MMA(0, 0, At, B0); PG8_MMA(0, 1, At, B1); PG8_BAR; PG8_SCHED;
            PG8_LDA(At, 1, 1); PG8_STAGE(PG8_SB(1, 0), b3, voffB); PG8_STAGE(PG8_SB(1, 1), b3 + hstep, voffB); PG8_STAGE(PG8_SA(1, 0), a3, voffA);
            PG8_WAIT_V(8); PG8_WAIT_L(0); PG8_BAR; PG8_MMA(1, 0, At, B0); PG8_MMA(1, 1, At, B1); PG8_BAR; PG8_SCHED;
            } else {
            PG8_LDB(B0, 0, 0); PG8_SCHED; PG8_LDA(At, 0, 0); PG8_STAGE(PG8_SA(1, 1), a1 + hstep, voffA);
            PG8_WAIT_L(8); PG8_BAR; PG8_WAIT_L(0); PG8_MMA(0, 0, At, B0); PG8_BAR; PG8_SCHED;
            PG8_LDB(B1, 0, 1); PG8_STAGE(PG8_SB(0, 0), b2, voffB);
            PG8_BAR; PG8_WAIT_L(0); PG8_MMA(0, 1, At, B1); PG8_BAR;
            PG8_LDA(At, 0, 1); PG8_STAGE(PG8_SA(0, 0), a2, voffA);
            PG8_BAR; PG8_WAIT_L(0); PG8_MMA(1, 0, At, B0); PG8_BAR; PG8_SCHED;
            PG8_STAGE(PG8_SB(0, 1), b2 + hstep, voffB);
            PG8_WAIT_V(6); PG8_BAR; PG8_MMA(1, 1, At, B1); PG8_BAR;
            PG8_LDB(B0, 1, 0); PG8_SCHED; PG8_LDA(At, 1, 0); PG8_STAGE(PG8_SA(0, 1), a2 + hstep, voffA);
            PG8_WAIT_L(8); PG8_BAR; PG8_WAIT_L(0); PG8_MMA(0, 0, At, B0); PG8_BAR; PG8_SCHED;
            PG8_LDB(B1, 1, 1); PG8_STAGE(PG8_SB(1, 0), b3, voffB);
            PG8_BAR; PG8_WAIT_L(0); PG8_MMA(0, 1, At, B1); PG8_BAR;
            PG8_LDA(At, 1, 1); PG8_STAGE(PG8_SA(1, 0), a3, voffA);
            PG8_BAR; PG8_WAIT_L(0); PG8_MMA(1, 0, At, B0); PG8_BAR; PG8_SCHED;
            PG8_STAGE(PG8_SB(1, 1), b3 + hstep, voffB);
            PG8_WAIT_V(6); PG8_BAR; PG8_MMA(1, 1, At, B1); PG8_BAR;
            }
        }
        if constexpr (ALIGN_EPI) { if (wr == 0) PG8_BAR; }
        if constexpr (!Epi::AFTER_DRAIN) { E(acc, cur, wr, wc, fr, fq); S.done(cur); }
        if (!has_next) break;
#pragma unroll
        for (int a = 0; a < 2; ++a)
#pragma unroll
            for (int b = 0; b < 2; ++b)
#pragma unroll
                for (int m = 0; m < 4; ++m)
#pragma unroll
                    for (int n = 0; n < 2; ++n) acc[a][b][m][n] = (f32x4){0.f, 0.f, 0.f, 0.f};
        cur = nxt; cA = nA; cB = nB; ++ui;
        if constexpr (ALIGN_EPI) { if (wr == 1) PG8_BAR; }
    }
    PG8_WAIT_V(0);
    if constexpr (!ALIGN_EPI) { if (wr == 0) PG8_BAR; }
    PG8_BAR;
    if constexpr (Epi::AFTER_DRAIN) { E.fused(acc, cur, wr, wc, fr, fq, lds, wid, lane); S.done(cur); }
#undef PG8_SA
#undef PG8_SB
#undef PG8_STAGE
#undef PG8_LDA
#undef PG8_LDB
#undef PG8_MMA
#undef PG8_CAT
#undef PG8_WAIT_V
#undef PG8_WAIT_L
#undef PG8_BAR
#undef PG8_SCHED
}
}
#include <hip/hip_bf16.h>
#include <hip/hip_bf16.h>
#include <cmath>
namespace attn_body {
using bf16=__hip_bfloat16;
using bf16x8=__attribute__((ext_vector_type(8)))short;
using s16x4=__attribute__((ext_vector_type(4)))short;
using f32x16=__attribute__((ext_vector_type(16)))float;
using u32x4=__attribute__((ext_vector_type(4)))unsigned;
constexpr int BATCH=4,NHEAD=16,SEQ=4096,D=64,DM=NHEAD*D;
constexpr int NW=8,QBLK=32,QB=QBLK*NW,KVBLK=64,NQB=SEQ/QB;
constexpr int ATTN_PITCH=DM, ATTN_UNIT_ROWS=QB;
__device__ __forceinline__ int crow(int r,int hi){return (r&3)+8*(r>>2)+4*hi;}
#define SBAR() __builtin_amdgcn_sched_barrier(0)
__device__ __forceinline__ void cmask(f32x16&p0,f32x16&p1,int jb,int qrel,int hi){
  const float NEG=-INFINITY; int kb=64*jb+4*hi;
  #pragma unroll
  for(int r=0;r<16;++r){int kv=kb+(r&3)+8*(r>>2); if(kv>qrel)p0[r]=NEG; if(kv+32>qrel)p1[r]=NEG;}
}

constexpr int NSLOT=3, SLOTB=8192, SLOTV=16384;
constexpr int LDS_K=0, LDS_V=NSLOT*SLOTB, LDS_WS=LDS_V+NSLOT*SLOTV, LDS_OST=LDS_WS+NW*64*4, LDS_BYTES=LDS_OST;
constexpr float C2=0.125f*1.4426950408889634f;
__device__ __forceinline__ void glds16(const void*gsrc,unsigned lds_dst){unsigned keep;
  asm volatile("s_mov_b32 %0, m0\n\ts_mov_b32 m0, %2\n\ts_nop 0\n\tglobal_load_lds_dwordx4 %1, off\n\ts_mov_b32 m0, %0":"=&s"(keep):"v"(gsrc),"s"(lds_dst):"memory");}
__device__ __forceinline__ float max3f(float a,float b,float c){float r;asm("v_max3_f32 %0, %1, %2, %3":"=v"(r):"v"(a),"v"(b),"v"(c));return r;}
__device__ __forceinline__ float max2f(float a,float b){float r;asm("v_max_f32_e32 %0, %1, %2":"=v"(r):"v"(a),"v"(b));return r;}
__device__ __forceinline__ float fadd_s(float a,float b){float r;asm("v_add_f32_e32 %0, %1, %2":"=v"(r):"v"(a),"v"(b));return r;}
__device__ __forceinline__ float fsub_s(float a,float b){float r;asm("v_sub_f32_e32 %0, %1, %2":"=v"(r):"v"(a),"v"(b));return r;}
typedef float f32x2_t __attribute__((ext_vector_type(2))); typedef __bf16 bf16x2_t __attribute__((ext_vector_type(2)));
__device__ __forceinline__ unsigned cvtpk_s(float lo,float hi){f32x2_t v={lo,hi};bf16x2_t b=__builtin_convertvector(v,bf16x2_t);return __builtin_bit_cast(unsigned,b);}
#define WAIT_BAR(N) asm volatile("s_waitcnt vmcnt(" #N ") lgkmcnt(0)\n\ts_barrier":::"memory")

__device__ __forceinline__ void qkt(f32x16&p0,f32x16&p1,const char*Kslot,const bf16x8*qr,int r32,int hi){ const f32x16 negm=f32x16{};
  const char*kb=Kslot+hi*1024+r32*16;
  #pragma unroll
  for(int d0=0;d0<4;++d0){
    const bf16x8 b0=*reinterpret_cast<const bf16x8*>(kb+d0*2048);
    const bf16x8 b1=*reinterpret_cast<const bf16x8*>(kb+d0*2048+512);
    if(d0==0){p0=__builtin_amdgcn_mfma_f32_32x32x16_bf16(b0,qr[0],negm,0,0,0);p1=__builtin_amdgcn_mfma_f32_32x32x16_bf16(b1,qr[0],negm,0,0,0);}
    else{p0=__builtin_amdgcn_mfma_f32_32x32x16_bf16(b0,qr[d0],p0,0,0,0);p1=__builtin_amdgcn_mfma_f32_32x32x16_bf16(b1,qr[d0],p1,0,0,0);}}
}
typedef __attribute__((address_space(3))) const char* lds_cptr;
typedef short v4i16_t __attribute__((ext_vector_type(4)));
__device__ __forceinline__ void kload8(bf16x8*kf,lds_cptr kp){
  kf[0]=*(const __attribute__((address_space(3))) bf16x8*)(kp);      kf[1]=*(const __attribute__((address_space(3))) bf16x8*)(kp+512);
  kf[2]=*(const __attribute__((address_space(3))) bf16x8*)(kp+2048); kf[3]=*(const __attribute__((address_space(3))) bf16x8*)(kp+2560);
  kf[4]=*(const __attribute__((address_space(3))) bf16x8*)(kp+4096); kf[5]=*(const __attribute__((address_space(3))) bf16x8*)(kp+4608);
  kf[6]=*(const __attribute__((address_space(3))) bf16x8*)(kp+6144); kf[7]=*(const __attribute__((address_space(3))) bf16x8*)(kp+6656);
}
__device__ __forceinline__ void kload2(bf16x8*kf,lds_cptr kp,int j){ kf[2*j]=*(const __attribute__((address_space(3))) bf16x8*)(kp+j*2048); kf[2*j+1]=*(const __attribute__((address_space(3))) bf16x8*)(kp+j*2048+512); }
__device__ __forceinline__ s16x4 vtr(lds_cptr p){ return __builtin_bit_cast(s16x4,__builtin_amdgcn_ds_read_tr16_b64_v4i16((__attribute__((address_space(3))) v4i16_t*)p)); }
__device__ __forceinline__ float rowmax(const f32x16&p0,const f32x16&p1){
  float a=max3f(p0[0],p0[1],p1[0]),b=max3f(p0[2],p0[3],p1[1]);a=max3f(a,p1[2],p1[3]);
  #pragma unroll
  for(int r=4;r<16;r+=4){a=max3f(a,p0[r],p0[r+1]);b=max3f(b,p0[r+2],p0[r+3]);a=max3f(a,p1[r],p1[r+1]);b=max3f(b,p1[r+2],p1[r+3]);}
  const float m=max2f(a,b);
  auto rr=__builtin_amdgcn_permlane32_swap(__float_as_uint(m),__float_as_uint(m),false,false);
  return max2f(__uint_as_float(rr[0]),__uint_as_float(rr[1]));
}
__device__ __forceinline__ void pv(f32x16*o,int vb,bf16x8 pa0,bf16x8 pa1,bf16x8 pa2,bf16x8 pa3){
  #pragma unroll
  for(int d0=0;d0<4;++d0){s16x4 lo[4],hi[4];
    #pragma unroll
    for(int ks=0;ks<4;++ks){
      asm volatile("ds_read_b64_tr_b16 %0,%1 offset:%c2":"=&v"(lo[ks]):"v"(vb),"i"(d0*4096+ks*1024):"memory");
      asm volatile("ds_read_b64_tr_b16 %0,%1 offset:%c2":"=&v"(hi[ks]):"v"(vb),"i"(d0*4096+ks*1024+512):"memory");}
    asm volatile("s_waitcnt lgkmcnt(0)":::"memory");SBAR();
    #define PK(k) (bf16x8){lo[k][0],lo[k][1],lo[k][2],lo[k][3],hi[k][0],hi[k][1],hi[k][2],hi[k][3]}
    o[d0]=__builtin_amdgcn_mfma_f32_32x32x16_bf16(pa0,PK(0),o[d0],0,0,0);
    o[d0]=__builtin_amdgcn_mfma_f32_32x32x16_bf16(pa1,PK(1),o[d0],0,0,0);
    o[d0]=__builtin_amdgcn_mfma_f32_32x32x16_bf16(pa2,PK(2),o[d0],0,0,0);
    o[d0]=__builtin_amdgcn_mfma_f32_32x32x16_bf16(pa3,PK(3),o[d0],0,0,0);
    #undef PK
  }
}

#ifndef ATTN_STORE16
#define ATTN_STORE16(p,v) (*(u32x4*)(p)=(v))
#endif
template<int THRL> __device__ __forceinline__ void attn_unit(bool FUSE,int b,int h,int hv,int qb,const bf16*Q,const bf16*__restrict__ K,const bf16*__restrict__ V,bf16*O,const bf16*O2,float lam,const float*gsub,char*shm){
  int tid_=threadIdx.x; asm volatile("":"+v"(tid_)); const int tid=tid_,lane=tid&63,r32=lane&31,hi=lane>>5; const int wid=__builtin_amdgcn_readfirstlane(tid>>6);
  const long rowbase=(long)b*SEQ; const int q0=qb*QB;
  const bf16*Qw=Q+(rowbase+q0+wid*QBLK)*DM+h*D;
  const bf16*Kh=K+rowbase*DM+h*D,*Vh=V+rowbase*DM+hv*2*D;
  const unsigned lds0=(unsigned)(uintptr_t)shm;
  float*wsf=(float*)(shm+LDS_WS)+wid*64;
  const bf16*ksrc=Kh+(long)lane*DM+wid*8;
  const bf16*vsrc=Vh+(long)(16*(wid&3)+(lane>>2))*DM+(wid>>2)*32+(lane&3)*8;
  const unsigned kdst=lds0+LDS_K+wid*1024, vdst=lds0+LDS_V+wid*1024;
  #define DMA_K(t,slot) glds16(ksrc+(long)(t)*KVBLK*DM,(unsigned)__builtin_amdgcn_readfirstlane(kdst+(slot)))
  #define DMA_V(t,slot) do{ glds16(vsrc+(long)(t)*KVBLK*DM,(unsigned)__builtin_amdgcn_readfirstlane(vdst+2*(slot))); glds16(vsrc+(long)(t)*KVBLK*DM+64,(unsigned)__builtin_amdgcn_readfirstlane(vdst+2*(slot)+8192)); }while(0)
  const int vb0=(int)(lds0+LDS_V)+((lane>>4)&1)*32+(lane&3)*8+(4*hi+((lane&15)>>2))*64;
  const char*Kbase=shm+LDS_K; bf16x8 kf[8];
  const lds_cptr shm3=(lds_cptr)shm; const lds_cptr kp0=shm3+LDS_K+hi*1024+r32*16; const lds_cptr vp0=shm3+LDS_V+((lane>>4)&1)*32+(lane&3)*8+(4*hi+((lane&15)>>2))*64;
  const int NT=(q0+QB)/KVBLK;
  DMA_K(0,0);DMA_V(0,0);DMA_K(1,SLOTB);
  bf16x8 qr[4];
  #pragma unroll
  for(int d0=0;d0<4;++d0)qr[d0]=*reinterpret_cast<const bf16x8*>(&Qw[(long)r32*DM+d0*16+hi*8]);
  float mhat=0.f,l_reg=0.f;f32x16 o[4];o[0]=f32x16{};o[1]=f32x16{};o[2]=f32x16{};o[3]=f32x16{};const f32x16 ZERO16=f32x16{};
  const int qrel=wid*QBLK+r32;
  #define CMASK(P0,P1,t) do{int jb_=(t)-(NT-4); if(jb_>=0)cmask(P0,P1,jb_,qrel,hi);}while(0)
  bool resc=false;
  #define START(P0,P1) do{ const float rm=rowmax(P0,P1); resc=false; \
    { const float dl=rm; mhat=fadd_s(mhat,dl); \
      _Pragma("unroll") for(int r=0;r<16;++r){P0[r]=fsub_s(P0[r],dl);P1[r]=fsub_s(P1[r],dl);} \
      } \
    _Pragma("unroll") for(int r=0;r<16;++r)P0[r]=__builtin_amdgcn_exp2f(P0[r]); }while(0)
  #define RESC() do{ if(resc){ asm volatile("s_waitcnt lgkmcnt(0)":::"memory"); \
      _Pragma("unroll") for(int d_=0;d_<4;++d_) _Pragma("unroll") for(int r=0;r<16;++r)o[d_][r]*=wsf[crow(r,hi)]; } }while(0)
  f32x16 pA0,pA1,pB0,pB1;
  int sl_prev=0,sl_cur=0,sl_next=SLOTB;
  #define ROT() do{sl_prev=sl_cur;sl_cur=sl_next;sl_next=(sl_next==(NSLOT-1)*SLOTB)?0:sl_next+SLOTB;}while(0)
  DMA_K(2,2*SLOTB);
  WAIT_BAR(3);
  qkt(pA0,pA1,Kbase,qr,r32,hi);asm volatile("s_nop 15\n\ts_nop 7":"+v"(pA0),"+v"(pA1));CMASK(pA0,pA1,0);
  START(pA0,pA1);
  _Pragma("unroll") for(int r=0;r<16;++r)pA1[r]=__builtin_amdgcn_exp2f(pA1[r]);
  WAIT_BAR(0);
  DMA_K(3,0);DMA_V(1,SLOTB);
  ROT();
  kload8(kf,kp0+sl_cur);
  WAIT_BAR(3);
  s16x4 vlo[8],vhi[8]; u32x4 pw0,pw1,pw2,pw3;
  #define PKW(P,B) cvtpk_s(P[B],P[B+1])
  #define PAF(k) __builtin_bit_cast(bf16x8,pw##k)
  #define VFR(i) (bf16x8){vlo[i][0],vlo[i][1],vlo[i][2],vlo[i][3],vhi[i][0],vhi[i][1],vhi[i][2],vhi[i][3]}
  #define PIN(x) asm volatile("":"+v"(x))
  #define MX3(a,b,c) __builtin_fmaxf(__builtin_fmaxf((a),(b)),(c))
  #define GAPA(MF,A0,A1,A2,A3,W0,W1,PW) do{ MF; sacc+=A0; sacc+=A1; sacc+=A2; sacc+=A3; PIN(sacc); W0; W1; PIN(PW); SBAR(); }while(0)
  #define EX(v) __builtin_amdgcn_exp2f(v)
  #define GAPB(MF,RD,X,B) do{ MF; RD; X[B]=EX(X[B]-mhat); X[B+1]=EX(X[B+1]-mhat); PIN(X); SBAR(); }while(0)
  #define VRD(i) do{ vlo[i]=vtr(vp_+(((i)>>2)*4096+((i)&3)*1024)); vhi[i]=vtr(vp_+(((i)>>2)*4096+((i)&3)*1024+512)); }while(0)
  #define VRD2(i) do{ vlo[i]=vtr(vp_+(8192+((i)>>2)*4096+((i)&3)*1024)); vhi[i]=vtr(vp_+(8192+((i)>>2)*4096+((i)&3)*1024+512)); }while(0)
  #define KRD(G,j) do{ if(G){ kload2(kf,kp0+sl_next,j); SBAR(); } }while(0)
  #define STEP(C0,C1,P0,P1,t,GK,GV,GL) do{ SBAR(); \
    const lds_cptr vp_=vp0+2*sl_prev; \
    VRD(0); SBAR(); float sacc=(P0[0]+P0[1]); \
    GAPA(C0=__builtin_amdgcn_mfma_f32_32x32x16_bf16(kf[0],qr[0],ZERO16,0,0,0), P0[2],P0[3],P0[4],P0[5],     pw0[0]=PKW(P0,0), pw0[1]=PKW(P0,2), pw0); \
    VRD(4); SBAR(); GAPA(C1=__builtin_amdgcn_mfma_f32_32x32x16_bf16(kf[1],qr[0],ZERO16,0,0,0), P0[6],P0[7],P0[8],P0[9],     pw0[2]=PKW(P0,4), pw0[3]=PKW(P0,6), pw0); \
    VRD(1); SBAR(); GAPA(C0=__builtin_amdgcn_mfma_f32_32x32x16_bf16(kf[2],qr[1],C0,0,0,0),   P0[10],P0[11],P0[12],P0[13], pw1[0]=PKW(P0,8), pw1[1]=PKW(P0,10), pw1); \
    VRD(5); SBAR(); GAPA(C1=__builtin_amdgcn_mfma_f32_32x32x16_bf16(kf[3],qr[1],C1,0,0,0),   P0[14],P0[15],P1[0],P1[1],   pw1[2]=PKW(P0,12),pw1[3]=PKW(P0,14), pw1); \
    VRD(2); SBAR(); GAPA(C0=__builtin_amdgcn_mfma_f32_32x32x16_bf16(kf[4],qr[2],C0,0,0,0),   P1[2],P1[3],P1[4],P1[5],     pw2[0]=PKW(P1,0), pw2[1]=PKW(P1,2), pw2); \
    VRD(6); SBAR(); GAPA(C1=__builtin_amdgcn_mfma_f32_32x32x16_bf16(kf[5],qr[2],C1,0,0,0),   P1[6],P1[7],P1[8],P1[9],     pw2[2]=PKW(P1,4), pw2[3]=PKW(P1,6), pw2); \
    VRD(3); SBAR(); GAPA(C0=__builtin_amdgcn_mfma_f32_32x32x16_bf16(kf[6],qr[3],C0,0,0,0),   P1[10],P1[11],P1[12],P1[13], pw3[0]=PKW(P1,8), pw3[1]=PKW(P1,10), pw3); \
    VRD(7); SBAR(); GAPA(C1=__builtin_amdgcn_mfma_f32_32x32x16_bf16(kf[7],qr[3],C1,0,0,0),   P1[14],P1[15],0.f,0.f,       pw3[2]=PKW(P1,12),pw3[3]=PKW(P1,14), pw3); \
    l_reg+=sacc; \
    if(GK){DMA_K((t)+3,sl_cur);} if(GV){DMA_V((t)+1,sl_next);} \
    CMASK(C0,C1,t); \
    { float a=MX3(C0[0],C0[1],C1[0]),b=MX3(C0[2],C0[3],C1[1]); a=MX3(a,C1[2],C1[3]); \
      _Pragma("unroll") for(int r=4;r<16;r+=4){a=MX3(a,C0[r],C0[r+1]);b=MX3(b,C0[r+2],C0[r+3]);a=MX3(a,C1[r],C1[r+1]);b=MX3(b,C1[r+2],C1[r+3]);} \
      float rm=__builtin_fmaxf(a,b); { auto rr=__builtin_amdgcn_permlane32_swap(__float_as_uint(rm),__float_as_uint(rm),false,false); rm=__builtin_fmaxf(__uint_as_float(rr[0]),__uint_as_float(rr[1])); } \
      resc=false; rm-=mhat;   \
      if(__builtin_expect(__any(rm>(float)THRL),0)){ const float dl=__builtin_fmaxf(rm,0.f); mhat+=dl; \
        const float f=__builtin_amdgcn_exp2f(-dl); l_reg*=f; if(hi==0)wsf[r32]=f; resc=true; } } \
    SBAR(); \
    GAPB(o[0]=__builtin_amdgcn_mfma_f32_32x32x16_bf16(PAF(0),VFR(0),o[0],0,0,0), VRD2(0), C0,0); \
    GAPB(o[1]=__builtin_amdgcn_mfma_f32_32x32x16_bf16(PAF(0),VFR(4),o[1],0,0,0), VRD2(4), C0,2); \
    GAPB(o[0]=__builtin_amdgcn_mfma_f32_32x32x16_bf16(PAF(1),VFR(1),o[0],0,0,0), VRD2(1), C0,4); \
    GAPB(o[1]=__builtin_amdgcn_mfma_f32_32x32x16_bf16(PAF(1),VFR(5),o[1],0,0,0), VRD2(5), C0,6); \
    GAPB(o[0]=__builtin_amdgcn_mfma_f32_32x32x16_bf16(PAF(2),VFR(2),o[0],0,0,0), VRD2(2), C0,8); \
    GAPB(o[1]=__builtin_amdgcn_mfma_f32_32x32x16_bf16(PAF(2),VFR(6),o[1],0,0,0), VRD2(6), C0,10); \
    GAPB(o[0]=__builtin_amdgcn_mfma_f32_32x32x16_bf16(PAF(3),VFR(3),o[0],0,0,0), VRD2(3), C0,12); \
    GAPB(o[1]=__builtin_amdgcn_mfma_f32_32x32x16_bf16(PAF(3),VFR(7),o[1],0,0,0), VRD2(7), C0,14); \
    KRD(GL,0); GAPB(o[2]=__builtin_amdgcn_mfma_f32_32x32x16_bf16(PAF(0),VFR(0),o[2],0,0,0), (void)0, C1,0); \
    GAPB(o[3]=__builtin_amdgcn_mfma_f32_32x32x16_bf16(PAF(0),VFR(4),o[3],0,0,0), (void)0, C1,2); \
    KRD(GL,1); GAPB(o[2]=__builtin_amdgcn_mfma_f32_32x32x16_bf16(PAF(1),VFR(1),o[2],0,0,0), (void)0, C1,4); \
    GAPB(o[3]=__builtin_amdgcn_mfma_f32_32x32x16_bf16(PAF(1),VFR(5),o[3],0,0,0), (void)0, C1,6); \
    KRD(GL,2); GAPB(o[2]=__builtin_amdgcn_mfma_f32_32x32x16_bf16(PAF(2),VFR(2),o[2],0,0,0), (void)0, C1,8); \
    GAPB(o[3]=__builtin_amdgcn_mfma_f32_32x32x16_bf16(PAF(2),VFR(6),o[3],0,0,0), (void)0, C1,10); \
    KRD(GL,3); GAPB(o[2]=__builtin_amdgcn_mfma_f32_32x32x16_bf16(PAF(3),VFR(3),o[2],0,0,0), (void)0, C1,12); \
    GAPB(o[3]=__builtin_amdgcn_mfma_f32_32x32x16_bf16(PAF(3),VFR(7),o[3],0,0,0), (void)0, C1,14); \
    }while(0)
  int t=1;
  #undef CMASK
  #define CMASK(P0,P1,t) do{}while(0)
  for(;t+5<NT;t+=2){
    STEP(pB0,pB1,pA0,pA1,t,true,true,true);     WAIT_BAR(3); RESC(); ROT();
    STEP(pA0,pA1,pB0,pB1,t+1,true,true,true);   WAIT_BAR(3); RESC(); ROT();
  }
  #undef CMASK
  #define CMASK(P0,P1,t) do{int jb_=(t)-(NT-4); if(jb_>=0)cmask(P0,P1,jb_,qrel,hi);}while(0)
  #define ENDW(tt) do{ if((tt)+3<NT){WAIT_BAR(3);} else if((tt)+2<NT){WAIT_BAR(2);} else {WAIT_BAR(0);} }while(0)
  for(;t+1<NT;t+=2){
    STEP(pB0,pB1,pA0,pA1,t,(t+3<NT),(t+1<NT),(t+1<NT));       ENDW(t);   RESC(); ROT();
    STEP(pA0,pA1,pB0,pB1,t+1,(t+4<NT),(t+2<NT),(t+2<NT));     ENDW(t+1); RESC(); ROT();
  }
  STEP(pB0,pB1,pA0,pA1,NT-1,false,false,false); RESC();
  { float sacc=pB0[0]+pB0[1]; _Pragma("unroll") for(int r=2;r<16;++r)sacc+=pB0[r]; _Pragma("unroll") for(int r=0;r<16;++r)sacc+=pB1[r]; l_reg+=sacc;
    pw0=(u32x4){PKW(pB0,0),PKW(pB0,2),PKW(pB0,4),PKW(pB0,6)};pw1=(u32x4){PKW(pB0,8),PKW(pB0,10),PKW(pB0,12),PKW(pB0,14)};pw2=(u32x4){PKW(pB1,0),PKW(pB1,2),PKW(pB1,4),PKW(pB1,6)};pw3=(u32x4){PKW(pB1,8),PKW(pB1,10),PKW(pB1,12),PKW(pB1,14)};
    SBAR(); pv(o,vb0+2*sl_cur,PAF(0),PAF(1),PAF(2),PAF(3)); }
  #undef PKW
  #undef PAF
  #undef VFR
  #undef PIN
  #undef MX3
  #undef GAPA
  #undef GAPB
  #undef EX
  #undef VRD
  #undef VRD2
  #undef KRD
  #undef STEP
  #undef ENDW
  {auto rr=__builtin_amdgcn_permlane32_swap(__float_as_uint(l_reg),__float_as_uint(l_reg),false,false);l_reg=__uint_as_float(rr[0])+__uint_as_float(rr[1]);}
  if(hi==0)wsf[32+r32]=l_reg;asm volatile("s_waitcnt lgkmcnt(0)":::"memory");
  float rli[16];
  #pragma unroll
  for(int r=0;r<16;++r)rli[r]=__builtin_amdgcn_rcpf(wsf[32+crow(r,hi)]);
  bf16*Ow=O+(rowbase+q0+wid*QBLK)*DM+hv*2*D;
  asm volatile("s_waitcnt lgkmcnt(0)\n\ts_barrier":::"memory");
  { bf16*stg=(bf16*)(shm+LDS_K)+wid*4096;
    const bf16*O2w=O2+(rowbase+q0+wid*QBLK)*DM+hv*2*D;
    #pragma unroll
    for(int r=0;r<16;++r){const int orow=crow(r,hi);
      #pragma unroll
      for(int d0=0;d0<4;++d0)stg[orow*128+d0*32+r32]=__float2bfloat16(o[d0][r]*rli[r]);}
    asm volatile("s_waitcnt lgkmcnt(0)":::"memory");
    #pragma unroll
    for(int i=0;i<4;++i){const int row=i*8+(lane>>3),ch=lane&7;
      const u32x4 v0=*(const u32x4*)(stg+row*128+ch*8), v1=*(const u32x4*)(stg+row*128+64+ch*8);
      if(!FUSE){ ATTN_STORE16(Ow+(long)row*DM+ch*8,v0); ATTN_STORE16(Ow+(long)row*DM+64+ch*8,v1); }
      else{ const u32x4 t0=*(const u32x4*)(O2w+(long)row*DM+ch*8), t1=*(const u32x4*)(O2w+(long)row*DM+64+ch*8);
        float c[16]; float ss=0.f;
        #pragma unroll
        for(int k=0;k<4;++k){ c[2*k]=__uint_as_float(v0[k]<<16)-lam*__uint_as_float(t0[k]<<16); c[2*k+1]=__uint_as_float(v0[k]&0xffff0000u)-lam*__uint_as_float(t0[k]&0xffff0000u);
          c[8+2*k]=__uint_as_float(v1[k]<<16)-lam*__uint_as_float(t1[k]<<16); c[8+2*k+1]=__uint_as_float(v1[k]&0xffff0000u)-lam*__uint_as_float(t1[k]&0xffff0000u); }
        #pragma unroll
        for(int k=0;k<16;++k)ss+=c[k]*c[k];
        ss+=__int_as_float(__builtin_amdgcn_ds_swizzle(__float_as_int(ss),(1<<10)|0x1f)); ss+=__int_as_float(__builtin_amdgcn_ds_swizzle(__float_as_int(ss),(2<<10)|0x1f)); ss+=__int_as_float(__builtin_amdgcn_ds_swizzle(__float_as_int(ss),(4<<10)|0x1f));
        const float rs=__builtin_amdgcn_rsqf(ss*(1.f/128.f)+1e-6f);
        const float4 g0=*(const float4*)(gsub+ch*8), g1=*(const float4*)(gsub+ch*8+4), g2=*(const float4*)(gsub+64+ch*8), g3=*(const float4*)(gsub+64+ch*8+4);
        u32x4 w0,w1;
        w0[0]=cvtpk_s(c[0]*rs*g0.x,c[1]*rs*g0.y); w0[1]=cvtpk_s(c[2]*rs*g0.z,c[3]*rs*g0.w); w0[2]=cvtpk_s(c[4]*rs*g1.x,c[5]*rs*g1.y); w0[3]=cvtpk_s(c[6]*rs*g1.z,c[7]*rs*g1.w);
        w1[0]=cvtpk_s(c[8]*rs*g2.x,c[9]*rs*g2.y); w1[1]=cvtpk_s(c[10]*rs*g2.z,c[11]*rs*g2.w); w1[2]=cvtpk_s(c[12]*rs*g3.x,c[13]*rs*g3.y); w1[3]=cvtpk_s(c[14]*rs*g3.z,c[15]*rs*g3.w);
        ATTN_STORE16(Ow+(long)row*DM+ch*8,w0); ATTN_STORE16(Ow+(long)row*DM+64+ch*8,w1); } } }
  asm volatile("s_waitcnt lgkmcnt(0)\n\ts_barrier":::"memory");
  #undef DMA_K
  #undef DMA_V
  #undef CMASK
  #undef START
  #undef RESC
  #undef ROT
}
constexpr int ATTN_LDS_BYTES=LDS_BYTES;
struct AttnTensors { const bf16* Q; const bf16* K; const bf16* V; bf16* O2; bf16* YB; };
template<int THRL=8> __device__ __forceinline__ void attn_phase(char*lds,const AttnTensors&T,float lam,const float*gsub,int vcu,int ncu){
  const int bh=(vcu&255)>>3, s=vcu&7; const int b=bh>>3, h=bh&7;
  const float lam_u=__uint_as_float(__builtin_amdgcn_readfirstlane(__float_as_uint(lam)));
  for(int i=0;i<4;++i){ const int qb=(i&2)?15-s:s; const bool fuse=(i&1)!=0;
    attn_unit<THRL>(fuse,b,fuse?2*h:2*h+1,h,qb,T.Q,T.K,T.V,fuse?T.YB:T.O2,T.O2,lam_u,gsub,lds);
  }
}
#undef SBAR
#undef WAIT_BAR
}
constexpr int NWAVES = 8;
#ifndef MK_MULTI
#define MK_MULTI 0
#endif
constexpr int NB = 4, SEQ = 4096, T = NB * SEQ, D = 1024, DIN = 7168, FF = 3584, NEXP = 8, PLE = 256, DEPTH = 2;
constexpr int NPAN = T / 256;
constexpr float EPS = 1e-6f;
constexpr int MOE_ROWS = 2 * T + NEXP * 256;
constexpr int MOE_PANELS = MOE_ROWS / 256, MOE_HALF = MOE_PANELS / 2;
constexpr size_t MiB = 1u << 20;
constexpr size_t WS_CTL = 0, CTL_ZERO_BYTES = 1 * MiB;
constexpr size_t WS_LRUW = 1 * MiB;
constexpr size_t WS_PAR = 1 * MiB + 512 * 1024;
constexpr size_t WS_SUM = 2 * MiB;
constexpr size_t WS_TOK = 4 * MiB;
constexpr size_t WS_LIST = 5 * MiB;
constexpr size_t WS_COS = 6 * MiB;
constexpr size_t WS_WSMALL = 10 * MiB;
constexpr size_t WL_STRIDE = 45 * MiB / 2, WL_WIN = 0, WL_WAB = 14 * MiB, WL_WO = 18 * MiB, WL_WPG = 20 * MiB, WL_WPP = 22 * MiB;
constexpr size_t WS_WGU = WS_WSMALL + 45 * MiB, WS_WD = WS_WGU + 14 * MiB;
constexpr size_t WS_PB = 76 * MiB;
constexpr size_t WS_H = 92 * MiB;
constexpr size_t WS_BIG = 124 * MiB, SLOT = 32 * MiB;
constexpr size_t WS_GG = WS_BIG, WS_RIN = WS_BIG + SLOT, WS_Q = WS_BIG + 2 * SLOT, WS_K = WS_BIG + 3 * SLOT, WS_V = WS_BIG + 4 * SLOT, WS_SGA = WS_BIG + 5 * SLOT, WS_SGB = WS_BIG + 6 * SLOT;
constexpr size_t WS_HL = WS_BIG + 7 * SLOT, WS_LP = WS_BIG + 8 * SLOT, WS_O1 = WS_BIG + 9 * SLOT, WS_O2 = WS_BIG + 10 * SLOT;
constexpr size_t WS_YA = WS_RIN, WS_YB = WS_Q, WS_T1 = WS_K, WS_MERGED = WS_GG, WS_F = WS_SGA;
constexpr size_t WS_ACT = WS_BIG;
constexpr size_t WS_PP = WS_BIG;
constexpr size_t WS_WMGU = WS_BIG, WS_WMD = WS_BIG + 56 * MiB, WS_ACT8 = WS_BIG + 84 * MiB, WS_HG = WS_BIG + 204 * MiB, WS_OE = WS_BIG + 240 * MiB;
constexpr int MOE_MAINP = 128, MOE_KS = 7, MOE_KSB = FF / MOE_KS;
constexpr size_t WS_OEP = WS_OE + 68 * MiB;
constexpr size_t WS_XR = WS_O2 + SLOT;
constexpr size_t WS_END = WS_XR + SLOT;
constexpr float SC_H = 8.f, SC_WGU = 32.f, SC_ACT = 8.f, SC_WD = 64.f;
constexpr int E8_H = 0x7c7c7c7c, E8_WGU = 0x7a7a7a7a, E8_ACT = 0x7c7c7c7c, E8_WD = 0x79797979;
static_assert(WS_OEP + (size_t)MOE_KS * 8 * 256 * D * 2 <= WS_O2 + SLOT && MOE_KS * MOE_KSB == FF && MOE_KSB % 256 == 0 && WS_OE + (size_t)MOE_ROWS * D * 2 <= WS_END && WS_ACT8 + (size_t)MOE_ROWS * FF <= WS_HG && WS_HG + (size_t)MOE_ROWS * D <= WS_OE && WS_WMD + (size_t)NEXP * D * FF <= WS_ACT8, "d_ws map");
constexpr int CW_TMO = 0, CW_CODE = 1;
constexpr int CW_CNT = 64;
constexpr int CW_BAR = 4096;
constexpr int RING_OFF = 0, RING_BYTES = 131072;
constexpr int LDSCTL_OFF = RING_BYTES, MISC_OFF = LDSCTL_OFF + 320;
constexpr int LDS_BYTES = 147456;
static_assert(MISC_OFF + 128 <= LDS_BYTES, "LDS map");
#define GAS __attribute__((address_space(1)))
#define LAS __attribute__((address_space(3)))
typedef unsigned short bf16;
typedef unsigned v4u __attribute__((ext_vector_type(4)));
typedef float f32x4 __attribute__((ext_vector_type(4)));
typedef short bf16x8 __attribute__((ext_vector_type(8)));
typedef GAS unsigned gu32;
typedef GAS unsigned long long gu64;
#define RLX_AGENT __ATOMIC_RELAXED, __HIP_MEMORY_SCOPE_AGENT
#define LDS_WAIT() asm volatile("s_waitcnt lgkmcnt(0)" ::: "memory")
#define VM_WAIT() asm volatile("s_waitcnt vmcnt(0)" ::: "memory")
__device__ __forceinline__ unsigned long long rt() { return __builtin_amdgcn_s_memrealtime(); }
__device__ __forceinline__ unsigned f2bf(float f) { unsigned u = __builtin_bit_cast(unsigned, f); return (u + 0x7fffu + ((u >> 16) & 1u)) >> 16; }
__device__ __forceinline__ unsigned pk2(float lo, float hi) { return f2bf(lo) | (f2bf(hi) << 16); }

#define XB_TMO      128
#define XB_XCNT(j)  (256  + 64 * (j))
#define XB_XSUB(j)  (1280 + 64 * (j))
#define XB_XGEN(j)  (2304 + 64 * (j))
#define XB_TOP      3328
#define XB_TOPGEN   3392
#define XCD_BAR_WORDS 3456
#define XB_SPIN_CAP (1u << 18)

__device__ __forceinline__ unsigned xb_ld(unsigned* p)              { return __hip_atomic_load(p, __ATOMIC_RELAXED, __HIP_MEMORY_SCOPE_AGENT); }
__device__ __forceinline__ unsigned xb_add(unsigned* p, unsigned v) { return __hip_atomic_fetch_add(p, v, __ATOMIC_RELAXED, __HIP_MEMORY_SCOPE_AGENT); }
__device__ __forceinline__ unsigned xb_xcc_id() { return (unsigned)__builtin_amdgcn_s_getreg((3 << 11) | 20) & 0xFu; }
#define XB_SPIN(cond, bar) do { unsigned _sp = 0; while (cond) { __builtin_amdgcn_s_sleep(1); \
    if ((++_sp & 255u) == 0u) { if (xb_ld(&(bar)[XB_TMO])) break; if (_sp > XB_SPIN_CAP) { atomicAdd(&(bar)[XB_TMO], 1u); break; } } } } while (0)

struct XcdBarrier {
    unsigned* bar; unsigned x;
    volatile LAS unsigned* st;
};

__device__ __forceinline__ XcdBarrier xcd_barrier_post(unsigned* bar, volatile LAS unsigned* st) {
    XcdBarrier b; b.bar = bar; b.x = xb_xcc_id(); b.st = st;
    if (threadIdx.x == 0) (void)xb_add(&bar[XB_XCNT(b.x)], 1u);
    return b;
}
__device__ __forceinline__ void xcd_barrier_complete(unsigned* bar, unsigned x, unsigned& nloc, unsigned& nx) {
    const unsigned G = gridDim.x * gridDim.y * gridDim.z;
    unsigned sum, cnt, mine, sp = 0u;
    for (;;) {
        sum = 0u; cnt = 0u; mine = 0u;
#pragma unroll
        for (unsigned j = 0; j < 16; ++j) { const unsigned c = xb_ld(&bar[XB_XCNT(j)]); sum += c; cnt += (c > 0u) ? 1u : 0u; mine = (j == x) ? c : mine; }
        if (sum == G) break;
        __builtin_amdgcn_s_sleep(1);
        if ((++sp & 255u) == 0u) { if (xb_ld(&bar[XB_TMO])) break; if (sp > XB_SPIN_CAP) { atomicAdd(&bar[XB_TMO], 1u); break; } }
    }
    nloc = mine > 0u ? mine : 1u; nx = cnt > 0u ? cnt : 1u;
}

__device__ __forceinline__ void xcd_barrier(const XcdBarrier& b) {
    asm volatile("s_waitcnt vmcnt(0)" ::: "memory");
    __syncthreads();
    if (threadIdx.x == 0) {
        unsigned* bar = b.bar; unsigned bx_ = b.x;
        asm volatile("" : "+s"(bar), "+s"(bx_));
        __builtin_amdgcn_s_waitcnt(0);
        unsigned nloc = b.st[0], nx = b.st[1];
        if (nloc == 0u) { xcd_barrier_complete(bar, bx_, nloc, nx); b.st[0] = nloc; b.st[1] = nx; }
        const unsigned old = xb_add(&bar[XB_XSUB(bx_)], 1u);
        const unsigned gen = old / nloc;
        if (old + 1u == (gen + 1u) * nloc) {
            __builtin_amdgcn_fence(__ATOMIC_RELEASE, "agent");
            asm volatile("s_waitcnt vmcnt(0)" ::: "memory");
            const unsigned og = xb_add(&bar[XB_TOP], 1u);
            const unsigned tg = og / nx;
            if (og + 1u == (tg + 1u) * nx) xb_add(&bar[XB_TOPGEN], 1u);
            else XB_SPIN(xb_ld(&bar[XB_TOPGEN]) == tg, bar);
            __builtin_amdgcn_fence(__ATOMIC_ACQUIRE, "agent");
            xb_add(&bar[XB_XGEN(bx_)], 1u);
            asm volatile("s_waitcnt vmcnt(0)" ::: "memory");
        } else {
            XB_SPIN(xb_ld(&bar[XB_XGEN(bx_)]) == gen, bar);
            __builtin_amdgcn_fence(__ATOMIC_ACQUIRE, "agent");
            asm volatile("s_waitcnt vmcnt(0)" ::: "memory");
        }
    }
    __syncthreads();
}
__device__ const float INV_FREQ[32] = {
    1.0f, 0.74989420933f, 0.56234132519f, 0.42169650343f, 0.31622776602f, 0.23713737057f, 0.17782794100f, 0.13335214322f,
    0.1f, 0.074989420933f, 0.056234132519f, 0.042169650343f, 0.031622776602f, 0.023713737057f, 0.017782794100f, 0.013335214322f,
    0.01f, 0.0074989420933f, 0.0056234132519f, 0.0042169650343f, 0.0031622776602f, 0.0023713737057f, 0.0017782794100f, 0.0013335214322f,
    0.001f, 0.00074989420933f, 0.00056234132519f, 0.00042169650343f, 0.00031622776602f, 0.00023713737057f, 0.00017782794100f, 0.00013335214322f };

#define SWZ_XOR(v, o) __int_as_float(__builtin_amdgcn_ds_swizzle(__float_as_int(v), ((o) << 10) | 0x1f))
__device__ __forceinline__ float half_sum(float v) {
    v += SWZ_XOR(v, 1); v += SWZ_XOR(v, 2); v += SWZ_XOR(v, 4); v += SWZ_XOR(v, 8); v += SWZ_XOR(v, 16);
    return v;
}
__device__ __forceinline__ float wave_sum(float v) {
    v = half_sum(v);
    const auto rr = __builtin_amdgcn_permlane32_swap(__float_as_uint(v), __float_as_uint(v), false, false);
    return __uint_as_float(rr[0]) + __uint_as_float(rr[1]);
}
__device__ __forceinline__ float dot4(f32x4 a, f32x4 b) { return (a.x * b.x + a.y * b.y) + (a.z * b.z + a.w * b.w); }
__device__ __forceinline__ float bf2f(unsigned short v) { return __uint_as_float((unsigned)v << 16); }
typedef unsigned u32x2 __attribute__((ext_vector_type(2)));
__device__ __forceinline__ f32x4 bf4_to_f(u32x2 w) { return (f32x4){__uint_as_float(w.x << 16), __uint_as_float(w.x & 0xffff0000u), __uint_as_float(w.y << 16), __uint_as_float(w.y & 0xffff0000u)}; }
__device__ __forceinline__ u32x2 f_to_bf4(f32x4 v) { u32x2 w; w.x = pk2(v.x, v.y); w.y = pk2(v.z, v.w); return w; }
__device__ __forceinline__ float sigm_f(float v) { return 1.0f / (1.0f + __expf(-v)); }

__device__ __forceinline__ f32x4 bfl4(v4u w) { return (f32x4){__uint_as_float(w.x << 16), __uint_as_float(w.x & 0xffff0000u), __uint_as_float(w.y << 16), __uint_as_float(w.y & 0xffff0000u)}; }
__device__ __forceinline__ f32x4 bfh4(v4u w) { return (f32x4){__uint_as_float(w.z << 16), __uint_as_float(w.z & 0xffff0000u), __uint_as_float(w.w << 16), __uint_as_float(w.w & 0xffff0000u)}; }
__device__ __forceinline__ v4u pk8bf(f32x4 a, f32x4 b) { v4u w; w.x = pk2(a.x, a.y); w.y = pk2(a.z, a.w); w.z = pk2(b.x, b.y); w.w = pk2(b.z, b.w); return w; }
__device__ __forceinline__ void tr_load(float (&r)[32], const float* W, int N, int k0, int n0, int lane) {
#pragma unroll
    for (int i = 0; i < 32; ++i) r[i] = W[(size_t)(k0 + 2 * i + (lane >> 5)) * N + n0 + (lane & 31)];
}
__device__ __forceinline__ void tr_store(const float (&r)[32], int K, bf16* WT, int dest_row0, int k0, LAS float* scr, int lane) {
#pragma unroll
    for (int i = 0; i < 32; ++i) scr[(2 * i + (lane >> 5)) * 33 + (lane & 31)] = r[i];
    LDS_WAIT(); asm volatile("" ::: "memory");
    const int c = lane & 7;
#pragma unroll
    for (int j = 0; j < 4; ++j) { const int n = (lane >> 3) + 8 * j; const LAS float* s = scr + (8 * c) * 33 + n;
        v4u o; o.x = pk2(s[0 * 33], s[1 * 33]); o.y = pk2(s[2 * 33], s[3 * 33]); o.z = pk2(s[4 * 33], s[5 * 33]); o.w = pk2(s[6 * 33], s[7 * 33]);
        *(v4u*)(WT + (size_t)(dest_row0 + n) * K + k0 + 8 * c) = o; }
    LDS_WAIT(); asm volatile("" ::: "memory");
}
template <int MAP> __device__ __forceinline__ int dest_row(int n0) {
    if (MAP == 1) { const int tile = n0 >> 8, w = n0 & 255; return tile * 256 + ((w & 63) >> 5) * 128 + (w >> 6) * 32; }
    if (MAP == 2) return (n0 >> 7) * 256 + (n0 & 127);
    if (MAP == 3) return (n0 >> 7) * 256 + 128 + (n0 & 127);
    return n0;
}
__device__ __forceinline__ float clamp8(float v) { return __builtin_fminf(__builtin_fmaxf(v, -448.f), 448.f); }
__device__ __forceinline__ unsigned pk4f8(float a, float b, float c, float d) { unsigned w = __builtin_amdgcn_cvt_pk_fp8_f32(clamp8(a), clamp8(b), 0u, false); return __builtin_amdgcn_cvt_pk_fp8_f32(clamp8(c), clamp8(d), w, true); }
__device__ __forceinline__ void tr_store8(const float (&r)[32], int K, unsigned char* WT, int dest_row0, int k0, float scale, LAS float* scr, int lane) {
#pragma unroll
    for (int i = 0; i < 32; ++i) scr[(2 * i + (lane >> 5)) * 33 + (lane & 31)] = r[i] * scale;
    LDS_WAIT(); asm volatile("" ::: "memory");
    const int c = lane & 3;
#pragma unroll
    for (int j = 0; j < 2; ++j) { const int n = (lane >> 2) + 16 * j; const LAS float* s = scr + (16 * c) * 33 + n;
        v4u o; o.x = pk4f8(s[0 * 33], s[1 * 33], s[2 * 33], s[3 * 33]); o.y = pk4f8(s[4 * 33], s[5 * 33], s[6 * 33], s[7 * 33]);
        o.z = pk4f8(s[8 * 33], s[9 * 33], s[10 * 33], s[11 * 33]); o.w = pk4f8(s[12 * 33], s[13 * 33], s[14 * 33], s[15 * 33]);
        *(v4u*)(WT + (size_t)(dest_row0 + n) * K + k0 + 16 * c) = o; }
    LDS_WAIT(); asm volatile("" ::: "memory");
}
struct TrItem { const float* W; bf16* WT; int K, N, dest_row0, k0, n0; float s8; };
template <int MAP> __device__ __forceinline__ TrItem tr_item(const float* W, int K, int N, bf16* WT, int row_off, int q, float s8 = 0.f) {
    const int nblk = N / 32, kb = q / nblk, nb = q - kb * nblk; TrItem t; t.W = W; t.WT = WT; t.K = K; t.N = N; t.dest_row0 = row_off + dest_row<MAP>(32 * nb); t.k0 = 64 * kb; t.n0 = 32 * nb; t.s8 = s8; return t;
}
#define TR_STORE(r, t) do { if (F8 && t.s8 != 0.f) tr_store8(r, t.K, (unsigned char*)t.WT, t.dest_row0, t.k0, t.s8, scr, lane); else tr_store(r, t.K, t.WT, t.dest_row0, t.k0, scr, lane); } while (0)
template <bool F8, class Dec> __device__ __forceinline__ void tr_run(const Dec& DEC, int nitems, LAS float* scr, int lane, int gw, int ngw) {
    int it = gw; if (it >= nitems) return;
    float ra[32], rb[32];
    TrItem a = DEC(it), b = a;
    tr_load(ra, a.W, a.N, a.k0, a.n0, lane);
    for (;;) {
        const int it1 = it + ngw; const bool h1 = it1 < nitems;
        if (h1) { b = DEC(it1); tr_load(rb, b.W, b.N, b.k0, b.n0, lane); }
        TR_STORE(ra, a);
        if (!h1) break;
        const int it2 = it1 + ngw; const bool h2 = it2 < nitems;
        if (h2) { a = DEC(it2); tr_load(ra, a.W, a.N, a.k0, a.n0, lane); }
        TR_STORE(rb, b);
        if (!h2) break;
        it = it2;
    }
}

__device__ __forceinline__ void row_post_pre(const f32x4 (&f)[4], const float* xin, float* xout, const float* gpost, const float* gpre, bf16* hrow, int lane, f32x4 (&hn)[4]) {
    float s = 0.f;
#pragma unroll
    for (int j = 0; j < 4; ++j) s += dot4(f[j], f[j]);
    const float rs = rsqrtf(wave_sum(s) * (1.f / D) + EPS);
    f32x4 xv[4]; float s2 = 0.f;
#pragma unroll
    for (int j = 0; j < 4; ++j) { xv[j] = ((const f32x4*)xin)[lane + 64 * j] + f[j] * rs * ((const f32x4*)gpost)[lane + 64 * j]; ((f32x4*)xout)[lane + 64 * j] = xv[j]; s2 += dot4(xv[j], xv[j]); }
    if (gpre) {
        const float rs2 = rsqrtf(wave_sum(s2) * (1.f / D) + EPS);
#pragma unroll
        for (int j = 0; j < 4; ++j) { hn[j] = xv[j] * rs2 * ((const f32x4*)gpre)[lane + 64 * j]; ((u32x2*)hrow)[lane + 64 * j] = f_to_bf4(hn[j]); }
    }
}
struct Args { const void* in[26]; float* out; unsigned char* ws; int ph_lo, ph_hi; };
enum { I_X = 0, I_P, I_POS, I_NORMG, I_WIN, I_CONVW, I_CONVB, I_LWA, I_LBA, I_LWX, I_LBX, I_LLAM, I_DLAM, I_SUBG, I_WPA, I_WPB, I_WOUT, I_FG, I_FU, I_FD, I_RW, I_MG, I_MU, I_MD, I_PWP, I_PWG };

constexpr int PO_NORMG = 0, PO_CONVW = PO_NORMG + DEPTH * 6 * D, PO_CONVB = PO_CONVW + DEPTH * 4 * D, PO_LBA = PO_CONVB + DEPTH * D, PO_LBX = PO_LBA + DEPTH * D, PO_LLAM = PO_LBX + DEPTH * D,
              PO_DLAM = PO_LLAM + DEPTH * D, PO_SUBG = PO_DLAM + DEPTH * 256, PO_RW = PO_SUBG + DEPTH * 128, PO_SUBGS = PO_RW + D * NEXP, PO_END = PO_SUBGS + DEPTH * 128;
static_assert((size_t)PO_END * 4 <= 512 * 1024, "parameter block");
__device__ __forceinline__ void p0_prologue(const Args& A, LAS unsigned char* lds, int vcu, int G) {
#define AIN(k) ((const void*)(const GAS void*)A.in[k])
    int tid_ = threadIdx.x; asm volatile("" : "+v"(tid_)); const int tid = tid_, lane = tid & 63, wave = __builtin_amdgcn_readfirstlane(tid >> 6); (void)tid; (void)lane; (void)wave;
    unsigned char* ws = (unsigned char*)(GAS unsigned char*)A.ws;
    LAS float* scr = (LAS float*)(lds + RING_OFF + wave * 16384);
    const int gw = vcu * NWAVES + wave, ngw = G * NWAVES;
    { struct Dec { const Args& A; unsigned char* ws;
          __device__ __forceinline__ TrItem operator()(int f) const {
              constexpr int I_IN = (D / 64) * (DIN / 32), I_SQ = (D / 64) * (D / 32), I_PP = (PLE / 64) * (D / 32), I_L = I_IN + 4 * I_SQ + I_PP, I_FF = (D / 64) * (FF / 32);
              if (f < DEPTH * I_L) { const int l = f / I_L; int r = f - l * I_L; unsigned char* wl = ws + WS_WSMALL + (size_t)l * WL_STRIDE;
                  if (r < I_IN) return tr_item<1>((const float*)AIN(I_WIN) + (size_t)l * D * DIN, D, DIN, (bf16*)(wl + WL_WIN), 0, r); r -= I_IN;
                  if (r < I_SQ) return tr_item<0>((const float*)AIN(I_WPA) + (size_t)l * D * D, D, D, (bf16*)(wl + WL_WAB), 0, r); r -= I_SQ;
                  if (r < I_SQ) return tr_item<0>((const float*)AIN(I_WPB) + (size_t)l * D * D, D, D, (bf16*)(wl + WL_WAB), D, r); r -= I_SQ;
                  if (r < I_SQ) return tr_item<0>((const float*)AIN(I_WOUT) + (size_t)l * D * D, D, D, (bf16*)(wl + WL_WO), 0, r); r -= I_SQ;
                  if (r < I_SQ) return tr_item<0>((const float*)AIN(I_PWG) + (size_t)l * D * D, D, D, (bf16*)(wl + WL_WPG), 0, r); r -= I_SQ;
                  return tr_item<0>((const float*)AIN(I_PWP) + (size_t)l * PLE * D, PLE, D, (bf16*)(wl + WL_WPP), 0, r); }
              int r = f - DEPTH * I_L;
              if (r < I_FF) return tr_item<2>((const float*)AIN(I_FG), D, FF, (bf16*)(ws + WS_WGU), 0, r); r -= I_FF;
              if (r < I_FF) return tr_item<3>((const float*)AIN(I_FU), D, FF, (bf16*)(ws + WS_WGU), 0, r); r -= I_FF;
              return tr_item<0>((const float*)AIN(I_FD), FF, D, (bf16*)(ws + WS_WD), 0, r); } };
      constexpr int NIT = DEPTH * ((D / 64) * (DIN / 32) + 4 * (D / 64) * (D / 32) + (PLE / 64) * (D / 32)) + 2 * (D / 64) * (FF / 32) + (FF / 64) * (D / 32);
      const Dec dec{A, ws}; tr_run<true>(dec, NIT, scr, lane, gw, ngw); }
    const int gt = gw * 64 + lane, ngt = ngw * 64;
    { const int* pos = (const int*)AIN(I_POS); float* pf = (float*)(ws + WS_COS); for (int i = gt; i < T; i += ngt) pf[i] = (float)pos[i]; }
    { const f32x4* p = (const f32x4*)AIN(I_P); u32x2* pb = (u32x2*)(ws + WS_PB);
      for (int i = gt; i < DEPTH * T * PLE / 4; i += ngt) pb[i] = f_to_bf4(p[i]); }
    { bf16* lw = (bf16*)(ws + WS_LRUW);
      for (int i = gt; i < DEPTH * 16 * 2 * 4096; i += ngt) { const int c = i & 63, d = (i >> 6) & 63, g = (i >> 12) & 1, n = (i >> 13) & 15, l = i >> 17;
          const float* src = (const float*)AIN(g ? I_LWX : I_LWA); lw[i] = (bf16)f2bf(src[((size_t)(l * 16 + n) * 64 + c) * 64 + d]); } }
    { const float* g0 = (const float*)AIN(I_NORMG);
      for (int m = gw; m < T; m += ngw) { const f32x4* xr = (const f32x4*)((const float*)AIN(I_X) + (size_t)m * D); f32x4 v[4]; float s = 0.f;
#pragma unroll
          for (int j = 0; j < 4; ++j) { v[j] = xr[lane + 64 * j]; s += dot4(v[j], v[j]); }
          const float rs = rsqrtf(wave_sum(s) * (1.f / D) + EPS);
#pragma unroll
          for (int j = 0; j < 4; ++j) { ((u32x2*)(ws + WS_XR + (size_t)m * D * 2))[lane + 64 * j] = f_to_bf4(v[j]); ((u32x2*)(ws + WS_H + (size_t)m * D * 2))[lane + 64 * j] = f_to_bf4(v[j] * rs * ((const f32x4*)g0)[lane + 64 * j]); } } }
    { float* par = (float*)(ws + WS_PAR);
      const int srcs[9] = {I_NORMG, I_CONVW, I_CONVB, I_LBA, I_LBX, I_LLAM, I_DLAM, I_SUBG, I_RW};
      const int offs[10] = {PO_NORMG, PO_CONVW, PO_CONVB, PO_LBA, PO_LBX, PO_LLAM, PO_DLAM, PO_SUBG, PO_RW, PO_SUBGS};
#pragma unroll
      for (int k = 0; k < 9; ++k) { const float* src = (const float*)AIN(srcs[k]); const int n = offs[k + 1] - offs[k];
          for (int i = gt; i < n; i += ngt) par[offs[k] + i] = src[i]; }
      for (int i = gt; i < DEPTH * 128; i += ngt) par[PO_SUBGS + i] = ((const float*)AIN(I_SUBG))[i] * (1.0f - (0.8f - 0.6f * expf(-0.3f * (float)(i >> 7)))); }
}

__device__ __forceinline__ unsigned short bf1(float v) { unsigned r; asm("v_cvt_pk_bf16_f32 %0, %1, %1" : "=v"(r) : "v"(v)); return (unsigned short)r; }
__device__ __forceinline__ float sigm_fast(float v) { return __builtin_amdgcn_rcpf(1.0f + __builtin_amdgcn_exp2f(-1.4426950408889634f * v)); }
__device__ __forceinline__ void lru_pass1(unsigned char* ws, LAS unsigned char* lds, int layer, int chunk) {
    int tid_ = threadIdx.x; asm volatile("" : "+v"(tid_)); const int tid = tid_, lane = tid & 63, wave = __builtin_amdgcn_readfirstlane(tid >> 6); (void)tid; (void)lane; (void)wave;
    typedef float f32x16 __attribute__((ext_vector_type(16)));
    const float* par = (const float*)(ws + WS_PAR);
    const int b = chunk >> 6, t0 = (chunk & 63) * 64; const size_t g0 = (size_t)b * SEQ + t0;
    LAS unsigned char* wl = lds + RING_OFF + wave * 16384;
    LAS bf16* U = (LAS bf16*)wl;
    LAS float* Gs = (LAS float*)(wl + 4608);
    const bf16* RIN = (const bf16*)(ws + WS_RIN); bf16* HL = (bf16*)(ws + WS_HL); bf16* LP = (bf16*)(ws + WS_LP);
    const int r32 = lane & 31, hi = lane >> 5;
    float h = 0.f, lpc = 0.f, xm3 = 0.f, xm2 = 0.f, xm1 = 0.f;
    v4u pre[4];
#define LRU_LOAD(nb_, tg_) do { _Pragma("unroll") for (int i = 0; i < 4; ++i) pre[i] = *(const v4u*)(RIN + (g0 + (tg_) * 32 + (lane >> 3) + 8 * i) * D + 64 * (2 * wave + (nb_)) + 8 * (lane & 7)); } while (0)
    LRU_LOAD(0, 0);
    for (int it = 0; it < 4; ++it) { const int nb = it >> 1, tg = it & 1;
        const int n = 2 * wave + nb, ch = 64 * n + lane;
        const float* cw = par + PO_CONVW + (size_t)layer * 4 * D;
        const float cw0 = cw[ch], cw1 = cw[D + ch], cw2 = cw[2 * D + ch], cw3 = cw[3 * D + ch], cb = par[PO_CONVB + layer * D + ch];
        const float ba = par[PO_LBA + layer * D + ch], bx = par[PO_LBX + layer * D + ch];
        const float lam = par[PO_LLAM + layer * D + ch];
        const float c8sp = -8.0f * 1.4426950408889634f * log1pf(__expf(-lam));
        const bf16* lw = (const bf16*)(ws + WS_LRUW) + (size_t)((layer * 16 + n) * 2) * 4096;
        if (tg == 0) { h = 0.f; lpc = 0.f; xm3 = 0.f; xm2 = 0.f; xm1 = 0.f;
            if (t0 > 0) { xm3 = bf2f(RIN[(g0 - 3) * D + ch]); xm2 = bf2f(RIN[(g0 - 2) * D + ch]); xm1 = bf2f(RIN[(g0 - 1) * D + ch]); } }
        const size_t gr = g0 + tg * 32;
        bf16x8 wf[2][2][4];
#pragma unroll
        for (int g = 0; g < 2; ++g)
#pragma unroll
            for (int dh = 0; dh < 2; ++dh)
#pragma unroll
                for (int ks = 0; ks < 4; ++ks) wf[g][dh][ks] = *(const bf16x8*)(lw + (size_t)g * 4096 + (32 * dh + r32) * 64 + 16 * ks + 8 * hi);
#pragma unroll
        for (int i = 0; i < 4; ++i) *(LAS v4u*)(U + ((lane >> 3) + 8 * i) * 72 + 8 * (lane & 7)) = pre[i];
        LDS_WAIT();
        if (it < 3) LRU_LOAD((it + 1) >> 1, (it + 1) & 1);
        float u[32];
#pragma unroll
        for (int t = 0; t < 32; ++t) { const float x = bf2f(U[t * 72 + lane]); u[t] = cb + cw0 * xm3 + cw1 * xm2 + cw2 * xm1 + cw3 * x; xm3 = xm2; xm2 = xm1; xm1 = x; U[t * 72 + lane] = bf1(u[t]); }
        LDS_WAIT();
        float gp[2][32];
#pragma unroll
        for (int g = 0; g < 2; ++g) {
            f32x16 c0 = {}, c1 = {};
#pragma unroll
            for (int ks = 0; ks < 4; ++ks) { const bf16x8 a = *(const LAS bf16x8*)(U + r32 * 72 + 16 * ks + 8 * hi);
                c0 = __builtin_amdgcn_mfma_f32_32x32x16_bf16(a, wf[g][0][ks], c0, 0, 0, 0); c1 = __builtin_amdgcn_mfma_f32_32x32x16_bf16(a, wf[g][1][ks], c1, 0, 0, 0); }
#pragma unroll
            for (int r = 0; r < 16; ++r) { const int row = (r & 3) + 8 * (r >> 2) + 4 * hi; Gs[row * 64 + r32] = c0[r]; Gs[row * 64 + 32 + r32] = c1[r]; }
            LDS_WAIT();
#pragma unroll
            for (int t = 0; t < 32; ++t) gp[g][t] = Gs[t * 64 + lane];
            LDS_WAIT();
        }
        LAS bf16* S2 = (LAS bf16*)Gs;
#pragma unroll
        for (int t = 0; t < 32; ++t) { const float rr = sigm_fast(gp[0][t] + ba), ii = sigm_fast(gp[1][t] + bx), la = c8sp * rr, a = __builtin_amdgcn_exp2f(la);
            const float bb = __builtin_amdgcn_sqrtf(fmaxf(0.f, 1.0f - a * a)) * ii * u[t];
            h = a * h + bb; lpc += la; U[t * 72 + lane] = bf1(h); S2[t * 72 + lane] = bf1(lpc); }
        LDS_WAIT();
#pragma unroll
        for (int i = 0; i < 4; ++i) { const int row = i * 8 + (lane >> 3), cc = lane & 7;
            const v4u a = *(const LAS v4u*)(U + row * 72 + cc * 8), c = *(const LAS v4u*)(S2 + row * 72 + cc * 8);
            *(v4u*)(HL + (gr + row) * D + 64 * n + cc * 8) = a; *(v4u*)(LP + (gr + row) * D + 64 * n + cc * 8) = c; }
        LDS_WAIT();
        if (tg == 1) { float* sum = (float*)(ws + WS_SUM) + (size_t)chunk * 2 * D; sum[ch] = lpc; sum[D + ch] = h; }
    }
#undef LRU_LOAD
}

__device__ __forceinline__ void tp_mix(unsigned char* ws, LAS unsigned char* lds, int layer, int chunk) {
    int tid_ = threadIdx.x; asm volatile("" : "+v"(tid_)); const int tid = tid_, lane = tid & 63, wave = __builtin_amdgcn_readfirstlane(tid >> 6); (void)tid; (void)lane; (void)wave;
    const float* par = (const float*)(ws + WS_PAR);
    LAS float* carry = (LAS float*)(lds + RING_OFF);
    { const float* sum = (const float*)(ws + WS_SUM);
      for (int ch = tid; ch < D; ch += NWAVES * 64) { float c = 0.f;
          const float* sp = sum + (size_t)(chunk & ~63) * 2 * D + ch; const int n = chunk & 63; int cc = 0;
          for (; cc + 8 <= n; cc += 8) { float la[8], bb[8];
#pragma unroll
              for (int k = 0; k < 8; ++k) { la[k] = sp[(size_t)(cc + k) * 2 * D]; bb[k] = sp[(size_t)(cc + k) * 2 * D + D]; }
#pragma unroll
              for (int k = 0; k < 8; ++k) c = __builtin_amdgcn_exp2f(la[k]) * c + bb[k]; }
          for (; cc < n; ++cc) c = __builtin_amdgcn_exp2f(sp[(size_t)cc * 2 * D]) * c + sp[(size_t)cc * 2 * D + D];
          carry[ch] = c; } }
    __syncthreads();
    const int b = chunk >> 6, t0 = (chunk & 63) * 64; const size_t g0 = (size_t)b * SEQ + t0;
    for (int rr = wave; rr < 64; rr += 2 * NWAVES) {
        v4u hl[2][2], lp[2][2], gg[2][2];
#pragma unroll
        for (int q = 0; q < 2; ++q) { const size_t ro = (g0 + rr + q * NWAVES) * D * 2;
#pragma unroll
            for (int j = 0; j < 2; ++j) { hl[q][j] = ((const v4u*)(ws + WS_HL + ro))[lane + 64 * j]; lp[q][j] = ((const v4u*)(ws + WS_LP + ro))[lane + 64 * j]; gg[q][j] = ((const v4u*)(ws + WS_GG + ro))[lane + 64 * j]; } }
#pragma unroll
        for (int q = 0; q < 2; ++q) { const size_t ro = (g0 + rr + q * NWAVES) * D * 2;
#pragma unroll
            for (int j = 0; j < 2; ++j) { const LAS f32x4* c4 = (const LAS f32x4*)carry + 128 * j + 2 * lane;
                const f32x4 l0 = bfl4(lp[q][j]), l1 = bfh4(lp[q][j]);
                const f32x4 e0 = {__builtin_amdgcn_exp2f(l0.x), __builtin_amdgcn_exp2f(l0.y), __builtin_amdgcn_exp2f(l0.z), __builtin_amdgcn_exp2f(l0.w)}, e1 = {__builtin_amdgcn_exp2f(l1.x), __builtin_amdgcn_exp2f(l1.y), __builtin_amdgcn_exp2f(l1.z), __builtin_amdgcn_exp2f(l1.w)};
                ((v4u*)(ws + WS_YA + ro))[lane + 64 * j] = pk8bf((bfl4(hl[q][j]) + e0 * c4[0]) * bfl4(gg[q][j]), (bfh4(hl[q][j]) + e1 * c4[1]) * bfh4(gg[q][j])); } }
    }
    __syncthreads();
}

template <bool DRY> __device__ __forceinline__ void route_row(unsigned char* ws, const LAS float* rwT, const f32x4 (&hn)[2][2], int m, int lane) {
    gu32* ctl = (gu32*)(ws + WS_CTL);
    float lg[NEXP];
#pragma unroll
    for (int e = 0; e < NEXP; ++e) { float s = 0.f;
#pragma unroll
        for (int j = 0; j < 2; ++j) { const LAS f32x4* r4 = (const LAS f32x4*)(rwT + e * D + 512 * j) + 2 * lane; s += dot4(hn[j][0], r4[0]) + dot4(hn[j][1], r4[1]); }
        lg[e] = wave_sum(s); }
    int e0 = 0; float v0 = lg[0];
#pragma unroll
    for (int e = 1; e < NEXP; ++e) if (lg[e] > v0) { v0 = lg[e]; e0 = e; }
    int e1 = -1; float v1 = -INFINITY;
#pragma unroll
    for (int e = 0; e < NEXP; ++e) if (e != e0 && lg[e] > v1) { v1 = lg[e]; e1 = e; }
    const float w1 = 1.0f / (1.0f + __expf(v0 - v1)), w0 = 1.0f - w1;
    if (DRY) { if (w0 + w1 + (float)e0 + (float)e1 == -12345.f) ((float*)(ws + WS_BIG))[m] = w0; }
    if (lane == 0 && !DRY) { const int p0 = (int)__hip_atomic_fetch_add(ctl + CW_CNT + 64 * e0, 1u, RLX_AGENT), p1 = (int)__hip_atomic_fetch_add(ctl + CW_CNT + 64 * e1, 1u, RLX_AGENT);
        int* lst = (int*)(ws + WS_LIST); lst[e0 * T + p0] = m; lst[e1 * T + p1] = m;
        int* ti = (int*)(ws + WS_TOK) + (size_t)m * 8; ti[0] = e0; ti[1] = p0; ti[2] = e1; ti[3] = p1; ti[4] = __float_as_int(w0); ti[5] = __float_as_int(w1); }
}
template <int SRC, bool ROUTE, bool DRY = false, bool H8 = false, bool FINAL = false> __device__ __forceinline__ void tp_post_pre(unsigned char* ws, float* xres, LAS unsigned char* lds, const float* gpost, const float* gpre, int vcu, int G) {
    int tid_ = threadIdx.x; asm volatile("" : "+v"(tid_)); const int tid = tid_, lane = tid & 63, wave = __builtin_amdgcn_readfirstlane(tid >> 6); (void)tid; (void)lane; (void)wave;
    gu32* ctl = (gu32*)(ws + WS_CTL);
    LAS float* rwT = (LAS float*)(lds + RING_OFF);
    int ps[NEXP];
    if (ROUTE) { const float* rw = (const float*)(ws + WS_PAR) + PO_RW; for (int i = tid; i < D * NEXP; i += NWAVES * 64) rwT[(i & 7) * D + (i >> 3)] = rw[i]; __syncthreads(); }
    if (SRC == 1) { int acc = 0;
#pragma unroll
        for (int e = 0; e < NEXP; ++e) { ps[e] = acc; acc += ((int)__hip_atomic_load(ctl + CW_CNT + 64 * e, RLX_AGENT) + 255) >> 8; } }
    const int gw = vcu * NWAVES + wave, ngw = G * NWAVES;
    f32x4 gp[2][2], gq[2][2];
#pragma unroll
    for (int j = 0; j < 2; ++j)
#pragma unroll
        for (int h = 0; h < 2; ++h) { gp[j][h] = ((const f32x4*)gpost)[128 * j + 2 * lane + h]; gq[j][h] = gpre ? ((const f32x4*)gpre)[128 * j + 2 * lane + h] : (f32x4){0.f, 0.f, 0.f, 0.f}; }
    unsigned char* xo = ws + (DRY ? WS_BIG : WS_XR); unsigned char* ho = ws + (DRY ? WS_BIG + 2 * SLOT : WS_H);
    constexpr int NR = (ROUTE || SRC == 1) ? 2 : 8;
    const bool xl = (ngw == 2048);
#define TP_ROW_OF(k) (xl ? ((gw >> 8) << 11) + (gw & 255) + ((k) << 8) : gw + (k) * ngw)
    for (int k0 = 0; TP_ROW_OF(k0) < T && k0 * ngw < T; k0 += NR) {
        v4u fa[NR][2], fc[NR][2], xr[NR][2]; float w0[NR], w1[NR];
#pragma unroll
        for (int r = 0; r < NR; ++r) { const int m = TP_ROW_OF(k0 + r); if ((k0 + r) * ngw < T && m < T) {
            if (SRC == 0) { const v4u* p = (const v4u*)(ws + WS_F + (size_t)m * D * 2) + lane; fa[r][0] = p[0]; fa[r][1] = p[64]; }
            else { const int* ti = (const int*)(ws + WS_TOK) + (size_t)m * 8; const int e0 = ti[0], p0 = ti[1], e1 = ti[2], p1 = ti[3]; w0[r] = __int_as_float(ti[4]); w1[r] = __int_as_float(ti[5]); int s0 = 0, s1 = 0;
#pragma unroll
                for (int e = 0; e < NEXP; ++e) { if (e == e0) s0 = ps[e]; if (e == e1) s1 = ps[e]; }
#define OE_ROW(dst, rw) do { const int rw_ = (rw); if (rw_ < MOE_MAINP * 256) { const v4u* q_ = (const v4u*)(ws + WS_OE + (size_t)rw_ * D * 2) + lane; dst[0] = q_[0]; dst[1] = q_[64]; } \
                    else { f32x4 a0_ = {0.f, 0.f, 0.f, 0.f}, a1_ = a0_, a2_ = a0_, a3_ = a0_; \
                        _Pragma("unroll") for (int ks_ = 0; ks_ < MOE_KS; ++ks_) { const v4u* q_ = (const v4u*)(ws + WS_OEP + ((size_t)ks_ * 8 * 256 + (rw_ - MOE_MAINP * 256)) * D * 2) + lane; const v4u x_ = q_[0], y_ = q_[64]; \
                            a0_ = a0_ + bfl4(x_); a1_ = a1_ + bfh4(x_); a2_ = a2_ + bfl4(y_); a3_ = a3_ + bfh4(y_); } \
                        dst[0] = pk8bf(a0_, a1_); dst[1] = pk8bf(a2_, a3_); } } while (0)
                OE_ROW(fa[r], s0 * 256 + p0); OE_ROW(fc[r], s1 * 256 + p1); }
#undef OE_ROW
            const v4u* xp = (const v4u*)(ws + WS_XR + (size_t)m * D * 2) + lane; xr[r][0] = xp[0]; xr[r][1] = xp[64]; } }
#pragma unroll
        for (int r = 0; r < NR; ++r) { const int m = TP_ROW_OF(k0 + r); if ((k0 + r) * ngw < T && m < T) {
            f32x4 f[2][2], xv[2][2]; float s = 0.f;
#pragma unroll
            for (int j = 0; j < 2; ++j) { f[j][0] = bfl4(fa[r][j]); f[j][1] = bfh4(fa[r][j]);
                if (SRC == 1) { f[j][0] = f[j][0] * w0[r] + bfl4(fc[r][j]) * w1[r]; f[j][1] = f[j][1] * w0[r] + bfh4(fc[r][j]) * w1[r]; }
                s += dot4(f[j][0], f[j][0]) + dot4(f[j][1], f[j][1]); }
            const float rs = rsqrtf(wave_sum(s) * (1.f / D) + EPS); float s2 = 0.f;
#pragma unroll
            for (int j = 0; j < 2; ++j) { xv[j][0] = bfl4(xr[r][j]) + f[j][0] * rs * gp[j][0]; xv[j][1] = bfh4(xr[r][j]) + f[j][1] * rs * gp[j][1];
                if (FINAL && !DRY) { f32x4* o = (f32x4*)(xres + (size_t)m * D) + 128 * j + 2 * lane; o[0] = xv[j][0]; o[1] = xv[j][1]; }
                else ((v4u*)(xo + (size_t)m * D * 2))[lane + 64 * j] = pk8bf(xv[j][0], xv[j][1]);
                s2 += dot4(xv[j][0], xv[j][0]) + dot4(xv[j][1], xv[j][1]); }
            if (gpre) { const float rs2 = rsqrtf(wave_sum(s2) * (1.f / D) + EPS);
#pragma unroll
                for (int j = 0; j < 2; ++j) { xv[j][0] = xv[j][0] * rs2 * gq[j][0]; xv[j][1] = xv[j][1] * rs2 * gq[j][1];
                    if (H8) { u32x2 w; w.x = pk4f8(xv[j][0].x * SC_H, xv[j][0].y * SC_H, xv[j][0].z * SC_H, xv[j][0].w * SC_H); w.y = pk4f8(xv[j][1].x * SC_H, xv[j][1].y * SC_H, xv[j][1].z * SC_H, xv[j][1].w * SC_H);
                        ((u32x2*)(ho + (size_t)m * D))[lane + 64 * j] = w; }
                    else ((v4u*)(ho + (size_t)m * D * 2))[lane + 64 * j] = pk8bf(xv[j][0], xv[j][1]); }
                if (ROUTE) route_row<DRY>(ws, rwT, xv, m, lane); } } }
    }
#undef TP_ROW_OF
    if (ROUTE) __syncthreads();
}

__device__ __forceinline__ void pm0_moe_setup(unsigned char* ws, const float* mg, const float* mu, const float* md, LAS unsigned char* lds, int vcu, int G) {
    int tid_ = threadIdx.x; asm volatile("" : "+v"(tid_)); const int tid = tid_, lane = tid & 63, wave = __builtin_amdgcn_readfirstlane(tid >> 6); (void)tid; (void)lane; (void)wave;
    gu32* ctl = (gu32*)(ws + WS_CTL);
    LAS float* scr = (LAS float*)(lds + RING_OFF + wave * 16384);
    const int gw = vcu * NWAVES + wave, ngw = G * NWAVES;
    int cs[NEXP + 1], ps[NEXP]; { int a = 0, p = 0;
#pragma unroll
        for (int e = 0; e < NEXP; ++e) { const int c = (int)__hip_atomic_load(ctl + CW_CNT + 64 * e, RLX_AGENT); cs[e] = a; ps[e] = p; a += c; p += (c + 255) >> 8; } cs[NEXP] = a; }
    const int* lst = (const int*)(ws + WS_LIST);
    for (int i = gw; i < cs[NEXP]; i += ngw) { int e = 0, base = 0, pst = 0;
#pragma unroll
        for (int k = 0; k < NEXP; ++k) if (i >= cs[k]) { e = k; base = cs[k]; pst = ps[k]; }
        const int pos = i - base, tok = lst[e * T + pos];
        ((v4u*)(ws + WS_HG + ((size_t)pst * 256 + pos) * D))[lane] = ((const v4u*)(ws + WS_H + (size_t)tok * D))[lane]; }
    { struct Dec { const float* mg; const float* mu; const float* md; unsigned char* ws;
          __device__ __forceinline__ TrItem operator()(int f) const {
              constexpr int I_FF = (D / 64) * (FF / 32);
              const int e = f / (3 * I_FF); int r = f - e * 3 * I_FF;
              if (r < I_FF) return tr_item<2>(mg + (size_t)e * D * FF, D, FF, (bf16*)(ws + WS_WMGU), e * 2 * FF, r, SC_WGU); r -= I_FF;
              if (r < I_FF) return tr_item<3>(mu + (size_t)e * D * FF, D, FF, (bf16*)(ws + WS_WMGU), e * 2 * FF, r, SC_WGU); r -= I_FF;
              return tr_item<0>(md + (size_t)e * FF * D, FF, D, (bf16*)(ws + WS_WMD), e * D, r, SC_WD); } };
      const Dec dec{mg, mu, md, ws}; tr_run<true>(dec, NEXP * 3 * (D / 64) * (FF / 32), scr, lane, gw, ngw); }
}
constexpr int NPH_L = 14, NPHASES = 1 + DEPTH * NPH_L;
__host__ __device__ constexpr bool phase_exists(int ph) { return ph == 0 || !((((ph - 1) % NPH_L) == 9 || ((ph - 1) % NPH_L) == 10) || (((ph - 1) / NPH_L) % 2 == 0 && ((ph - 1) % NPH_L) == 6)); }

__global__ void __launch_bounds__(NWAVES * 64, 2) mk_fwd(Args args) {
    extern __shared__ __attribute__((aligned(16))) unsigned char lds_raw[];
    LAS unsigned char* lds = (LAS unsigned char*)lds_raw;
    volatile LAS unsigned* MISC = (volatile LAS unsigned*)(lds + MISC_OFF);
    const int tid = threadIdx.x;
    const int Gk = gridDim.x; const int bxk = blockIdx.x; const int vcuk = (Gk % 8 == 0) ? (bxk % 8) * (Gk / 8) + bxk / 8 : bxk;
    for (int u = tid; u < (LDS_BYTES - LDSCTL_OFF) / 4; u += NWAVES * 64) ((LAS unsigned*)(lds + LDSCTL_OFF))[u] = 0u;
    __syncthreads();
    XcdBarrier bar; bar.bar = (unsigned*)(args.ws + WS_CTL) + CW_BAR; bar.x = 0; bar.st = nullptr;
    if (!MK_MULTI) bar = xcd_barrier_post((unsigned*)(args.ws + WS_CTL) + CW_BAR, MISC + 8);
    const int lo = args.ph_lo, hi = args.ph_hi;
#ifndef DIS
#define DIS 0
#endif
#ifndef REPN
#define REPN 1
#endif
#ifndef REP
#define REP 0
#endif
#define EN(b) (!((DIS >> (b)) & 1))
#define IN(k) (lo <= (k) && (k) < hi)
#define PH_WS int z_ = 0, G = Gk, bx = bxk, vcu = vcuk; asm volatile("" : "+s"(z_), "+s"(G), "+s"(bx), "+s"(vcu)); unsigned char* ws = (unsigned char*)((GAS unsigned char*)args.ws + z_); (void)ws; (void)G; (void)bx; (void)vcu
#define XOUT ((float*)((GAS float*)args.out + z_))
#define GIN(k) ((const float*)((const GAS float*)args.in[k] + z_))
#define SEAM(k) do { if ((k) + 1 < hi) { if (MK_MULTI) { if (tid == 0) __hip_atomic_store((gu32*)(ws + WS_CTL) + CW_TMO, 0xBADBA0u, RLX_AGENT); } else xcd_barrier(bar); } } while (0)

    if (EN(0) && IN(0)) { PH_WS;
#if (REP >> 0) & 1
            for (int repn_ = 0; repn_ < REPN; ++repn_)
        { p0_prologue(args, lds, vcu, G); }
        __syncthreads();
#endif
        p0_prologue(args, lds, vcu, G);
        SEAM(0); }

    for (int l = 0; l < DEPTH; ++l) {
        const int pb = 1 + NPH_L * l;
        if (EN(1) && IN(pb + 0)) { PH_WS;
#if (REP >> 1) & 1
            for (int repn_ = 0; repn_ < REPN; ++repn_)
            { unsigned char* wl = ws + WS_WSMALL + (size_t)l * WL_STRIDE;
            pg8::Gemm g{(const pg8::bf16_t*)(ws + WS_H), (const pg8::bf16_t*)(wl + WL_WIN), T, DIN, D}; pg8::StaticOrder S; S.init(T, DIN, G, bx);
            pg8::EpiInProj E{(pg8::bf16_t*)(ws + WS_BIG), SLOT / 2, (const float*)(ws + WS_COS), attn_body::C2};
#ifdef STAGGER_US
            if (bx & 1) { const unsigned long long t0_ = __builtin_amdgcn_s_memrealtime(); while (__builtin_amdgcn_s_memrealtime() - t0_ < (unsigned long long)(STAGGER_US * 100)) __builtin_amdgcn_s_sleep(8); }
#endif
            pg8::gemm_phase<pg8::EpiInProj, pg8::StaticOrder, true, true>(lds + RING_OFF, g, S, E);
            }
            __syncthreads();
#endif
            unsigned char* wl = ws + WS_WSMALL + (size_t)l * WL_STRIDE;
            pg8::Gemm g{(const pg8::bf16_t*)(ws + WS_H), (const pg8::bf16_t*)(wl + WL_WIN), T, DIN, D}; pg8::StaticOrder S; S.init(T, DIN, G, bx);
            pg8::EpiInProj E{(pg8::bf16_t*)(ws + WS_BIG), SLOT / 2, (const float*)(ws + WS_COS), attn_body::C2};
#ifdef STAGGER_US
            if (bx & 1) { const unsigned long long t0_ = __builtin_amdgcn_s_memrealtime(); while (__builtin_amdgcn_s_memrealtime() - t0_ < (unsigned long long)(STAGGER_US * 100)) __builtin_amdgcn_s_sleep(8); }
#endif
            pg8::gemm_phase<pg8::EpiInProj, pg8::StaticOrder, true, true>(lds + RING_OFF, g, S, E);

            SEAM(pb + 0);
        }
        if (EN(2) && IN(pb + 1)) { PH_WS;
#if (REP >> 2) & 1
            for (int repn_ = 0; repn_ < REPN; ++repn_)
            {
#if !defined(NO_LRU) && !defined(DUP_NO_LRU)
            for (int c = vcu; c < 256; c += G) lru_pass1(ws, lds, l, c);
            __syncthreads();
#endif
#if !defined(NO_ATT) && !defined(DUP_NO_ATT)
            const attn_body::AttnTensors AT{(const attn_body::bf16*)(ws + WS_Q), (const attn_body::bf16*)(ws + WS_K), (const attn_body::bf16*)(ws + WS_V), (attn_body::bf16*)(ws + WS_O2), (attn_body::bf16*)(ws + WS_YB)};
            { const float* par = (const float*)(ws + WS_PAR); const float* dl = par + PO_DLAM + l * 256; int t_ = threadIdx.x; asm volatile("" : "+v"(t_)); const int ln_ = t_ & 63;
              const float lamv = expf(wave_sum(dl[ln_] * dl[64 + ln_])) - expf(wave_sum(dl[128 + ln_] * dl[192 + ln_])) + (0.8f - 0.6f * expf(-0.3f * (float)l));
              attn_body::attn_phase<8>((char*)lds_raw + RING_OFF, AT, lamv, par + PO_SUBGS + l * 128, vcu, G); }
#endif
            }
            __syncthreads();
#endif

#ifndef NO_LRU
            for (int c = vcu; c < 256; c += G) lru_pass1(ws, lds, l, c);
            __syncthreads();
#endif
#ifndef NO_ATT
            const attn_body::AttnTensors AT{(const attn_body::bf16*)(ws + WS_Q), (const attn_body::bf16*)(ws + WS_K), (const attn_body::bf16*)(ws + WS_V), (attn_body::bf16*)(ws + WS_O2), (attn_body::bf16*)(ws + WS_YB)};
            { const float* par = (const float*)(ws + WS_PAR); const float* dl = par + PO_DLAM + l * 256; int t_ = threadIdx.x; asm volatile("" : "+v"(t_)); const int ln_ = t_ & 63;
              const float lamv = expf(wave_sum(dl[ln_] * dl[64 + ln_])) - expf(wave_sum(dl[128 + ln_] * dl[192 + ln_])) + (0.8f - 0.6f * expf(-0.3f * (float)l));
              attn_body::attn_phase<8>((char*)lds_raw + RING_OFF, AT, lamv, par + PO_SUBGS + l * 128, vcu, G); }
#endif

            SEAM(pb + 1);
        }
        if (EN(3) && IN(pb + 2)) { PH_WS;
#if (REP >> 3) & 1
            for (int repn_ = 0; repn_ < REPN; ++repn_)
            { for (int c = vcu; c < 256; c += G) tp_mix(ws, lds, l, c); }
            __syncthreads();
#endif
            for (int c = vcu; c < 256; c += G) tp_mix(ws, lds, l, c);
            SEAM(pb + 2); }
        if (EN(4) && IN(pb + 3)) { PH_WS;
#if (REP >> 4) & 1
            for (int repn_ = 0; repn_ < REPN; ++repn_)
            { unsigned char* wl = ws + WS_WSMALL + (size_t)l * WL_STRIDE;
            pg8::Gemm g{(const pg8::bf16_t*)(ws + WS_YA), (const pg8::bf16_t*)(wl + WL_WAB), T, D, D}; pg8::PairOrder S; S.base.init(T, D, G, bx);
            pg8::EpiMerge E{(const pg8::bf16_t*)(ws + WS_SGA), (const pg8::bf16_t*)(ws + WS_SGB), (pg8::bf16_t*)(ws + WS_T1), (pg8::bf16_t*)(ws + WS_MERGED), NPAN};
            pg8::gemm_phase<pg8::EpiMerge, pg8::PairOrder, true, true>(lds + RING_OFF, g, S, E);
            }
            __syncthreads();
#endif
            unsigned char* wl = ws + WS_WSMALL + (size_t)l * WL_STRIDE;
            pg8::Gemm g{(const pg8::bf16_t*)(ws + WS_YA), (const pg8::bf16_t*)(wl + WL_WAB), T, D, D}; pg8::PairOrder S; S.base.init(T, D, G, bx);
            pg8::EpiMerge E{(const pg8::bf16_t*)(ws + WS_SGA), (const pg8::bf16_t*)(ws + WS_SGB), (pg8::bf16_t*)(ws + WS_T1), (pg8::bf16_t*)(ws + WS_MERGED), NPAN};
            pg8::gemm_phase<pg8::EpiMerge, pg8::PairOrder, true, true>(lds + RING_OFF, g, S, E);

            SEAM(pb + 3);
        }
        if (EN(5) && IN(pb + 4)) { PH_WS;
#if (REP >> 5) & 1
            for (int repn_ = 0; repn_ < REPN; ++repn_)
            { unsigned char* wl = ws + WS_WSMALL + (size_t)l * WL_STRIDE;
            pg8::Gemm g{(const pg8::bf16_t*)(ws + WS_MERGED), (const pg8::bf16_t*)(wl + WL_WO), T, D, D}; pg8::StaticOrder S; S.init(T, D, G, bx);
            pg8::EpiPlainBf16 E{(pg8::bf16_t*)(ws + WS_F), D, 3};
            pg8::gemm_phase<pg8::EpiPlainBf16, pg8::StaticOrder, false, true>(lds + RING_OFF, g, S, E);
            }
            __syncthreads();
#endif
            unsigned char* wl = ws + WS_WSMALL + (size_t)l * WL_STRIDE;
            pg8::Gemm g{(const pg8::bf16_t*)(ws + WS_MERGED), (const pg8::bf16_t*)(wl + WL_WO), T, D, D}; pg8::StaticOrder S; S.init(T, D, G, bx);
            pg8::EpiPlainBf16 E{(pg8::bf16_t*)(ws + WS_F), D, 3};
            pg8::gemm_phase<pg8::EpiPlainBf16, pg8::StaticOrder, false, true>(lds + RING_OFF, g, S, E);

            SEAM(pb + 4);
        }
        if (EN(6) && IN(pb + 5)) { PH_WS;
#if (REP >> 6) & 1
            for (int repn_ = 0; repn_ < REPN; ++repn_)
            { const float* ng = (const float*)(ws + WS_PAR) + PO_NORMG + (size_t)l * 6 * D;
            if (l & 1) tp_post_pre<0, true, true, true>(ws, XOUT, lds, ng + 1 * D, ng + 2 * D, vcu, G);
            else tp_post_pre<0, false, true>(ws, XOUT, lds, ng + 1 * D, ng + 2 * D, vcu, G);
            }
            __syncthreads();
#endif
            const float* ng = (const float*)(ws + WS_PAR) + PO_NORMG + (size_t)l * 6 * D;
            if (l & 1) tp_post_pre<0, true, false, true>(ws, XOUT, lds, ng + 1 * D, ng + 2 * D, vcu, G);
            else tp_post_pre<0, false>(ws, XOUT, lds, ng + 1 * D, ng + 2 * D, vcu, G);

            SEAM(pb + 5);
        }
        if (!(l & 1)) {
            if (EN(7) && IN(pb + 7)) { PH_WS;
#if (REP >> 7) & 1
            for (int repn_ = 0; repn_ < REPN; ++repn_)
                {
                pg8::Gemm g{(const pg8::bf16_t*)(ws + WS_H), (const pg8::bf16_t*)(ws + WS_WGU), T, 2 * FF, D}; pg8::StaticOrder S; S.init(T, 2 * FF, G, bx);
                pg8::EpiSwiGLU E{(pg8::bf16_t*)(ws + WS_ACT), FF, 2 * FF / 256, 0};
#ifdef STAGGER_US
            if (bx & 1) { const unsigned long long t0_ = __builtin_amdgcn_s_memrealtime(); while (__builtin_amdgcn_s_memrealtime() - t0_ < (unsigned long long)(STAGGER_US * 100)) __builtin_amdgcn_s_sleep(8); }
#endif
                pg8::gemm_phase<pg8::EpiSwiGLU, pg8::StaticOrder, true, true>(lds + RING_OFF, g, S, E);
                }
                __syncthreads();
#endif

                pg8::Gemm g{(const pg8::bf16_t*)(ws + WS_H), (const pg8::bf16_t*)(ws + WS_WGU), T, 2 * FF, D}; pg8::StaticOrder S; S.init(T, 2 * FF, G, bx);
                pg8::EpiSwiGLU E{(pg8::bf16_t*)(ws + WS_ACT), FF, 2 * FF / 256, 0};
#ifdef STAGGER_US
            if (bx & 1) { const unsigned long long t0_ = __builtin_amdgcn_s_memrealtime(); while (__builtin_amdgcn_s_memrealtime() - t0_ < (unsigned long long)(STAGGER_US * 100)) __builtin_amdgcn_s_sleep(8); }
#endif
                pg8::gemm_phase<pg8::EpiSwiGLU, pg8::StaticOrder, true, true>(lds + RING_OFF, g, S, E);

                SEAM(pb + 7);
            }
            if (EN(8) && IN(pb + 8)) { PH_WS;
#if (REP >> 8) & 1
            for (int repn_ = 0; repn_ < REPN; ++repn_)
                {
                pg8::Gemm g{(const pg8::bf16_t*)(ws + WS_ACT), (const pg8::bf16_t*)(ws + WS_WD), T, D, FF}; pg8::StaticOrder S; S.init(T, D, G, bx);
                pg8::EpiPlainBf16 E{(pg8::bf16_t*)(ws + WS_F), D, 3};
                pg8::gemm_phase<pg8::EpiPlainBf16, pg8::StaticOrder, false, true>(lds + RING_OFF, g, S, E);
                }
                __syncthreads();
#endif

                pg8::Gemm g{(const pg8::bf16_t*)(ws + WS_ACT), (const pg8::bf16_t*)(ws + WS_WD), T, D, FF}; pg8::StaticOrder S; S.init(T, D, G, bx);
                pg8::EpiPlainBf16 E{(pg8::bf16_t*)(ws + WS_F), D, 3};
                pg8::gemm_phase<pg8::EpiPlainBf16, pg8::StaticOrder, false, true>(lds + RING_OFF, g, S, E);

                SEAM(pb + 8);
            }
            if (EN(9) && IN(pb + 11)) { PH_WS;
#if (REP >> 9) & 1
            for (int repn_ = 0; repn_ < REPN; ++repn_)
                { const float* ng = (const float*)(ws + WS_PAR) + PO_NORMG + (size_t)l * 6 * D;
                tp_post_pre<0, false, true>(ws, XOUT, lds, ng + 3 * D, ng + 4 * D, vcu, G); }
                __syncthreads();
#endif
                const float* ng = (const float*)(ws + WS_PAR) + PO_NORMG + (size_t)l * 6 * D;
                tp_post_pre<0, false>(ws, XOUT, lds, ng + 3 * D, ng + 4 * D, vcu, G);
                SEAM(pb + 11); }
        } else {
            if (EN(10) && IN(pb + 6)) { PH_WS;
#if (REP >> 10) & 1
            for (int repn_ = 0; repn_ < REPN; ++repn_)
                { pm0_moe_setup(ws, GIN(I_MG), GIN(I_MU), GIN(I_MD), lds, vcu, G); }
                __syncthreads();
#endif
                pm0_moe_setup(ws, GIN(I_MG), GIN(I_MU), GIN(I_MD), lds, vcu, G);
                SEAM(pb + 6); }
            if (EN(11) && IN(pb + 7)) { PH_WS; gu32* ctl = (gu32*)(ws + WS_CTL);
                int ps[NEXP + 1]; { int p = 0;
#pragma unroll
                    for (int e = 0; e < NEXP; ++e) { ps[e] = p; p += ((int)__hip_atomic_load(ctl + CW_CNT + 64 * e, RLX_AGENT) + 255) >> 8; } ps[NEXP] = p; }
#if (REP >> 11) & 1
                for (int rep_ = 0; rep_ < 2; ++rep_)
#endif
                {
                pg8::Gemm g{(const pg8::bf16_t*)(ws + WS_HG), (const pg8::bf16_t*)(ws + WS_WMGU), ps[NEXP] * 256, 2 * FF, D / 2, E8_H, E8_WGU};
                pg8::MoeOrder S; S.base.init(ps[NEXP] * 256, 2 * FF, G, bx); S.plo = 0; S.ps1 = ps[1]; S.ps2 = ps[2]; S.ps3 = ps[3]; S.ps4 = ps[4]; S.ps5 = ps[5]; S.ps6 = ps[6]; S.ps7 = ps[7];
                pg8::EpiSwiGLU8 E{ws + WS_ACT8, FF, 2 * FF / 256, 0, SC_ACT};
#ifdef STAGGER_US
            if (bx & 1) { const unsigned long long t0_ = __builtin_amdgcn_s_memrealtime(); while (__builtin_amdgcn_s_memrealtime() - t0_ < (unsigned long long)(STAGGER_US * 100)) __builtin_amdgcn_s_sleep(8); }
#endif
                pg8::gemm_phase<pg8::EpiSwiGLU8, pg8::MoeOrder, true, true, true>(lds + RING_OFF, g, S, E);
                }
                SEAM(pb + 7);
            }
            if (EN(12) && IN(pb + 8)) { PH_WS; gu32* ctl = (gu32*)(ws + WS_CTL);
                int ps[NEXP + 1]; { int p = 0;
#pragma unroll
                    for (int e = 0; e < NEXP; ++e) { ps[e] = p; p += ((int)__hip_atomic_load(ctl + CW_CNT + 64 * e, RLX_AGENT) + 255) >> 8; } ps[NEXP] = p; }
#if (REP >> 12) & 1
                for (int rep_ = 0; rep_ < 2; ++rep_)
#endif
                {
                const int npm = ps[NEXP] < MOE_MAINP ? ps[NEXP] : MOE_MAINP;
                pg8::Gemm g{(const pg8::bf16_t*)(ws + WS_ACT8), (const pg8::bf16_t*)(ws + WS_WMD), npm * 256, D, FF / 2, E8_ACT, E8_WD};
                pg8::MoeOrder S; S.base.init(npm * 256, D, G, bx); S.plo = 0; S.ps1 = ps[1]; S.ps2 = ps[2]; S.ps3 = ps[3]; S.ps4 = ps[4]; S.ps5 = ps[5]; S.ps6 = ps[6]; S.ps7 = ps[7];
                pg8::EpiPlainBf16 E{(pg8::bf16_t*)(ws + WS_OE), D, 3};
                pg8::gemm_phase<pg8::EpiPlainBf16, pg8::MoeOrder, true, true, true>(lds + RING_OFF, g, S, E);
                if (ps[NEXP] > MOE_MAINP) {
                    __syncthreads();
                    pg8::Gemm g2{(const pg8::bf16_t*)(ws + WS_ACT8), (const pg8::bf16_t*)(ws + WS_WMD), (ps[NEXP] - MOE_MAINP) * 256, D, MOE_KSB / 2, E8_ACT, E8_WD, FF / 2};
                    pg8::MoeKSplitOrder S2{G, bx, MOE_MAINP, ps[NEXP] - MOE_MAINP, D / 256, MOE_KS, MOE_KSB, ps[1], ps[2], ps[3], ps[4], ps[5], ps[6], ps[7]};
                    pg8::EpiSliceBf16 E2{(pg8::bf16_t*)(ws + WS_OEP), D, 3, MOE_MAINP, MOE_KSB, (size_t)8 * 256 * D};
                    pg8::gemm_phase<pg8::EpiSliceBf16, pg8::MoeKSplitOrder, true, true, true>(lds + RING_OFF, g2, S2, E2);
                }
                }
                SEAM(pb + 8);
            }
            if (EN(13) && IN(pb + 11)) { PH_WS;
#if (REP >> 13) & 1
            for (int repn_ = 0; repn_ < REPN; ++repn_)
                { const float* ng = (const float*)(ws + WS_PAR) + PO_NORMG + (size_t)l * 6 * D;
                tp_post_pre<1, false, true>(ws, XOUT, lds, ng + 3 * D, ng + 4 * D, vcu, G); }
                __syncthreads();
#endif
                const float* ng = (const float*)(ws + WS_PAR) + PO_NORMG + (size_t)l * 6 * D;
                tp_post_pre<1, false>(ws, XOUT, lds, ng + 3 * D, ng + 4 * D, vcu, G);
                SEAM(pb + 11); }
        }
        if (EN(14) && IN(pb + 12)) { PH_WS;
#if (REP >> 14) & 1
            for (int repn_ = 0; repn_ < REPN; ++repn_)
            { unsigned char* wl = ws + WS_WSMALL + (size_t)l * WL_STRIDE;
            { pg8::Gemm g{(const pg8::bf16_t*)(ws + WS_PB) + (size_t)l * T * PLE, (const pg8::bf16_t*)(wl + WL_WPP), T, D, PLE}; pg8::StaticOrder S; S.init(T, D, G, bx);
              pg8::EpiPlainBf16 E{(pg8::bf16_t*)(ws + WS_PP), D, 3};
              pg8::gemm_phase<pg8::EpiPlainBf16, pg8::StaticOrder, false, true>(lds + RING_OFF, g, S, E); }
            __syncthreads();
            { pg8::Gemm g{(const pg8::bf16_t*)(ws + WS_H), (const pg8::bf16_t*)(wl + WL_WPG), T, D, D}; pg8::StaticOrder S; S.init(T, D, G, bx);
              pg8::EpiPleGate E{(pg8::bf16_t*)(ws + WS_F), (const pg8::bf16_t*)(ws + WS_PP), D};
              pg8::gemm_phase<pg8::EpiPleGate, pg8::StaticOrder, false, true>(lds + RING_OFF, g, S, E); }
            }
            __syncthreads();
#endif
            unsigned char* wl = ws + WS_WSMALL + (size_t)l * WL_STRIDE;
            { pg8::Gemm g{(const pg8::bf16_t*)(ws + WS_PB) + (size_t)l * T * PLE, (const pg8::bf16_t*)(wl + WL_WPP), T, D, PLE}; pg8::StaticOrder S; S.init(T, D, G, bx);
              pg8::EpiPlainBf16 E{(pg8::bf16_t*)(ws + WS_PP), D, 3};
              pg8::gemm_phase<pg8::EpiPlainBf16, pg8::StaticOrder, false, true>(lds + RING_OFF, g, S, E); }
            __syncthreads();
            { pg8::Gemm g{(const pg8::bf16_t*)(ws + WS_H), (const pg8::bf16_t*)(wl + WL_WPG), T, D, D}; pg8::StaticOrder S; S.init(T, D, G, bx);
              pg8::EpiPleGate E{(pg8::bf16_t*)(ws + WS_F), (const pg8::bf16_t*)(ws + WS_PP), D};
              pg8::gemm_phase<pg8::EpiPleGate, pg8::StaticOrder, false, true>(lds + RING_OFF, g, S, E); }

            SEAM(pb + 12);
        }
        if (EN(15) && IN(pb + 13)) { PH_WS;
#if (REP >> 15) & 1
            for (int repn_ = 0; repn_ < REPN; ++repn_)
            { const float* ng = (const float*)(ws + WS_PAR) + PO_NORMG + (size_t)l * 6 * D;
            tp_post_pre<0, false, true>(ws, XOUT, lds, ng + 5 * D, (l + 1 < DEPTH) ? ng + 6 * D : nullptr, vcu, G); }
            __syncthreads();
#endif
            const float* ng = (const float*)(ws + WS_PAR) + PO_NORMG + (size_t)l * 6 * D;
            if (l + 1 < DEPTH) tp_post_pre<0, false>(ws, XOUT, lds, ng + 5 * D, ng + 6 * D, vcu, G);
            else tp_post_pre<0, false, false, false, true>(ws, XOUT, lds, ng + 5 * D, nullptr, vcu, G);
            SEAM(pb + 13); }
    }
#undef IN
#undef SEAM
#undef PH_WS
}

extern "C" void kernel_launch(void* const* d_in, const int* in_sizes, int n_in, void* d_out, int out_size, void* d_ws, size_t ws_size, hipStream_t stream) {
    static int grid = 0;
    if (grid == 0) {
        if (n_in != 26 || in_sizes[0] != T * D || out_size != T * D || ws_size < WS_END) { fprintf(stderr, "kernel_launch: unexpected shapes / workspace (n_in %d, in0 %d, out %d, ws %zu < %zu); nothing launched\n", n_in, n_in > 0 ? in_sizes[0] : -1, out_size, ws_size, (size_t)WS_END); grid = -1; return; }
        int dev = 0, cus = 0, per_cu = 0;
        if (hipGetDevice(&dev) != hipSuccess || hipDeviceGetAttribute(&cus, hipDeviceAttributeMultiprocessorCount, dev) != hipSuccess) { grid = -1; return; }
        if (hipFuncSetAttribute((const void*)mk_fwd, hipFuncAttributeMaxDynamicSharedMemorySize, LDS_BYTES) != hipSuccess) { fprintf(stderr, "kernel_launch: hipFuncSetAttribute failed\n"); grid = -1; return; }
        if (hipOccupancyMaxActiveBlocksPerMultiprocessor(&per_cu, (const void*)mk_fwd, NWAVES * 64, LDS_BYTES) != hipSuccess || per_cu < 1) { fprintf(stderr, "kernel_launch: occupancy query reports %d workgroups per CU\n", per_cu); (void)hipGetLastError(); grid = -1; return; }
        grid = cus;
    }
    if (grid < 0) return;
    if (hipMemsetAsync((char*)d_ws + WS_CTL, 0, CTL_ZERO_BYTES, stream) != hipSuccess) return;
    Args a{};
    for (int i = 0; i < 26; ++i) a.in[i] = d_in[i];
    a.out = (float*)d_out; a.ws = (unsigned char*)d_ws;
#if MK_MULTI
    for (int ph = 0; ph < NPHASES; ++ph) { if (!phase_exists(ph)) continue; a.ph_lo = ph; a.ph_hi = ph + 1; hipLaunchKernelGGL(mk_fwd, dim3(grid), dim3(NWAVES * 64), LDS_BYTES, stream, a); }
#else
    a.ph_lo = 0; a.ph_hi = NPHASES;
    hipLaunchKernelGGL(mk_fwd, dim3(grid), dim3(NWAVES * 64), LDS_BYTES, stream, a);
#endif
}
```

```cpp
#include <hip/hip_runtime.h>
#include <hip/hip_bf16.h>
#include <cstdio>
#include <cstdint>
#include <cmath>
namespace pg8 {
#define PG8_LAS __attribute__((address_space(3)))
typedef unsigned short bf16_t;
typedef short bf16x8 __attribute__((ext_vector_type(8)));
typedef float f32x4 __attribute__((ext_vector_type(4)));
typedef unsigned u32x4 __attribute__((ext_vector_type(4)));
constexpr int BM = 256, BK = 64, HALF = 128, HTB = HALF * BK * 2  , STAGE_BYTES = 8 * HTB, NXCD = 8, WGM = 8;

__host__ __device__ __forceinline__ int lds_byte(int r, int c) { const int st = (r >> 4) * 2 + (c >> 5), rr = r & 15, cc = c & 31, ob = rr * 64 + cc * 2; return st * 1024 + (ob ^ (((ob >> 9) & 1) << 5)); }
__host__ __device__ __forceinline__ void stage_rc(int b, int& R, int& C) { const int st = b / 1024, sb = b % 1024, swz = sb ^ (((sb >> 9) & 1) << 5); R = (st >> 1) * 16 + swz / 64; C = (st & 1) * 32 + (swz % 64) / 2; }
__host__ __device__ __forceinline__ int perm32(int rho) { const int n = rho >> 4, i = rho & 15; return 8 * (i >> 2) + 4 * n + (i & 3); }

struct Unit { int pm, pn; };
typedef int v4i_t __attribute__((ext_vector_type(4)));
typedef int v8i_t __attribute__((ext_vector_type(8)));
struct Gemm { const bf16_t* A; const bf16_t* Bt; int M, N, K; int sa = 0x7f7f7f7f, sb = 0x7f7f7f7f; };

struct StaticOrder {
    int nM, nN, nwg, G, c;
    __host__ __device__ void init(int M, int N, int G_, int c_) { nM = M / BM; nN = N / BM; nwg = nM * nN; G = G_; c = c_; }
    __host__ __device__ bool next(int i, Unit& u) const {
        const long L = (long)i * G + c; if (L >= nwg) return false;
        int wgid = (int)L; { const int q = nwg / NXCD, r = nwg % NXCD, xcd = wgid % NXCD, off = wgid / NXCD; wgid = (xcd < r ? xcd * (q + 1) : r * (q + 1) + (xcd - r) * q) + off; }
        const int nig = WGM * nN, gid = wgid / nig, fm = gid * WGM, gsz = (nM - fm) < WGM ? (nM - fm) : WGM;
        u.pm = fm + ((wgid % nig) % gsz); u.pn = (wgid % nig) / gsz; return true;
    }
    __device__ __forceinline__ void a_ready(const Unit&) const {}
    __device__ __forceinline__ void done(const Unit&) const {}
};

__device__ __forceinline__ unsigned cvt_pk_bf16(float lo, float hi) { unsigned r; asm volatile("v_cvt_pk_bf16_f32 %0, %1, %2" : "=v"(r) : "v"(lo), "v"(hi)); return r; }
typedef float f32x2 __attribute__((ext_vector_type(2)));
__device__ __forceinline__ f32x2 gelu_pk(f32x2 v) {
    const f32x2 av = __builtin_elementwise_abs(v), d = av * 0.2316418882f + 1.0f;
    f32x2 t; t.x = __builtin_amdgcn_rcpf(d.x); t.y = __builtin_amdgcn_rcpf(d.y);
    f32x2 q = t * 0.5307027145f + (-0.7265760135f); q = q * t + 0.7107068705f; q = q * t + (-0.142248368f); q = q * t + 0.127414796f; q = q * t;
    const f32x2 s = (v * v) * (-0.72134752044f);
    f32x2 e; e.x = __builtin_amdgcn_exp2f(s.x); e.y = __builtin_amdgcn_exp2f(s.y);
    const f32x2 m = v * (q * e), r = v - m;
    f32x2 o; o.x = v.x < 0.f ? m.x : r.x; o.y = v.y < 0.f ? m.y : r.y; return o;
}

typedef unsigned u32x2 __attribute__((ext_vector_type(2)));
#ifndef NT_EPI
#define NT_EPI 0
#endif
#if NT_EPI
#define ST16(p, v) __builtin_nontemporal_store((v), (u32x4*)(p))
#define ST8(p, v) __builtin_nontemporal_store((v), (u32x2*)(p))
#else
#define ST16(p, v) (*(u32x4*)(p) = (v))
#define ST8(p, v) (*(u32x2*)(p) = (v))
#endif
__device__ __forceinline__ float sigm(float v) { return __builtin_amdgcn_rcpf(1.0f + __builtin_amdgcn_exp2f(-1.4426950408889634f * v)); }
__device__ __forceinline__ f32x4 sigm4(f32x4 v) { return (f32x4){sigm(v[0]), sigm(v[1]), sigm(v[2]), sigm(v[3])}; }
__device__ __forceinline__ float gelu_tanh1(float v) { return v * sigm(1.5957691216057308f * v * (1.0f + 0.044715f * v * v)); }
__device__ __forceinline__ f32x4 gelu_tanh4(f32x4 v) { return (f32x4){gelu_tanh1(v[0]), gelu_tanh1(v[1]), gelu_tanh1(v[2]), gelu_tanh1(v[3])}; }
__device__ __forceinline__ u32x4 pack8(f32x4 a, f32x4 b) { u32x4 w; w.x = cvt_pk_bf16(a[0], a[1]); w.y = cvt_pk_bf16(a[2], a[3]); w.z = cvt_pk_bf16(b[0], b[1]); w.w = cvt_pk_bf16(b[2], b[3]); return w; }
__device__ __forceinline__ f32x4 bf_lo4(u32x4 w) { return (f32x4){__uint_as_float(w.x << 16), __uint_as_float(w.x & 0xffff0000u), __uint_as_float(w.y << 16), __uint_as_float(w.y & 0xffff0000u)}; }
__device__ __forceinline__ f32x4 bf_hi4(u32x4 w) { return (f32x4){__uint_as_float(w.z << 16), __uint_as_float(w.z & 0xffff0000u), __uint_as_float(w.w << 16), __uint_as_float(w.w & 0xffff0000u)}; }

struct EpiF32 {
    static constexpr bool PERM = false, AFTER_DRAIN = false;
    float* C; int ldc;
    __device__ __forceinline__ void operator()(const f32x4 (&acc)[2][2][4][2], const Unit& u, int wr, int wc, int fr, int fq) const {
        const int row0 = u.pm * BM + wr * 64 + fr, col0 = u.pn * BM + wc * 32 + 4 * fq;
#pragma unroll
        for (int ai = 0; ai < 2; ++ai)
#pragma unroll
            for (int m = 0; m < 4; ++m) { float* rowp = C + (size_t)(row0 + ai * HALF + m * 16) * ldc + col0;
#pragma unroll
                for (int bj = 0; bj < 2; ++bj)
#pragma unroll
                    for (int n = 0; n < 2; ++n) *(f32x4*)(rowp + bj * HALF + n * 16) = acc[ai][bj][m][n]; }
    }
};

__device__ const float ROPE_REV[32] = {
    0.15915494309f, 0.11934937021f, 0.089499401609f, 0.067115083005f, 0.050329212104f, 0.037741584717f, 0.028302195831f, 0.021223652765f,
    0.015915494309f, 0.011934937021f, 0.0089499401609f, 0.0067115083005f, 0.0050329212104f, 0.0037741584717f, 0.0028302195831f, 0.0021223652765f,
    0.0015915494309f, 0.0011934937021f, 0.00089499401609f, 0.00067115083005f, 0.00050329212104f, 0.00037741584717f, 0.00028302195831f, 0.00021223652765f,
    0.00015915494309f, 0.00011934937021f, 8.9499401609e-05f, 6.7115083005e-05f, 5.0329212104e-05f, 3.7741584717e-05f, 2.8302195831e-05f, 2.1223652765e-05f };
__device__ __forceinline__ f32x4 cos_rev4(f32x4 r) { return (f32x4){__builtin_amdgcn_cosf(__builtin_amdgcn_fractf(r[0])), __builtin_amdgcn_cosf(__builtin_amdgcn_fractf(r[1])), __builtin_amdgcn_cosf(__builtin_amdgcn_fractf(r[2])), __builtin_amdgcn_cosf(__builtin_amdgcn_fractf(r[3]))}; }
__device__ __forceinline__ f32x4 sin_rev4(f32x4 r) { return (f32x4){__builtin_amdgcn_sinf(__builtin_amdgcn_fractf(r[0])), __builtin_amdgcn_sinf(__builtin_amdgcn_fractf(r[1])), __builtin_amdgcn_sinf(__builtin_amdgcn_fractf(r[2])), __builtin_amdgcn_sinf(__builtin_amdgcn_fractf(r[3]))}; }
struct EpiInProj {
    static constexpr bool PERM = true, AFTER_DRAIN = false;
    bf16_t* out; size_t slot_stride; const float* posf; float qscale;
    __device__ __forceinline__ void operator()(const f32x4 (&acc)[2][2][4][2], const Unit& u, int wr, int wc, int fr, int fq) const {
        const int type = u.pn >> 2, sub = u.pn & 3;
        bf16_t* base = out + (size_t)type * slot_stride;
        const int row0 = u.pm * BM + wr * 64 + fr;
        if (type == 2 || type == 3) {
            const float sc = (type == 2) ? qscale : 1.0f;
            const int colb = sub * 256 + wc * 64 + 8 * fq;
            const f32x4 cf0 = *(const f32x4*)(ROPE_REV + 8 * fq), cf1 = *(const f32x4*)(ROPE_REV + 8 * fq + 4);
            float pv[2][4];
#pragma unroll
            for (int ai = 0; ai < 2; ++ai)
#pragma unroll
                for (int m = 0; m < 4; ++m) pv[ai][m] = posf[row0 + ai * HALF + m * 16];
#pragma unroll
            for (int ai = 0; ai < 2; ++ai)
#pragma unroll
                for (int m = 0; m < 4; ++m) { const int r = row0 + ai * HALF + m * 16;
                    const float p = pv[ai][m];
                    const f32x4 r0 = cf0 * p, r1 = cf1 * p;
                    const f32x4 c0 = cos_rev4(r0) * sc, c1 = cos_rev4(r1) * sc, s0 = sin_rev4(r0) * sc, s1 = sin_rev4(r1) * sc;
                    const f32x4 x0a = acc[ai][0][m][0], x0b = acc[ai][0][m][1], x1a = acc[ai][1][m][0], x1b = acc[ai][1][m][1];
                    const f32x4 y0a = x0a * c0 - x1a * s0, y0b = x0b * c1 - x1b * s1, y1a = x1a * c0 + x0a * s0, y1b = x1b * c1 + x0b * s1;
                    bf16_t* rowp = base + (size_t)r * 1024 + colb;
                    ST16(rowp, pack8(y0a, y0b)); ST16(rowp + 32, pack8(y1a, y1b)); }
        } else {
            const int colb = sub * 256 + wc * 64 + 8 * fq;
#pragma unroll
            for (int ai = 0; ai < 2; ++ai)
#pragma unroll
                for (int m = 0; m < 4; ++m) { bf16_t* rowp = base + (size_t)(row0 + ai * HALF + m * 16) * 1024 + colb;
#pragma unroll
                    for (int bj = 0; bj < 2; ++bj) { f32x4 v0 = acc[ai][bj][m][0], v1 = acc[ai][bj][m][1];
                        if (type == 0) { v0 = gelu_tanh4(v0); v1 = gelu_tanh4(v1); }
                        else if (type >= 5) { v0 = sigm4(v0); v1 = sigm4(v1); }
                        ST16(rowp + bj * 32, pack8(v0, v1)); } }
        }
    }
};

struct EpiMerge {
    static constexpr bool PERM = true, AFTER_DRAIN = false;
    const bf16_t* sga; const bf16_t* sgb; bf16_t* t1; bf16_t* merged; int nM;
    __device__ __forceinline__ void operator()(const f32x4 (&acc)[2][2][4][2], const Unit& u, int wr, int wc, int fr, int fq) const {
        const bool sel = u.pm >= nM; const int pm = sel ? u.pm - nM : u.pm, pn = u.pn & 3;
        const bf16_t* sg = sel ? sgb : sga;
        const int row0 = pm * BM + wr * 64 + fr, col0 = pn * BM + wc * 32 + 8 * fq;
#pragma unroll
        for (int ai = 0; ai < 2; ++ai) {
            u32x4 g[4][2], t[4][2];
#pragma unroll
            for (int m = 0; m < 4; ++m)
#pragma unroll
                for (int bj = 0; bj < 2; ++bj) { const size_t off = (size_t)(row0 + ai * HALF + m * 16) * 1024 + col0 + bj * HALF;
                    g[m][bj] = *(const u32x4*)(sg + off); if (sel) t[m][bj] = *(const u32x4*)(t1 + off); }
#pragma unroll
            for (int m = 0; m < 4; ++m)
#pragma unroll
                for (int bj = 0; bj < 2; ++bj) { const size_t off = (size_t)(row0 + ai * HALF + m * 16) * 1024 + col0 + bj * HALF;
                    f32x4 v0 = acc[ai][bj][m][0] * bf_lo4(g[m][bj]), v1 = acc[ai][bj][m][1] * bf_hi4(g[m][bj]);
                    if (!sel) *(u32x4*)(t1 + off) = pack8(v0, v1);
                    else { v0 = v0 + bf_lo4(t[m][bj]); v1 = v1 + bf_hi4(t[m][bj]); *(u32x4*)(merged + off) = pack8(v0, v1); } } }
    }
};

struct EpiSwiGLU {
    static constexpr bool PERM = true, AFTER_DRAIN = false;
    bf16_t* O; int ldc; int nper; int pm_sub;
    __device__ __forceinline__ void operator()(const f32x4 (&acc)[2][2][4][2], const Unit& u, int wr, int wc, int fr, int fq) const {
        const int pn = u.pn % nper;
        const int row0 = (u.pm - pm_sub) * BM + wr * 64 + fr, col0 = pn * HALF + wc * 32 + 8 * fq;
#pragma unroll
        for (int ai = 0; ai < 2; ++ai)
#pragma unroll
            for (int m = 0; m < 4; ++m) { const f32x4 g0 = acc[ai][0][m][0], g1 = acc[ai][0][m][1], u0 = acc[ai][1][m][0], u1 = acc[ai][1][m][1];
                const f32x4 a0 = g0 * sigm4(g0) * u0, a1 = g1 * sigm4(g1) * u1;
                ST16(O + (size_t)(row0 + ai * HALF + m * 16) * ldc + col0, pack8(a0, a1)); }
    }
};

__device__ __forceinline__ unsigned pk4_fp8(f32x4 v) { unsigned w = __builtin_amdgcn_cvt_pk_fp8_f32(v[0], v[1], 0u, false); return __builtin_amdgcn_cvt_pk_fp8_f32(v[2], v[3], w, true); }
__device__ __forceinline__ f32x4 clamp448(f32x4 v) { return (f32x4){__builtin_fminf(__builtin_fmaxf(v[0], -448.f), 448.f), __builtin_fminf(__builtin_fmaxf(v[1], -448.f), 448.f), __builtin_fminf(__builtin_fmaxf(v[2], -448.f), 448.f), __builtin_fminf(__builtin_fmaxf(v[3], -448.f), 448.f)}; }
struct EpiSwiGLU8 {
    static constexpr bool PERM = true, AFTER_DRAIN = false;
    unsigned char* O; int ldc; int nper; int pm_sub; float oscale;
    __device__ __forceinline__ void operator()(const f32x4 (&acc)[2][2][4][2], const Unit& u, int wr, int wc, int fr, int fq) const {
        const int pn = u.pn % nper;
        const int row0 = (u.pm - pm_sub) * BM + wr * 64 + fr, col0 = pn * HALF + wc * 32 + 8 * fq;
#pragma unroll
        for (int ai = 0; ai < 2; ++ai)
#pragma unroll
            for (int m = 0; m < 4; ++m) { const f32x4 g0 = acc[ai][0][m][0], g1 = acc[ai][0][m][1], u0 = acc[ai][1][m][0], u1 = acc[ai][1][m][1];
                const f32x4 a0 = clamp448(g0 * sigm4(g0) * u0 * oscale), a1 = clamp448(g1 * sigm4(g1) * u1 * oscale);
                u32x2 w; w.x = pk4_fp8(a0); w.y = pk4_fp8(a1);
                ST8(O + (size_t)(row0 + ai * HALF + m * 16) * ldc + col0, w); }
    }
};

typedef int i32x4 __attribute__((ext_vector_type(4)));
__device__ __forceinline__ f32x4 icvt(f32x4 a) { return __builtin_convertvector(__builtin_bit_cast(i32x4, a), f32x4); }
struct EpiSwiGLUq {
    static constexpr bool PERM = true, AFTER_DRAIN = false;
    bf16_t* O; int ldc; const float* sa; const float* sb;
    __device__ __forceinline__ void operator()(const f32x4 (&acc)[2][2][4][2], const Unit& u, int wr, int wc, int fr, int fq) const {
        const int row0 = u.pm * BM + wr * 64 + fr, col0 = u.pn * HALF + wc * 32 + 8 * fq, gc0 = u.pn * BM + wc * 32 + 8 * fq;
        const f32x4 bg0 = *(const f32x4*)(sb + gc0), bg1 = *(const f32x4*)(sb + gc0 + 4), bu0 = *(const f32x4*)(sb + gc0 + HALF), bu1 = *(const f32x4*)(sb + gc0 + HALF + 4);
        float sr[2][4];
#pragma unroll
        for (int ai = 0; ai < 2; ++ai)
#pragma unroll
            for (int m = 0; m < 4; ++m) sr[ai][m] = sa[row0 + ai * HALF + m * 16];
#pragma unroll
        for (int ai = 0; ai < 2; ++ai)
#pragma unroll
            for (int m = 0; m < 4; ++m) { const float s = sr[ai][m];
                const f32x4 g0 = icvt(acc[ai][0][m][0]) * (bg0 * s), g1 = icvt(acc[ai][0][m][1]) * (bg1 * s), u0 = icvt(acc[ai][1][m][0]) * (bu0 * s), u1 = icvt(acc[ai][1][m][1]) * (bu1 * s);
                const f32x4 a0 = g0 * sigm4(g0) * u0, a1 = g1 * sigm4(g1) * u1;
                ST16(O + (size_t)(row0 + ai * HALF + m * 16) * ldc + col0, pack8(a0, a1)); }
    }
};
struct EpiInProjq {
    static constexpr bool PERM = true, AFTER_DRAIN = false;
    bf16_t* out; size_t slot_stride; const float* posf; float qscale; const float* sa; const float* sb;
    __device__ __forceinline__ void operator()(const f32x4 (&acc)[2][2][4][2], const Unit& u, int wr, int wc, int fr, int fq) const {
        const int type = u.pn >> 2, sub = u.pn & 3;
        bf16_t* base = out + (size_t)type * slot_stride;
        const int row0 = u.pm * BM + wr * 64 + fr, gc0 = u.pn * BM + wc * 32 + 8 * fq;
        const f32x4 b00 = *(const f32x4*)(sb + gc0), b01 = *(const f32x4*)(sb + gc0 + 4), b10 = *(const f32x4*)(sb + gc0 + HALF), b11 = *(const f32x4*)(sb + gc0 + HALF + 4);
        const int colb = sub * 256 + wc * 64 + 8 * fq;
        if (type == 2 || type == 3) {
            const float sc = (type == 2) ? qscale : 1.0f;
            const f32x4 cf0 = *(const f32x4*)(ROPE_REV + 8 * fq), cf1 = *(const f32x4*)(ROPE_REV + 8 * fq + 4);
#pragma unroll
            for (int ai = 0; ai < 2; ++ai) {
                float sr[4], pv[4];
#pragma unroll
                for (int m = 0; m < 4; ++m) { sr[m] = sa[row0 + ai * HALF + m * 16]; pv[m] = posf[row0 + ai * HALF + m * 16]; }
#pragma unroll
                for (int m = 0; m < 4; ++m) { const int r = row0 + ai * HALF + m * 16; const float p = pv[m], s = sr[m] * sc;
                    bf16_t* rowp = base + (size_t)r * 1024 + colb;
                    { const f32x4 r0 = cf0 * p; const f32x4 c0 = cos_rev4(r0), s0 = sin_rev4(r0);
                      const f32x4 x0a = icvt(acc[ai][0][m][0]) * (b00 * s), x1a = icvt(acc[ai][1][m][0]) * (b10 * s);
                      const f32x4 y0a = x0a * c0 - x1a * s0, y1a = x1a * c0 + x0a * s0;
                      const f32x4 r1 = cf1 * p; const f32x4 c1 = cos_rev4(r1), s1 = sin_rev4(r1);
                      const f32x4 x0b = icvt(acc[ai][0][m][1]) * (b01 * s), x1b = icvt(acc[ai][1][m][1]) * (b11 * s);
                      const f32x4 y0b = x0b * c1 - x1b * s1, y1b = x1b * c1 + x0b * s1;
                      ST16(rowp, pack8(y0a, y0b)); ST16(rowp + 32, pack8(y1a, y1b)); } } }
        } else {
#pragma unroll
            for (int ai = 0; ai < 2; ++ai) {
                float sr[4];
#pragma unroll
                for (int m = 0; m < 4; ++m) sr[m] = sa[row0 + ai * HALF + m * 16];
#pragma unroll
                for (int m = 0; m < 4; ++m) { bf16_t* rowp = base + (size_t)(row0 + ai * HALF + m * 16) * 1024 + colb; const float s = sr[m];
#pragma unroll
                    for (int bj = 0; bj < 2; ++bj) { f32x4 v0 = icvt(acc[ai][bj][m][0]) * ((bj ? b10 : b00) * s), v1 = icvt(acc[ai][bj][m][1]) * ((bj ? b11 : b01) * s);
                        if (type == 0) { v0 = gelu_tanh4(v0); v1 = gelu_tanh4(v1); }
                        else if (type >= 5) { v0 = sigm4(v0); v1 = sigm4(v1); }
                        ST16(rowp + bj * 32, pack8(v0, v1)); } } }
        }
    }
};

struct EpiPlainBf16 {
    static constexpr bool PERM = true, AFTER_DRAIN = false;
    bf16_t* O; int ldc; int pn_mask;
    __device__ __forceinline__ void operator()(const f32x4 (&acc)[2][2][4][2], const Unit& u, int wr, int wc, int fr, int fq) const {
        const int row0 = u.pm * BM + wr * 64 + fr, col0 = (u.pn & pn_mask) * BM + wc * 32 + 8 * fq;
#pragma unroll
        for (int ai = 0; ai < 2; ++ai)
#pragma unroll
            for (int m = 0; m < 4; ++m) { bf16_t* rowp = O + (size_t)(row0 + ai * HALF + m * 16) * ldc + col0;
#pragma unroll
                for (int bj = 0; bj < 2; ++bj) ST16(rowp + bj * HALF, pack8(acc[ai][bj][m][0], acc[ai][bj][m][1])); }
    }
};

struct EpiPleGate {
    static constexpr bool PERM = true, AFTER_DRAIN = false;
    bf16_t* O; const bf16_t* PP; int ldc;
    __device__ __forceinline__ void operator()(const f32x4 (&acc)[2][2][4][2], const Unit& u, int wr, int wc, int fr, int fq) const {
        const int row0 = u.pm * BM + wr * 64 + fr, col0 = u.pn * BM + wc * 32 + 8 * fq;
#pragma unroll
        for (int ai = 0; ai < 2; ++ai) {
            u32x4 p[4][2];
#pragma unroll
            for (int m = 0; m < 4; ++m)
#pragma unroll
                for (int bj = 0; bj < 2; ++bj) p[m][bj] = *(const u32x4*)(PP + (size_t)(row0 + ai * HALF + m * 16) * ldc + col0 + bj * HALF);
#pragma unroll
            for (int m = 0; m < 4; ++m)
#pragma unroll
                for (int bj = 0; bj < 2; ++bj) { const size_t ro = (size_t)(row0 + ai * HALF + m * 16) * ldc + col0 + bj * HALF;
                    *(u32x4*)(O + ro) = pack8(sigm4(acc[ai][bj][m][0]) * bf_lo4(p[m][bj]), sigm4(acc[ai][bj][m][1]) * bf_hi4(p[m][bj])); } }
    }
};

struct PairOrder {
    StaticOrder base;
    __device__ __forceinline__ bool next(int i, Unit& u) const { if (!base.next(i >> 1, u)) return false; if (i & 1) { u.pm += base.nM; u.pn += base.nN; } return true; }
    __device__ __forceinline__ void a_ready(const Unit&) const {}
    __device__ __forceinline__ void done(const Unit&) const {}
};
struct MoeOrder {
    StaticOrder base; int plo; int ps1, ps2, ps3, ps4, ps5, ps6, ps7;
    __device__ __forceinline__ bool next(int i, Unit& u) const {
        if (!base.next(i, u)) return false;
        const int p = u.pm + plo;
        const int e = (p >= ps1) + (p >= ps2) + (p >= ps3) + (p >= ps4) + (p >= ps5) + (p >= ps6) + (p >= ps7);
        u.pm = p; u.pn += e * base.nN; return true;
    }
    __device__ __forceinline__ void a_ready(const Unit&) const {}
    __device__ __forceinline__ void done(const Unit&) const {}
};
template <class Epi, class Sched, bool ALIGN_EPI = false, bool SP2 = false, int QM = 0>
__device__ __forceinline__ void gemm_phase(PG8_LAS unsigned char* lds, const Gemm g, const Sched& S, const Epi& E) {
    int tid_ = threadIdx.x; asm volatile("" : "+v"(tid_));
    const int tid = tid_, wid = __builtin_amdgcn_readfirstlane(tid >> 6), lane = tid & 63, wr = wid >> 2, wc = wid & 3, fr = lane & 15, fq = lane >> 4;
    const int K = g.K, nt = K / BK;
    unsigned voffA[2], voffB[2];
#pragma unroll
    for (int i = 0; i < 2; ++i) { int R, C; stage_rc(tid * 16 + i * 8192, R, C); const int Rb = Epi::PERM ? ((R & ~31) + perm32(R & 31)) : R;
        voffA[i] = (unsigned)(R * K + C) * 2u; voffB[i] = (unsigned)(Rb * K + C) * 2u; }
    const size_t kstep = (size_t)(BK * 2);
    const size_t hstep = (size_t)HALF * K * 2;
    const size_t tstep = 2 * hstep;
    const unsigned ldsw = (unsigned)wid * 1024u;
    const int aoff = lds_byte(wr * 64 + fr, fq * 8), boff = lds_byte(wc * 32 + fr, fq * 8);
#define PG8_SA(b, h) (((b) * 2 + (h)) * HTB)
#define PG8_SB(b, h) ((4 + (b) * 2 + (h)) * HTB)
#define PG8_STAGE(bufoff, gbase, voff) do { _Pragma("unroll") for (int _i = 0; _i < 2; ++_i) \
        __builtin_amdgcn_global_load_lds((const unsigned*)((const char*)(gbase) + (voff)[_i]), (PG8_LAS unsigned*)(lds + (bufoff) + ldsw + _i * 8192), 16, 0, 0); } while (0)
#define PG8_CAT(a, b) __builtin_shufflevector(__builtin_bit_cast(v4i_t, a), __builtin_bit_cast(v4i_t, b), 0, 1, 2, 3, 4, 5, 6, 7)
#define PG8_LDA(dst, b, h) do { _Pragma("unroll") for (int m = 0; m < 4; ++m) { const bf16x8 r0_ = *(const PG8_LAS bf16x8*)(lds + PG8_SA(b, h) + aoff + m * 2048), r1_ = *(const PG8_LAS bf16x8*)(lds + PG8_SA(b, h) + aoff + m * 2048 + 1024); \
        if constexpr (QM == 1) dst##8[m] = PG8_CAT(r0_, r1_); else { dst[m][0] = r0_; dst[m][1] = r1_; } } } while (0)
#define PG8_LDB(dst, b, h) do { _Pragma("unroll") for (int n = 0; n < 2; ++n) { const bf16x8 r0_ = *(const PG8_LAS bf16x8*)(lds + PG8_SB(b, h) + boff + n * 2048), r1_ = *(const PG8_LAS bf16x8*)(lds + PG8_SB(b, h) + boff + n * 2048 + 1024); \
        if constexpr (QM == 1) dst##8[n] = PG8_CAT(r0_, r1_); else { dst[n][0] = r0_; dst[n][1] = r1_; } } } while (0)
#define PG8_MMA(ai, bj, At, Bt) do { __builtin_amdgcn_s_setprio(1); _Pragma("unroll") for (int m = 0; m < 4; ++m) _Pragma("unroll") for (int n = 0; n < 2; ++n) { \
        if constexpr (QM == 2) { _Pragma("unroll") for (int k = 0; k < 2; ++k) acc[ai][bj][m][n] = __builtin_bit_cast(f32x4, __builtin_amdgcn_mfma_i32_16x16x64_i8(__builtin_bit_cast(v4i_t, Bt[n][k]), __builtin_bit_cast(v4i_t, At[m][k]), __builtin_bit_cast(v4i_t, acc[ai][bj][m][n]), 0, 0, 0)); } \
        else if constexpr (QM == 1) asm volatile("v_mfma_scale_f32_16x16x128_f8f6f4 %0, %1, %2, %0, %3, %4 op_sel_hi:[0,0,0]" : "+v"(acc[ai][bj][m][n]) : "v"(Bt##8[n]), "v"(At##8[m]), "v"(sbv), "v"(sav));   \
        else { _Pragma("unroll") for (int k = 0; k < 2; ++k) acc[ai][bj][m][n] = __builtin_amdgcn_mfma_f32_16x16x32_bf16(Bt[n][k], At[m][k], acc[ai][bj][m][n], 0, 0, 0); } } \
        __builtin_amdgcn_s_setprio(0); } while (0)
#define PG8_WAIT_V(n) asm volatile("s_waitcnt vmcnt(" #n ")" ::: "memory")
#define PG8_WAIT_L(n) asm volatile("s_waitcnt lgkmcnt(" #n ")" ::: "memory")
#define PG8_BAR __builtin_amdgcn_s_barrier()
#define PG8_SCHED __builtin_amdgcn_sched_barrier(0)
    Unit cur, nxt; int ui = 0;
    if (!S.next(0, cur)) return;
    f32x4 acc[2][2][4][2];
#pragma unroll
    for (int a = 0; a < 2; ++a)
#pragma unroll
        for (int b = 0; b < 2; ++b)
#pragma unroll
            for (int m = 0; m < 4; ++m)
#pragma unroll
                for (int n = 0; n < 2; ++n) acc[a][b][m][n] = (f32x4){0.f, 0.f, 0.f, 0.f};
    bf16x8 At[4][2], B0[2][2], B1[2][2];
    v8i_t At8[4], B08[2], B18[2];
    (void)At; (void)B0; (void)B1; (void)At8; (void)B08; (void)B18;
    const int sav = g.sa, sbv = g.sb; (void)sav; (void)sbv;
    const char* cA = (const char*)g.A + (size_t)cur.pm * tstep; const char* cB = (const char*)g.Bt + (size_t)cur.pn * tstep;
    S.a_ready(cur);
    if constexpr (SP2) {
        PG8_STAGE(PG8_SB(0, 0), cB, voffB); PG8_STAGE(PG8_SB(0, 1), cB + hstep, voffB); PG8_STAGE(PG8_SA(0, 0), cA, voffA); PG8_STAGE(PG8_SA(0, 1), cA + hstep, voffA);
        if (wr == 1) PG8_BAR;
        PG8_WAIT_V(2); PG8_BAR;
        PG8_STAGE(PG8_SB(1, 0), cB + kstep, voffB); PG8_STAGE(PG8_SA(1, 0), cA + kstep, voffA); PG8_STAGE(PG8_SB(1, 1), cB + hstep + kstep, voffB);
        PG8_WAIT_V(6); PG8_BAR;
    } else {
        PG8_STAGE(PG8_SB(0, 0), cB, voffB); PG8_STAGE(PG8_SA(0, 0), cA, voffA); PG8_STAGE(PG8_SB(0, 1), cB + hstep, voffB); PG8_STAGE(PG8_SA(0, 1), cA + hstep, voffA);
        if (wr == 1) PG8_BAR;
        PG8_WAIT_V(4); PG8_BAR;
        PG8_STAGE(PG8_SB(1, 0), cB + kstep, voffB); PG8_STAGE(PG8_SA(1, 0), cA + kstep, voffA); PG8_STAGE(PG8_SB(1, 1), cB + hstep + kstep, voffB);
        PG8_WAIT_V(6); PG8_BAR;
    }
    for (;;) {
        const bool has_next = S.next(ui + 1, nxt);
        const char* nA = has_next ? (const char*)g.A + (size_t)nxt.pm * tstep : cA; const char* nB = has_next ? (const char*)g.Bt + (size_t)nxt.pn * tstep : cB;
        for (int t = 0; t < nt; t += 2) {
            const bool last = (t == nt - 2);
            const char* a1 = cA + (size_t)(t + 1) * kstep;
            const char* a2 = last ? nA : cA + (size_t)(t + 2) * kstep; const char* b2 = last ? nB : cB + (size_t)(t + 2) * kstep;
            const char* a3 = a2 + kstep; const char* b3 = b2 + kstep;
            if (last && has_next) S.a_ready(nxt);
            if constexpr (SP2) {
            PG8_LDB(B0, 0, 0); PG8_LDB(B1, 0, 1); PG8_SCHED; PG8_LDA(At, 0, 0); PG8_STAGE(PG8_SA(1, 1), a1 + hstep, voffA);
            PG8_WAIT_V(8); PG8_WAIT_L(0); PG8_BAR; PG8_MMA(0, 0, At, B0); PG8_MMA(0, 1, At, B1); PG8_BAR; PG8_SCHED;
            PG8_LDA(At, 0, 1); PG8_STAGE(PG8_SB(0, 0), b2, voffB); PG8_STAGE(PG8_SB(0, 1), b2 + hstep, voffB); PG8_STAGE(PG8_SA(0, 0), a2, voffA);
            PG8_WAIT_V(8); PG8_WAIT_L(0); PG8_BAR; PG8_MMA(1, 0, At, B0); PG8_MMA(1, 1, At, B1); PG8_BAR; PG8_SCHED;
            PG8_LDB(B0, 1, 0); PG8_LDB(B1, 1, 1); PG8_SCHED; PG8_LDA(At, 1, 0); PG8_STAGE(PG8_SA(0, 1), a2 + hstep, voffA);
            PG8_WAIT_V(8); PG8_WAIT_L(0); PG8_BAR; PG8_MMA(0, 0, At, B0); PG8_MMA(0, 1, At, B1); PG8_BAR; PG8_SCHED;
            PG8_LDA(At, 1, 1); PG8_STAGE(PG8_SB(1, 0), b3, voffB); PG8_STAGE(PG8_SB(1, 1), b3 + hstep, voffB); PG8_STAGE(PG8_SA(1, 0), a3, voffA);
            PG8_WAIT_V(8); PG8_WAIT_L(0); PG8_BAR; PG8_MMA(1, 0, At, B0); PG8_MMA(1, 1, At, B1); PG8_BAR; PG8_SCHED;
            } else {
            PG8_LDB(B0, 0, 0); PG8_SCHED; PG8_LDA(At, 0, 0); PG8_STAGE(PG8_SA(1, 1), a1 + hstep, voffA);
            PG8_WAIT_L(8); PG8_BAR; PG8_WAIT_L(0); PG8_MMA(0, 0, At, B0); PG8_BAR; PG8_SCHED;
            PG8_LDB(B1, 0, 1); PG8_STAGE(PG8_SB(0, 0), b2, voffB);
            PG8_BAR; PG8_WAIT_L(0); PG8_MMA(0, 1, At, B1); PG8_BAR;
            PG8_LDA(At, 0, 1); PG8_STAGE(PG8_SA(0, 0), a2, voffA);
            PG8_BAR; PG8_WAIT_L(0); PG8_MMA(1, 0, At, B0); PG8_BAR; PG8_SCHED;
            PG8_STAGE(PG8_SB(0, 1), b2 + hstep, voffB);
            PG8_WAIT_V(6); PG8_BAR; PG8_MMA(1, 1, At, B1); PG8_BAR;
            PG8_LDB(B0, 1, 0); PG8_SCHED; PG8_LDA(At, 1, 0); PG8_STAGE(PG8_SA(0, 1), a2 + hstep, voffA);
            PG8_WAIT_L(8); PG8_BAR; PG8_WAIT_L(0); PG8_MMA(0, 0, At, B0); PG8_BAR; PG8_SCHED;
            PG8_LDB(B1, 1, 1); PG8_STAGE(PG8_SB(1, 0), b3, voffB);
            PG8_BAR; PG8_WAIT_L(0); PG8_MMA(0, 1, At, B1); PG8_BAR;
            PG8_LDA(At, 1, 1); PG8_STAGE(PG8_SA(1, 0), a3, voffA);
            PG8_BAR; PG8_WAIT_L(0); PG8_MMA(1, 0, At, B0); PG8_BAR; PG8_SCHED;
            PG8_STAGE(PG8_SB(1, 1), b3 + hstep, voffB);
            PG8_WAIT_V(6); PG8_BAR; PG8_MMA(1, 1, At, B1); PG8_BAR;
            }
        }
        if constexpr (ALIGN_EPI) { if (wr == 0) PG8_BAR; }
        if constexpr (!Epi::AFTER_DRAIN) { E(acc, cur, wr, wc, fr, fq); S.done(cur); }
        if (!has_next) break;
#pragma unroll
        for (int a = 0; a < 2; ++a)
#pragma unroll
            for (int b = 0; b < 2; ++b)
#pragma unroll
                for (int m = 0; m < 4; ++m)
#pragma unroll
                    for (int n = 0; n < 2; ++n) acc[a][b][m][n] = (f32x4){0.f, 0.f, 0.f, 0.f};
        cur = nxt; cA = nA; cB = nB; ++ui;
        if constexpr (ALIGN_EPI) { if (wr == 1) PG8_BAR; }
    }
    PG8_WAIT_V(0);
    if constexpr (!ALIGN_EPI) { if (wr == 0) PG8_BAR; }
    PG8_BAR;
    if constexpr (Epi::AFTER_DRAIN) { E.fused(acc, cur, wr, wc, fr, fq, lds, wid, lane); S.done(cur); }
#undef PG8_SA
#undef PG8_SB
#undef PG8_STAGE
#undef PG8_LDA
#undef PG8_LDB
#undef PG8_MMA
#undef PG8_CAT
#undef PG8_WAIT_V
#undef PG8_WAIT_L
#undef PG8_BAR
#undef PG8_SCHED
}
}
#include <hip/hip_bf16.h>
#include <hip/hip_bf16.h>
#include <cmath>
namespace attn_body {
using bf16=__hip_bfloat16;
using bf16x8=__attribute__((ext_vector_type(8)))short;
using s16x4=__attribute__((ext_vector_type(4)))short;
using f32x16=__attribute__((ext_vector_type(16)))float;
using u32x4=__attribute__((ext_vector_type(4)))unsigned;
constexpr int BATCH=4,NHEAD=16,SEQ=4096,D=64,DM=NHEAD*D;
constexpr int NW=8,QBLK=32,QB=QBLK*NW,KVBLK=64,NQB=SEQ/QB;
constexpr int ATTN_PITCH=DM, ATTN_UNIT_ROWS=QB;
__device__ __forceinline__ int crow(int r,int hi){return (r&3)+8*(r>>2)+4*hi;}
#define SBAR() __builtin_amdgcn_sched_barrier(0)
__device__ __forceinline__ void cmask(f32x16&p0,f32x16&p1,int jb,int qrel,int hi){
  const float NEG=-INFINITY; int kb=64*jb+4*hi;
  #pragma unroll
  for(int r=0;r<16;++r){int kv=kb+(r&3)+8*(r>>2); if(kv>qrel)p0[r]=NEG; if(kv+32>qrel)p1[r]=NEG;}
}

constexpr int NSLOT=3, SLOTB=8192, SLOTV=16384;
constexpr int LDS_K=0, LDS_V=NSLOT*SLOTB, LDS_WS=LDS_V+NSLOT*SLOTV, LDS_OST=LDS_WS+NW*64*4, LDS_BYTES=LDS_OST;
constexpr float C2=0.125f*1.4426950408889634f;
__device__ __forceinline__ void glds16(const void*gsrc,unsigned lds_dst){unsigned keep;
  asm volatile("s_mov_b32 %0, m0\n\ts_mov_b32 m0, %2\n\ts_nop 0\n\tglobal_load_lds_dwordx4 %1, off\n\ts_mov_b32 m0, %0":"=&s"(keep):"v"(gsrc),"s"(lds_dst):"memory");}
__device__ __forceinline__ float max3f(float a,float b,float c){float r;asm("v_max3_f32 %0, %1, %2, %3":"=v"(r):"v"(a),"v"(b),"v"(c));return r;}
__device__ __forceinline__ float max2f(float a,float b){float r;asm("v_max_f32_e32 %0, %1, %2":"=v"(r):"v"(a),"v"(b));return r;}
__device__ __forceinline__ float fadd_s(float a,float b){float r;asm("v_add_f32_e32 %0, %1, %2":"=v"(r):"v"(a),"v"(b));return r;}
__device__ __forceinline__ float fsub_s(float a,float b){float r;asm("v_sub_f32_e32 %0, %1, %2":"=v"(r):"v"(a),"v"(b));return r;}
typedef float f32x2_t __attribute__((ext_vector_type(2))); typedef __bf16 bf16x2_t __attribute__((ext_vector_type(2)));
__device__ __forceinline__ unsigned cvtpk_s(float lo,float hi){f32x2_t v={lo,hi};bf16x2_t b=__builtin_convertvector(v,bf16x2_t);return __builtin_bit_cast(unsigned,b);}
#define WAIT_BAR(N) asm volatile("s_waitcnt vmcnt(" #N ") lgkmcnt(0)\n\ts_barrier":::"memory")

__device__ __forceinline__ void qkt(f32x16&p0,f32x16&p1,const char*Kslot,const bf16x8*qr,int r32,int hi){ const f32x16 negm=f32x16{};
  const char*kb=Kslot+hi*1024+r32*16;
  #pragma unroll
  for(int d0=0;d0<4;++d0){
    const bf16x8 b0=*reinterpret_cast<const bf16x8*>(kb+d0*2048);
    const bf16x8 b1=*reinterpret_cast<const bf16x8*>(kb+d0*2048+512);
    if(d0==0){p0=__builtin_amdgcn_mfma_f32_32x32x16_bf16(b0,qr[0],negm,0,0,0);p1=__builtin_amdgcn_mfma_f32_32x32x16_bf16(b1,qr[0],negm,0,0,0);}
    else{p0=__builtin_amdgcn_mfma_f32_32x32x16_bf16(b0,qr[d0],p0,0,0,0);p1=__builtin_amdgcn_mfma_f32_32x32x16_bf16(b1,qr[d0],p1,0,0,0);}}
}
typedef __attribute__((address_space(3))) const char* lds_cptr;
typedef short v4i16_t __attribute__((ext_vector_type(4)));
__device__ __forceinline__ void kload8(bf16x8*kf,lds_cptr kp){
  kf[0]=*(const __attribute__((address_space(3))) bf16x8*)(kp);      kf[1]=*(const __attribute__((address_space(3))) bf16x8*)(kp+512);
  kf[2]=*(const __attribute__((address_space(3))) bf16x8*)(kp+2048); kf[3]=*(const __attribute__((address_space(3))) bf16x8*)(kp+2560);
  kf[4]=*(const __attribute__((address_space(3))) bf16x8*)(kp+4096); kf[5]=*(const __attribute__((address_space(3))) bf16x8*)(kp+4608);
  kf[6]=*(const __attribute__((address_space(3))) bf16x8*)(kp+6144); kf[7]=*(const __attribute__((address_space(3))) bf16x8*)(kp+6656);
}
__device__ __forceinline__ void kload2(bf16x8*kf,lds_cptr kp,int j){ kf[2*j]=*(const __attribute__((address_space(3))) bf16x8*)(kp+j*2048); kf[2*j+1]=*(const __attribute__((address_space(3))) bf16x8*)(kp+j*2048+512); }
__device__ __forceinline__ s16x4 vtr(lds_cptr p){ return __builtin_bit_cast(s16x4,__builtin_amdgcn_ds_read_tr16_b64_v4i16((__attribute__((address_space(3))) v4i16_t*)p)); }
__device__ __forceinline__ float rowmax(const f32x16&p0,const f32x16&p1){
  float a=max3f(p0[0],p0[1],p1[0]),b=max3f(p0[2],p0[3],p1[1]);a=max3f(a,p1[2],p1[3]);
  #pragma unroll
  for(int r=4;r<16;r+=4){a=max3f(a,p0[r],p0[r+1]);b=max3f(b,p0[r+2],p0[r+3]);a=max3f(a,p1[r],p1[r+1]);b=max3f(b,p1[r+2],p1[r+3]);}
  const float m=max2f(a,b);
  auto rr=__builtin_amdgcn_permlane32_swap(__float_as_uint(m),__float_as_uint(m),false,false);
  return max2f(__uint_as_float(rr[0]),__uint_as_float(rr[1]));
}
__device__ __forceinline__ void pv(f32x16*o,int vb,bf16x8 pa0,bf16x8 pa1,bf16x8 pa2,bf16x8 pa3){
  #pragma unroll
  for(int d0=0;d0<4;++d0){s16x4 lo[4],hi[4];
    #pragma unroll
    for(int ks=0;ks<4;++ks){
      asm volatile("ds_read_b64_tr_b16 %0,%1 offset:%c2":"=&v"(lo[ks]):"v"(vb),"i"(d0*4096+ks*1024):"memory");
      asm volatile("ds_read_b64_tr_b16 %0,%1 offset:%c2":"=&v"(hi[ks]):"v"(vb),"i"(d0*4096+ks*1024+512):"memory");}
    asm volatile("s_waitcnt lgkmcnt(0)":::"memory");SBAR();
    #define PK(k) (bf16x8){lo[k][0],lo[k][1],lo[k][2],lo[k][3],hi[k][0],hi[k][1],hi[k][2],hi[k][3]}
    o[d0]=__builtin_amdgcn_mfma_f32_32x32x16_bf16(pa0,PK(0),o[d0],0,0,0);
    o[d0]=__builtin_amdgcn_mfma_f32_32x32x16_bf16(pa1,PK(1),o[d0],0,0,0);
    o[d0]=__builtin_amdgcn_mfma_f32_32x32x16_bf16(pa2,PK(2),o[d0],0,0,0);
    o[d0]=__builtin_amdgcn_mfma_f32_32x32x16_bf16(pa3,PK(3),o[d0],0,0,0);
    #undef PK
  }
}

#ifndef ATTN_STORE16
#define ATTN_STORE16(p,v) (*(u32x4*)(p)=(v))
#endif
template<int THRL> __device__ __forceinline__ void attn_unit(bool FUSE,int b,int h,int hv,int qb,const bf16*Q,const bf16*__restrict__ K,const bf16*__restrict__ V,bf16*O,const bf16*O2,float lam,const float*gsub,char*shm){
  int tid_=threadIdx.x; asm volatile("":"+v"(tid_)); const int tid=tid_,lane=tid&63,r32=lane&31,hi=lane>>5; const int wid=__builtin_amdgcn_readfirstlane(tid>>6);
  const long rowbase=(long)b*SEQ; const int q0=qb*QB;
  const bf16*Qw=Q+(rowbase+q0+wid*QBLK)*DM+h*D;
  const bf16*Kh=K+rowbase*DM+h*D,*Vh=V+rowbase*DM+hv*2*D;
  const unsigned lds0=(unsigned)(uintptr_t)shm;
  float*wsf=(float*)(shm+LDS_WS)+wid*64;
  const bf16*ksrc=Kh+(long)lane*DM+wid*8;
  const bf16*vsrc=Vh+(long)(16*(wid&3)+(lane>>2))*DM+(wid>>2)*32+(lane&3)*8;
  const unsigned kdst=lds0+LDS_K+wid*1024, vdst=lds0+LDS_V+wid*1024;
  #define DMA_K(t,slot) glds16(ksrc+(long)(t)*KVBLK*DM,(unsigned)__builtin_amdgcn_readfirstlane(kdst+(slot)))
  #define DMA_V(t,slot) do{ glds16(vsrc+(long)(t)*KVBLK*DM,(unsigned)__builtin_amdgcn_readfirstlane(vdst+2*(slot))); glds16(vsrc+(long)(t)*KVBLK*DM+64,(unsigned)__builtin_amdgcn_readfirstlane(vdst+2*(slot)+8192)); }while(0)
  const int vb0=(int)(lds0+LDS_V)+((lane>>4)&1)*32+(lane&3)*8+(4*hi+((lane&15)>>2))*64;
  const char*Kbase=shm+LDS_K; bf16x8 kf[8];
  const lds_cptr shm3=(lds_cptr)shm; const lds_cptr kp0=shm3+LDS_K+hi*1024+r32*16; const lds_cptr vp0=shm3+LDS_V+((lane>>4)&1)*32+(lane&3)*8+(4*hi+((lane&15)>>2))*64;
  const int NT=(q0+QB)/KVBLK;
  DMA_K(0,0);DMA_V(0,0);DMA_K(1,SLOTB);
  bf16x8 qr[4];
  #pragma unroll
  for(int d0=0;d0<4;++d0)qr[d0]=*reinterpret_cast<const bf16x8*>(&Qw[(long)r32*DM+d0*16+hi*8]);
  float mhat=0.f,l_reg=0.f;f32x16 o[4];o[0]=f32x16{};o[1]=f32x16{};o[2]=f32x16{};o[3]=f32x16{};const f32x16 ZERO16=f32x16{};
  const int qrel=wid*QBLK+r32;
  #define CMASK(P0,P1,t) do{int jb_=(t)-(NT-4); if(jb_>=0)cmask(P0,P1,jb_,qrel,hi);}while(0)
  bool resc=false;
  #define START(P0,P1) do{ const float rm=rowmax(P0,P1); resc=false; \
    { const float dl=rm; mhat=fadd_s(mhat,dl); \
      _Pragma("unroll") for(int r=0;r<16;++r){P0[r]=fsub_s(P0[r],dl);P1[r]=fsub_s(P1[r],dl);} \
      } \
    _Pragma("unroll") for(int r=0;r<16;++r)P0[r]=__builtin_amdgcn_exp2f(P0[r]); }while(0)
  #define RESC() do{ if(resc){ asm volatile("s_waitcnt lgkmcnt(0)":::"memory"); \
      _Pragma("unroll") for(int d_=0;d_<4;++d_) _Pragma("unroll") for(int r=0;r<16;++r)o[d_][r]*=wsf[crow(r,hi)]; } }while(0)
  f32x16 pA0,pA1,pB0,pB1;
  int sl_prev=0,sl_cur=0,sl_next=SLOTB;
  #define ROT() do{sl_prev=sl_cur;sl_cur=sl_next;sl_next=(sl_next==(NSLOT-1)*SLOTB)?0:sl_next+SLOTB;}while(0)
  DMA_K(2,2*SLOTB);
  WAIT_BAR(3);
  qkt(pA0,pA1,Kbase,qr,r32,hi);asm volatile("s_nop 15\n\ts_nop 7":"+v"(pA0),"+v"(pA1));CMASK(pA0,pA1,0);
  START(pA0,pA1);
  _Pragma("unroll") for(int r=0;r<16;++r)pA1[r]=__builtin_amdgcn_exp2f(pA1[r]);
  WAIT_BAR(0);
  DMA_K(3,0);DMA_V(1,SLOTB);
  ROT();
  kload8(kf,kp0+sl_cur);
  WAIT_BAR(3);
  s16x4 vlo[8],vhi[8]; u32x4 pw0,pw1,pw2,pw3;
  #define PKW(P,B) cvtpk_s(P[B],P[B+1])
  #define PAF(k) __builtin_bit_cast(bf16x8,pw##k)
  #define VFR(i) (bf16x8){vlo[i][0],vlo[i][1],vlo[i][2],vlo[i][3],vhi[i][0],vhi[i][1],vhi[i][2],vhi[i][3]}
  #define PIN(x) asm volatile("":"+v"(x))
  #define MX3(a,b,c) __builtin_fmaxf(__builtin_fmaxf((a),(b)),(c))
  #define GAPA(MF,A0,A1,A2,A3,W0,W1,PW) do{ MF; sacc+=A0; sacc+=A1; sacc+=A2; sacc+=A3; PIN(sacc); W0; W1; PIN(PW); SBAR(); }while(0)
  #define EX(v) __builtin_amdgcn_exp2f(v)
  #define GAPB(MF,RD,X,B) do{ MF; RD; X[B]=EX(X[B]-mhat); X[B+1]=EX(X[B+1]-mhat); PIN(X); SBAR(); }while(0)
  #define VRD(i) do{ vlo[i]=vtr(vp_+(((i)>>2)*4096+((i)&3)*1024)); vhi[i]=vtr(vp_+(((i)>>2)*4096+((i)&3)*1024+512)); }while(0)
  #define VRD2(i) do{ vlo[i]=vtr(vp_+(8192+((i)>>2)*4096+((i)&3)*1024)); vhi[i]=vtr(vp_+(8192+((i)>>2)*4096+((i)&3)*1024+512)); }while(0)
  #define KRD(G,j) do{ if(G){ kload2(kf,kp0+sl_next,j); SBAR(); } }while(0)
  #define STEP(C0,C1,P0,P1,t,GK,GV,GL) do{ SBAR(); \
    const lds_cptr vp_=vp0+2*sl_prev; \
    VRD(0); SBAR(); float sacc=(P0[0]+P0[1]); \
    GAPA(C0=__builtin_amdgcn_mfma_f32_32x32x16_bf16(kf[0],qr[0],ZERO16,0,0,0), P0[2],P0[3],P0[4],P0[5],     pw0[0]=PKW(P0,0), pw0[1]=PKW(P0,2), pw0); \
    VRD(4); SBAR(); GAPA(C1=__builtin_amdgcn_mfma_f32_32x32x16_bf16(kf[1],qr[0],ZERO16,0,0,0), P0[6],P0[7],P0[8],P0[9],     pw0[2]=PKW(P0,4), pw0[3]=PKW(P0,6), pw0); \
    VRD(1); SBAR(); GAPA(C0=__builtin_amdgcn_mfma_f32_32x32x16_bf16(kf[2],qr[1],C0,0,0,0),   P0[10],P0[11],P0[12],P0[13], pw1[0]=PKW(P0,8), pw1[1]=PKW(P0,10), pw1); \
    VRD(5); SBAR(); GAPA(C1=__builtin_amdgcn_mfma_f32_32x32x16_bf16(kf[3],qr[1],C1,0,0,0),   P0[14],P0[15],P1[0],P1[1],   pw1[2]=PKW(P0,12),pw1[3]=PKW(P0,14), pw1); \
    VRD(2); SBAR(); GAPA(C0=__builtin_amdgcn_mfma_f32_32x32x16_bf16(kf[4],qr[2],C0,0,0,0),   P1[2],P1[3],P1[4],P1[5],     pw2[0]=PKW(P1,0), pw2[1]=PKW(P1,2), pw2); \
    VRD(6); SBAR(); GAPA(C1=__builtin_amdgcn_mfma_f32_32x32x16_bf16(kf[5],qr[2],C1,0,0,0),   P1[6],P1[7],P1[8],P1[9],     pw2[2]=PKW(P1,4), pw2[3]=PKW(P1,6), pw2); \
    VRD(3); SBAR(); GAPA(C0=__builtin_amdgcn_mfma_f32_32x32x16_bf16(kf[6],qr[3],C0,0,0,0),   P1[10],P1[11],P1[12],P1[13], pw3[0]=PKW(P1,8), pw3[1]=PKW(P1,10), pw3); \
    VRD(7); SBAR(); GAPA(C1=__builtin_amdgcn_mfma_f32_32x32x16_bf16(kf[7],qr[3],C1,0,0,0),   P1[14],P1[15],0.f,0.f,       pw3[2]=PKW(P1,12),pw3[3]=PKW(P1,14), pw3); \
    l_reg+=sacc; \
    if(GK){DMA_K((t)+3,sl_cur);} if(GV){DMA_V((t)+1,sl_next);} \
    CMASK(C0,C1,t); \
    { float a=MX3(C0[0],C0[1],C1[0]),b=MX3(C0[2],C0[3],C1[1]); a=MX3(a,C1[2],C1[3]); \
      _Pragma("unroll") for(int r=4;r<16;r+=4){a=MX3(a,C0[r],C0[r+1]);b=MX3(b,C0[r+2],C0[r+3]);a=MX3(a,C1[r],C1[r+1]);b=MX3(b,C1[r+2],C1[r+3]);} \
      float rm=__builtin_fmaxf(a,b); { auto rr=__builtin_amdgcn_permlane32_swap(__float_as_uint(rm),__float_as_uint(rm),false,false); rm=__builtin_fmaxf(__uint_as_float(rr[0]),__uint_as_float(rr[1])); } \
      resc=false; rm-=mhat;   \
      if(__builtin_expect(__any(rm>(float)THRL),0)){ const float dl=__builtin_fmaxf(rm,0.f); mhat+=dl; \
        const float f=__builtin_amdgcn_exp2f(-dl); l_reg*=f; if(hi==0)wsf[r32]=f; resc=true; } } \
    SBAR(); \
    GAPB(o[0]=__builtin_amdgcn_mfma_f32_32x32x16_bf16(PAF(0),VFR(0),o[0],0,0,0), VRD2(0), C0,0); \
    GAPB(o[1]=__builtin_amdgcn_mfma_f32_32x32x16_bf16(PAF(0),VFR(4),o[1],0,0,0), VRD2(4), C0,2); \
    GAPB(o[0]=__builtin_amdgcn_mfma_f32_32x32x16_bf16(PAF(1),VFR(1),o[0],0,0,0), VRD2(1), C0,4); \
    GAPB(o[1]=__builtin_amdgcn_mfma_f32_32x32x16_bf16(PAF(1),VFR(5),o[1],0,0,0), VRD2(5), C0,6); \
    GAPB(o[0]=__builtin_amdgcn_mfma_f32_32x32x16_bf16(PAF(2),VFR(2),o[0],0,0,0), VRD2(2), C0,8); \
    GAPB(o[1]=__builtin_amdgcn_mfma_f32_32x32x16_bf16(PAF(2),VFR(6),o[1],0,0,0), VRD2(6), C0,10); \
    GAPB(o[0]=__builtin_amdgcn_mfma_f32_32x32x16_bf16(PAF(3),VFR(3),o[0],0,0,0), VRD2(3), C0,12); \
    GAPB(o[1]=__builtin_amdgcn_mfma_f32_32x32x16_bf16(PAF(3),VFR(7),o[1],0,0,0), VRD2(7), C0,14); \
    KRD(GL,0); GAPB(o[2]=__builtin_amdgcn_mfma_f32_32x32x16_bf16(PAF(0),VFR(0),o[2],0,0,0), (void)0, C1,0); \
    GAPB(o[3]=__builtin_amdgcn_mfma_f32_32x32x16_bf16(PAF(0),VFR(4),o[3],0,0,0), (void)0, C1,2); \
    KRD(GL,1); GAPB(o[2]=__builtin_amdgcn_mfma_f32_32x32x16_bf16(PAF(1),VFR(1),o[2],0,0,0), (void)0, C1,4); \
    GAPB(o[3]=__builtin_amdgcn_mfma_f32_32x32x16_bf16(PAF(1),VFR(5),o[3],0,0,0), (void)0, C1,6); \
    KRD(GL,2); GAPB(o[2]=__builtin_amdgcn_mfma_f32_32x32x16_bf16(PAF(2),VFR(2),o[2],0,0,0), (void)0, C1,8); \
    GAPB(o[3]=__builtin_amdgcn_mfma_f32_32x32x16_bf16(PAF(2),VFR(6),o[3],0,0,0), (void)0, C1,10); \
    KRD(GL,3); GAPB(o[2]=__builtin_amdgcn_mfma_f32_32x32x16_bf16(PAF(3),VFR(3),o[2],0,0,0), (void)0, C1,12); \
    GAPB(o[3]=__builtin_amdgcn_mfma_f32_32x32x16_bf16(PAF(3),VFR(7),o[3],0,0,0), (void)0, C1,14); \
    }while(0)
  int t=1;
  #undef CMASK
  #define CMASK(P0,P1,t) do{}while(0)
  for(;t+5<NT;t+=2){
    STEP(pB0,pB1,pA0,pA1,t,true,true,true);     WAIT_BAR(3); RESC(); ROT();
    STEP(pA0,pA1,pB0,pB1,t+1,true,true,true);   WAIT_BAR(3); RESC(); ROT();
  }
  #undef CMASK
  #define CMASK(P0,P1,t) do{int jb_=(t)-(NT-4); if(jb_>=0)cmask(P0,P1,jb_,qrel,hi);}while(0)
  #define ENDW(tt) do{ if((tt)+3<NT){WAIT_BAR(3);} else if((tt)+2<NT){WAIT_BAR(2);} else {WAIT_BAR(0);} }while(0)
  for(;t+1<NT;t+=2){
    STEP(pB0,pB1,pA0,pA1,t,(t+3<NT),(t+1<NT),(t+1<NT));       ENDW(t);   RESC(); ROT();
    STEP(pA0,pA1,pB0,pB1,t+1,(t+4<NT),(t+2<NT),(t+2<NT));     ENDW(t+1); RESC(); ROT();
  }
  STEP(pB0,pB1,pA0,pA1,NT-1,false,false,false); RESC();
  { float sacc=pB0[0]+pB0[1]; _Pragma("unroll") for(int r=2;r<16;++r)sacc+=pB0[r]; _Pragma("unroll") for(int r=0;r<16;++r)sacc+=pB1[r]; l_reg+=sacc;
    pw0=(u32x4){PKW(pB0,0),PKW(pB0,2),PKW(pB0,4),PKW(pB0,6)};pw1=(u32x4){PKW(pB0,8),PKW(pB0,10),PKW(pB0,12),PKW(pB0,14)};pw2=(u32x4){PKW(pB1,0),PKW(pB1,2),PKW(pB1,4),PKW(pB1,6)};pw3=(u32x4){PKW(pB1,8),PKW(pB1,10),PKW(pB1,12),PKW(pB1,14)};
    SBAR(); pv(o,vb0+2*sl_cur,PAF(0),PAF(1),PAF(2),PAF(3)); }
  #undef PKW
  #undef PAF
  #undef VFR
  #undef PIN
  #undef MX3
  #undef GAPA
  #undef GAPB
  #undef EX
  #undef VRD
  #undef VRD2
  #undef KRD
  #undef STEP
  #undef ENDW
  {auto rr=__builtin_amdgcn_permlane32_swap(__float_as_uint(l_reg),__float_as_uint(l_reg),false,false);l_reg=__uint_as_float(rr[0])+__uint_as_float(rr[1]);}
  if(hi==0)wsf[32+r32]=l_reg;asm volatile("s_waitcnt lgkmcnt(0)":::"memory");
  float rli[16];
  #pragma unroll
  for(int r=0;r<16;++r)rli[r]=__builtin_amdgcn_rcpf(wsf[32+crow(r,hi)]);
  bf16*Ow=O+(rowbase+q0+wid*QBLK)*DM+hv*2*D;
  asm volatile("s_waitcnt lgkmcnt(0)\n\ts_barrier":::"memory");
  { bf16*stg=(bf16*)(shm+LDS_K)+wid*4096;
    const bf16*O2w=O2+(rowbase+q0+wid*QBLK)*DM+hv*2*D;
    #pragma unroll
    for(int r=0;r<16;++r){const int orow=crow(r,hi);
      #pragma unroll
      for(int d0=0;d0<4;++d0)stg[orow*128+d0*32+r32]=__float2bfloat16(o[d0][r]*rli[r]);}
    asm volatile("s_waitcnt lgkmcnt(0)":::"memory");
    #pragma unroll
    for(int i=0;i<4;++i){const int row=i*8+(lane>>3),ch=lane&7;
      const u32x4 v0=*(const u32x4*)(stg+row*128+ch*8), v1=*(const u32x4*)(stg+row*128+64+ch*8);
      if(!FUSE){ ATTN_STORE16(Ow+(long)row*DM+ch*8,v0); ATTN_STORE16(Ow+(long)row*DM+64+ch*8,v1); }
      else{ const u32x4 t0=*(const u32x4*)(O2w+(long)row*DM+ch*8), t1=*(const u32x4*)(O2w+(long)row*DM+64+ch*8);
        float c[16]; float ss=0.f;
        #pragma unroll
        for(int k=0;k<4;++k){ c[2*k]=__uint_as_float(v0[k]<<16)-lam*__uint_as_float(t0[k]<<16); c[2*k+1]=__uint_as_float(v0[k]&0xffff0000u)-lam*__uint_as_float(t0[k]&0xffff0000u);
          c[8+2*k]=__uint_as_float(v1[k]<<16)-lam*__uint_as_float(t1[k]<<16); c[8+2*k+1]=__uint_as_float(v1[k]&0xffff0000u)-lam*__uint_as_float(t1[k]&0xffff0000u); }
        #pragma unroll
        for(int k=0;k<16;++k)ss+=c[k]*c[k];
        ss+=__int_as_float(__builtin_amdgcn_ds_swizzle(__float_as_int(ss),(1<<10)|0x1f)); ss+=__int_as_float(__builtin_amdgcn_ds_swizzle(__float_as_int(ss),(2<<10)|0x1f)); ss+=__int_as_float(__builtin_amdgcn_ds_swizzle(__float_as_int(ss),(4<<10)|0x1f));
        const float rs=__builtin_amdgcn_rsqf(ss*(1.f/128.f)+1e-6f);
        const float4 g0=*(const float4*)(gsub+ch*8), g1=*(const float4*)(gsub+ch*8+4), g2=*(const float4*)(gsub+64+ch*8), g3=*(const float4*)(gsub+64+ch*8+4);
        u32x4 w0,w1;
        w0[0]=cvtpk_s(c[0]*rs*g0.x,c[1]*rs*g0.y); w0[1]=cvtpk_s(c[2]*rs*g0.z,c[3]*rs*g0.w); w0[2]=cvtpk_s(c[4]*rs*g1.x,c[5]*rs*g1.y); w0[3]=cvtpk_s(c[6]*rs*g1.z,c[7]*rs*g1.w);
        w1[0]=cvtpk_s(c[8]*rs*g2.x,c[9]*rs*g2.y); w1[1]=cvtpk_s(c[10]*rs*g2.z,c[11]*rs*g2.w); w1[2]=cvtpk_s(c[12]*rs*g3.x,c[13]*rs*g3.y); w1[3]=cvtpk_s(c[14]*rs*g3.z,c[15]*rs*g3.w);
        ATTN_STORE16(Ow+(long)row*DM+ch*8,w0); ATTN_STORE16(Ow+(long)row*DM+64+ch*8,w1); } } }
  asm volatile("s_waitcnt lgkmcnt(0)\n\ts_barrier":::"memory");
  #undef DMA_K
  #undef DMA_V
  #undef CMASK
  #undef START
  #undef RESC
  #undef ROT
}
constexpr int ATTN_LDS_BYTES=LDS_BYTES;
struct AttnTensors { const bf16* Q; const bf16* K; const bf16* V; bf16* O2; bf16* YB; };
template<int THRL=8> __device__ __forceinline__ void attn_phase(char*lds,const AttnTensors&T,float lam,const float*gsub,int vcu,int ncu){
  const int bh=(vcu&255)>>3, s=vcu&7; const int b=bh>>3, h=bh&7;
  const float lam_u=__uint_as_float(__builtin_amdgcn_readfirstlane(__float_as_uint(lam)));
  for(int i=0;i<4;++i){ const int qb=(i&2)?15-s:s; const bool fuse=(i&1)!=0;
    attn_unit<THRL>(fuse,b,fuse?2*h:2*h+1,h,qb,T.Q,T.K,T.V,fuse?T.YB:T.O2,T.O2,lam_u,gsub,lds);
  }
}
#undef SBAR
#undef WAIT_BAR
}
constexpr int NWAVES = 8;
#ifndef MK_MULTI
#define MK_MULTI 0
#endif
constexpr int NB = 4, SEQ = 4096, T = NB * SEQ, D = 1024, DIN = 7168, FF = 3584, NEXP = 8, PLE = 256, DEPTH = 2;
constexpr int NPAN = T / 256;
constexpr float EPS = 1e-6f;
constexpr int MOE_ROWS = 2 * T + NEXP * 256;
constexpr int MOE_PANELS = MOE_ROWS / 256, MOE_HALF = MOE_PANELS / 2;
constexpr size_t MiB = 1u << 20;
constexpr size_t WS_CTL = 0, CTL_ZERO_BYTES = 1 * MiB;
constexpr size_t WS_LRUW = 1 * MiB;
constexpr size_t WS_PAR = 1 * MiB + 512 * 1024;
constexpr size_t WS_SUM = 2 * MiB;
constexpr size_t WS_TOK = 4 * MiB;
constexpr size_t WS_LIST = 5 * MiB;
constexpr size_t WS_COS = 6 * MiB;
constexpr size_t WS_WSMALL = 10 * MiB;
constexpr size_t WL_STRIDE = 45 * MiB / 2, WL_WIN = 0, WL_WAB = 14 * MiB, WL_WO = 18 * MiB, WL_WPG = 20 * MiB, WL_WPP = 22 * MiB;
constexpr size_t WS_WGU = WS_WSMALL + 45 * MiB, WS_WD = WS_WGU + 14 * MiB;
constexpr size_t WS_PB = 76 * MiB;
constexpr size_t WS_H = 92 * MiB;
constexpr size_t WS_BIG = 124 * MiB, SLOT = 32 * MiB;
constexpr size_t WS_GG = WS_BIG, WS_RIN = WS_BIG + SLOT, WS_Q = WS_BIG + 2 * SLOT, WS_K = WS_BIG + 3 * SLOT, WS_V = WS_BIG + 4 * SLOT, WS_SGA = WS_BIG + 5 * SLOT, WS_SGB = WS_BIG + 6 * SLOT;
constexpr size_t WS_HL = WS_BIG + 7 * SLOT, WS_LP = WS_BIG + 8 * SLOT, WS_O1 = WS_BIG + 9 * SLOT, WS_O2 = WS_BIG + 10 * SLOT;
constexpr size_t WS_YA = WS_RIN, WS_YB = WS_Q, WS_T1 = WS_K, WS_MERGED = WS_GG, WS_F = WS_SGA;
constexpr size_t WS_ACT = WS_BIG;
constexpr size_t WS_PP = WS_BIG;
constexpr size_t WS_WMGU = WS_BIG, WS_WMD = WS_BIG + 56 * MiB, WS_ACT8 = WS_BIG + 84 * MiB, WS_HG = WS_BIG + 204 * MiB, WS_OE = WS_BIG + 240 * MiB;
constexpr size_t WS_XR = WS_O2 + SLOT;
constexpr size_t WS_WIN8 = WS_XR + SLOT;
constexpr size_t WS_WGU8 = WS_WIN8 + 14 * MiB;
constexpr size_t WS_SB = WS_WGU8 + 7 * MiB;
constexpr size_t WS_SA = WS_COS + 128 * 1024;
constexpr size_t WS_END = WS_SB + 1 * MiB;
constexpr float SC_H = 8.f, SC_WGU = 32.f, SC_ACT = 8.f, SC_WD = 64.f;
constexpr int E8_H = 0x7c7c7c7c, E8_WGU = 0x7a7a7a7a, E8_ACT = 0x7c7c7c7c, E8_WD = 0x79797979;
static_assert(WS_OE + (size_t)MOE_ROWS * D * 2 <= WS_END && WS_ACT8 + (size_t)MOE_ROWS * FF <= WS_HG && WS_HG + (size_t)MOE_ROWS * D <= WS_OE && WS_WMD + (size_t)NEXP * D * FF <= WS_ACT8, "d_ws map");
constexpr int CW_TMO = 0, CW_CODE = 1;
constexpr int CW_CNT = 64;
constexpr int CW_BAR = 4096;
constexpr int RING_OFF = 0, RING_BYTES = 131072;
constexpr int LDSCTL_OFF = RING_BYTES, MISC_OFF = LDSCTL_OFF + 320;
constexpr int LDS_BYTES = 147456;
static_assert(MISC_OFF + 128 <= LDS_BYTES, "LDS map");
#define GAS __attribute__((address_space(1)))
#define LAS __attribute__((address_space(3)))
typedef unsigned short bf16;
typedef unsigned v4u __attribute__((ext_vector_type(4)));
typedef float f32x4 __attribute__((ext_vector_type(4)));
typedef short bf16x8 __attribute__((ext_vector_type(8)));
typedef GAS unsigned gu32;
typedef GAS unsigned long long gu64;
#define RLX_AGENT __ATOMIC_RELAXED, __HIP_MEMORY_SCOPE_AGENT
#define LDS_WAIT() asm volatile("s_waitcnt lgkmcnt(0)" ::: "memory")
#define VM_WAIT() asm volatile("s_waitcnt vmcnt(0)" ::: "memory")
__device__ __forceinline__ unsigned long long rt() { return __builtin_amdgcn_s_memrealtime(); }
__device__ __forceinline__ unsigned f2bf(float f) { unsigned u = __builtin_bit_cast(unsigned, f); return (u + 0x7fffu + ((u >> 16) & 1u)) >> 16; }
__device__ __forceinline__ unsigned pk2(float lo, float hi) { return f2bf(lo) | (f2bf(hi) << 16); }

#define XB_TMO      128
#define XB_XCNT(j)  (256  + 64 * (j))
#define XB_XSUB(j)  (1280 + 64 * (j))
#define XB_XGEN(j)  (2304 + 64 * (j))
#define XB_TOP      3328
#define XB_TOPGEN   3392
#define XCD_BAR_WORDS 3456
#define XB_SPIN_CAP (1u << 18)

__device__ __forceinline__ unsigned xb_ld(unsigned* p)              { return __hip_atomic_load(p, __ATOMIC_RELAXED, __HIP_MEMORY_SCOPE_AGENT); }
__device__ __forceinline__ unsigned xb_add(unsigned* p, unsigned v) { return __hip_atomic_fetch_add(p, v, __ATOMIC_RELAXED, __HIP_MEMORY_SCOPE_AGENT); }
__device__ __forceinline__ unsigned xb_xcc_id() { return (unsigned)__builtin_amdgcn_s_getreg((3 << 11) | 20) & 0xFu; }
#define XB_SPIN(cond, bar) do { unsigned _sp = 0; while (cond) { __builtin_amdgcn_s_sleep(1); \
    if ((++_sp & 255u) == 0u) { if (xb_ld(&(bar)[XB_TMO])) break; if (_sp > XB_SPIN_CAP) { atomicAdd(&(bar)[XB_TMO], 1u); break; } } } } while (0)

struct XcdBarrier {
    unsigned* bar; unsigned x;
    volatile LAS unsigned* st;
};

__device__ __forceinline__ XcdBarrier xcd_barrier_post(unsigned* bar, volatile LAS unsigned* st) {
    XcdBarrier b; b.bar = bar; b.x = xb_xcc_id(); b.st = st;
    if (threadIdx.x == 0) (void)xb_add(&bar[XB_XCNT(b.x)], 1u);
    return b;
}
__device__ __forceinline__ void xcd_barrier_complete(unsigned* bar, unsigned x, unsigned& nloc, unsigned& nx) {
    const unsigned G = gridDim.x * gridDim.y * gridDim.z;
    unsigned sum, cnt, mine, sp = 0u;
    for (;;) {
        sum = 0u; cnt = 0u; mine = 0u;
#pragma unroll
        for (unsigned j = 0; j < 16; ++j) { const unsigned c = xb_ld(&bar[XB_XCNT(j)]); sum += c; cnt += (c > 0u) ? 1u : 0u; mine = (j == x) ? c : mine; }
        if (sum == G) break;
        __builtin_amdgcn_s_sleep(1);
        if ((++sp & 255u) == 0u) { if (xb_ld(&bar[XB_TMO])) break; if (sp > XB_SPIN_CAP) { atomicAdd(&bar[XB_TMO], 1u); break; } }
    }
    nloc = mine > 0u ? mine : 1u; nx = cnt > 0u ? cnt : 1u;
}

__device__ __forceinline__ void xcd_barrier(const XcdBarrier& b) {
    asm volatile("s_waitcnt vmcnt(0)" ::: "memory");
    __syncthreads();
    if (threadIdx.x == 0) {
        unsigned* bar = b.bar; unsigned bx_ = b.x;
        asm volatile("" : "+s"(bar), "+s"(bx_));
        __builtin_amdgcn_s_waitcnt(0);
        unsigned nloc = b.st[0], nx = b.st[1];
        if (nloc == 0u) { xcd_barrier_complete(bar, bx_, nloc, nx); b.st[0] = nloc; b.st[1] = nx; }
        const unsigned old = xb_add(&bar[XB_XSUB(bx_)], 1u);
        const unsigned gen = old / nloc;
        if (old + 1u == (gen + 1u) * nloc) {
            __builtin_amdgcn_fence(__ATOMIC_RELEASE, "agent");
            asm volatile("s_waitcnt vmcnt(0)" ::: "memory");
            const unsigned og = xb_add(&bar[XB_TOP], 1u);
            const unsigned tg = og / nx;
            if (og + 1u == (tg + 1u) * nx) xb_add(&bar[XB_TOPGEN], 1u);
            else XB_SPIN(xb_ld(&bar[XB_TOPGEN]) == tg, bar);
            __builtin_amdgcn_fence(__ATOMIC_ACQUIRE, "agent");
            xb_add(&bar[XB_XGEN(bx_)], 1u);
            asm volatile("s_waitcnt vmcnt(0)" ::: "memory");
        } else {
            XB_SPIN(xb_ld(&bar[XB_XGEN(bx_)]) == gen, bar);
            __builtin_amdgcn_fence(__ATOMIC_ACQUIRE, "agent");
            asm volatile("s_waitcnt vmcnt(0)" ::: "memory");
        }
    }
    __syncthreads();
}
__device__ const float INV_FREQ[32] = {
    1.0f, 0.74989420933f, 0.56234132519f, 0.42169650343f, 0.31622776602f, 0.23713737057f, 0.17782794100f, 0.13335214322f,
    0.1f, 0.074989420933f, 0.056234132519f, 0.042169650343f, 0.031622776602f, 0.023713737057f, 0.017782794100f, 0.013335214322f,
    0.01f, 0.0074989420933f, 0.0056234132519f, 0.0042169650343f, 0.0031622776602f, 0.0023713737057f, 0.0017782794100f, 0.0013335214322f,
    0.001f, 0.00074989420933f, 0.00056234132519f, 0.00042169650343f, 0.00031622776602f, 0.00023713737057f, 0.00017782794100f, 0.00013335214322f };

#define SWZ_XOR(v, o) __int_as_float(__builtin_amdgcn_ds_swizzle(__float_as_int(v), ((o) << 10) | 0x1f))
__device__ __forceinline__ float half_sum(float v) {
    v += SWZ_XOR(v, 1); v += SWZ_XOR(v, 2); v += SWZ_XOR(v, 4); v += SWZ_XOR(v, 8); v += SWZ_XOR(v, 16);
    return v;
}
__device__ __forceinline__ float wave_sum(float v) {
    v = half_sum(v);
    const auto rr = __builtin_amdgcn_permlane32_swap(__float_as_uint(v), __float_as_uint(v), false, false);
    return __uint_as_float(rr[0]) + __uint_as_float(rr[1]);
}
__device__ __forceinline__ float dot4(f32x4 a, f32x4 b) { return (a.x * b.x + a.y * b.y) + (a.z * b.z + a.w * b.w); }
__device__ __forceinline__ float bf2f(unsigned short v) { return __uint_as_float((unsigned)v << 16); }
typedef unsigned u32x2 __attribute__((ext_vector_type(2)));
__device__ __forceinline__ f32x4 bf4_to_f(u32x2 w) { return (f32x4){__uint_as_float(w.x << 16), __uint_as_float(w.x & 0xffff0000u), __uint_as_float(w.y << 16), __uint_as_float(w.y & 0xffff0000u)}; }
__device__ __forceinline__ u32x2 f_to_bf4(f32x4 v) { u32x2 w; w.x = pk2(v.x, v.y); w.y = pk2(v.z, v.w); return w; }
__device__ __forceinline__ float sigm_f(float v) { return 1.0f / (1.0f + __expf(-v)); }

__device__ __forceinline__ f32x4 bfl4(v4u w) { return (f32x4){__uint_as_float(w.x << 16), __uint_as_float(w.x & 0xffff0000u), __uint_as_float(w.y << 16), __uint_as_float(w.y & 0xffff0000u)}; }
__device__ __forceinline__ f32x4 bfh4(v4u w) { return (f32x4){__uint_as_float(w.z << 16), __uint_as_float(w.z & 0xffff0000u), __uint_as_float(w.w << 16), __uint_as_float(w.w & 0xffff0000u)}; }
__device__ __forceinline__ v4u pk8bf(f32x4 a, f32x4 b) { v4u w; w.x = pk2(a.x, a.y); w.y = pk2(a.z, a.w); w.z = pk2(b.x, b.y); w.w = pk2(b.z, b.w); return w; }
__device__ __forceinline__ float wave_max(float v) {
    v = fmaxf(v, SWZ_XOR(v, 1)); v = fmaxf(v, SWZ_XOR(v, 2)); v = fmaxf(v, SWZ_XOR(v, 4)); v = fmaxf(v, SWZ_XOR(v, 8)); v = fmaxf(v, SWZ_XOR(v, 16));
    const auto rr = __builtin_amdgcn_permlane32_swap(__float_as_uint(v), __float_as_uint(v), false, false);
    return fmaxf(__uint_as_float(rr[0]), __uint_as_float(rr[1]));
}
__device__ __forceinline__ float amax4(f32x4 v) { return fmaxf(fmaxf(fabsf(v.x), fabsf(v.y)), fmaxf(fabsf(v.z), fabsf(v.w))); }
__device__ __forceinline__ unsigned q4i8(f32x4 v, float k) {
    const int a = (int)rintf(v.x * k), b = (int)rintf(v.y * k), c = (int)rintf(v.z * k), d = (int)rintf(v.w * k);
    return (unsigned)(a & 255) | ((unsigned)(b & 255) << 8) | ((unsigned)(c & 255) << 16) | ((unsigned)d << 24);
}
__device__ __forceinline__ void wq_row(const bf16* src, unsigned char* dst, float* scale, int lane) {
    const v4u a = ((const v4u*)src)[2 * lane], b = ((const v4u*)src)[2 * lane + 1];
    const f32x4 v0 = bfl4(a), v1 = bfh4(a), v2 = bfl4(b), v3 = bfh4(b);
    const float mx = wave_max(fmaxf(fmaxf(amax4(v0), amax4(v1)), fmaxf(amax4(v2), amax4(v3))));
    const float k = 127.f / fmaxf(mx, 1e-30f);
    v4u o; o.x = q4i8(v0, k); o.y = q4i8(v1, k); o.z = q4i8(v2, k); o.w = q4i8(v3, k);
    ((v4u*)dst)[lane] = o;
    if (lane == 0) *scale = mx * (1.f / 127.f);
}
__device__ __forceinline__ void tr_load(float (&r)[32], const float* W, int N, int k0, int n0, int lane) {
#pragma unroll
    for (int i = 0; i < 32; ++i) r[i] = W[(size_t)(k0 + 2 * i + (lane >> 5)) * N + n0 + (lane & 31)];
}
__device__ __forceinline__ void tr_store(const float (&r)[32], int K, bf16* WT, int dest_row0, int k0, LAS float* scr, int lane) {
#pragma unroll
    for (int i = 0; i < 32; ++i) scr[(2 * i + (lane >> 5)) * 33 + (lane & 31)] = r[i];
    LDS_WAIT(); asm volatile("" ::: "memory");
    const int c = lane & 7;
#pragma unroll
    for (int j = 0; j < 4; ++j) { const int n = (lane >> 3) + 8 * j; const LAS float* s = scr + (8 * c) * 33 + n;
        v4u o; o.x = pk2(s[0 * 33], s[1 * 33]); o.y = pk2(s[2 * 33], s[3 * 33]); o.z = pk2(s[4 * 33], s[5 * 33]); o.w = pk2(s[6 * 33], s[7 * 33]);
        *(v4u*)(WT + (size_t)(dest_row0 + n) * K + k0 + 8 * c) = o; }
    LDS_WAIT(); asm volatile("" ::: "memory");
}
template <int MAP> __device__ __forceinline__ int dest_row(int n0) {
    if (MAP == 1) { const int tile = n0 >> 8, w = n0 & 255; return tile * 256 + ((w & 63) >> 5) * 128 + (w >> 6) * 32; }
    if (MAP == 2) return (n0 >> 7) * 256 + (n0 & 127);
    if (MAP == 3) return (n0 >> 7) * 256 + 128 + (n0 & 127);
    return n0;
}
__device__ __forceinline__ float clamp8(float v) { return __builtin_fminf(__builtin_fmaxf(v, -448.f), 448.f); }
__device__ __forceinline__ unsigned pk4f8(float a, float b, float c, float d) { unsigned w = __builtin_amdgcn_cvt_pk_fp8_f32(clamp8(a), clamp8(b), 0u, false); return __builtin_amdgcn_cvt_pk_fp8_f32(clamp8(c), clamp8(d), w, true); }
__device__ __forceinline__ void tr_store8(const float (&r)[32], int K, unsigned char* WT, int dest_row0, int k0, float scale, LAS float* scr, int lane) {
#pragma unroll
    for (int i = 0; i < 32; ++i) scr[(2 * i + (lane >> 5)) * 33 + (lane & 31)] = r[i] * scale;
    LDS_WAIT(); asm volatile("" ::: "memory");
    const int c = lane & 3;
#pragma unroll
    for (int j = 0; j < 2; ++j) { const int n = (lane >> 2) + 16 * j; const LAS float* s = scr + (16 * c) * 33 + n;
        v4u o; o.x = pk4f8(s[0 * 33], s[1 * 33], s[2 * 33], s[3 * 33]); o.y = pk4f8(s[4 * 33], s[5 * 33], s[6 * 33], s[7 * 33]);
        o.z = pk4f8(s[8 * 33], s[9 * 33], s[10 * 33], s[11 * 33]); o.w = pk4f8(s[12 * 33], s[13 * 33], s[14 * 33], s[15 * 33]);
        *(v4u*)(WT + (size_t)(dest_row0 + n) * K + k0 + 16 * c) = o; }
    LDS_WAIT(); asm volatile("" ::: "memory");
}
struct TrItem { const float* W; bf16* WT; int K, N, dest_row0, k0, n0; float s8; };
template <int MAP> __device__ __forceinline__ TrItem tr_item(const float* W, int K, int N, bf16* WT, int row_off, int q, float s8 = 0.f) {
    const int nblk = N / 32, kb = q / nblk, nb = q - kb * nblk; TrItem t; t.W = W; t.WT = WT; t.K = K; t.N = N; t.dest_row0 = row_off + dest_row<MAP>(32 * nb); t.k0 = 64 * kb; t.n0 = 32 * nb; t.s8 = s8; return t;
}
#define TR_STORE(r, t) do { if (F8 && t.s8 != 0.f) tr_store8(r, t.K, (unsigned char*)t.WT, t.dest_row0, t.k0, t.s8, scr, lane); else tr_store(r, t.K, t.WT, t.dest_row0, t.k0, scr, lane); } while (0)
template <bool F8, class Dec> __device__ __forceinline__ void tr_run(const Dec& DEC, int nitems, LAS float* scr, int lane, int gw, int ngw) {
    int it = gw; if (it >= nitems) return;
    float ra[32], rb[32];
    TrItem a = DEC(it), b = a;
    tr_load(ra, a.W, a.N, a.k0, a.n0, lane);
    for (;;) {
        const int it1 = it + ngw; const bool h1 = it1 < nitems;
        if (h1) { b = DEC(it1); tr_load(rb, b.W, b.N, b.k0, b.n0, lane); }
        TR_STORE(ra, a);
        if (!h1) break;
        const int it2 = it1 + ngw; const bool h2 = it2 < nitems;
        if (h2) { a = DEC(it2); tr_load(ra, a.W, a.N, a.k0, a.n0, lane); }
        TR_STORE(rb, b);
        if (!h2) break;
        it = it2;
    }
}

__device__ __forceinline__ void row_post_pre(const f32x4 (&f)[4], const float* xin, float* xout, const float* gpost, const float* gpre, bf16* hrow, int lane, f32x4 (&hn)[4]) {
    float s = 0.f;
#pragma unroll
    for (int j = 0; j < 4; ++j) s += dot4(f[j], f[j]);
    const float rs = rsqrtf(wave_sum(s) * (1.f / D) + EPS);
    f32x4 xv[4]; float s2 = 0.f;
#pragma unroll
    for (int j = 0; j < 4; ++j) { xv[j] = ((const f32x4*)xin)[lane + 64 * j] + f[j] * rs * ((const f32x4*)gpost)[lane + 64 * j]; ((f32x4*)xout)[lane + 64 * j] = xv[j]; s2 += dot4(xv[j], xv[j]); }
    if (gpre) {
        const float rs2 = rsqrtf(wave_sum(s2) * (1.f / D) + EPS);
#pragma unroll
        for (int j = 0; j < 4; ++j) { hn[j] = xv[j] * rs2 * ((const f32x4*)gpre)[lane + 64 * j]; ((u32x2*)hrow)[lane + 64 * j] = f_to_bf4(hn[j]); }
    }
}
struct Args { const void* in[26]; float* out; unsigned char* ws; int ph_lo, ph_hi; };
enum { I_X = 0, I_P, I_POS, I_NORMG, I_WIN, I_CONVW, I_CONVB, I_LWA, I_LBA, I_LWX, I_LBX, I_LLAM, I_DLAM, I_SUBG, I_WPA, I_WPB, I_WOUT, I_FG, I_FU, I_FD, I_RW, I_MG, I_MU, I_MD, I_PWP, I_PWG };

constexpr int PO_NORMG = 0, PO_CONVW = PO_NORMG + DEPTH * 6 * D, PO_CONVB = PO_CONVW + DEPTH * 4 * D, PO_LBA = PO_CONVB + DEPTH * D, PO_LBX = PO_LBA + DEPTH * D, PO_LLAM = PO_LBX + DEPTH * D,
              PO_DLAM = PO_LLAM + DEPTH * D, PO_SUBG = PO_DLAM + DEPTH * 256, PO_RW = PO_SUBG + DEPTH * 128, PO_SUBGS = PO_RW + D * NEXP, PO_END = PO_SUBGS + DEPTH * 128;
static_assert((size_t)PO_END * 4 <= 512 * 1024, "parameter block");
__device__ __forceinline__ void p0_prologue(const Args& A, LAS unsigned char* lds, int vcu, int G) {
#define AIN(k) ((const void*)(const GAS void*)A.in[k])
    int tid_ = threadIdx.x; asm volatile("" : "+v"(tid_)); const int tid = tid_, lane = tid & 63, wave = __builtin_amdgcn_readfirstlane(tid >> 6); (void)tid; (void)lane; (void)wave;
    unsigned char* ws = (unsigned char*)(GAS unsigned char*)A.ws;
    LAS float* scr = (LAS float*)(lds + RING_OFF + wave * 16384);
    const int gw = vcu * NWAVES + wave, ngw = G * NWAVES;
    { struct Dec { const Args& A; unsigned char* ws;
          __device__ __forceinline__ TrItem operator()(int f) const {
              constexpr int I_IN = (D / 64) * (DIN / 32), I_SQ = (D / 64) * (D / 32), I_PP = (PLE / 64) * (D / 32), I_L = I_IN + 4 * I_SQ + I_PP, I_FF = (D / 64) * (FF / 32);
              if (f < DEPTH * I_L) { const int l = f / I_L; int r = f - l * I_L; unsigned char* wl = ws + WS_WSMALL + (size_t)l * WL_STRIDE;
                  if (r < I_IN) return tr_item<1>((const float*)AIN(I_WIN) + (size_t)l * D * DIN, D, DIN, (bf16*)(wl + WL_WIN), 0, r); r -= I_IN;
                  if (r < I_SQ) return tr_item<0>((const float*)AIN(I_WPA) + (size_t)l * D * D, D, D, (bf16*)(wl + WL_WAB), 0, r); r -= I_SQ;
                  if (r < I_SQ) return tr_item<0>((const float*)AIN(I_WPB) + (size_t)l * D * D, D, D, (bf16*)(wl + WL_WAB), D, r); r -= I_SQ;
                  if (r < I_SQ) return tr_item<0>((const float*)AIN(I_WOUT) + (size_t)l * D * D, D, D, (bf16*)(wl + WL_WO), 0, r); r -= I_SQ;
                  if (r < I_SQ) return tr_item<0>((const float*)AIN(I_PWG) + (size_t)l * D * D, D, D, (bf16*)(wl + WL_WPG), 0, r); r -= I_SQ;
                  return tr_item<0>((const float*)AIN(I_PWP) + (size_t)l * PLE * D, PLE, D, (bf16*)(wl + WL_WPP), 0, r); }
              int r = f - DEPTH * I_L;
              if (r < I_FF) return tr_item<2>((const float*)AIN(I_FG), D, FF, (bf16*)(ws + WS_WGU), 0, r); r -= I_FF;
              if (r < I_FF) return tr_item<3>((const float*)AIN(I_FU), D, FF, (bf16*)(ws + WS_WGU), 0, r); r -= I_FF;
              return tr_item<0>((const float*)AIN(I_FD), FF, D, (bf16*)(ws + WS_WD), 0, r); } };
      constexpr int NIT = DEPTH * ((D / 64) * (DIN / 32) + 4 * (D / 64) * (D / 32) + (PLE / 64) * (D / 32)) + 2 * (D / 64) * (FF / 32) + (FF / 64) * (D / 32);
      const Dec dec{A, ws}; tr_run<true>(dec, NIT, scr, lane, gw, ngw); }
    const int gt = gw * 64 + lane, ngt = ngw * 64;
    { const int* pos = (const int*)AIN(I_POS); float* pf = (float*)(ws + WS_COS); for (int i = gt; i < T; i += ngt) pf[i] = (float)pos[i]; }
    { const f32x4* p = (const f32x4*)AIN(I_P); u32x2* pb = (u32x2*)(ws + WS_PB);
      for (int i = gt; i < DEPTH * T * PLE / 4; i += ngt) pb[i] = f_to_bf4(p[i]); }
    { bf16* lw = (bf16*)(ws + WS_LRUW);
      for (int i = gt; i < DEPTH * 16 * 2 * 4096; i += ngt) { const int c = i & 63, d = (i >> 6) & 63, g = (i >> 12) & 1, n = (i >> 13) & 15, l = i >> 17;
          const float* src = (const float*)AIN(g ? I_LWX : I_LWA); lw[i] = (bf16)f2bf(src[((size_t)(l * 16 + n) * 64 + c) * 64 + d]); } }
    { const float* g0 = (const float*)AIN(I_NORMG);
      for (int m = gw; m < T; m += ngw) { const f32x4* xr = (const f32x4*)((const float*)AIN(I_X) + (size_t)m * D); f32x4 v[4]; float s = 0.f;
#pragma unroll
          for (int j = 0; j < 4; ++j) { v[j] = xr[lane + 64 * j]; s += dot4(v[j], v[j]); }
          const float rs = rsqrtf(wave_sum(s) * (1.f / D) + EPS);
          float mx = 0.f;
#pragma unroll
          for (int j = 0; j < 4; ++j) { ((u32x2*)(ws + WS_XR + (size_t)m * D * 2))[lane + 64 * j] = f_to_bf4(v[j]); v[j] = v[j] * rs * ((const f32x4*)g0)[lane + 64 * j]; mx = fmaxf(mx, amax4(v[j])); }
          mx = wave_max(mx); const float kq = 127.f / fmaxf(mx, 1e-30f);
#pragma unroll
          for (int j = 0; j < 4; ++j) ((unsigned*)(ws + WS_H + (size_t)m * D))[lane + 64 * j] = q4i8(v[j], kq);
          if (lane == 0) ((float*)(ws + WS_SA))[m] = mx * (1.f / 127.f); } }
    { float* par = (float*)(ws + WS_PAR);
      const int srcs[9] = {I_NORMG, I_CONVW, I_CONVB, I_LBA, I_LBX, I_LLAM, I_DLAM, I_SUBG, I_RW};
      const int offs[10] = {PO_NORMG, PO_CONVW, PO_CONVB, PO_LBA, PO_LBX, PO_LLAM, PO_DLAM, PO_SUBG, PO_RW, PO_SUBGS};
#pragma unroll
      for (int k = 0; k < 9; ++k) { const float* src = (const float*)AIN(srcs[k]); const int n = offs[k + 1] - offs[k];
          for (int i = gt; i < n; i += ngt) par[offs[k] + i] = src[i]; }
      for (int i = gt; i < DEPTH * 128; i += ngt) par[PO_SUBGS + i] = ((const float*)AIN(I_SUBG))[i] * (1.0f - (0.8f - 0.6f * expf(-0.3f * (float)(i >> 7)))); }
}

__device__ __forceinline__ void p0_quant_weights(unsigned char* ws, int vcu, int G) {
    int tid_ = threadIdx.x; asm volatile("" : "+v"(tid_)); const int lane = tid_ & 63, wave = __builtin_amdgcn_readfirstlane(tid_ >> 6);
    const int gw = vcu * NWAVES + wave, ngw = G * NWAVES;
    for (int r = gw; r < 3 * DIN; r += ngw) { const int which = r / DIN, n = r - which * DIN;
        const bf16* src = which < 2 ? (const bf16*)(ws + WS_WSMALL + (size_t)which * WL_STRIDE + WL_WIN) + (size_t)n * D : (const bf16*)(ws + WS_WGU) + (size_t)n * D;
        unsigned char* dst = (which < 2 ? ws + WS_WIN8 + (size_t)which * DIN * D : ws + WS_WGU8) + (size_t)n * D;
        wq_row(src, dst, (float*)(ws + WS_SB) + r, lane); }
}

__device__ __forceinline__ unsigned short bf1(float v) { unsigned r; asm("v_cvt_pk_bf16_f32 %0, %1, %1" : "=v"(r) : "v"(v)); return (unsigned short)r; }
__device__ __forceinline__ float sigm_fast(float v) { return __builtin_amdgcn_rcpf(1.0f + __builtin_amdgcn_exp2f(-1.4426950408889634f * v)); }
__device__ __forceinline__ void lru_pass1(unsigned char* ws, LAS unsigned char* lds, int layer, int chunk) {
    int tid_ = threadIdx.x; asm volatile("" : "+v"(tid_)); const int tid = tid_, lane = tid & 63, wave = __builtin_amdgcn_readfirstlane(tid >> 6); (void)tid; (void)lane; (void)wave;
    typedef float f32x16 __attribute__((ext_vector_type(16)));
    const float* par = (const float*)(ws + WS_PAR);
    const int b = chunk >> 6, t0 = (chunk & 63) * 64; const size_t g0 = (size_t)b * SEQ + t0;
    LAS unsigned char* wl = lds + RING_OFF + wave * 16384;
    LAS bf16* U = (LAS bf16*)wl;
    LAS float* Gs = (LAS float*)(wl + 4608);
    const bf16* RIN = (const bf16*)(ws + WS_RIN); bf16* HL = (bf16*)(ws + WS_HL); bf16* LP = (bf16*)(ws + WS_LP);
    const int r32 = lane & 31, hi = lane >> 5;
    float h = 0.f, lpc = 0.f, xm3 = 0.f, xm2 = 0.f, xm1 = 0.f;
    v4u pre[4];
#define LRU_LOAD(nb_, tg_) do { _Pragma("unroll") for (int i = 0; i < 4; ++i) pre[i] = *(const v4u*)(RIN + (g0 + (tg_) * 32 + (lane >> 3) + 8 * i) * D + 64 * (2 * wave + (nb_)) + 8 * (lane & 7)); } while (0)
    LRU_LOAD(0, 0);
    for (int it = 0; it < 4; ++it) { const int nb = it >> 1, tg = it & 1;
        const int n = 2 * wave + nb, ch = 64 * n + lane;
        const float* cw = par + PO_CONVW + (size_t)layer * 4 * D;
        const float cw0 = cw[ch], cw1 = cw[D + ch], cw2 = cw[2 * D + ch], cw3 = cw[3 * D + ch], cb = par[PO_CONVB + layer * D + ch];
        const float ba = par[PO_LBA + layer * D + ch], bx = par[PO_LBX + layer * D + ch];
        const float lam = par[PO_LLAM + layer * D + ch];
        const float c8sp = -8.0f * 1.4426950408889634f * log1pf(__expf(-lam));
        const bf16* lw = (const bf16*)(ws + WS_LRUW) + (size_t)((layer * 16 + n) * 2) * 4096;
        if (tg == 0) { h = 0.f; lpc = 0.f; xm3 = 0.f; xm2 = 0.f; xm1 = 0.f;
            if (t0 > 0) { xm3 = bf2f(RIN[(g0 - 3) * D + ch]); xm2 = bf2f(RIN[(g0 - 2) * D + ch]); xm1 = bf2f(RIN[(g0 - 1) * D + ch]); } }
        const size_t gr = g0 + tg * 32;
        bf16x8 wf[2][2][4];
#pragma unroll
        for (int g = 0; g < 2; ++g)
#pragma unroll
            for (int dh = 0; dh < 2; ++dh)
#pragma unroll
                for (int ks = 0; ks < 4; ++ks) wf[g][dh][ks] = *(const bf16x8*)(lw + (size_t)g * 4096 + (32 * dh + r32) * 64 + 16 * ks + 8 * hi);
#pragma unroll
        for (int i = 0; i < 4; ++i) *(LAS v4u*)(U + ((lane >> 3) + 8 * i) * 72 + 8 * (lane & 7)) = pre[i];
        LDS_WAIT();
        if (it < 3) LRU_LOAD((it + 1) >> 1, (it + 1) & 1);
        float u[32];
#pragma unroll
        for (int t = 0; t < 32; ++t) { const float x = bf2f(U[t * 72 + lane]); u[t] = cb + cw0 * xm3 + cw1 * xm2 + cw2 * xm1 + cw3 * x; xm3 = xm2; xm2 = xm1; xm1 = x; U[t * 72 + lane] = bf1(u[t]); }
        LDS_WAIT();
        float gp[2][32];
#pragma unroll
        for (int g = 0; g < 2; ++g) {
            f32x16 c0 = {}, c1 = {};
#pragma unroll
            for (int ks = 0; ks < 4; ++ks) { const bf16x8 a = *(const LAS bf16x8*)(U + r32 * 72 + 16 * ks + 8 * hi);
                c0 = __builtin_amdgcn_mfma_f32_32x32x16_bf16(a, wf[g][0][ks], c0, 0, 0, 0); c1 = __builtin_amdgcn_mfma_f32_32x32x16_bf16(a, wf[g][1][ks], c1, 0, 0, 0); }
#pragma unroll
            for (int r = 0; r < 16; ++r) { const int row = (r & 3) + 8 * (r >> 2) + 4 * hi; Gs[row * 64 + r32] = c0[r]; Gs[row * 64 + 32 + r32] = c1[r]; }
            LDS_WAIT();
#pragma unroll
            for (int t = 0; t < 32; ++t) gp[g][t] = Gs[t * 64 + lane];
            LDS_WAIT();
        }
        LAS bf16* S2 = (LAS bf16*)Gs;
#pragma unroll
        for (int t = 0; t < 32; ++t) { const float rr = sigm_fast(gp[0][t] + ba), ii = sigm_fast(gp[1][t] + bx), la = c8sp * rr, a = __builtin_amdgcn_exp2f(la);
            const float bb = __builtin_amdgcn_sqrtf(fmaxf(0.f, 1.0f - a * a)) * ii * u[t];
            h = a * h + bb; lpc += la; U[t * 72 + lane] = bf1(h); S2[t * 72 + lane] = bf1(lpc); }
        LDS_WAIT();
#pragma unroll
        for (int i = 0; i < 4; ++i) { const int row = i * 8 + (lane >> 3), cc = lane & 7;
            const v4u a = *(const LAS v4u*)(U + row * 72 + cc * 8), c = *(const LAS v4u*)(S2 + row * 72 + cc * 8);
            *(v4u*)(HL + (gr + row) * D + 64 * n + cc * 8) = a; *(v4u*)(LP + (gr + row) * D + 64 * n + cc * 8) = c; }
        LDS_WAIT();
        if (tg == 1) { float* sum = (float*)(ws + WS_SUM) + (size_t)chunk * 2 * D; sum[ch] = lpc; sum[D + ch] = h; }
    }
#undef LRU_LOAD
}

__device__ __forceinline__ void tp_mix(unsigned char* ws, LAS unsigned char* lds, int layer, int chunk) {
    int tid_ = threadIdx.x; asm volatile("" : "+v"(tid_)); const int tid = tid_, lane = tid & 63, wave = __builtin_amdgcn_readfirstlane(tid >> 6); (void)tid; (void)lane; (void)wave;
    const float* par = (const float*)(ws + WS_PAR);
    LAS float* carry = (LAS float*)(lds + RING_OFF);
    { const float* sum = (const float*)(ws + WS_SUM);
      for (int ch = tid; ch < D; ch += NWAVES * 64) { float c = 0.f;
          const float* sp = sum + (size_t)(chunk & ~63) * 2 * D + ch; const int n = chunk & 63; int cc = 0;
          for (; cc + 8 <= n; cc += 8) { float la[8], bb[8];
#pragma unroll
              for (int k = 0; k < 8; ++k) { la[k] = sp[(size_t)(cc + k) * 2 * D]; bb[k] = sp[(size_t)(cc + k) * 2 * D + D]; }
#pragma unroll
              for (int k = 0; k < 8; ++k) c = __builtin_amdgcn_exp2f(la[k]) * c + bb[k]; }
          for (; cc < n; ++cc) c = __builtin_amdgcn_exp2f(sp[(size_t)cc * 2 * D]) * c + sp[(size_t)cc * 2 * D + D];
          carry[ch] = c; } }
    __syncthreads();
    const int b = chunk >> 6, t0 = (chunk & 63) * 64; const size_t g0 = (size_t)b * SEQ + t0;
    for (int rr = wave; rr < 64; rr += 2 * NWAVES) {
        v4u hl[2][2], lp[2][2], gg[2][2];
#pragma unroll
        for (int q = 0; q < 2; ++q) { const size_t ro = (g0 + rr + q * NWAVES) * D * 2;
#pragma unroll
            for (int j = 0; j < 2; ++j) { hl[q][j] = ((const v4u*)(ws + WS_HL + ro))[lane + 64 * j]; lp[q][j] = ((const v4u*)(ws + WS_LP + ro))[lane + 64 * j]; gg[q][j] = ((const v4u*)(ws + WS_GG + ro))[lane + 64 * j]; } }
#pragma unroll
        for (int q = 0; q < 2; ++q) { const size_t ro = (g0 + rr + q * NWAVES) * D * 2;
#pragma unroll
            for (int j = 0; j < 2; ++j) { const LAS f32x4* c4 = (const LAS f32x4*)carry + 128 * j + 2 * lane;
                const f32x4 l0 = bfl4(lp[q][j]), l1 = bfh4(lp[q][j]);
                const f32x4 e0 = {__builtin_amdgcn_exp2f(l0.x), __builtin_amdgcn_exp2f(l0.y), __builtin_amdgcn_exp2f(l0.z), __builtin_amdgcn_exp2f(l0.w)}, e1 = {__builtin_amdgcn_exp2f(l1.x), __builtin_amdgcn_exp2f(l1.y), __builtin_amdgcn_exp2f(l1.z), __builtin_amdgcn_exp2f(l1.w)};
                ((v4u*)(ws + WS_YA + ro))[lane + 64 * j] = pk8bf((bfl4(hl[q][j]) + e0 * c4[0]) * bfl4(gg[q][j]), (bfh4(hl[q][j]) + e1 * c4[1]) * bfh4(gg[q][j])); } }
    }
    __syncthreads();
}

template <bool DRY> __device__ __forceinline__ void route_row(unsigned char* ws, const LAS float* rwT, const f32x4 (&hn)[2][2], int m, int lane) {
    gu32* ctl = (gu32*)(ws + WS_CTL);
    float lg[NEXP];
#pragma unroll
    for (int e = 0; e < NEXP; ++e) { float s = 0.f;
#pragma unroll
        for (int j = 0; j < 2; ++j) { const LAS f32x4* r4 = (const LAS f32x4*)(rwT + e * D + 512 * j) + 2 * lane; s += dot4(hn[j][0], r4[0]) + dot4(hn[j][1], r4[1]); }
        lg[e] = wave_sum(s); }
    int e0 = 0; float v0 = lg[0];
#pragma unroll
    for (int e = 1; e < NEXP; ++e) if (lg[e] > v0) { v0 = lg[e]; e0 = e; }
    int e1 = -1; float v1 = -INFINITY;
#pragma unroll
    for (int e = 0; e < NEXP; ++e) if (e != e0 && lg[e] > v1) { v1 = lg[e]; e1 = e; }
    const float w1 = 1.0f / (1.0f + __expf(v0 - v1)), w0 = 1.0f - w1;
    if (DRY) { if (w0 + w1 + (float)e0 + (float)e1 == -12345.f) ((float*)(ws + WS_BIG))[m] = w0; }
    if (lane == 0 && !DRY) { const int p0 = (int)__hip_atomic_fetch_add(ctl + CW_CNT + 64 * e0, 1u, RLX_AGENT), p1 = (int)__hip_atomic_fetch_add(ctl + CW_CNT + 64 * e1, 1u, RLX_AGENT);
        int* lst = (int*)(ws + WS_LIST); lst[e0 * T + p0] = m; lst[e1 * T + p1] = m;
        int* ti = (int*)(ws + WS_TOK) + (size_t)m * 8; ti[0] = e0; ti[1] = p0; ti[2] = e1; ti[3] = p1; ti[4] = __float_as_int(w0); ti[5] = __float_as_int(w1); }
}
template <int SRC, bool ROUTE, bool DRY = false, bool H8 = false, bool FINAL = false, bool HQ = false> __device__ __forceinline__ void tp_post_pre(unsigned char* ws, float* xres, LAS unsigned char* lds, const float* gpost, const float* gpre, int vcu, int G) {
    int tid_ = threadIdx.x; asm volatile("" : "+v"(tid_)); const int tid = tid_, lane = tid & 63, wave = __builtin_amdgcn_readfirstlane(tid >> 6); (void)tid; (void)lane; (void)wave;
    gu32* ctl = (gu32*)(ws + WS_CTL);
    LAS float* rwT = (LAS float*)(lds + RING_OFF);
    int ps[NEXP];
    if (ROUTE) { const float* rw = (const float*)(ws + WS_PAR) + PO_RW; for (int i = tid; i < D * NEXP; i += NWAVES * 64) rwT[(i & 7) * D + (i >> 3)] = rw[i]; __syncthreads(); }
    if (SRC == 1) { int acc = 0;
#pragma unroll
        for (int e = 0; e < NEXP; ++e) { ps[e] = acc; acc += ((int)__hip_atomic_load(ctl + CW_CNT + 64 * e, RLX_AGENT) + 255) >> 8; } }
    const int gw = vcu * NWAVES + wave, ngw = G * NWAVES;
    f32x4 gp[2][2], gq[2][2];
#pragma unroll
    for (int j = 0; j < 2; ++j)
#pragma unroll
        for (int h = 0; h < 2; ++h) { gp[j][h] = ((const f32x4*)gpost)[128 * j + 2 * lane + h]; gq[j][h] = gpre ? ((const f32x4*)gpre)[128 * j + 2 * lane + h] : (f32x4){0.f, 0.f, 0.f, 0.f}; }
    unsigned char* xo = ws + (DRY ? WS_BIG : WS_XR); unsigned char* ho = ws + (DRY ? WS_BIG + 2 * SLOT : WS_H);
    constexpr int NR = (ROUTE || SRC == 1) ? 2 : 8;
    const bool xl = (ngw == 2048);
#define TP_ROW_OF(k) (xl ? ((gw >> 8) << 11) + (gw & 255) + ((k) << 8) : gw + (k) * ngw)
    for (int k0 = 0; TP_ROW_OF(k0) < T && k0 * ngw < T; k0 += NR) {
        v4u fa[NR][2], fc[NR][2], xr[NR][2]; float w0[NR], w1[NR];
#pragma unroll
        for (int r = 0; r < NR; ++r) { const int m = TP_ROW_OF(k0 + r); if ((k0 + r) * ngw < T && m < T) {
            if (SRC == 0) { const v4u* p = (const v4u*)(ws + WS_F + (size_t)m * D * 2) + lane; fa[r][0] = p[0]; fa[r][1] = p[64]; }
            else { const int* ti = (const int*)(ws + WS_TOK) + (size_t)m * 8; const int e0 = ti[0], p0 = ti[1], e1 = ti[2], p1 = ti[3]; w0[r] = __int_as_float(ti[4]); w1[r] = __int_as_float(ti[5]); int s0 = 0, s1 = 0;
#pragma unroll
                for (int e = 0; e < NEXP; ++e) { if (e == e0) s0 = ps[e]; if (e == e1) s1 = ps[e]; }
                const v4u* a = (const v4u*)(ws + WS_OE + ((size_t)s0 * 256 + p0) * D * 2) + lane; const v4u* c = (const v4u*)(ws + WS_OE + ((size_t)s1 * 256 + p1) * D * 2) + lane;
                fa[r][0] = a[0]; fa[r][1] = a[64]; fc[r][0] = c[0]; fc[r][1] = c[64]; }
            const v4u* xp = (const v4u*)(ws + WS_XR + (size_t)m * D * 2) + lane; xr[r][0] = xp[0]; xr[r][1] = xp[64]; } }
#pragma unroll
        for (int r = 0; r < NR; ++r) { const int m = TP_ROW_OF(k0 + r); if ((k0 + r) * ngw < T && m < T) {
            f32x4 f[2][2], xv[2][2]; float s = 0.f;
#pragma unroll
            for (int j = 0; j < 2; ++j) { f[j][0] = bfl4(fa[r][j]); f[j][1] = bfh4(fa[r][j]);
                if (SRC == 1) { f[j][0] = f[j][0] * w0[r] + bfl4(fc[r][j]) * w1[r]; f[j][1] = f[j][1] * w0[r] + bfh4(fc[r][j]) * w1[r]; }
                s += dot4(f[j][0], f[j][0]) + dot4(f[j][1], f[j][1]); }
            const float rs = rsqrtf(wave_sum(s) * (1.f / D) + EPS); float s2 = 0.f;
#pragma unroll
            for (int j = 0; j < 2; ++j) { xv[j][0] = bfl4(xr[r][j]) + f[j][0] * rs * gp[j][0]; xv[j][1] = bfh4(xr[r][j]) + f[j][1] * rs * gp[j][1];
                if (FINAL && !DRY) { f32x4* o = (f32x4*)(xres + (size_t)m * D) + 128 * j + 2 * lane; o[0] = xv[j][0]; o[1] = xv[j][1]; }
                else ((v4u*)(xo + (size_t)m * D * 2))[lane + 64 * j] = pk8bf(xv[j][0], xv[j][1]);
                s2 += dot4(xv[j][0], xv[j][0]) + dot4(xv[j][1], xv[j][1]); }
            if (gpre) { const float rs2 = rsqrtf(wave_sum(s2) * (1.f / D) + EPS);
#pragma unroll
                for (int j = 0; j < 2; ++j) { xv[j][0] = xv[j][0] * rs2 * gq[j][0]; xv[j][1] = xv[j][1] * rs2 * gq[j][1];
                    if (H8) { u32x2 w; w.x = pk4f8(xv[j][0].x * SC_H, xv[j][0].y * SC_H, xv[j][0].z * SC_H, xv[j][0].w * SC_H); w.y = pk4f8(xv[j][1].x * SC_H, xv[j][1].y * SC_H, xv[j][1].z * SC_H, xv[j][1].w * SC_H);
                        ((u32x2*)(ho + (size_t)m * D))[lane + 64 * j] = w; }
                    else if (!HQ) ((v4u*)(ho + (size_t)m * D * 2))[lane + 64 * j] = pk8bf(xv[j][0], xv[j][1]); }
                if (HQ) { const float mx = wave_max(fmaxf(fmaxf(amax4(xv[0][0]), amax4(xv[0][1])), fmaxf(amax4(xv[1][0]), amax4(xv[1][1])))); const float kq = 127.f / fmaxf(mx, 1e-30f);
#pragma unroll
                    for (int j = 0; j < 2; ++j) { u32x2 w; w.x = q4i8(xv[j][0], kq); w.y = q4i8(xv[j][1], kq); ((u32x2*)(ho + (size_t)m * D))[lane + 64 * j] = w; }
                    if (lane == 0 && !DRY) ((float*)(ws + WS_SA))[m] = mx * (1.f / 127.f); }
                if (ROUTE) route_row<DRY>(ws, rwT, xv, m, lane); } } }
    }
#undef TP_ROW_OF
    if (ROUTE) __syncthreads();
}

__device__ __forceinline__ void pm0_moe_setup(unsigned char* ws, const float* mg, const float* mu, const float* md, LAS unsigned char* lds, int vcu, int G) {
    int tid_ = threadIdx.x; asm volatile("" : "+v"(tid_)); const int tid = tid_, lane = tid & 63, wave = __builtin_amdgcn_readfirstlane(tid >> 6); (void)tid; (void)lane; (void)wave;
    gu32* ctl = (gu32*)(ws + WS_CTL);
    LAS float* scr = (LAS float*)(lds + RING_OFF + wave * 16384);
    const int gw = vcu * NWAVES + wave, ngw = G * NWAVES;
    int cs[NEXP + 1], ps[NEXP]; { int a = 0, p = 0;
#pragma unroll
        for (int e = 0; e < NEXP; ++e) { const int c = (int)__hip_atomic_load(ctl + CW_CNT + 64 * e, RLX_AGENT); cs[e] = a; ps[e] = p; a += c; p += (c + 255) >> 8; } cs[NEXP] = a; }
    const int* lst = (const int*)(ws + WS_LIST);
    for (int i = gw; i < cs[NEXP]; i += ngw) { int e = 0, base = 0, pst = 0;
#pragma unroll
        for (int k = 0; k < NEXP; ++k) if (i >= cs[k]) { e = k; base = cs[k]; pst = ps[k]; }
        const int pos = i - base, tok = lst[e * T + pos];
        ((v4u*)(ws + WS_HG + ((size_t)pst * 256 + pos) * D))[lane] = ((const v4u*)(ws + WS_H + (size_t)tok * D))[lane]; }
    { struct Dec { const float* mg; const float* mu; const float* md; unsigned char* ws;
          __device__ __forceinline__ TrItem operator()(int f) const {
              constexpr int I_FF = (D / 64) * (FF / 32);
              const int e = f / (3 * I_FF); int r = f - e * 3 * I_FF;
              if (r < I_FF) return tr_item<2>(mg + (size_t)e * D * FF, D, FF, (bf16*)(ws + WS_WMGU), e * 2 * FF, r, SC_WGU); r -= I_FF;
              if (r < I_FF) return tr_item<3>(mu + (size_t)e * D * FF, D, FF, (bf16*)(ws + WS_WMGU), e * 2 * FF, r, SC_WGU); r -= I_FF;
              return tr_item<0>(md + (size_t)e * FF * D, FF, D, (bf16*)(ws + WS_WMD), e * D, r, SC_WD); } };
      const Dec dec{mg, mu, md, ws}; tr_run<true>(dec, NEXP * 3 * (D / 64) * (FF / 32), scr, lane, gw, ngw); }
}
constexpr int NPH_L = 14, NPHASES = 1 + DEPTH * NPH_L;
__host__ __device__ constexpr bool phase_exists(int ph) { return ph == 0 || !((((ph - 1) % NPH_L) == 9 || ((ph - 1) % NPH_L) == 10) || (((ph - 1) / NPH_L) % 2 == 0 && ((ph - 1) % NPH_L) == 6)); }

__global__ void __launch_bounds__(NWAVES * 64, 2) mk_fwd(Args args) {
    extern __shared__ __attribute__((aligned(16))) unsigned char lds_raw[];
    LAS unsigned char* lds = (LAS unsigned char*)lds_raw;
    volatile LAS unsigned* MISC = (volatile LAS unsigned*)(lds + MISC_OFF);
    const int tid = threadIdx.x;
    const int Gk = gridDim.x; const int bxk = blockIdx.x; const int vcuk = (Gk % 8 == 0) ? (bxk % 8) * (Gk / 8) + bxk / 8 : bxk;
    for (int u = tid; u < (LDS_BYTES - LDSCTL_OFF) / 4; u += NWAVES * 64) ((LAS unsigned*)(lds + LDSCTL_OFF))[u] = 0u;
    __syncthreads();
    XcdBarrier bar; bar.bar = (unsigned*)(args.ws + WS_CTL) + CW_BAR; bar.x = 0; bar.st = nullptr;
    if (!MK_MULTI) bar = xcd_barrier_post((unsigned*)(args.ws + WS_CTL) + CW_BAR, MISC + 8);
    const int lo = args.ph_lo, hi = args.ph_hi;
#ifndef DIS
#define DIS 0
#endif
#ifndef REP
#define REP 0
#endif
#define EN(b) (!((DIS >> (b)) & 1))
#define IN(k) (lo <= (k) && (k) < hi)
#define PH_WS int z_ = 0, G = Gk, bx = bxk, vcu = vcuk; asm volatile("" : "+s"(z_), "+s"(G), "+s"(bx), "+s"(vcu)); unsigned char* ws = (unsigned char*)((GAS unsigned char*)args.ws + z_); (void)ws; (void)G; (void)bx; (void)vcu
#define XOUT ((float*)((GAS float*)args.out + z_))
#define GIN(k) ((const float*)((const GAS float*)args.in[k] + z_))
#define SEAM(k) do { if ((k) + 1 < hi) { if (MK_MULTI) { if (tid == 0) __hip_atomic_store((gu32*)(ws + WS_CTL) + CW_TMO, 0xBADBA0u, RLX_AGENT); } else xcd_barrier(bar); } } while (0)

    if (EN(0) && IN(0)) { PH_WS;
#if (REP >> 0) & 1
        { p0_prologue(args, lds, vcu, G); }
        __syncthreads();
#endif
        p0_prologue(args, lds, vcu, G);
        xcd_barrier(bar);
        p0_quant_weights(ws, vcu, G);
        SEAM(0); }

    for (int l = 0; l < DEPTH; ++l) {
        const int pb = 1 + NPH_L * l;
        if (EN(1) && IN(pb + 0)) { PH_WS;
#if (REP >> 1) & 1
            { unsigned char* wl = ws + WS_WSMALL + (size_t)l * WL_STRIDE;
            pg8::Gemm g{(const pg8::bf16_t*)(ws + WS_H), (const pg8::bf16_t*)(ws + WS_WIN8 + (size_t)l * DIN * D), T, DIN, D / 2}; pg8::StaticOrder S; S.init(T, DIN, G, bx); (void)wl;
            pg8::EpiInProjq E{(pg8::bf16_t*)(ws + WS_BIG), SLOT / 2, (const float*)(ws + WS_COS), attn_body::C2, (const float*)(ws + WS_SA), (const float*)(ws + WS_SB) + (size_t)l * DIN};
#ifdef STAGGER_US
            if (bx & 1) { const unsigned long long t0_ = __builtin_amdgcn_s_memrealtime(); while (__builtin_amdgcn_s_memrealtime() - t0_ < (unsigned long long)(STAGGER_US * 100)) __builtin_amdgcn_s_sleep(8); }
#endif
            pg8::gemm_phase<pg8::EpiInProjq, pg8::StaticOrder, true, true, 2>(lds + RING_OFF, g, S, E);
            }
            __syncthreads();
#endif
            unsigned char* wl = ws + WS_WSMALL + (size_t)l * WL_STRIDE;
            pg8::Gemm g{(const pg8::bf16_t*)(ws + WS_H), (const pg8::bf16_t*)(ws + WS_WIN8 + (size_t)l * DIN * D), T, DIN, D / 2}; pg8::StaticOrder S; S.init(T, DIN, G, bx); (void)wl;
            pg8::EpiInProjq E{(pg8::bf16_t*)(ws + WS_BIG), SLOT / 2, (const float*)(ws + WS_COS), attn_body::C2, (const float*)(ws + WS_SA), (const float*)(ws + WS_SB) + (size_t)l * DIN};
#ifdef STAGGER_US
            if (bx & 1) { const unsigned long long t0_ = __builtin_amdgcn_s_memrealtime(); while (__builtin_amdgcn_s_memrealtime() - t0_ < (unsigned long long)(STAGGER_US * 100)) __builtin_amdgcn_s_sleep(8); }
#endif
            pg8::gemm_phase<pg8::EpiInProjq, pg8::StaticOrder, true, true, 2>(lds + RING_OFF, g, S, E);

            SEAM(pb + 0);
        }
        if (EN(2) && IN(pb + 1)) { PH_WS;
#if (REP >> 2) & 1
            {
#if !defined(NO_LRU) && !defined(DUP_NO_LRU)
            for (int c = vcu; c < 256; c += G) lru_pass1(ws, lds, l, c);
            __syncthreads();
#endif
#if !defined(NO_ATT) && !defined(DUP_NO_ATT)
            const attn_body::AttnTensors AT{(const attn_body::bf16*)(ws + WS_Q), (const attn_body::bf16*)(ws + WS_K), (const attn_body::bf16*)(ws + WS_V), (attn_body::bf16*)(ws + WS_O2), (attn_body::bf16*)(ws + WS_YB)};
            { const float* par = (const float*)(ws + WS_PAR); const float* dl = par + PO_DLAM + l * 256; int t_ = threadIdx.x; asm volatile("" : "+v"(t_)); const int ln_ = t_ & 63;
              const float lamv = expf(wave_sum(dl[ln_] * dl[64 + ln_])) - expf(wave_sum(dl[128 + ln_] * dl[192 + ln_])) + (0.8f - 0.6f * expf(-0.3f * (float)l));
              attn_body::attn_phase<8>((char*)lds_raw + RING_OFF, AT, lamv, par + PO_SUBGS + l * 128, vcu, G); }
#endif
            }
            __syncthreads();
#endif

#ifndef NO_LRU
            for (int c = vcu; c < 256; c += G) lru_pass1(ws, lds, l, c);
            __syncthreads();
#endif
#ifndef NO_ATT
            const attn_body::AttnTensors AT{(const attn_body::bf16*)(ws + WS_Q), (const attn_body::bf16*)(ws + WS_K), (const attn_body::bf16*)(ws + WS_V), (attn_body::bf16*)(ws + WS_O2), (attn_body::bf16*)(ws + WS_YB)};
            { const float* par = (const float*)(ws + WS_PAR); const float* dl = par + PO_DLAM + l * 256; int t_ = threadIdx.x; asm volatile("" : "+v"(t_)); const int ln_ = t_ & 63;
              const float lamv = expf(wave_sum(dl[ln_] * dl[64 + ln_])) - expf(wave_sum(dl[128 + ln_] * dl[192 + ln_])) + (0.8f - 0.6f * expf(-0.3f * (float)l));
              attn_body::attn_phase<8>((char*)lds_raw + RING_OFF, AT, lamv, par + PO_SUBGS + l * 128, vcu, G); }
#endif

            SEAM(pb + 1);
        }
        if (EN(3) && IN(pb + 2)) { PH_WS;
#if (REP >> 3) & 1
            { for (int c = vcu; c < 256; c += G) tp_mix(ws, lds, l, c); }
            __syncthreads();
#endif
            for (int c = vcu; c < 256; c += G) tp_mix(ws, lds, l, c);
            SEAM(pb + 2); }
        if (EN(4) && IN(pb + 3)) { PH_WS;
#if (REP >> 4) & 1
            { unsigned char* wl = ws + WS_WSMALL + (size_t)l * WL_STRIDE;
            pg8::Gemm g{(const pg8::bf16_t*)(ws + WS_YA), (const pg8::bf16_t*)(wl + WL_WAB), T, D, D}; pg8::PairOrder S; S.base.init(T, D, G, bx);
            pg8::EpiMerge E{(const pg8::bf16_t*)(ws + WS_SGA), (const pg8::bf16_t*)(ws + WS_SGB), (pg8::bf16_t*)(ws + WS_T1), (pg8::bf16_t*)(ws + WS_MERGED), NPAN};
            pg8::gemm_phase<pg8::EpiMerge, pg8::PairOrder, true, true>(lds + RING_OFF, g, S, E);
            }
            __syncthreads();
#endif
            unsigned char* wl = ws + WS_WSMALL + (size_t)l * WL_STRIDE;
            pg8::Gemm g{(const pg8::bf16_t*)(ws + WS_YA), (const pg8::bf16_t*)(wl + WL_WAB), T, D, D}; pg8::PairOrder S; S.base.init(T, D, G, bx);
            pg8::EpiMerge E{(const pg8::bf16_t*)(ws + WS_SGA), (const pg8::bf16_t*)(ws + WS_SGB), (pg8::bf16_t*)(ws + WS_T1), (pg8::bf16_t*)(ws + WS_MERGED), NPAN};
            pg8::gemm_phase<pg8::EpiMerge, pg8::PairOrder, true, true>(lds + RING_OFF, g, S, E);

            SEAM(pb + 3);
        }
        if (EN(5) && IN(pb + 4)) { PH_WS;
#if (REP >> 5) & 1
            { unsigned char* wl = ws + WS_WSMALL + (size_t)l * WL_STRIDE;
            pg8::Gemm g{(const pg8::bf16_t*)(ws + WS_MERGED), (const pg8::bf16_t*)(wl + WL_WO), T, D, D}; pg8::StaticOrder S; S.init(T, D, G, bx);
            pg8::EpiPlainBf16 E{(pg8::bf16_t*)(ws + WS_F), D, 3};
            pg8::gemm_phase<pg8::EpiPlainBf16, pg8::StaticOrder, false, true>(lds + RING_OFF, g, S, E);
            }
            __syncthreads();
#endif
            unsigned char* wl = ws + WS_WSMALL + (size_t)l * WL_STRIDE;
            pg8::Gemm g{(const pg8::bf16_t*)(ws + WS_MERGED), (const pg8::bf16_t*)(wl + WL_WO), T, D, D}; pg8::StaticOrder S; S.init(T, D, G, bx);
            pg8::EpiPlainBf16 E{(pg8::bf16_t*)(ws + WS_F), D, 3};
            pg8::gemm_phase<pg8::EpiPlainBf16, pg8::StaticOrder, false, true>(lds + RING_OFF, g, S, E);

            SEAM(pb + 4);
        }
        if (EN(6) && IN(pb + 5)) { PH_WS;
#if (REP >> 6) & 1
            { const float* ng = (const float*)(ws + WS_PAR) + PO_NORMG + (size_t)l * 6 * D;
            if (l & 1) tp_post_pre<0, true, true, true>(ws, XOUT, lds, ng + 1 * D, ng + 2 * D, vcu, G);
            else tp_post_pre<0, false, true, false, false, true>(ws, XOUT, lds, ng + 1 * D, ng + 2 * D, vcu, G);
            }
            __syncthreads();
#endif
            const float* ng = (const float*)(ws + WS_PAR) + PO_NORMG + (size_t)l * 6 * D;
            if (l & 1) tp_post_pre<0, true, false, true>(ws, XOUT, lds, ng + 1 * D, ng + 2 * D, vcu, G);
            else tp_post_pre<0, false, false, false, false, true>(ws, XOUT, lds, ng + 1 * D, ng + 2 * D, vcu, G);

            SEAM(pb + 5);
        }
        if (!(l & 1)) {
            if (EN(7) && IN(pb + 7)) { PH_WS;
#if (REP >> 7) & 1
                {
                pg8::Gemm g{(const pg8::bf16_t*)(ws + WS_H), (const pg8::bf16_t*)(ws + WS_WGU8), T, 2 * FF, D / 2}; pg8::StaticOrder S; S.init(T, 2 * FF, G, bx);
                pg8::EpiSwiGLUq E{(pg8::bf16_t*)(ws + WS_ACT), FF, (const float*)(ws + WS_SA), (const float*)(ws + WS_SB) + 2 * DIN};
#ifdef STAGGER_US
            if (bx & 1) { const unsigned long long t0_ = __builtin_amdgcn_s_memrealtime(); while (__builtin_amdgcn_s_memrealtime() - t0_ < (unsigned long long)(STAGGER_US * 100)) __builtin_amdgcn_s_sleep(8); }
#endif
                pg8::gemm_phase<pg8::EpiSwiGLUq, pg8::StaticOrder, true, true, 2>(lds + RING_OFF, g, S, E);
                }
                __syncthreads();
#endif

                pg8::Gemm g{(const pg8::bf16_t*)(ws + WS_H), (const pg8::bf16_t*)(ws + WS_WGU8), T, 2 * FF, D / 2}; pg8::StaticOrder S; S.init(T, 2 * FF, G, bx);
                pg8::EpiSwiGLUq E{(pg8::bf16_t*)(ws + WS_ACT), FF, (const float*)(ws + WS_SA), (const float*)(ws + WS_SB) + 2 * DIN};
#ifdef STAGGER_US
            if (bx & 1) { const unsigned long long t0_ = __builtin_amdgcn_s_memrealtime(); while (__builtin_amdgcn_s_memrealtime() - t0_ < (unsigned long long)(STAGGER_US * 100)) __builtin_amdgcn_s_sleep(8); }
#endif
                pg8::gemm_phase<pg8::EpiSwiGLUq, pg8::StaticOrder, true, true, 2>(lds + RING_OFF, g, S, E);

                SEAM(pb + 7);
            }
            if (EN(8) && IN(pb + 8)) { PH_WS;
#if (REP >> 8) & 1
                {
                pg8::Gemm g{(const pg8::bf16_t*)(ws + WS_ACT), (const pg8::bf16_t*)(ws + WS_WD), T, D, FF}; pg8::StaticOrder S; S.init(T, D, G, bx);
                pg8::EpiPlainBf16 E{(pg8::bf16_t*)(ws + WS_F), D, 3};
                pg8::gemm_phase<pg8::EpiPlainBf16, pg8::StaticOrder, false, true>(lds + RING_OFF, g, S, E);
                }
                __syncthreads();
#endif

                pg8::Gemm g{(const pg8::bf16_t*)(ws + WS_ACT), (const pg8::bf16_t*)(ws + WS_WD), T, D, FF}; pg8::StaticOrder S; S.init(T, D, G, bx);
                pg8::EpiPlainBf16 E{(pg8::bf16_t*)(ws + WS_F), D, 3};
                pg8::gemm_phase<pg8::EpiPlainBf16, pg8::StaticOrder, false, true>(lds + RING_OFF, g, S, E);

                SEAM(pb + 8);
            }
            if (EN(9) && IN(pb + 11)) { PH_WS;
#if (REP >> 9) & 1
                { const float* ng = (const float*)(ws + WS_PAR) + PO_NORMG + (size_t)l * 6 * D;
                tp_post_pre<0, false, true>(ws, XOUT, lds, ng + 3 * D, ng + 4 * D, vcu, G); }
                __syncthreads();
#endif
                const float* ng = (const float*)(ws + WS_PAR) + PO_NORMG + (size_t)l * 6 * D;
                tp_post_pre<0, false>(ws, XOUT, lds, ng + 3 * D, ng + 4 * D, vcu, G);
                SEAM(pb + 11); }
        } else {
            if (EN(10) && IN(pb + 6)) { PH_WS;
#if (REP >> 10) & 1
                { pm0_moe_setup(ws, GIN(I_MG), GIN(I_MU), GIN(I_MD), lds, vcu, G); }
                __syncthreads();
#endif
                pm0_moe_setup(ws, GIN(I_MG), GIN(I_MU), GIN(I_MD), lds, vcu, G);
                SEAM(pb + 6); }
            if (EN(11) && IN(pb + 7)) { PH_WS; gu32* ctl = (gu32*)(ws + WS_CTL);
                int ps[NEXP + 1]; { int p = 0;
#pragma unroll
                    for (int e = 0; e < NEXP; ++e) { ps[e] = p; p += ((int)__hip_atomic_load(ctl + CW_CNT + 64 * e, RLX_AGENT) + 255) >> 8; } ps[NEXP] = p; }
#if (REP >> 11) & 1
                for (int rep_ = 0; rep_ < 2; ++rep_)
#endif
                {
                pg8::Gemm g{(const pg8::bf16_t*)(ws + WS_HG), (const pg8::bf16_t*)(ws + WS_WMGU), ps[NEXP] * 256, 2 * FF, D / 2, E8_H, E8_WGU};
                pg8::MoeOrder S; S.base.init(ps[NEXP] * 256, 2 * FF, G, bx); S.plo = 0; S.ps1 = ps[1]; S.ps2 = ps[2]; S.ps3 = ps[3]; S.ps4 = ps[4]; S.ps5 = ps[5]; S.ps6 = ps[6]; S.ps7 = ps[7];
                pg8::EpiSwiGLU8 E{ws + WS_ACT8, FF, 2 * FF / 256, 0, SC_ACT};
#ifdef STAGGER_US
            if (bx & 1) { const unsigned long long t0_ = __builtin_amdgcn_s_memrealtime(); while (__builtin_amdgcn_s_memrealtime() - t0_ < (unsigned long long)(STAGGER_US * 100)) __builtin_amdgcn_s_sleep(8); }
#endif
                pg8::gemm_phase<pg8::EpiSwiGLU8, pg8::MoeOrder, true, true, true>(lds + RING_OFF, g, S, E);
                }
                SEAM(pb + 7);
            }
            if (EN(12) && IN(pb + 8)) { PH_WS; gu32* ctl = (gu32*)(ws + WS_CTL);
                int ps[NEXP + 1]; { int p = 0;
#pragma unroll
                    for (int e = 0; e < NEXP; ++e) { ps[e] = p; p += ((int)__hip_atomic_load(ctl + CW_CNT + 64 * e, RLX_AGENT) + 255) >> 8; } ps[NEXP] = p; }
#if (REP >> 12) & 1
                for (int rep_ = 0; rep_ < 2; ++rep_)
#endif
                {
                pg8::Gemm g{(const pg8::bf16_t*)(ws + WS_ACT8), (const pg8::bf16_t*)(ws + WS_WMD), ps[NEXP] * 256, D, FF / 2, E8_ACT, E8_WD};
                pg8::MoeOrder S; S.base.init(ps[NEXP] * 256, D, G, bx); S.plo = 0; S.ps1 = ps[1]; S.ps2 = ps[2]; S.ps3 = ps[3]; S.ps4 = ps[4]; S.ps5 = ps[5]; S.ps6 = ps[6]; S.ps7 = ps[7];
                pg8::EpiPlainBf16 E{(pg8::bf16_t*)(ws + WS_OE), D, 3};
                pg8::gemm_phase<pg8::EpiPlainBf16, pg8::MoeOrder, true, true, true>(lds + RING_OFF, g, S, E);
                }
                SEAM(pb + 8);
            }
            if (EN(13) && IN(pb + 11)) { PH_WS;
#if (REP >> 13) & 1
                { const float* ng = (const float*)(ws + WS_PAR) + PO_NORMG + (size_t)l * 6 * D;
                tp_post_pre<1, false, true>(ws, XOUT, lds, ng + 3 * D, ng + 4 * D, vcu, G); }
                __syncthreads();
#endif
                const float* ng = (const float*)(ws + WS_PAR) + PO_NORMG + (size_t)l * 6 * D;
                tp_post_pre<1, false>(ws, XOUT, lds, ng + 3 * D, ng + 4 * D, vcu, G);
                SEAM(pb + 11); }
        }
        if (EN(14) && IN(pb + 12)) { PH_WS;
#if (REP >> 14) & 1
            { unsigned char* wl = ws + WS_WSMALL + (size_t)l * WL_STRIDE;
            { pg8::Gemm g{(const pg8::bf16_t*)(ws + WS_PB) + (size_t)l * T * PLE, (const pg8::bf16_t*)(wl + WL_WPP), T, D, PLE}; pg8::StaticOrder S; S.init(T, D, G, bx);
              pg8::EpiPlainBf16 E{(pg8::bf16_t*)(ws + WS_PP), D, 3};
              pg8::gemm_phase<pg8::EpiPlainBf16, pg8::StaticOrder, false, true>(lds + RING_OFF, g, S, E); }
            __syncthreads();
            { pg8::Gemm g{(const pg8::bf16_t*)(ws + WS_H), (const pg8::bf16_t*)(wl + WL_WPG), T, D, D}; pg8::StaticOrder S; S.init(T, D, G, bx);
              pg8::EpiPleGate E{(pg8::bf16_t*)(ws + WS_F), (const pg8::bf16_t*)(ws + WS_PP), D};
              pg8::gemm_phase<pg8::EpiPleGate, pg8::StaticOrder, false, true>(lds + RING_OFF, g, S, E); }
            }
            __syncthreads();
#endif
            unsigned char* wl = ws + WS_WSMALL + (size_t)l * WL_STRIDE;
            { pg8::Gemm g{(const pg8::bf16_t*)(ws + WS_PB) + (size_t)l * T * PLE, (const pg8::bf16_t*)(wl + WL_WPP), T, D, PLE}; pg8::StaticOrder S; S.init(T, D, G, bx);
              pg8::EpiPlainBf16 E{(pg8::bf16_t*)(ws + WS_PP), D, 3};
              pg8::gemm_phase<pg8::EpiPlainBf16, pg8::StaticOrder, false, true>(lds + RING_OFF, g, S, E); }
            __syncthreads();
            { pg8::Gemm g{(const pg8::bf16_t*)(ws + WS_H), (const pg8::bf16_t*)(wl + WL_WPG), T, D, D}; pg8::StaticOrder S; S.init(T, D, G, bx);
              pg8::EpiPleGate E{(pg8::bf16_t*)(ws + WS_F), (const pg8::bf16_t*)(ws + WS_PP), D};
              pg8::gemm_phase<pg8::EpiPleGate, pg8::StaticOrder, false, true>(lds + RING_OFF, g, S, E); }

            SEAM(pb + 12);
        }
        if (EN(15) && IN(pb + 13)) { PH_WS;
#if (REP >> 15) & 1
            { const float* ng = (const float*)(ws + WS_PAR) + PO_NORMG + (size_t)l * 6 * D;
            tp_post_pre<0, false, true>(ws, XOUT, lds, ng + 5 * D, (l + 1 < DEPTH) ? ng + 6 * D : nullptr, vcu, G); }
            __syncthreads();
#endif
            const float* ng = (const float*)(ws + WS_PAR) + PO_NORMG + (size_t)l * 6 * D;
            if (l + 1 < DEPTH) tp_post_pre<0, false, false, false, false, true>(ws, XOUT, lds, ng + 5 * D, ng + 6 * D, vcu, G);
            else tp_post_pre<0, false, false, false, true>(ws, XOUT, lds, ng + 5 * D, nullptr, vcu, G);
            SEAM(pb + 13); }
    }
#undef IN
#undef SEAM
#undef PH_WS
}

extern "C" void kernel_launch(void* const* d_in, const int* in_sizes, int n_in, void* d_out, int out_size, void* d_ws, size_t ws_size, hipStream_t stream) {
    static int grid = 0;
    if (grid == 0) {
        if (n_in != 26 || in_sizes[0] != T * D || out_size != T * D || ws_size < WS_END) { fprintf(stderr, "kernel_launch: unexpected shapes / workspace (n_in %d, in0 %d, out %d, ws %zu < %zu); nothing launched\n", n_in, n_in > 0 ? in_sizes[0] : -1, out_size, ws_size, (size_t)WS_END); grid = -1; return; }
        int dev = 0, cus = 0, per_cu = 0;
        if (hipGetDevice(&dev) != hipSuccess || hipDeviceGetAttribute(&cus, hipDeviceAttributeMultiprocessorCount, dev) != hipSuccess) { grid = -1; return; }
        if (hipFuncSetAttribute((const void*)mk_fwd, hipFuncAttributeMaxDynamicSharedMemorySize, LDS_BYTES) != hipSuccess) { fprintf(stderr, "kernel_launch: hipFuncSetAttribute failed\n"); grid = -1; return; }
        if (hipOccupancyMaxActiveBlocksPerMultiprocessor(&per_cu, (const void*)mk_fwd, NWAVES * 64, LDS_BYTES) != hipSuccess || per_cu < 1) { fprintf(stderr, "kernel_launch: occupancy query reports %d workgroups per CU\n", per_cu); (void)hipGetLastError(); grid = -1; return; }
        grid = cus;
    }
    if (grid < 0) return;
    if (hipMemsetAsync((char*)d_ws + WS_CTL, 0, CTL_ZERO_BYTES, stream) != hipSuccess) return;
    Args a{};
    for (int i = 0; i < 26; ++i) a.in[i] = d_in[i];
    a.out = (float*)d_out; a.ws = (unsigned char*)d_ws;
#if MK_MULTI
    for (int ph = 0; ph < NPHASES; ++ph) { if (!phase_exists(ph)) continue; a.ph_lo = ph; a.ph_hi = ph + 1; hipLaunchKernelGGL(mk_fwd, dim3(grid), dim3(NWAVES * 64), LDS_BYTES, stream, a); }
#else
    a.ph_lo = 0; a.ph_hi = NPHASES;
    hipLaunchKernelGGL(mk_fwd, dim3(grid), dim3(NWAVES * 64), LDS_BYTES, stream, a);
#endif
}
```

```cpp
#include <hip/hip_runtime.h>
#include <hip/hip_bf16.h>
#include <cstdio>
#include <cstdint>
#include <cmath>
namespace pg8 {
#define PG8_LAS __attribute__((address_space(3)))
typedef unsigned short bf16_t;
typedef short bf16x8 __attribute__((ext_vector_type(8)));
typedef float f32x4 __attribute__((ext_vector_type(4)));
typedef unsigned u32x4 __attribute__((ext_vector_type(4)));
constexpr int BM = 256, BK = 64, HALF = 128, HTB = HALF * BK * 2  , STAGE_BYTES = 8 * HTB, NXCD = 8, WGM = 8;

__host__ __device__ __forceinline__ int lds_byte(int r, int c) { const int st = (r >> 4) * 2 + (c >> 5), rr = r & 15, cc = c & 31, ob = rr * 64 + cc * 2; return st * 1024 + (ob ^ (((ob >> 9) & 1) << 5)); }
__host__ __device__ __forceinline__ void stage_rc(int b, int& R, int& C) { const int st = b / 1024, sb = b % 1024, swz = sb ^ (((sb >> 9) & 1) << 5); R = (st >> 1) * 16 + swz / 64; C = (st & 1) * 32 + (swz % 64) / 2; }
__host__ __device__ __forceinline__ int perm32(int rho) { const int n = rho >> 4, i = rho & 15; return 8 * (i >> 2) + 4 * n + (i & 3); }

struct Unit { int pm, pn; int ko = 0; };
typedef int v4i_t __attribute__((ext_vector_type(4)));
typedef int v8i_t __attribute__((ext_vector_type(8)));
struct Gemm { const bf16_t* A; const bf16_t* Bt; int M, N, K; int sa = 0x7f7f7f7f, sb = 0x7f7f7f7f; int ld = 0; };

struct StaticOrder {
    int nM, nN, nwg, G, c;
    __host__ __device__ void init(int M, int N, int G_, int c_) { nM = M / BM; nN = N / BM; nwg = nM * nN; G = G_; c = c_; }
    __host__ __device__ bool next(int i, Unit& u) const {
        const long L = (long)i * G + c; if (L >= nwg) return false;
        int wgid = (int)L; { const int q = nwg / NXCD, r = nwg % NXCD, xcd = wgid % NXCD, off = wgid / NXCD; wgid = (xcd < r ? xcd * (q + 1) : r * (q + 1) + (xcd - r) * q) + off; }
        const int nig = WGM * nN, gid = wgid / nig, fm = gid * WGM, gsz = (nM - fm) < WGM ? (nM - fm) : WGM;
        u.pm = fm + ((wgid % nig) % gsz); u.pn = (wgid % nig) / gsz; return true;
    }
    __device__ __forceinline__ void a_ready(const Unit&) const {}
    __device__ __forceinline__ void done(const Unit&) const {}
};

__device__ __forceinline__ unsigned cvt_pk_bf16(float lo, float hi) { unsigned r; asm volatile("v_cvt_pk_bf16_f32 %0, %1, %2" : "=v"(r) : "v"(lo), "v"(hi)); return r; }
typedef float f32x2 __attribute__((ext_vector_type(2)));
__device__ __forceinline__ f32x2 gelu_pk(f32x2 v) {
    const f32x2 av = __builtin_elementwise_abs(v), d = av * 0.2316418882f + 1.0f;
    f32x2 t; t.x = __builtin_amdgcn_rcpf(d.x); t.y = __builtin_amdgcn_rcpf(d.y);
    f32x2 q = t * 0.5307027145f + (-0.7265760135f); q = q * t + 0.7107068705f; q = q * t + (-0.142248368f); q = q * t + 0.127414796f; q = q * t;
    const f32x2 s = (v * v) * (-0.72134752044f);
    f32x2 e; e.x = __builtin_amdgcn_exp2f(s.x); e.y = __builtin_amdgcn_exp2f(s.y);
    const f32x2 m = v * (q * e), r = v - m;
    f32x2 o; o.x = v.x < 0.f ? m.x : r.x; o.y = v.y < 0.f ? m.y : r.y; return o;
}

typedef unsigned u32x2 __attribute__((ext_vector_type(2)));
#ifndef NT_EPI
#define NT_EPI 0
#endif
#if NT_EPI
#define ST16(p, v) __builtin_nontemporal_store((v), (u32x4*)(p))
#define ST8(p, v) __builtin_nontemporal_store((v), (u32x2*)(p))
#else
#define ST16(p, v) (*(u32x4*)(p) = (v))
#define ST8(p, v) (*(u32x2*)(p) = (v))
#endif
__device__ __forceinline__ float sigm(float v) { return __builtin_amdgcn_rcpf(1.0f + __builtin_amdgcn_exp2f(-1.4426950408889634f * v)); }
__device__ __forceinline__ f32x4 sigm4(f32x4 v) { return (f32x4){sigm(v[0]), sigm(v[1]), sigm(v[2]), sigm(v[3])}; }
__device__ __forceinline__ float gelu_tanh1(float v) { return v * sigm(1.5957691216057308f * v * (1.0f + 0.044715f * v * v)); }
__device__ __forceinline__ f32x4 gelu_tanh4(f32x4 v) { return (f32x4){gelu_tanh1(v[0]), gelu_tanh1(v[1]), gelu_tanh1(v[2]), gelu_tanh1(v[3])}; }
__device__ __forceinline__ u32x4 pack8(f32x4 a, f32x4 b) { u32x4 w; w.x = cvt_pk_bf16(a[0], a[1]); w.y = cvt_pk_bf16(a[2], a[3]); w.z = cvt_pk_bf16(b[0], b[1]); w.w = cvt_pk_bf16(b[2], b[3]); return w; }
__device__ __forceinline__ f32x4 bf_lo4(u32x4 w) { return (f32x4){__uint_as_float(w.x << 16), __uint_as_float(w.x & 0xffff0000u), __uint_as_float(w.y << 16), __uint_as_float(w.y & 0xffff0000u)}; }
__device__ __forceinline__ f32x4 bf_hi4(u32x4 w) { return (f32x4){__uint_as_float(w.z << 16), __uint_as_float(w.z & 0xffff0000u), __uint_as_float(w.w << 16), __uint_as_float(w.w & 0xffff0000u)}; }

struct EpiF32 {
    static constexpr bool PERM = false, AFTER_DRAIN = false;
    float* C; int ldc;
    __device__ __forceinline__ void operator()(const f32x4 (&acc)[2][2][4][2], const Unit& u, int wr, int wc, int fr, int fq) const {
        const int row0 = u.pm * BM + wr * 64 + fr, col0 = u.pn * BM + wc * 32 + 4 * fq;
#pragma unroll
        for (int ai = 0; ai < 2; ++ai)
#pragma unroll
            for (int m = 0; m < 4; ++m) { float* rowp = C + (size_t)(row0 + ai * HALF + m * 16) * ldc + col0;
#pragma unroll
                for (int bj = 0; bj < 2; ++bj)
#pragma unroll
                    for (int n = 0; n < 2; ++n) *(f32x4*)(rowp + bj * HALF + n * 16) = acc[ai][bj][m][n]; }
    }
};

__device__ const float ROPE_REV[32] = {
    0.15915494309f, 0.11934937021f, 0.089499401609f, 0.067115083005f, 0.050329212104f, 0.037741584717f, 0.028302195831f, 0.021223652765f,
    0.015915494309f, 0.011934937021f, 0.0089499401609f, 0.0067115083005f, 0.0050329212104f, 0.0037741584717f, 0.0028302195831f, 0.0021223652765f,
    0.0015915494309f, 0.0011934937021f, 0.00089499401609f, 0.00067115083005f, 0.00050329212104f, 0.00037741584717f, 0.00028302195831f, 0.00021223652765f,
    0.00015915494309f, 0.00011934937021f, 8.9499401609e-05f, 6.7115083005e-05f, 5.0329212104e-05f, 3.7741584717e-05f, 2.8302195831e-05f, 2.1223652765e-05f };
__device__ __forceinline__ f32x4 cos_rev4(f32x4 r) { return (f32x4){__builtin_amdgcn_cosf(__builtin_amdgcn_fractf(r[0])), __builtin_amdgcn_cosf(__builtin_amdgcn_fractf(r[1])), __builtin_amdgcn_cosf(__builtin_amdgcn_fractf(r[2])), __builtin_amdgcn_cosf(__builtin_amdgcn_fractf(r[3]))}; }
__device__ __forceinline__ f32x4 sin_rev4(f32x4 r) { return (f32x4){__builtin_amdgcn_sinf(__builtin_amdgcn_fractf(r[0])), __builtin_amdgcn_sinf(__builtin_amdgcn_fractf(r[1])), __builtin_amdgcn_sinf(__builtin_amdgcn_fractf(r[2])), __builtin_amdgcn_sinf(__builtin_amdgcn_fractf(r[3]))}; }
struct EpiInProj {
    static constexpr bool PERM = true, AFTER_DRAIN = false;
    bf16_t* out; size_t slot_stride; const float* posf; float qscale;
    __device__ __forceinline__ void operator()(const f32x4 (&acc)[2][2][4][2], const Unit& u, int wr, int wc, int fr, int fq) const {
        const int type = u.pn >> 2, sub = u.pn & 3;
        bf16_t* base = out + (size_t)type * slot_stride;
        const int row0 = u.pm * BM + wr * 64 + fr;
        if (type == 2 || type == 3) {
            const float sc = (type == 2) ? qscale : 1.0f;
            const int colb = sub * 256 + wc * 64 + 8 * fq;
            const f32x4 cf0 = *(const f32x4*)(ROPE_REV + 8 * fq), cf1 = *(const f32x4*)(ROPE_REV + 8 * fq + 4);
            float pv[2][4];
#pragma unroll
            for (int ai = 0; ai < 2; ++ai)
#pragma unroll
                for (int m = 0; m < 4; ++m) pv[ai][m] = posf[row0 + ai * HALF + m * 16];
#pragma unroll
            for (int ai = 0; ai < 2; ++ai)
#pragma unroll
                for (int m = 0; m < 4; ++m) { const int r = row0 + ai * HALF + m * 16;
                    const float p = pv[ai][m];
                    const f32x4 r0 = cf0 * p, r1 = cf1 * p;
                    const f32x4 c0 = cos_rev4(r0) * sc, c1 = cos_rev4(r1) * sc, s0 = sin_rev4(r0) * sc, s1 = sin_rev4(r1) * sc;
                    const f32x4 x0a = acc[ai][0][m][0], x0b = acc[ai][0][m][1], x1a = acc[ai][1][m][0], x1b = acc[ai][1][m][1];
                    const f32x4 y0a = x0a * c0 - x1a * s0, y0b = x0b * c1 - x1b * s1, y1a = x1a * c0 + x0a * s0, y1b = x1b * c1 + x0b * s1;
                    bf16_t* rowp = base + (size_t)r * 1024 + colb;
                    ST16(rowp, pack8(y0a, y0b)); ST16(rowp + 32, pack8(y1a, y1b)); }
        } else {
            const int colb = sub * 256 + wc * 64 + 8 * fq;
#pragma unroll
            for (int ai = 0; ai < 2; ++ai)
#pragma unroll
                for (int m = 0; m < 4; ++m) { bf16_t* rowp = base + (size_t)(row0 + ai * HALF + m * 16) * 1024 + colb;
#pragma unroll
                    for (int bj = 0; bj < 2; ++bj) { f32x4 v0 = acc[ai][bj][m][0], v1 = acc[ai][bj][m][1];
                        if (type == 0) { v0 = gelu_tanh4(v0); v1 = gelu_tanh4(v1); }
                        else if (type >= 5) { v0 = sigm4(v0); v1 = sigm4(v1); }
                        ST16(rowp + bj * 32, pack8(v0, v1)); } }
        }
    }
};

struct EpiMerge {
    static constexpr bool PERM = true, AFTER_DRAIN = false;
    const bf16_t* sga; const bf16_t* sgb; bf16_t* t1; bf16_t* merged; int nM;
    __device__ __forceinline__ void operator()(const f32x4 (&acc)[2][2][4][2], const Unit& u, int wr, int wc, int fr, int fq) const {
        const bool sel = u.pm >= nM; const int pm = sel ? u.pm - nM : u.pm, pn = u.pn & 3;
        const bf16_t* sg = sel ? sgb : sga;
        const int row0 = pm * BM + wr * 64 + fr, col0 = pn * BM + wc * 32 + 8 * fq;
#pragma unroll
        for (int ai = 0; ai < 2; ++ai) {
            u32x4 g[4][2], t[4][2];
#pragma unroll
            for (int m = 0; m < 4; ++m)
#pragma unroll
                for (int bj = 0; bj < 2; ++bj) { const size_t off = (size_t)(row0 + ai * HALF + m * 16) * 1024 + col0 + bj * HALF;
                    g[m][bj] = *(const u32x4*)(sg + off); if (sel) t[m][bj] = *(const u32x4*)(t1 + off); }
#pragma unroll
            for (int m = 0; m < 4; ++m)
#pragma unroll
                for (int bj = 0; bj < 2; ++bj) { const size_t off = (size_t)(row0 + ai * HALF + m * 16) * 1024 + col0 + bj * HALF;
                    f32x4 v0 = acc[ai][bj][m][0] * bf_lo4(g[m][bj]), v1 = acc[ai][bj][m][1] * bf_hi4(g[m][bj]);
                    if (!sel) *(u32x4*)(t1 + off) = pack8(v0, v1);
                    else { v0 = v0 + bf_lo4(t[m][bj]); v1 = v1 + bf_hi4(t[m][bj]); *(u32x4*)(merged + off) = pack8(v0, v1); } } }
    }
};

struct EpiSwiGLU {
    static constexpr bool PERM = true, AFTER_DRAIN = false;
    bf16_t* O; int ldc; int nper; int pm_sub;
    __device__ __forceinline__ void operator()(const f32x4 (&acc)[2][2][4][2], const Unit& u, int wr, int wc, int fr, int fq) const {
        const int pn = u.pn % nper;
        const int row0 = (u.pm - pm_sub) * BM + wr * 64 + fr, col0 = pn * HALF + wc * 32 + 8 * fq;
#pragma unroll
        for (int ai = 0; ai < 2; ++ai)
#pragma unroll
            for (int m = 0; m < 4; ++m) { const f32x4 g0 = acc[ai][0][m][0], g1 = acc[ai][0][m][1], u0 = acc[ai][1][m][0], u1 = acc[ai][1][m][1];
                const f32x4 a0 = g0 * sigm4(g0) * u0, a1 = g1 * sigm4(g1) * u1;
                ST16(O + (size_t)(row0 + ai * HALF + m * 16) * ldc + col0, pack8(a0, a1)); }
    }
};

__device__ __forceinline__ unsigned pk4_fp8(f32x4 v) { unsigned w = __builtin_amdgcn_cvt_pk_fp8_f32(v[0], v[1], 0u, false); return __builtin_amdgcn_cvt_pk_fp8_f32(v[2], v[3], w, true); }
__device__ __forceinline__ f32x4 clamp448(f32x4 v) { return (f32x4){__builtin_fminf(__builtin_fmaxf(v[0], -448.f), 448.f), __builtin_fminf(__builtin_fmaxf(v[1], -448.f), 448.f), __builtin_fminf(__builtin_fmaxf(v[2], -448.f), 448.f), __builtin_fminf(__builtin_fmaxf(v[3], -448.f), 448.f)}; }
struct EpiSwiGLU8 {
    static constexpr bool PERM = true, AFTER_DRAIN = false;
    unsigned char* O; int ldc; int nper; int pm_sub; float oscale;
    __device__ __forceinline__ void operator()(const f32x4 (&acc)[2][2][4][2], const Unit& u, int wr, int wc, int fr, int fq) const {
        const int pn = u.pn % nper;
        const int row0 = (u.pm - pm_sub) * BM + wr * 64 + fr, col0 = pn * HALF + wc * 32 + 8 * fq;
#pragma unroll
        for (int ai = 0; ai < 2; ++ai)
#pragma unroll
            for (int m = 0; m < 4; ++m) { const f32x4 g0 = acc[ai][0][m][0], g1 = acc[ai][0][m][1], u0 = acc[ai][1][m][0], u1 = acc[ai][1][m][1];
                const f32x4 a0 = clamp448(g0 * sigm4(g0) * u0 * oscale), a1 = clamp448(g1 * sigm4(g1) * u1 * oscale);
                u32x2 w; w.x = pk4_fp8(a0); w.y = pk4_fp8(a1);
                ST8(O + (size_t)(row0 + ai * HALF + m * 16) * ldc + col0, w); }
    }
};

typedef int i32x4 __attribute__((ext_vector_type(4)));
__device__ __forceinline__ f32x4 icvt(f32x4 a) { return __builtin_convertvector(__builtin_bit_cast(i32x4, a), f32x4); }
struct EpiSwiGLUq {
    static constexpr bool PERM = true, AFTER_DRAIN = false;
    bf16_t* O; int ldc; const float* sa; const float* sb;
    __device__ __forceinline__ void operator()(const f32x4 (&acc)[2][2][4][2], const Unit& u, int wr, int wc, int fr, int fq) const {
        const int row0 = u.pm * BM + wr * 64 + fr, col0 = u.pn * HALF + wc * 32 + 8 * fq, gc0 = u.pn * BM + wc * 32 + 8 * fq;
        const f32x4 bg0 = *(const f32x4*)(sb + gc0), bg1 = *(const f32x4*)(sb + gc0 + 4), bu0 = *(const f32x4*)(sb + gc0 + HALF), bu1 = *(const f32x4*)(sb + gc0 + HALF + 4);
        float sr[2][4];
#pragma unroll
        for (int ai = 0; ai < 2; ++ai)
#pragma unroll
            for (int m = 0; m < 4; ++m) sr[ai][m] = sa[row0 + ai * HALF + m * 16];
#pragma unroll
        for (int ai = 0; ai < 2; ++ai)
#pragma unroll
            for (int m = 0; m < 4; ++m) { const float s = sr[ai][m];
                const f32x4 g0 = icvt(acc[ai][0][m][0]) * (bg0 * s), g1 = icvt(acc[ai][0][m][1]) * (bg1 * s), u0 = icvt(acc[ai][1][m][0]) * (bu0 * s), u1 = icvt(acc[ai][1][m][1]) * (bu1 * s);
                const f32x4 a0 = g0 * sigm4(g0) * u0, a1 = g1 * sigm4(g1) * u1;
                ST16(O + (size_t)(row0 + ai * HALF + m * 16) * ldc + col0, pack8(a0, a1)); }
    }
};
struct EpiInProjq {
    static constexpr bool PERM = true, AFTER_DRAIN = false;
    bf16_t* out; size_t slot_stride; const float* posf; float qscale; const float* sa; const float* sb;
    __device__ __forceinline__ void operator()(const f32x4 (&acc)[2][2][4][2], const Unit& u, int wr, int wc, int fr, int fq) const {
        const int type = u.pn >> 2, sub = u.pn & 3;
        bf16_t* base = out + (size_t)type * slot_stride;
        const int row0 = u.pm * BM + wr * 64 + fr, gc0 = u.pn * BM + wc * 32 + 8 * fq;
        const f32x4 b00 = *(const f32x4*)(sb + gc0), b01 = *(const f32x4*)(sb + gc0 + 4), b10 = *(const f32x4*)(sb + gc0 + HALF), b11 = *(const f32x4*)(sb + gc0 + HALF + 4);
        const int colb = sub * 256 + wc * 64 + 8 * fq;
        if (type == 2 || type == 3) {
            const float sc = (type == 2) ? qscale : 1.0f;
            const f32x4 cf0 = *(const f32x4*)(ROPE_REV + 8 * fq), cf1 = *(const f32x4*)(ROPE_REV + 8 * fq + 4);
#pragma unroll
            for (int ai = 0; ai < 2; ++ai) {
                float sr[4], pv[4];
#pragma unroll
                for (int m = 0; m < 4; ++m) { sr[m] = sa[row0 + ai * HALF + m * 16]; pv[m] = posf[row0 + ai * HALF + m * 16]; }
#pragma unroll
                for (int m = 0; m < 4; ++m) { const int r = row0 + ai * HALF + m * 16; const float p = pv[m], s = sr[m] * sc;
                    bf16_t* rowp = base + (size_t)r * 1024 + colb;
                    { const f32x4 r0 = cf0 * p; const f32x4 c0 = cos_rev4(r0), s0 = sin_rev4(r0);
                      const f32x4 x0a = icvt(acc[ai][0][m][0]) * (b00 * s), x1a = icvt(acc[ai][1][m][0]) * (b10 * s);
                      const f32x4 y0a = x0a * c0 - x1a * s0, y1a = x1a * c0 + x0a * s0;
                      const f32x4 r1 = cf1 * p; const f32x4 c1 = cos_rev4(r1), s1 = sin_rev4(r1);
                      const f32x4 x0b = icvt(acc[ai][0][m][1]) * (b01 * s), x1b = icvt(acc[ai][1][m][1]) * (b11 * s);
                      const f32x4 y0b = x0b * c1 - x1b * s1, y1b = x1b * c1 + x0b * s1;
                      ST16(rowp, pack8(y0a, y0b)); ST16(rowp + 32, pack8(y1a, y1b)); } } }
        } else {
#pragma unroll
            for (int ai = 0; ai < 2; ++ai) {
                float sr[4];
#pragma unroll
                for (int m = 0; m < 4; ++m) sr[m] = sa[row0 + ai * HALF + m * 16];
#pragma unroll
                for (int m = 0; m < 4; ++m) { bf16_t* rowp = base + (size_t)(row0 + ai * HALF + m * 16) * 1024 + colb; const float s = sr[m];
#pragma unroll
                    for (int bj = 0; bj < 2; ++bj) { f32x4 v0 = icvt(acc[ai][bj][m][0]) * ((bj ? b10 : b00) * s), v1 = icvt(acc[ai][bj][m][1]) * ((bj ? b11 : b01) * s);
                        if (type == 0) { v0 = gelu_tanh4(v0); v1 = gelu_tanh4(v1); }
                        else if (type >= 5) { v0 = sigm4(v0); v1 = sigm4(v1); }
                        ST16(rowp + bj * 32, pack8(v0, v1)); } } }
        }
    }
};

struct EpiPleGateq {
    static constexpr bool PERM = true, AFTER_DRAIN = false;
    bf16_t* O; const bf16_t* PP; int ldc; const float* sa; const float* sb;
    __device__ __forceinline__ void operator()(const f32x4 (&acc)[2][2][4][2], const Unit& u, int wr, int wc, int fr, int fq) const {
        const int row0 = u.pm * BM + wr * 64 + fr, col0 = u.pn * BM + wc * 32 + 8 * fq;
        const f32x4 b00 = *(const f32x4*)(sb + col0), b01 = *(const f32x4*)(sb + col0 + 4), b10 = *(const f32x4*)(sb + col0 + HALF), b11 = *(const f32x4*)(sb + col0 + HALF + 4);
#pragma unroll
        for (int ai = 0; ai < 2; ++ai) {
            u32x4 p[4][2]; float sr[4];
#pragma unroll
            for (int m = 0; m < 4; ++m) { sr[m] = sa[row0 + ai * HALF + m * 16];
#pragma unroll
                for (int bj = 0; bj < 2; ++bj) p[m][bj] = *(const u32x4*)(PP + (size_t)(row0 + ai * HALF + m * 16) * ldc + col0 + bj * HALF); }
#pragma unroll
            for (int m = 0; m < 4; ++m)
#pragma unroll
                for (int bj = 0; bj < 2; ++bj) { const size_t ro = (size_t)(row0 + ai * HALF + m * 16) * ldc + col0 + bj * HALF;
                    *(u32x4*)(O + ro) = pack8(sigm4(icvt(acc[ai][bj][m][0]) * ((bj ? b10 : b00) * sr[m])) * bf_lo4(p[m][bj]), sigm4(icvt(acc[ai][bj][m][1]) * ((bj ? b11 : b01) * sr[m])) * bf_hi4(p[m][bj])); } }
    }
};
struct EpiPlainBf16 {
    static constexpr bool PERM = true, AFTER_DRAIN = false;
    bf16_t* O; int ldc; int pn_mask;
    __device__ __forceinline__ void operator()(const f32x4 (&acc)[2][2][4][2], const Unit& u, int wr, int wc, int fr, int fq) const {
        const int row0 = u.pm * BM + wr * 64 + fr, col0 = (u.pn & pn_mask) * BM + wc * 32 + 8 * fq;
#pragma unroll
        for (int ai = 0; ai < 2; ++ai)
#pragma unroll
            for (int m = 0; m < 4; ++m) { bf16_t* rowp = O + (size_t)(row0 + ai * HALF + m * 16) * ldc + col0;
#pragma unroll
                for (int bj = 0; bj < 2; ++bj) ST16(rowp + bj * HALF, pack8(acc[ai][bj][m][0], acc[ai][bj][m][1])); }
    }
};

struct EpiPleGate {
    static constexpr bool PERM = true, AFTER_DRAIN = false;
    bf16_t* O; const bf16_t* PP; int ldc;
    __device__ __forceinline__ void operator()(const f32x4 (&acc)[2][2][4][2], const Unit& u, int wr, int wc, int fr, int fq) const {
        const int row0 = u.pm * BM + wr * 64 + fr, col0 = u.pn * BM + wc * 32 + 8 * fq;
#pragma unroll
        for (int ai = 0; ai < 2; ++ai) {
            u32x4 p[4][2];
#pragma unroll
            for (int m = 0; m < 4; ++m)
#pragma unroll
                for (int bj = 0; bj < 2; ++bj) p[m][bj] = *(const u32x4*)(PP + (size_t)(row0 + ai * HALF + m * 16) * ldc + col0 + bj * HALF);
#pragma unroll
            for (int m = 0; m < 4; ++m)
#pragma unroll
                for (int bj = 0; bj < 2; ++bj) { const size_t ro = (size_t)(row0 + ai * HALF + m * 16) * ldc + col0 + bj * HALF;
                    *(u32x4*)(O + ro) = pack8(sigm4(acc[ai][bj][m][0]) * bf_lo4(p[m][bj]), sigm4(acc[ai][bj][m][1]) * bf_hi4(p[m][bj])); } }
    }
};

struct MoeKSplitOrder {
    int G, c, p0, npan, nN, S, kbytes; int ps1, ps2, ps3, ps4, ps5, ps6, ps7;
    __device__ __forceinline__ bool next(int i, Unit& u) const {
        const int L = i * G + c; if (L >= npan * nN * S) return false;
        const int ks = L % S, r = L / S, pn = r % nN, p = p0 + r / nN;
        const int e = (p >= ps1) + (p >= ps2) + (p >= ps3) + (p >= ps4) + (p >= ps5) + (p >= ps6) + (p >= ps7);
        u.pm = p; u.pn = e * nN + pn; u.ko = ks * kbytes; return true;
    }
    __device__ __forceinline__ void a_ready(const Unit&) const {}
    __device__ __forceinline__ void done(const Unit&) const {}
};
struct EpiSliceBf16 {
    static constexpr bool PERM = true, AFTER_DRAIN = false;
    bf16_t* O; int ldc; int pn_mask; int p0; int kbytes; size_t slice_stride;
    __device__ __forceinline__ void operator()(const f32x4 (&acc)[2][2][4][2], const Unit& u, int wr, int wc, int fr, int fq) const {
        bf16_t* Ob = O + (size_t)(u.ko / kbytes) * slice_stride;
        const int row0 = (u.pm - p0) * BM + wr * 64 + fr, col0 = (u.pn & pn_mask) * BM + wc * 32 + 8 * fq;
#pragma unroll
        for (int ai = 0; ai < 2; ++ai)
#pragma unroll
            for (int m = 0; m < 4; ++m) { bf16_t* rowp = Ob + (size_t)(row0 + ai * HALF + m * 16) * ldc + col0;
#pragma unroll
                for (int bj = 0; bj < 2; ++bj) ST16(rowp + bj * HALF, pack8(acc[ai][bj][m][0], acc[ai][bj][m][1])); }
    }
};
struct PairOrder {
    StaticOrder base;
    __device__ __forceinline__ bool next(int i, Unit& u) const { if (!base.next(i >> 1, u)) return false; if (i & 1) { u.pm += base.nM; u.pn += base.nN; } return true; }
    __device__ __forceinline__ void a_ready(const Unit&) const {}
    __device__ __forceinline__ void done(const Unit&) const {}
};
struct MoeOrder {
    StaticOrder base; int plo; int ps1, ps2, ps3, ps4, ps5, ps6, ps7;
    __device__ __forceinline__ bool next(int i, Unit& u) const {
        if (!base.next(i, u)) return false;
        const int p = u.pm + plo;
        const int e = (p >= ps1) + (p >= ps2) + (p >= ps3) + (p >= ps4) + (p >= ps5) + (p >= ps6) + (p >= ps7);
        u.pm = p; u.pn += e * base.nN; return true;
    }
    __device__ __forceinline__ void a_ready(const Unit&) const {}
    __device__ __forceinline__ void done(const Unit&) const {}
};
template <class Epi, class Sched, bool ALIGN_EPI = false, bool SP2 = false, int QM = 0>
__device__ __forceinline__ void gemm_phase(PG8_LAS unsigned char* lds, const Gemm g, const Sched& S, const Epi& E) {
    int tid_ = threadIdx.x; asm volatile("" : "+v"(tid_));
    const int tid = tid_, wid = __builtin_amdgcn_readfirstlane(tid >> 6), lane = tid & 63, wr = wid >> 2, wc = wid & 3, fr = lane & 15, fq = lane >> 4;
    const int K = g.K, nt = K / BK, LD = g.ld ? g.ld : K;
    unsigned voffA[2], voffB[2];
#pragma unroll
    for (int i = 0; i < 2; ++i) { int R, C; stage_rc(tid * 16 + i * 8192, R, C); const int Rb = Epi::PERM ? ((R & ~31) + perm32(R & 31)) : R;
        voffA[i] = (unsigned)(R * LD + C) * 2u; voffB[i] = (unsigned)(Rb * LD + C) * 2u; }
    const size_t kstep = (size_t)(BK * 2);
    const size_t hstep = (size_t)HALF * LD * 2;
    const size_t tstep = 2 * hstep;
    const unsigned ldsw = (unsigned)wid * 1024u;
    const int aoff = lds_byte(wr * 64 + fr, fq * 8), boff = lds_byte(wc * 32 + fr, fq * 8);
#define PG8_SA(b, h) (((b) * 2 + (h)) * HTB)
#define PG8_SB(b, h) ((4 + (b) * 2 + (h)) * HTB)
#define PG8_STAGE(bufoff, gbase, voff) do { _Pragma("unroll") for (int _i = 0; _i < 2; ++_i) \
        __builtin_amdgcn_global_load_lds((const unsigned*)((const char*)(gbase) + (voff)[_i]), (PG8_LAS unsigned*)(lds + (bufoff) + ldsw + _i * 8192), 16, 0, 0); } while (0)
#define PG8_CAT(a, b) __builtin_shufflevector(__builtin_bit_cast(v4i_t, a), __builtin_bit_cast(v4i_t, b), 0, 1, 2, 3, 4, 5, 6, 7)
#define PG8_LDA(dst, b, h) do { _Pragma("unroll") for (int m = 0; m < 4; ++m) { const bf16x8 r0_ = *(const PG8_LAS bf16x8*)(lds + PG8_SA(b, h) + aoff + m * 2048), r1_ = *(const PG8_LAS bf16x8*)(lds + PG8_SA(b, h) + aoff + m * 2048 + 1024); \
        if constexpr (QM == 1) dst##8[m] = PG8_CAT(r0_, r1_); else { dst[m][0] = r0_; dst[m][1] = r1_; } } } while (0)
#define PG8_LDB(dst, b, h) do { _Pragma("unroll") for (int n = 0; n < 2; ++n) { const bf16x8 r0_ = *(const PG8_LAS bf16x8*)(lds + PG8_SB(b, h) + boff + n * 2048), r1_ = *(const PG8_LAS bf16x8*)(lds + PG8_SB(b, h) + boff + n * 2048 + 1024); \
        if constexpr (QM == 1) dst##8[n] = PG8_CAT(r0_, r1_); else { dst[n][0] = r0_; dst[n][1] = r1_; } } } while (0)
#define PG8_MMA(ai, bj, At, Bt) do { __builtin_amdgcn_s_setprio(1); _Pragma("unroll") for (int m = 0; m < 4; ++m) _Pragma("unroll") for (int n = 0; n < 2; ++n) { \
        if constexpr (QM == 2) { _Pragma("unroll") for (int k = 0; k < 2; ++k) acc[ai][bj][m][n] = __builtin_bit_cast(f32x4, __builtin_amdgcn_mfma_i32_16x16x64_i8(__builtin_bit_cast(v4i_t, Bt[n][k]), __builtin_bit_cast(v4i_t, At[m][k]), __builtin_bit_cast(v4i_t, acc[ai][bj][m][n]), 0, 0, 0)); } \
        else if constexpr (QM == 1) asm volatile("v_mfma_scale_f32_16x16x128_f8f6f4 %0, %1, %2, %0, %3, %4 op_sel_hi:[0,0,0]" : "+v"(acc[ai][bj][m][n]) : "v"(Bt##8[n]), "v"(At##8[m]), "v"(sbv), "v"(sav));   \
        else { _Pragma("unroll") for (int k = 0; k < 2; ++k) acc[ai][bj][m][n] = __builtin_amdgcn_mfma_f32_16x16x32_bf16(Bt[n][k], At[m][k], acc[ai][bj][m][n], 0, 0, 0); } } \
        __builtin_amdgcn_s_setprio(0); } while (0)
#define PG8_WAIT_V(n) asm volatile("s_waitcnt vmcnt(" #n ")" ::: "memory")
#define PG8_WAIT_L(n) asm volatile("s_waitcnt lgkmcnt(" #n ")" ::: "memory")
#define PG8_BAR __builtin_amdgcn_s_barrier()
#define PG8_SCHED __builtin_amdgcn_sched_barrier(0)
    Unit cur, nxt; int ui = 0;
    if (!S.next(0, cur)) return;
    f32x4 acc[2][2][4][2];
#pragma unroll
    for (int a = 0; a < 2; ++a)
#pragma unroll
        for (int b = 0; b < 2; ++b)
#pragma unroll
            for (int m = 0; m < 4; ++m)
#pragma unroll
                for (int n = 0; n < 2; ++n) acc[a][b][m][n] = (f32x4){0.f, 0.f, 0.f, 0.f};
    bf16x8 At[4][2], B0[2][2], B1[2][2];
    v8i_t At8[4], B08[2], B18[2];
    (void)At; (void)B0; (void)B1; (void)At8; (void)B08; (void)B18;
    const int sav = g.sa, sbv = g.sb; (void)sav; (void)sbv;
    const char* cA = (const char*)g.A + (size_t)cur.pm * tstep + cur.ko; const char* cB = (const char*)g.Bt + (size_t)cur.pn * tstep + cur.ko;
    S.a_ready(cur);
    if constexpr (SP2) {
        PG8_STAGE(PG8_SB(0, 0), cB, voffB); PG8_STAGE(PG8_SB(0, 1), cB + hstep, voffB); PG8_STAGE(PG8_SA(0, 0), cA, voffA); PG8_STAGE(PG8_SA(0, 1), cA + hstep, voffA);
        if (wr == 1) PG8_BAR;
        PG8_WAIT_V(2); PG8_BAR;
        PG8_STAGE(PG8_SB(1, 0), cB + kstep, voffB); PG8_STAGE(PG8_SA(1, 0), cA + kstep, voffA); PG8_STAGE(PG8_SB(1, 1), cB + hstep + kstep, voffB);
        PG8_WAIT_V(6); PG8_BAR;
    } else {
        PG8_STAGE(PG8_SB(0, 0), cB, voffB); PG8_STAGE(PG8_SA(0, 0), cA, voffA); PG8_STAGE(PG8_SB(0, 1), cB + hstep, voffB); PG8_STAGE(PG8_SA(0, 1), cA + hstep, voffA);
        if (wr == 1) PG8_BAR;
        PG8_WAIT_V(4); PG8_BAR;
        PG8_STAGE(PG8_SB(1, 0), cB + kstep, voffB); PG8_STAGE(PG8_SA(1, 0), cA + kstep, voffA); PG8_STAGE(PG8_SB(1, 1), cB + hstep + kstep, voffB);
        PG8_WAIT_V(6); PG8_BAR;
    }
    for (;;) {
        const bool has_next = S.next(ui + 1, nxt);
        const char* nA = has_next ? (const char*)g.A + (size_t)nxt.pm * tstep + nxt.ko : cA; const char* nB = has_next ? (const char*)g.Bt + (size_t)nxt.pn * tstep + nxt.ko : cB;
        for (int t = 0; t < nt; t += 2) {
            const bool last = (t == nt - 2);
            const char* a1 = cA + (size_t)(t + 1) * kstep;
            const char* a2 = last ? nA : cA + (size_t)(t + 2) * kstep; const char* b2 = last ? nB : cB + (size_t)(t + 2) * kstep;
            const char* a3 = a2 + kstep; const char* b3 = b2 + kstep;
            if (last && has_next) S.a_ready(nxt);
            if constexpr (SP2) {
            PG8_LDB(B0, 0, 0); PG8_LDB(B1, 0, 1); PG8_SCHED; PG8_LDA(At, 0, 0); PG8_STAGE(PG8_SA(1, 1), a1 + hstep, voffA);
            PG8_WAIT_V(8); PG8_WAIT_L(0); PG8_BAR; PG8_MMA(0, 0, At, B0); PG8_MMA(0, 1, At, B1); PG8_BAR; PG8_SCHED;
            PG8_LDA(At, 0, 1); PG8_STAGE(PG8_SB(0, 0), b2, voffB); PG8_STAGE(PG8_SB(0, 1), b2 + hstep, voffB); PG8_STAGE(PG8_SA(0, 0), a2, voffA);
            PG8_WAIT_V(8); PG8_WAIT_L(0); PG8_BAR; PG8_MMA(1, 0, At, B0); PG8_MMA(1, 1, At, B1); PG8_BAR; PG8_SCHED;
            PG8_LDB(B0, 1, 0); PG8_LDB(B1, 1, 1); PG8_SCHED; PG8_LDA(At, 1, 0); PG8_STAGE(PG8_SA(0, 1), a2 + hstep, voffA);
            PG8_WAIT_V(8); PG8_WAIT_L(0); PG8_BAR; PG8_MMA(0, 0, At, B0); PG8_MMA(0, 1, At, B1); PG8_BAR; PG8_SCHED;
            PG8_LDA(At, 1, 1); PG8_STAGE(PG8_SB(1, 0), b3, voffB); PG8_STAGE(PG8_SB(1, 1), b3 + hstep, voffB); PG8_STAGE(PG8_SA(1, 0), a3, voffA);
            PG8_WAIT_V(8); PG8_WAIT_L(0); PG8_BAR; PG8_MMA(1, 0, At, B0); PG8_MMA(1, 1, At, B1); PG8_BAR; PG8_SCHED;
            } else {
            PG8_LDB(B0, 0, 0); PG8_SCHED; PG8_LDA(At, 0, 0); PG8_STAGE(PG8_SA(1, 1), a1 + hstep, voffA);
            PG8_WAIT_L(8); PG8_BAR; PG8_WAIT_L(0); PG8_MMA(0, 0, At, B0); PG8_BAR; PG8_SCHED;
            PG8_LDB(B1, 0, 1); PG8_STAGE(PG8_SB(0, 0), b2, voffB);
            PG8_BAR; PG8_WAIT_L(0); PG8_MMA(0, 1, At, B1); PG8_BAR;
            PG8_LDA(At, 0, 1); PG8_STAGE(PG8_SA(0, 0), a2, voffA);
            PG8_BAR; PG8_WAIT_L(0); PG8_MMA(1, 0, At, B0); PG8_BAR; PG8_SCHED;
            PG8_STAGE(PG8_SB(0, 1), b2 + hstep, voffB);
            PG8_WAIT_V(6); PG8_BAR; PG8_MMA(1, 1, At, B1); PG8_BAR;
            PG8_LDB(B0, 1, 0); PG8_SCHED; PG8_LDA(At, 1, 0); PG8_STAGE(PG8_SA(0, 1), a2 + hstep, voffA);
            PG8_WAIT_L(8); PG8_BAR; PG8_WAIT_L(0); PG8_MMA(0, 0, At, B0); PG8_BAR; PG8_SCHED;
            PG8_LDB(B1, 1, 1); PG8_STAGE(PG8_SB(1, 0), b3, voffB);
            PG8_BAR; PG8_WAIT_L(0); PG8_MMA(0, 1, At, B1); PG8_BAR;
            PG8_LDA(At, 1, 1); PG8_STAGE(PG8_SA(1, 0), a3, voffA);
            PG8_BAR; PG8_WAIT_L(0); PG8_MMA(1, 0, At, B0); PG8_BAR; PG8_SCHED;
            PG8_STAGE(PG8_SB(1, 1), b3 + hstep, voffB);
            PG8_WAIT_V(6); PG8_BAR; PG8_MMA(1, 1, At, B1); PG8_BAR;
            }
        }
        if constexpr (ALIGN_EPI) { if (wr == 0) PG8_BAR; }
        if constexpr (!Epi::AFTER_DRAIN) { E(acc, cur, wr, wc, fr, fq); S.done(cur); }
        if (!has_next) break;
#pragma unroll
        for (int a = 0; a < 2; ++a)
#pragma unroll
            for (int b = 0; b < 2; ++b)
#pragma unroll
                for (int m = 0; m < 4; ++m)
#pragma unroll
                    for (int n = 0; n < 2; ++n) acc[a][b][m][n] = (f32x4){0.f, 0.f, 0.f, 0.f};
        cur = nxt; cA = nA; cB = nB; ++ui;
        if constexpr (ALIGN_EPI) { if (wr == 1) PG8_BAR; }
    }
    PG8_WAIT_V(0);
    if constexpr (!ALIGN_EPI) { if (wr == 0) PG8_BAR; }
    PG8_BAR;
    if constexpr (Epi::AFTER_DRAIN) { E.fused(acc, cur, wr, wc, fr, fq, lds, wid, lane); S.done(cur); }
#undef PG8_SA
#undef PG8_SB
#undef PG8_STAGE
#undef PG8_LDA
#undef PG8_LDB
#undef PG8_MMA
#undef PG8_CAT
#undef PG8_WAIT_V
#undef PG8_WAIT_L
#undef PG8_BAR
#undef PG8_SCHED
}
}
#include <hip/hip_bf16.h>
#include <hip/hip_bf16.h>
#include <cmath>
namespace attn_body {
using bf16=__hip_bfloat16;
using bf16x8=__attribute__((ext_vector_type(8)))short;
using s16x4=__attribute__((ext_vector_type(4)))short;
using f32x16=__attribute__((ext_vector_type(16)))float;
using u32x4=__attribute__((ext_vector_type(4)))unsigned;
constexpr int BATCH=4,NHEAD=16,SEQ=4096,D=64,DM=NHEAD*D;
constexpr int NW=8,QBLK=32,QB=QBLK*NW,KVBLK=64,NQB=SEQ/QB;
constexpr int ATTN_PITCH=DM, ATTN_UNIT_ROWS=QB;
__device__ __forceinline__ int crow(int r,int hi){return (r&3)+8*(r>>2)+4*hi;}
#define SBAR() __builtin_amdgcn_sched_barrier(0)
__device__ __forceinline__ void cmask(f32x16&p0,f32x16&p1,int jb,int qrel,int hi){
  const float NEG=-INFINITY; int kb=64*jb+4*hi;
  #pragma unroll
  for(int r=0;r<16;++r){int kv=kb+(r&3)+8*(r>>2); if(kv>qrel)p0[r]=NEG; if(kv+32>qrel)p1[r]=NEG;}
}

constexpr int NSLOT=3, SLOTB=8192, SLOTV=16384;
constexpr int LDS_K=0, LDS_V=NSLOT*SLOTB, LDS_WS=LDS_V+NSLOT*SLOTV, LDS_OST=LDS_WS+NW*64*4, LDS_BYTES=LDS_OST;
constexpr float C2=0.125f*1.4426950408889634f;
__device__ __forceinline__ void glds16(const void*gsrc,unsigned lds_dst){unsigned keep;
  asm volatile("s_mov_b32 %0, m0\n\ts_mov_b32 m0, %2\n\ts_nop 0\n\tglobal_load_lds_dwordx4 %1, off\n\ts_mov_b32 m0, %0":"=&s"(keep):"v"(gsrc),"s"(lds_dst):"memory");}
__device__ __forceinline__ float max3f(float a,float b,float c){float r;asm("v_max3_f32 %0, %1, %2, %3":"=v"(r):"v"(a),"v"(b),"v"(c));return r;}
__device__ __forceinline__ float max2f(float a,float b){float r;asm("v_max_f32_e32 %0, %1, %2":"=v"(r):"v"(a),"v"(b));return r;}
__device__ __forceinline__ float fadd_s(float a,float b){float r;asm("v_add_f32_e32 %0, %1, %2":"=v"(r):"v"(a),"v"(b));return r;}
__device__ __forceinline__ float fsub_s(float a,float b){float r;asm("v_sub_f32_e32 %0, %1, %2":"=v"(r):"v"(a),"v"(b));return r;}
typedef float f32x2_t __attribute__((ext_vector_type(2))); typedef __bf16 bf16x2_t __attribute__((ext_vector_type(2)));
__device__ __forceinline__ unsigned cvtpk_s(float lo,float hi){f32x2_t v={lo,hi};bf16x2_t b=__builtin_convertvector(v,bf16x2_t);return __builtin_bit_cast(unsigned,b);}
#define WAIT_BAR(N) asm volatile("s_waitcnt vmcnt(" #N ") lgkmcnt(0)\n\ts_barrier":::"memory")

__device__ __forceinline__ void qkt(f32x16&p0,f32x16&p1,const char*Kslot,const bf16x8*qr,int r32,int hi){ const f32x16 negm=f32x16{};
  const char*kb=Kslot+hi*1024+r32*16;
  #pragma unroll
  for(int d0=0;d0<4;++d0){
    const bf16x8 b0=*reinterpret_cast<const bf16x8*>(kb+d0*2048);
    const bf16x8 b1=*reinterpret_cast<const bf16x8*>(kb+d0*2048+512);
    if(d0==0){p0=__builtin_amdgcn_mfma_f32_32x32x16_bf16(b0,qr[0],negm,0,0,0);p1=__builtin_amdgcn_mfma_f32_32x32x16_bf16(b1,qr[0],negm,0,0,0);}
    else{p0=__builtin_amdgcn_mfma_f32_32x32x16_bf16(b0,qr[d0],p0,0,0,0);p1=__builtin_amdgcn_mfma_f32_32x32x16_bf16(b1,qr[d0],p1,0,0,0);}}
}
typedef __attribute__((address_space(3))) const char* lds_cptr;
typedef short v4i16_t __attribute__((ext_vector_type(4)));
__device__ __forceinline__ void kload8(bf16x8*kf,lds_cptr kp){
  kf[0]=*(const __attribute__((address_space(3))) bf16x8*)(kp);      kf[1]=*(const __attribute__((address_space(3))) bf16x8*)(kp+512);
  kf[2]=*(const __attribute__((address_space(3))) bf16x8*)(kp+2048); kf[3]=*(const __attribute__((address_space(3))) bf16x8*)(kp+2560);
  kf[4]=*(const __attribute__((address_space(3))) bf16x8*)(kp+4096); kf[5]=*(const __attribute__((address_space(3))) bf16x8*)(kp+4608);
  kf[6]=*(const __attribute__((address_space(3))) bf16x8*)(kp+6144); kf[7]=*(const __attribute__((address_space(3))) bf16x8*)(kp+6656);
}
__device__ __forceinline__ void kload2(bf16x8*kf,lds_cptr kp,int j){ kf[2*j]=*(const __attribute__((address_space(3))) bf16x8*)(kp+j*2048); kf[2*j+1]=*(const __attribute__((address_space(3))) bf16x8*)(kp+j*2048+512); }
__device__ __forceinline__ s16x4 vtr(lds_cptr p){ return __builtin_bit_cast(s16x4,__builtin_amdgcn_ds_read_tr16_b64_v4i16((__attribute__((address_space(3))) v4i16_t*)p)); }
__device__ __forceinline__ float rowmax(const f32x16&p0,const f32x16&p1){
  float a=max3f(p0[0],p0[1],p1[0]),b=max3f(p0[2],p0[3],p1[1]);a=max3f(a,p1[2],p1[3]);
  #pragma unroll
  for(int r=4;r<16;r+=4){a=max3f(a,p0[r],p0[r+1]);b=max3f(b,p0[r+2],p0[r+3]);a=max3f(a,p1[r],p1[r+1]);b=max3f(b,p1[r+2],p1[r+3]);}
  const float m=max2f(a,b);
  auto rr=__builtin_amdgcn_permlane32_swap(__float_as_uint(m),__float_as_uint(m),false,false);
  return max2f(__uint_as_float(rr[0]),__uint_as_float(rr[1]));
}
__device__ __forceinline__ void pv(f32x16*o,int vb,bf16x8 pa0,bf16x8 pa1,bf16x8 pa2,bf16x8 pa3){
  #pragma unroll
  for(int d0=0;d0<4;++d0){s16x4 lo[4],hi[4];
    #pragma unroll
    for(int ks=0;ks<4;++ks){
      asm volatile("ds_read_b64_tr_b16 %0,%1 offset:%c2":"=&v"(lo[ks]):"v"(vb),"i"(d0*4096+ks*1024):"memory");
      asm volatile("ds_read_b64_tr_b16 %0,%1 offset:%c2":"=&v"(hi[ks]):"v"(vb),"i"(d0*4096+ks*1024+512):"memory");}
    asm volatile("s_waitcnt lgkmcnt(0)":::"memory");SBAR();
    #define PK(k) (bf16x8){lo[k][0],lo[k][1],lo[k][2],lo[k][3],hi[k][0],hi[k][1],hi[k][2],hi[k][3]}
    o[d0]=__builtin_amdgcn_mfma_f32_32x32x16_bf16(pa0,PK(0),o[d0],0,0,0);
    o[d0]=__builtin_amdgcn_mfma_f32_32x32x16_bf16(pa1,PK(1),o[d0],0,0,0);
    o[d0]=__builtin_amdgcn_mfma_f32_32x32x16_bf16(pa2,PK(2),o[d0],0,0,0);
    o[d0]=__builtin_amdgcn_mfma_f32_32x32x16_bf16(pa3,PK(3),o[d0],0,0,0);
    #undef PK
  }
}

#ifndef ATTN_STORE16
#define ATTN_STORE16(p,v) (*(u32x4*)(p)=(v))
#endif
template<int THRL> __device__ __forceinline__ void attn_unit(bool FUSE,int b,int h,int hv,int qb,const bf16*Q,const bf16*__restrict__ K,const bf16*__restrict__ V,bf16*O,const bf16*O2,float lam,const float*gsub,char*shm){
  int tid_=threadIdx.x; asm volatile("":"+v"(tid_)); const int tid=tid_,lane=tid&63,r32=lane&31,hi=lane>>5; const int wid=__builtin_amdgcn_readfirstlane(tid>>6);
  const long rowbase=(long)b*SEQ; const int q0=qb*QB;
  const bf16*Qw=Q+(rowbase+q0+wid*QBLK)*DM+h*D;
  const bf16*Kh=K+rowbase*DM+h*D,*Vh=V+rowbase*DM+hv*2*D;
  const unsigned lds0=(unsigned)(uintptr_t)shm;
  float*wsf=(float*)(shm+LDS_WS)+wid*64;
  const bf16*ksrc=Kh+(long)lane*DM+wid*8;
  const bf16*vsrc=Vh+(long)(16*(wid&3)+(lane>>2))*DM+(wid>>2)*32+(lane&3)*8;
  const unsigned kdst=lds0+LDS_K+wid*1024, vdst=lds0+LDS_V+wid*1024;
  #define DMA_K(t,slot) glds16(ksrc+(long)(t)*KVBLK*DM,(unsigned)__builtin_amdgcn_readfirstlane(kdst+(slot)))
  #define DMA_V(t,slot) do{ glds16(vsrc+(long)(t)*KVBLK*DM,(unsigned)__builtin_amdgcn_readfirstlane(vdst+2*(slot))); glds16(vsrc+(long)(t)*KVBLK*DM+64,(unsigned)__builtin_amdgcn_readfirstlane(vdst+2*(slot)+8192)); }while(0)
  const int vb0=(int)(lds0+LDS_V)+((lane>>4)&1)*32+(lane&3)*8+(4*hi+((lane&15)>>2))*64;
  const char*Kbase=shm+LDS_K; bf16x8 kf[8];
  const lds_cptr shm3=(lds_cptr)shm; const lds_cptr kp0=shm3+LDS_K+hi*1024+r32*16; const lds_cptr vp0=shm3+LDS_V+((lane>>4)&1)*32+(lane&3)*8+(4*hi+((lane&15)>>2))*64;
  const int NT=(q0+QB)/KVBLK;
  DMA_K(0,0);DMA_V(0,0);DMA_K(1,SLOTB);
  bf16x8 qr[4];
  #pragma unroll
  for(int d0=0;d0<4;++d0)qr[d0]=*reinterpret_cast<const bf16x8*>(&Qw[(long)r32*DM+d0*16+hi*8]);
  float mhat=0.f,l_reg=0.f;f32x16 o[4];o[0]=f32x16{};o[1]=f32x16{};o[2]=f32x16{};o[3]=f32x16{};const f32x16 ZERO16=f32x16{};
  const int qrel=wid*QBLK+r32;
  #define CMASK(P0,P1,t) do{int jb_=(t)-(NT-4); if(jb_>=0)cmask(P0,P1,jb_,qrel,hi);}while(0)
  bool resc=false;
  #define START(P0,P1) do{ const float rm=rowmax(P0,P1); resc=false; \
    { const float dl=rm; mhat=fadd_s(mhat,dl); \
      _Pragma("unroll") for(int r=0;r<16;++r){P0[r]=fsub_s(P0[r],dl);P1[r]=fsub_s(P1[r],dl);} \
      } \
    _Pragma("unroll") for(int r=0;r<16;++r)P0[r]=__builtin_amdgcn_exp2f(P0[r]); }while(0)
  #define RESC() do{ if(resc){ asm volatile("s_waitcnt lgkmcnt(0)":::"memory"); \
      _Pragma("unroll") for(int d_=0;d_<4;++d_) _Pragma("unroll") for(int r=0;r<16;++r)o[d_][r]*=wsf[crow(r,hi)]; } }while(0)
  f32x16 pA0,pA1,pB0,pB1;
  int sl_prev=0,sl_cur=0,sl_next=SLOTB;
  #define ROT() do{sl_prev=sl_cur;sl_cur=sl_next;sl_next=(sl_next==(NSLOT-1)*SLOTB)?0:sl_next+SLOTB;}while(0)
  DMA_K(2,2*SLOTB);
  WAIT_BAR(3);
  qkt(pA0,pA1,Kbase,qr,r32,hi);asm volatile("s_nop 15\n\ts_nop 7":"+v"(pA0),"+v"(pA1));CMASK(pA0,pA1,0);
  START(pA0,pA1);
  _Pragma("unroll") for(int r=0;r<16;++r)pA1[r]=__builtin_amdgcn_exp2f(pA1[r]);
  WAIT_BAR(0);
  DMA_K(3,0);DMA_V(1,SLOTB);
  ROT();
  kload8(kf,kp0+sl_cur);
  WAIT_BAR(3);
  s16x4 vlo[8],vhi[8]; u32x4 pw0,pw1,pw2,pw3;
  #define PKW(P,B) cvtpk_s(P[B],P[B+1])
  #define PAF(k) __builtin_bit_cast(bf16x8,pw##k)
  #define VFR(i) (bf16x8){vlo[i][0],vlo[i][1],vlo[i][2],vlo[i][3],vhi[i][0],vhi[i][1],vhi[i][2],vhi[i][3]}
  #define PIN(x) asm volatile("":"+v"(x))
  #define MX3(a,b,c) __builtin_fmaxf(__builtin_fmaxf((a),(b)),(c))
  #define GAPA(MF,A0,A1,A2,A3,W0,W1,PW) do{ MF; sacc+=A0; sacc+=A1; sacc+=A2; sacc+=A3; PIN(sacc); W0; W1; PIN(PW); SBAR(); }while(0)
  #define EX(v) __builtin_amdgcn_exp2f(v)
  #define GAPB(MF,RD,X,B) do{ MF; RD; X[B]=EX(X[B]-mhat); X[B+1]=EX(X[B+1]-mhat); PIN(X); SBAR(); }while(0)
  #define VRD(i) do{ vlo[i]=vtr(vp_+(((i)>>2)*4096+((i)&3)*1024)); vhi[i]=vtr(vp_+(((i)>>2)*4096+((i)&3)*1024+512)); }while(0)
  #define VRD2(i) do{ vlo[i]=vtr(vp_+(8192+((i)>>2)*4096+((i)&3)*1024)); vhi[i]=vtr(vp_+(8192+((i)>>2)*4096+((i)&3)*1024+512)); }while(0)
  #define KRD(G,j) do{ if(G){ kload2(kf,kp0+sl_next,j); SBAR(); } }while(0)
  #define STEP(C0,C1,P0,P1,t,GK,GV,GL) do{ SBAR(); \
    const lds_cptr vp_=vp0+2*sl_prev; \
    VRD(0); SBAR(); float sacc=(P0[0]+P0[1]); \
    GAPA(C0=__builtin_amdgcn_mfma_f32_32x32x16_bf16(kf[0],qr[0],ZERO16,0,0,0), P0[2],P0[3],P0[4],P0[5],     pw0[0]=PKW(P0,0), pw0[1]=PKW(P0,2), pw0); \
    VRD(4); SBAR(); GAPA(C1=__builtin_amdgcn_mfma_f32_32x32x16_bf16(kf[1],qr[0],ZERO16,0,0,0), P0[6],P0[7],P0[8],P0[9],     pw0[2]=PKW(P0,4), pw0[3]=PKW(P0,6), pw0); \
    VRD(1); SBAR(); GAPA(C0=__builtin_amdgcn_mfma_f32_32x32x16_bf16(kf[2],qr[1],C0,0,0,0),   P0[10],P0[11],P0[12],P0[13], pw1[0]=PKW(P0,8), pw1[1]=PKW(P0,10), pw1); \
    VRD(5); SBAR(); GAPA(C1=__builtin_amdgcn_mfma_f32_32x32x16_bf16(kf[3],qr[1],C1,0,0,0),   P0[14],P0[15],P1[0],P1[1],   pw1[2]=PKW(P0,12),pw1[3]=PKW(P0,14), pw1); \
    VRD(2); SBAR(); GAPA(C0=__builtin_amdgcn_mfma_f32_32x32x16_bf16(kf[4],qr[2],C0,0,0,0),   P1[2],P1[3],P1[4],P1[5],     pw2[0]=PKW(P1,0), pw2[1]=PKW(P1,2), pw2); \
    VRD(6); SBAR(); GAPA(C1=__builtin_amdgcn_mfma_f32_32x32x16_bf16(kf[5],qr[2],C1,0,0,0),   P1[6],P1[7],P1[8],P1[9],     pw2[2]=PKW(P1,4), pw2[3]=PKW(P1,6), pw2); \
    VRD(3); SBAR(); GAPA(C0=__builtin_amdgcn_mfma_f32_32x32x16_bf16(kf[6],qr[3],C0,0,0,0),   P1[10],P1[11],P1[12],P1[13], pw3[0]=PKW(P1,8), pw3[1]=PKW(P1,10), pw3); \
    VRD(7); SBAR(); GAPA(C1=__builtin_amdgcn_mfma_f32_32x32x16_bf16(kf[7],qr[3],C1,0,0,0),   P1[14],P1[15],0.f,0.f,       pw3[2]=PKW(P1,12),pw3[3]=PKW(P1,14), pw3); \
    l_reg+=sacc; \
    if(GK){DMA_K((t)+3,sl_cur);} if(GV){DMA_V((t)+1,sl_next);} \
    CMASK(C0,C1,t); \
    { float a=MX3(C0[0],C0[1],C1[0]),b=MX3(C0[2],C0[3],C1[1]); a=MX3(a,C1[2],C1[3]); \
      _Pragma("unroll") for(int r=4;r<16;r+=4){a=MX3(a,C0[r],C0[r+1]);b=MX3(b,C0[r+2],C0[r+3]);a=MX3(a,C1[r],C1[r+1]);b=MX3(b,C1[r+2],C1[r+3]);} \
      float rm=__builtin_fmaxf(a,b); { auto rr=__builtin_amdgcn_permlane32_swap(__float_as_uint(rm),__float_as_uint(rm),false,false); rm=__builtin_fmaxf(__uint_as_float(rr[0]),__uint_as_float(rr[1])); } \
      resc=false; rm-=mhat;   \
      if(__builtin_expect(__any(rm>(float)THRL),0)){ const float dl=__builtin_fmaxf(rm,0.f); mhat+=dl; \
        const float f=__builtin_amdgcn_exp2f(-dl); l_reg*=f; if(hi==0)wsf[r32]=f; resc=true; } } \
    SBAR(); \
    GAPB(o[0]=__builtin_amdgcn_mfma_f32_32x32x16_bf16(PAF(0),VFR(0),o[0],0,0,0), VRD2(0), C0,0); \
    GAPB(o[1]=__builtin_amdgcn_mfma_f32_32x32x16_bf16(PAF(0),VFR(4),o[1],0,0,0), VRD2(4), C0,2); \
    GAPB(o[0]=__builtin_amdgcn_mfma_f32_32x32x16_bf16(PAF(1),VFR(1),o[0],0,0,0), VRD2(1), C0,4); \
    GAPB(o[1]=__builtin_amdgcn_mfma_f32_32x32x16_bf16(PAF(1),VFR(5),o[1],0,0,0), VRD2(5), C0,6); \
    GAPB(o[0]=__builtin_amdgcn_mfma_f32_32x32x16_bf16(PAF(2),VFR(2),o[0],0,0,0), VRD2(2), C0,8); \
    GAPB(o[1]=__builtin_amdgcn_mfma_f32_32x32x16_bf16(PAF(2),VFR(6),o[1],0,0,0), VRD2(6), C0,10); \
    GAPB(o[0]=__builtin_amdgcn_mfma_f32_32x32x16_bf16(PAF(3),VFR(3),o[0],0,0,0), VRD2(3), C0,12); \
    GAPB(o[1]=__builtin_amdgcn_mfma_f32_32x32x16_bf16(PAF(3),VFR(7),o[1],0,0,0), VRD2(7), C0,14); \
    KRD(GL,0); GAPB(o[2]=__builtin_amdgcn_mfma_f32_32x32x16_bf16(PAF(0),VFR(0),o[2],0,0,0), (void)0, C1,0); \
    GAPB(o[3]=__builtin_amdgcn_mfma_f32_32x32x16_bf16(PAF(0),VFR(4),o[3],0,0,0), (void)0, C1,2); \
    KRD(GL,1); GAPB(o[2]=__builtin_amdgcn_mfma_f32_32x32x16_bf16(PAF(1),VFR(1),o[2],0,0,0), (void)0, C1,4); \
    GAPB(o[3]=__builtin_amdgcn_mfma_f32_32x32x16_bf16(PAF(1),VFR(5),o[3],0,0,0), (void)0, C1,6); \
    KRD(GL,2); GAPB(o[2]=__builtin_amdgcn_mfma_f32_32x32x16_bf16(PAF(2),VFR(2),o[2],0,0,0), (void)0, C1,8); \
    GAPB(o[3]=__builtin_amdgcn_mfma_f32_32x32x16_bf16(PAF(2),VFR(6),o[3],0,0,0), (void)0, C1,10); \
    KRD(GL,3); GAPB(o[2]=__builtin_amdgcn_mfma_f32_32x32x16_bf16(PAF(3),VFR(3),o[2],0,0,0), (void)0, C1,12); \
    GAPB(o[3]=__builtin_amdgcn_mfma_f32_32x32x16_bf16(PAF(3),VFR(7),o[3],0,0,0), (void)0, C1,14); \
    }while(0)
  int t=1;
  #undef CMASK
  #define CMASK(P0,P1,t) do{}while(0)
  for(;t+5<NT;t+=2){
    STEP(pB0,pB1,pA0,pA1,t,true,true,true);     WAIT_BAR(3); RESC(); ROT();
    STEP(pA0,pA1,pB0,pB1,t+1,true,true,true);   WAIT_BAR(3); RESC(); ROT();
  }
  #undef CMASK
  #define CMASK(P0,P1,t) do{int jb_=(t)-(NT-4); if(jb_>=0)cmask(P0,P1,jb_,qrel,hi);}while(0)
  #define ENDW(tt) do{ if((tt)+3<NT){WAIT_BAR(3);} else if((tt)+2<NT){WAIT_BAR(2);} else {WAIT_BAR(0);} }while(0)
  for(;t+1<NT;t+=2){
    STEP(pB0,pB1,pA0,pA1,t,(t+3<NT),(t+1<NT),(t+1<NT));       ENDW(t);   RESC(); ROT();
    STEP(pA0,pA1,pB0,pB1,t+1,(t+4<NT),(t+2<NT),(t+2<NT));     ENDW(t+1); RESC(); ROT();
  }
  STEP(pB0,pB1,pA0,pA1,NT-1,false,false,false); RESC();
  { float sacc=pB0[0]+pB0[1]; _Pragma("unroll") for(int r=2;r<16;++r)sacc+=pB0[r]; _Pragma("unroll") for(int r=0;r<16;++r)sacc+=pB1[r]; l_reg+=sacc;
    pw0=(u32x4){PKW(pB0,0),PKW(pB0,2),PKW(pB0,4),PKW(pB0,6)};pw1=(u32x4){PKW(pB0,8),PKW(pB0,10),PKW(pB0,12),PKW(pB0,14)};pw2=(u32x4){PKW(pB1,0),PKW(pB1,2),PKW(pB1,4),PKW(pB1,6)};pw3=(u32x4){PKW(pB1,8),PKW(pB1,10),PKW(pB1,12),PKW(pB1,14)};
    SBAR(); pv(o,vb0+2*sl_cur,PAF(0),PAF(1),PAF(2),PAF(3)); }
  #undef PKW
  #undef PAF
  #undef VFR
  #undef PIN
  #undef MX3
  #undef GAPA
  #undef GAPB
  #undef EX
  #undef VRD
  #undef VRD2
  #undef KRD
  #undef STEP
  #undef ENDW
  {auto rr=__builtin_amdgcn_permlane32_swap(__float_as_uint(l_reg),__float_as_uint(l_reg),false,false);l_reg=__uint_as_float(rr[0])+__uint_as_float(rr[1]);}
  if(hi==0)wsf[32+r32]=l_reg;asm volatile("s_waitcnt lgkmcnt(0)":::"memory");
  float rli[16];
  #pragma unroll
  for(int r=0;r<16;++r)rli[r]=__builtin_amdgcn_rcpf(wsf[32+crow(r,hi)]);
  bf16*Ow=O+(rowbase+q0+wid*QBLK)*DM+hv*2*D;
  asm volatile("s_waitcnt lgkmcnt(0)\n\ts_barrier":::"memory");
  { bf16*stg=(bf16*)(shm+LDS_K)+wid*4096;
    const bf16*O2w=O2+(rowbase+q0+wid*QBLK)*DM+hv*2*D;
    #pragma unroll
    for(int r=0;r<16;++r){const int orow=crow(r,hi);
      #pragma unroll
      for(int d0=0;d0<4;++d0)stg[orow*128+d0*32+r32]=__float2bfloat16(o[d0][r]*rli[r]);}
    asm volatile("s_waitcnt lgkmcnt(0)":::"memory");
    #pragma unroll
    for(int i=0;i<4;++i){const int row=i*8+(lane>>3),ch=lane&7;
      const u32x4 v0=*(const u32x4*)(stg+row*128+ch*8), v1=*(const u32x4*)(stg+row*128+64+ch*8);
      if(!FUSE){ ATTN_STORE16(Ow+(long)row*DM+ch*8,v0); ATTN_STORE16(Ow+(long)row*DM+64+ch*8,v1); }
      else{ const u32x4 t0=*(const u32x4*)(O2w+(long)row*DM+ch*8), t1=*(const u32x4*)(O2w+(long)row*DM+64+ch*8);
        float c[16]; float ss=0.f;
        #pragma unroll
        for(int k=0;k<4;++k){ c[2*k]=__uint_as_float(v0[k]<<16)-lam*__uint_as_float(t0[k]<<16); c[2*k+1]=__uint_as_float(v0[k]&0xffff0000u)-lam*__uint_as_float(t0[k]&0xffff0000u);
          c[8+2*k]=__uint_as_float(v1[k]<<16)-lam*__uint_as_float(t1[k]<<16); c[8+2*k+1]=__uint_as_float(v1[k]&0xffff0000u)-lam*__uint_as_float(t1[k]&0xffff0000u); }
        #pragma unroll
        for(int k=0;k<16;++k)ss+=c[k]*c[k];
        ss+=__int_as_float(__builtin_amdgcn_ds_swizzle(__float_as_int(ss),(1<<10)|0x1f)); ss+=__int_as_float(__builtin_amdgcn_ds_swizzle(__float_as_int(ss),(2<<10)|0x1f)); ss+=__int_as_float(__builtin_amdgcn_ds_swizzle(__float_as_int(ss),(4<<10)|0x1f));
        const float rs=__builtin_amdgcn_rsqf(ss*(1.f/128.f)+1e-6f);
        const float4 g0=*(const float4*)(gsub+ch*8), g1=*(const float4*)(gsub+ch*8+4), g2=*(const float4*)(gsub+64+ch*8), g3=*(const float4*)(gsub+64+ch*8+4);
        u32x4 w0,w1;
        w0[0]=cvtpk_s(c[0]*rs*g0.x,c[1]*rs*g0.y); w0[1]=cvtpk_s(c[2]*rs*g0.z,c[3]*rs*g0.w); w0[2]=cvtpk_s(c[4]*rs*g1.x,c[5]*rs*g1.y); w0[3]=cvtpk_s(c[6]*rs*g1.z,c[7]*rs*g1.w);
        w1[0]=cvtpk_s(c[8]*rs*g2.x,c[9]*rs*g2.y); w1[1]=cvtpk_s(c[10]*rs*g2.z,c[11]*rs*g2.w); w1[2]=cvtpk_s(c[12]*rs*g3.x,c[13]*rs*g3.y); w1[3]=cvtpk_s(c[14]*rs*g3.z,c[15]*rs*g3.w);
        ATTN_STORE16(Ow+(long)row*DM+ch*8,w0); ATTN_STORE16(Ow+(long)row*DM+64+ch*8,w1); } } }
  asm volatile("s_waitcnt lgkmcnt(0)\n\ts_barrier":::"memory");
  #undef DMA_K
  #undef DMA_V
  #undef CMASK
  #undef START
  #undef RESC
  #undef ROT
}
constexpr int ATTN_LDS_BYTES=LDS_BYTES;
struct AttnTensors { const bf16* Q; const bf16* K; const bf16* V; bf16* O2; bf16* YB; };
template<int THRL=8> __device__ __forceinline__ void attn_phase(char*lds,const AttnTensors&T,float lam,const float*gsub,int vcu,int ncu){
  const int bh=(vcu&255)>>3, s=vcu&7; const int b=bh>>3, h=bh&7;
  const float lam_u=__uint_as_float(__builtin_amdgcn_readfirstlane(__float_as_uint(lam)));
  for(int i=0;i<4;++i){ const int qb=(i&2)?15-s:s; const bool fuse=(i&1)!=0;
    attn_unit<THRL>(fuse,b,fuse?2*h:2*h+1,h,qb,T.Q,T.K,T.V,fuse?T.YB:T.O2,T.O2,lam_u,gsub,lds);
  }
}
#undef SBAR
#undef WAIT_BAR
}
constexpr int NWAVES = 8;
#ifndef MK_MULTI
#define MK_MULTI 0
#endif
constexpr int NB = 4, SEQ = 4096, T = NB * SEQ, D = 1024, DIN = 7168, FF = 3584, NEXP = 8, PLE = 256, DEPTH = 2;
constexpr int NPAN = T / 256;
constexpr float EPS = 1e-6f;
constexpr int MOE_ROWS = 2 * T + NEXP * 256;
constexpr int MOE_PANELS = MOE_ROWS / 256, MOE_HALF = MOE_PANELS / 2;
constexpr size_t MiB = 1u << 20;
constexpr size_t WS_CTL = 0, CTL_ZERO_BYTES = 1 * MiB;
constexpr size_t WS_LRUW = 1 * MiB;
constexpr size_t WS_PAR = 1 * MiB + 512 * 1024;
constexpr size_t WS_SUM = 2 * MiB;
constexpr size_t WS_TOK = 4 * MiB;
constexpr size_t WS_LIST = 5 * MiB;
constexpr size_t WS_COS = 6 * MiB;
constexpr size_t WS_WSMALL = 10 * MiB;
constexpr size_t WL_STRIDE = 45 * MiB / 2, WL_WIN = 0, WL_WAB = 14 * MiB, WL_WO = 18 * MiB, WL_WPG = 20 * MiB, WL_WPP = 22 * MiB;
constexpr size_t WS_WGU = WS_WSMALL + 45 * MiB, WS_WD = WS_WGU + 14 * MiB;
constexpr size_t WS_PB = 76 * MiB;
constexpr size_t WS_H = 92 * MiB;
constexpr size_t WS_BIG = 124 * MiB, SLOT = 32 * MiB;
constexpr size_t WS_GG = WS_BIG, WS_RIN = WS_BIG + SLOT, WS_Q = WS_BIG + 2 * SLOT, WS_K = WS_BIG + 3 * SLOT, WS_V = WS_BIG + 4 * SLOT, WS_SGA = WS_BIG + 5 * SLOT, WS_SGB = WS_BIG + 6 * SLOT;
constexpr size_t WS_HL = WS_BIG + 7 * SLOT, WS_LP = WS_BIG + 8 * SLOT, WS_O1 = WS_BIG + 9 * SLOT, WS_O2 = WS_BIG + 10 * SLOT;
constexpr size_t WS_YA = WS_RIN, WS_YB = WS_Q, WS_T1 = WS_K, WS_MERGED = WS_GG, WS_F = WS_SGA;
constexpr size_t WS_ACT = WS_BIG;
constexpr size_t WS_PP = WS_BIG;
constexpr size_t WS_WMGU = WS_BIG, WS_WMD = WS_BIG + 56 * MiB, WS_ACT8 = WS_BIG + 84 * MiB, WS_HG = WS_BIG + 204 * MiB, WS_OE = WS_BIG + 240 * MiB;
constexpr int MOE_MAINP = 128, MOE_KS = 7, MOE_KSB = FF / MOE_KS;
constexpr size_t WS_OEP = WS_OE + 68 * MiB;
constexpr size_t WS_XR = WS_O2 + SLOT;
constexpr size_t WS_WIN8 = WS_XR + SLOT;
constexpr size_t WS_WGU8 = WS_WIN8 + 14 * MiB;
constexpr size_t WS_SB = WS_WGU8 + 7 * MiB;
constexpr size_t WS_SA = WS_COS + 128 * 1024;
constexpr size_t WS_WPG8 = WS_SB + 1 * MiB;
constexpr size_t WS_END = WS_WPG8 + 2 * MiB;
constexpr float SC_H = 8.f, SC_WGU = 32.f, SC_ACT = 8.f, SC_WD = 64.f;
constexpr int E8_H = 0x7c7c7c7c, E8_WGU = 0x7a7a7a7a, E8_ACT = 0x7c7c7c7c, E8_WD = 0x79797979;
static_assert(WS_OEP + (size_t)MOE_KS * 8 * 256 * D * 2 <= WS_O2 + SLOT && MOE_KS * MOE_KSB == FF && MOE_KSB % 256 == 0 && WS_OE + (size_t)MOE_ROWS * D * 2 <= WS_END && WS_ACT8 + (size_t)MOE_ROWS * FF <= WS_HG && WS_HG + (size_t)MOE_ROWS * D <= WS_OE && WS_WMD + (size_t)NEXP * D * FF <= WS_ACT8, "d_ws map");
constexpr int CW_TMO = 0, CW_CODE = 1;
constexpr int CW_CNT = 64;
constexpr int CW_BAR = 4096;
constexpr int RING_OFF = 0, RING_BYTES = 131072;
constexpr int LDSCTL_OFF = RING_BYTES, MISC_OFF = LDSCTL_OFF + 320;
constexpr int LDS_BYTES = 147456;
static_assert(MISC_OFF + 128 <= LDS_BYTES, "LDS map");
#define GAS __attribute__((address_space(1)))
#define LAS __attribute__((address_space(3)))
typedef unsigned short bf16;
typedef unsigned v4u __attribute__((ext_vector_type(4)));
typedef float f32x4 __attribute__((ext_vector_type(4)));
typedef short bf16x8 __attribute__((ext_vector_type(8)));
typedef GAS unsigned gu32;
typedef GAS unsigned long long gu64;
#define RLX_AGENT __ATOMIC_RELAXED, __HIP_MEMORY_SCOPE_AGENT
#define LDS_WAIT() asm volatile("s_waitcnt lgkmcnt(0)" ::: "memory")
#define VM_WAIT() asm volatile("s_waitcnt vmcnt(0)" ::: "memory")
__device__ __forceinline__ unsigned long long rt() { return __builtin_amdgcn_s_memrealtime(); }
__device__ __forceinline__ unsigned f2bf(float f) { unsigned u = __builtin_bit_cast(unsigned, f); return (u + 0x7fffu + ((u >> 16) & 1u)) >> 16; }
__device__ __forceinline__ unsigned pk2(float lo, float hi) { return f2bf(lo) | (f2bf(hi) << 16); }

#define XB_TMO      128
#define XB_XCNT(j)  (256  + 64 * (j))
#define XB_XSUB(j)  (1280 + 64 * (j))
#define XB_XGEN(j)  (2304 + 64 * (j))
#define XB_TOP      3328
#define XB_TOPGEN   3392
#define XCD_BAR_WORDS 3456
#define XB_SPIN_CAP (1u << 18)

__device__ __forceinline__ unsigned xb_ld(unsigned* p)              { return __hip_atomic_load(p, __ATOMIC_RELAXED, __HIP_MEMORY_SCOPE_AGENT); }
__device__ __forceinline__ unsigned xb_add(unsigned* p, unsigned v) { return __hip_atomic_fetch_add(p, v, __ATOMIC_RELAXED, __HIP_MEMORY_SCOPE_AGENT); }
__device__ __forceinline__ unsigned xb_xcc_id() { return (unsigned)__builtin_amdgcn_s_getreg((3 << 11) | 20) & 0xFu; }
#define XB_SPIN(cond, bar) do { unsigned _sp = 0; while (cond) { __builtin_amdgcn_s_sleep(1); \
    if ((++_sp & 255u) == 0u) { if (xb_ld(&(bar)[XB_TMO])) break; if (_sp > XB_SPIN_CAP) { atomicAdd(&(bar)[XB_TMO], 1u); break; } } } } while (0)

struct XcdBarrier {
    unsigned* bar; unsigned x;
    volatile LAS unsigned* st;
};

__device__ __forceinline__ XcdBarrier xcd_barrier_post(unsigned* bar, volatile LAS unsigned* st) {
    XcdBarrier b; b.bar = bar; b.x = xb_xcc_id(); b.st = st;
    if (threadIdx.x == 0) (void)xb_add(&bar[XB_XCNT(b.x)], 1u);
    return b;
}
__device__ __forceinline__ void xcd_barrier_complete(unsigned* bar, unsigned x, unsigned& nloc, unsigned& nx) {
    const unsigned G = gridDim.x * gridDim.y * gridDim.z;
    unsigned sum, cnt, mine, sp = 0u;
    for (;;) {
        sum = 0u; cnt = 0u; mine = 0u;
#pragma unroll
        for (unsigned j = 0; j < 16; ++j) { const unsigned c = xb_ld(&bar[XB_XCNT(j)]); sum += c; cnt += (c > 0u) ? 1u : 0u; mine = (j == x) ? c : mine; }
        if (sum == G) break;
        __builtin_amdgcn_s_sleep(1);
        if ((++sp & 255u) == 0u) { if (xb_ld(&bar[XB_TMO])) break; if (sp > XB_SPIN_CAP) { atomicAdd(&bar[XB_TMO], 1u); break; } }
    }
    nloc = mine > 0u ? mine : 1u; nx = cnt > 0u ? cnt : 1u;
}

__device__ __forceinline__ void xcd_barrier(const XcdBarrier& b) {
    asm volatile("s_waitcnt vmcnt(0)" ::: "memory");
    __syncthreads();
    if (threadIdx.x == 0) {
        unsigned* bar = b.bar; unsigned bx_ = b.x;
        asm volatile("" : "+s"(bar), "+s"(bx_));
        __builtin_amdgcn_s_waitcnt(0);
        unsigned nloc = b.st[0], nx = b.st[1];
        if (nloc == 0u) { xcd_barrier_complete(bar, bx_, nloc, nx); b.st[0] = nloc; b.st[1] = nx; }
        const unsigned old = xb_add(&bar[XB_XSUB(bx_)], 1u);
        const unsigned gen = old / nloc;
        if (old + 1u == (gen + 1u) * nloc) {
            __builtin_amdgcn_fence(__ATOMIC_RELEASE, "agent");
            asm volatile("s_waitcnt vmcnt(0)" ::: "memory");
            const unsigned og = xb_add(&bar[XB_TOP], 1u);
            const unsigned tg = og / nx;
            if (og + 1u == (tg + 1u) * nx) xb_add(&bar[XB_TOPGEN], 1u);
            else XB_SPIN(xb_ld(&bar[XB_TOPGEN]) == tg, bar);
            __builtin_amdgcn_fence(__ATOMIC_ACQUIRE, "agent");
            xb_add(&bar[XB_XGEN(bx_)], 1u);
            asm volatile("s_waitcnt vmcnt(0)" ::: "memory");
        } else {
            XB_SPIN(xb_ld(&bar[XB_XGEN(bx_)]) == gen, bar);
            __builtin_amdgcn_fence(__ATOMIC_ACQUIRE, "agent");
            asm volatile("s_waitcnt vmcnt(0)" ::: "memory");
        }
    }
    __syncthreads();
}
__device__ const float INV_FREQ[32] = {
    1.0f, 0.74989420933f, 0.56234132519f, 0.42169650343f, 0.31622776602f, 0.23713737057f, 0.17782794100f, 0.13335214322f,
    0.1f, 0.074989420933f, 0.056234132519f, 0.042169650343f, 0.031622776602f, 0.023713737057f, 0.017782794100f, 0.013335214322f,
    0.01f, 0.0074989420933f, 0.0056234132519f, 0.0042169650343f, 0.0031622776602f, 0.0023713737057f, 0.0017782794100f, 0.0013335214322f,
    0.001f, 0.00074989420933f, 0.00056234132519f, 0.00042169650343f, 0.00031622776602f, 0.00023713737057f, 0.00017782794100f, 0.00013335214322f };

#define SWZ_XOR(v, o) __int_as_float(__builtin_amdgcn_ds_swizzle(__float_as_int(v), ((o) << 10) | 0x1f))
__device__ __forceinline__ float half_sum(float v) {
    v += SWZ_XOR(v, 1); v += SWZ_XOR(v, 2); v += SWZ_XOR(v, 4); v += SWZ_XOR(v, 8); v += SWZ_XOR(v, 16);
    return v;
}
__device__ __forceinline__ float wave_sum(float v) {
    v = half_sum(v);
    const auto rr = __builtin_amdgcn_permlane32_swap(__float_as_uint(v), __float_as_uint(v), false, false);
    return __uint_as_float(rr[0]) + __uint_as_float(rr[1]);
}
__device__ __forceinline__ float dot4(f32x4 a, f32x4 b) { return (a.x * b.x + a.y * b.y) + (a.z * b.z + a.w * b.w); }
__device__ __forceinline__ float bf2f(unsigned short v) { return __uint_as_float((unsigned)v << 16); }
typedef unsigned u32x2 __attribute__((ext_vector_type(2)));
__device__ __forceinline__ f32x4 bf4_to_f(u32x2 w) { return (f32x4){__uint_as_float(w.x << 16), __uint_as_float(w.x & 0xffff0000u), __uint_as_float(w.y << 16), __uint_as_float(w.y & 0xffff0000u)}; }
__device__ __forceinline__ u32x2 f_to_bf4(f32x4 v) { u32x2 w; w.x = pk2(v.x, v.y); w.y = pk2(v.z, v.w); return w; }
__device__ __forceinline__ float sigm_f(float v) { return 1.0f / (1.0f + __expf(-v)); }

__device__ __forceinline__ f32x4 bfl4(v4u w) { return (f32x4){__uint_as_float(w.x << 16), __uint_as_float(w.x & 0xffff0000u), __uint_as_float(w.y << 16), __uint_as_float(w.y & 0xffff0000u)}; }
__device__ __forceinline__ f32x4 bfh4(v4u w) { return (f32x4){__uint_as_float(w.z << 16), __uint_as_float(w.z & 0xffff0000u), __uint_as_float(w.w << 16), __uint_as_float(w.w & 0xffff0000u)}; }
__device__ __forceinline__ v4u pk8bf(f32x4 a, f32x4 b) { v4u w; w.x = pk2(a.x, a.y); w.y = pk2(a.z, a.w); w.z = pk2(b.x, b.y); w.w = pk2(b.z, b.w); return w; }
__device__ __forceinline__ float wave_max(float v) {
    v = fmaxf(v, SWZ_XOR(v, 1)); v = fmaxf(v, SWZ_XOR(v, 2)); v = fmaxf(v, SWZ_XOR(v, 4)); v = fmaxf(v, SWZ_XOR(v, 8)); v = fmaxf(v, SWZ_XOR(v, 16));
    const auto rr = __builtin_amdgcn_permlane32_swap(__float_as_uint(v), __float_as_uint(v), false, false);
    return fmaxf(__uint_as_float(rr[0]), __uint_as_float(rr[1]));
}
__device__ __forceinline__ float amax4(f32x4 v) { return fmaxf(fmaxf(fabsf(v.x), fabsf(v.y)), fmaxf(fabsf(v.z), fabsf(v.w))); }
__device__ __forceinline__ unsigned q4i8(f32x4 v, float k) {
    const int a = (int)rintf(v.x * k), b = (int)rintf(v.y * k), c = (int)rintf(v.z * k), d = (int)rintf(v.w * k);
    return (unsigned)(a & 255) | ((unsigned)(b & 255) << 8) | ((unsigned)(c & 255) << 16) | ((unsigned)d << 24);
}
__device__ __forceinline__ void wq_row(const bf16* src, unsigned char* dst, float* scale, int lane) {
    const v4u a = ((const v4u*)src)[2 * lane], b = ((const v4u*)src)[2 * lane + 1];
    const f32x4 v0 = bfl4(a), v1 = bfh4(a), v2 = bfl4(b), v3 = bfh4(b);
    const float mx = wave_max(fmaxf(fmaxf(amax4(v0), amax4(v1)), fmaxf(amax4(v2), amax4(v3))));
    const float k = 127.f / fmaxf(mx, 1e-30f);
    v4u o; o.x = q4i8(v0, k); o.y = q4i8(v1, k); o.z = q4i8(v2, k); o.w = q4i8(v3, k);
    ((v4u*)dst)[lane] = o;
    if (lane == 0) *scale = mx * (1.f / 127.f);
}
__device__ __forceinline__ void tr_load(float (&r)[32], const float* W, int N, int k0, int n0, int lane) {
#pragma unroll
    for (int i = 0; i < 32; ++i) r[i] = W[(size_t)(k0 + 2 * i + (lane >> 5)) * N + n0 + (lane & 31)];
}
__device__ __forceinline__ void tr_store(const float (&r)[32], int K, bf16* WT, int dest_row0, int k0, LAS float* scr, int lane) {
#pragma unroll
    for (int i = 0; i < 32; ++i) scr[(2 * i + (lane >> 5)) * 33 + (lane & 31)] = r[i];
    LDS_WAIT(); asm volatile("" ::: "memory");
    const int c = lane & 7;
#pragma unroll
    for (int j = 0; j < 4; ++j) { const int n = (lane >> 3) + 8 * j; const LAS float* s = scr + (8 * c) * 33 + n;
        v4u o; o.x = pk2(s[0 * 33], s[1 * 33]); o.y = pk2(s[2 * 33], s[3 * 33]); o.z = pk2(s[4 * 33], s[5 * 33]); o.w = pk2(s[6 * 33], s[7 * 33]);
        *(v4u*)(WT + (size_t)(dest_row0 + n) * K + k0 + 8 * c) = o; }
    LDS_WAIT(); asm volatile("" ::: "memory");
}
template <int MAP> __device__ __forceinline__ int dest_row(int n0) {
    if (MAP == 1) { const int tile = n0 >> 8, w = n0 & 255; return tile * 256 + ((w & 63) >> 5) * 128 + (w >> 6) * 32; }
    if (MAP == 2) return (n0 >> 7) * 256 + (n0 & 127);
    if (MAP == 3) return (n0 >> 7) * 256 + 128 + (n0 & 127);
    return n0;
}
__device__ __forceinline__ float clamp8(float v) { return __builtin_fminf(__builtin_fmaxf(v, -448.f), 448.f); }
__device__ __forceinline__ unsigned pk4f8(float a, float b, float c, float d) { unsigned w = __builtin_amdgcn_cvt_pk_fp8_f32(clamp8(a), clamp8(b), 0u, false); return __builtin_amdgcn_cvt_pk_fp8_f32(clamp8(c), clamp8(d), w, true); }
__device__ __forceinline__ void tr_store8(const float (&r)[32], int K, unsigned char* WT, int dest_row0, int k0, float scale, LAS float* scr, int lane) {
#pragma unroll
    for (int i = 0; i < 32; ++i) scr[(2 * i + (lane >> 5)) * 33 + (lane & 31)] = r[i] * scale;
    LDS_WAIT(); asm volatile("" ::: "memory");
    const int c = lane & 3;
#pragma unroll
    for (int j = 0; j < 2; ++j) { const int n = (lane >> 2) + 16 * j; const LAS float* s = scr + (16 * c) * 33 + n;
        v4u o; o.x = pk4f8(s[0 * 33], s[1 * 33], s[2 * 33], s[3 * 33]); o.y = pk4f8(s[4 * 33], s[5 * 33], s[6 * 33], s[7 * 33]);
        o.z = pk4f8(s[8 * 33], s[9 * 33], s[10 * 33], s[11 * 33]); o.w = pk4f8(s[12 * 33], s[13 * 33], s[14 * 33], s[15 * 33]);
        *(v4u*)(WT + (size_t)(dest_row0 + n) * K + k0 + 16 * c) = o; }
    LDS_WAIT(); asm volatile("" ::: "memory");
}
struct TrItem { const float* W; bf16* WT; int K, N, dest_row0, k0, n0; float s8; };
template <int MAP> __device__ __forceinline__ TrItem tr_item(const float* W, int K, int N, bf16* WT, int row_off, int q, float s8 = 0.f) {
    const int nblk = N / 32, kb = q / nblk, nb = q - kb * nblk; TrItem t; t.W = W; t.WT = WT; t.K = K; t.N = N; t.dest_row0 = row_off + dest_row<MAP>(32 * nb); t.k0 = 64 * kb; t.n0 = 32 * nb; t.s8 = s8; return t;
}
#define TR_STORE(r, t) do { if (F8 && t.s8 != 0.f) tr_store8(r, t.K, (unsigned char*)t.WT, t.dest_row0, t.k0, t.s8, scr, lane); else tr_store(r, t.K, t.WT, t.dest_row0, t.k0, scr, lane); } while (0)
template <bool F8, class Dec> __device__ __forceinline__ void tr_run(const Dec& DEC, int nitems, LAS float* scr, int lane, int gw, int ngw) {
    int it = gw; if (it >= nitems) return;
    float ra[32], rb[32];
    TrItem a = DEC(it), b = a;
    tr_load(ra, a.W, a.N, a.k0, a.n0, lane);
    for (;;) {
        const int it1 = it + ngw; const bool h1 = it1 < nitems;
        if (h1) { b = DEC(it1); tr_load(rb, b.W, b.N, b.k0, b.n0, lane); }
        TR_STORE(ra, a);
        if (!h1) break;
        const int it2 = it1 + ngw; const bool h2 = it2 < nitems;
        if (h2) { a = DEC(it2); tr_load(ra, a.W, a.N, a.k0, a.n0, lane); }
        TR_STORE(rb, b);
        if (!h2) break;
        it = it2;
    }
}

__device__ __forceinline__ void row_post_pre(const f32x4 (&f)[4], const float* xin, float* xout, const float* gpost, const float* gpre, bf16* hrow, int lane, f32x4 (&hn)[4]) {
    float s = 0.f;
#pragma unroll
    for (int j = 0; j < 4; ++j) s += dot4(f[j], f[j]);
    const float rs = rsqrtf(wave_sum(s) * (1.f / D) + EPS);
    f32x4 xv[4]; float s2 = 0.f;
#pragma unroll
    for (int j = 0; j < 4; ++j) { xv[j] = ((const f32x4*)xin)[lane + 64 * j] + f[j] * rs * ((const f32x4*)gpost)[lane + 64 * j]; ((f32x4*)xout)[lane + 64 * j] = xv[j]; s2 += dot4(xv[j], xv[j]); }
    if (gpre) {
        const float rs2 = rsqrtf(wave_sum(s2) * (1.f / D) + EPS);
#pragma unroll
        for (int j = 0; j < 4; ++j) { hn[j] = xv[j] * rs2 * ((const f32x4*)gpre)[lane + 64 * j]; ((u32x2*)hrow)[lane + 64 * j] = f_to_bf4(hn[j]); }
    }
}
struct Args { const void* in[26]; float* out; unsigned char* ws; int ph_lo, ph_hi; };
enum { I_X = 0, I_P, I_POS, I_NORMG, I_WIN, I_CONVW, I_CONVB, I_LWA, I_LBA, I_LWX, I_LBX, I_LLAM, I_DLAM, I_SUBG, I_WPA, I_WPB, I_WOUT, I_FG, I_FU, I_FD, I_RW, I_MG, I_MU, I_MD, I_PWP, I_PWG };

constexpr int PO_NORMG = 0, PO_CONVW = PO_NORMG + DEPTH * 6 * D, PO_CONVB = PO_CONVW + DEPTH * 4 * D, PO_LBA = PO_CONVB + DEPTH * D, PO_LBX = PO_LBA + DEPTH * D, PO_LLAM = PO_LBX + DEPTH * D,
              PO_DLAM = PO_LLAM + DEPTH * D, PO_SUBG = PO_DLAM + DEPTH * 256, PO_RW = PO_SUBG + DEPTH * 128, PO_SUBGS = PO_RW + D * NEXP, PO_END = PO_SUBGS + DEPTH * 128;
static_assert((size_t)PO_END * 4 <= 512 * 1024, "parameter block");
__device__ __forceinline__ void p0_prologue(const Args& A, LAS unsigned char* lds, int vcu, int G) {
#define AIN(k) ((const void*)(const GAS void*)A.in[k])
    int tid_ = threadIdx.x; asm volatile("" : "+v"(tid_)); const int tid = tid_, lane = tid & 63, wave = __builtin_amdgcn_readfirstlane(tid >> 6); (void)tid; (void)lane; (void)wave;
    unsigned char* ws = (unsigned char*)(GAS unsigned char*)A.ws;
    LAS float* scr = (LAS float*)(lds + RING_OFF + wave * 16384);
    const int gw = vcu * NWAVES + wave, ngw = G * NWAVES;
    { struct Dec { const Args& A; unsigned char* ws;
          __device__ __forceinline__ TrItem operator()(int f) const {
              constexpr int I_IN = (D / 64) * (DIN / 32), I_SQ = (D / 64) * (D / 32), I_PP = (PLE / 64) * (D / 32), I_L = I_IN + 4 * I_SQ + I_PP, I_FF = (D / 64) * (FF / 32);
              if (f < DEPTH * I_L) { const int l = f / I_L; int r = f - l * I_L; unsigned char* wl = ws + WS_WSMALL + (size_t)l * WL_STRIDE;
                  if (r < I_IN) return tr_item<1>((const float*)AIN(I_WIN) + (size_t)l * D * DIN, D, DIN, (bf16*)(wl + WL_WIN), 0, r); r -= I_IN;
                  if (r < I_SQ) return tr_item<0>((const float*)AIN(I_WPA) + (size_t)l * D * D, D, D, (bf16*)(wl + WL_WAB), 0, r); r -= I_SQ;
                  if (r < I_SQ) return tr_item<0>((const float*)AIN(I_WPB) + (size_t)l * D * D, D, D, (bf16*)(wl + WL_WAB), D, r); r -= I_SQ;
                  if (r < I_SQ) return tr_item<0>((const float*)AIN(I_WOUT) + (size_t)l * D * D, D, D, (bf16*)(wl + WL_WO), 0, r); r -= I_SQ;
                  if (r < I_SQ) return tr_item<0>((const float*)AIN(I_PWG) + (size_t)l * D * D, D, D, (bf16*)(wl + WL_WPG), 0, r); r -= I_SQ;
                  return tr_item<0>((const float*)AIN(I_PWP) + (size_t)l * PLE * D, PLE, D, (bf16*)(wl + WL_WPP), 0, r); }
              int r = f - DEPTH * I_L;
              if (r < I_FF) return tr_item<2>((const float*)AIN(I_FG), D, FF, (bf16*)(ws + WS_WGU), 0, r); r -= I_FF;
              if (r < I_FF) return tr_item<3>((const float*)AIN(I_FU), D, FF, (bf16*)(ws + WS_WGU), 0, r); r -= I_FF;
              return tr_item<0>((const float*)AIN(I_FD), FF, D, (bf16*)(ws + WS_WD), 0, r); } };
      constexpr int NIT = DEPTH * ((D / 64) * (DIN / 32) + 4 * (D / 64) * (D / 32) + (PLE / 64) * (D / 32)) + 2 * (D / 64) * (FF / 32) + (FF / 64) * (D / 32);
      const Dec dec{A, ws}; tr_run<true>(dec, NIT, scr, lane, gw, ngw); }
    const int gt = gw * 64 + lane, ngt = ngw * 64;
    { const int* pos = (const int*)AIN(I_POS); float* pf = (float*)(ws + WS_COS); for (int i = gt; i < T; i += ngt) pf[i] = (float)pos[i]; }
    { const f32x4* p = (const f32x4*)AIN(I_P); u32x2* pb = (u32x2*)(ws + WS_PB);
      for (int i = gt; i < DEPTH * T * PLE / 4; i += ngt) pb[i] = f_to_bf4(p[i]); }
    { bf16* lw = (bf16*)(ws + WS_LRUW);
      for (int i = gt; i < DEPTH * 16 * 2 * 4096; i += ngt) { const int c = i & 63, d = (i >> 6) & 63, g = (i >> 12) & 1, n = (i >> 13) & 15, l = i >> 17;
          const float* src = (const float*)AIN(g ? I_LWX : I_LWA); lw[i] = (bf16)f2bf(src[((size_t)(l * 16 + n) * 64 + c) * 64 + d]); } }
    { const float* g0 = (const float*)AIN(I_NORMG);
      for (int m = gw; m < T; m += ngw) { const f32x4* xr = (const f32x4*)((const float*)AIN(I_X) + (size_t)m * D); f32x4 v[4]; float s = 0.f;
#pragma unroll
          for (int j = 0; j < 4; ++j) { v[j] = xr[lane + 64 * j]; s += dot4(v[j], v[j]); }
          const float rs = rsqrtf(wave_sum(s) * (1.f / D) + EPS);
          float mx = 0.f;
#pragma unroll
          for (int j = 0; j < 4; ++j) { ((u32x2*)(ws + WS_XR + (size_t)m * D * 2))[lane + 64 * j] = f_to_bf4(v[j]); v[j] = v[j] * rs * ((const f32x4*)g0)[lane + 64 * j]; mx = fmaxf(mx, amax4(v[j])); }
          mx = wave_max(mx); const float kq = 127.f / fmaxf(mx, 1e-30f);
#pragma unroll
          for (int j = 0; j < 4; ++j) ((unsigned*)(ws + WS_H + (size_t)m * D))[lane + 64 * j] = q4i8(v[j], kq);
          if (lane == 0) ((float*)(ws + WS_SA))[m] = mx * (1.f / 127.f); } }
    { float* par = (float*)(ws + WS_PAR);
      const int srcs[9] = {I_NORMG, I_CONVW, I_CONVB, I_LBA, I_LBX, I_LLAM, I_DLAM, I_SUBG, I_RW};
      const int offs[10] = {PO_NORMG, PO_CONVW, PO_CONVB, PO_LBA, PO_LBX, PO_LLAM, PO_DLAM, PO_SUBG, PO_RW, PO_SUBGS};
#pragma unroll
      for (int k = 0; k < 9; ++k) { const float* src = (const float*)AIN(srcs[k]); const int n = offs[k + 1] - offs[k];
          for (int i = gt; i < n; i += ngt) par[offs[k] + i] = src[i]; }
      for (int i = gt; i < DEPTH * 128; i += ngt) par[PO_SUBGS + i] = ((const float*)AIN(I_SUBG))[i] * (1.0f - (0.8f - 0.6f * expf(-0.3f * (float)(i >> 7)))); }
}

__device__ __forceinline__ void p0_quant_weights(unsigned char* ws, int vcu, int G) {
    int tid_ = threadIdx.x; asm volatile("" : "+v"(tid_)); const int lane = tid_ & 63, wave = __builtin_amdgcn_readfirstlane(tid_ >> 6);
    const int gw = vcu * NWAVES + wave, ngw = G * NWAVES;
    for (int r = gw; r < 3 * DIN + DEPTH * D; r += ngw) {
        if (r >= 3 * DIN) { const int l = (r - 3 * DIN) / D, n = (r - 3 * DIN) - l * D;
            wq_row((const bf16*)(ws + WS_WSMALL + (size_t)l * WL_STRIDE + WL_WPG) + (size_t)n * D, ws + WS_WPG8 + ((size_t)l * D + n) * D, (float*)(ws + WS_SB) + r, lane); continue; }
        const int which = r / DIN, n = r - which * DIN;
        const bf16* src = which < 2 ? (const bf16*)(ws + WS_WSMALL + (size_t)which * WL_STRIDE + WL_WIN) + (size_t)n * D : (const bf16*)(ws + WS_WGU) + (size_t)n * D;
        unsigned char* dst = (which < 2 ? ws + WS_WIN8 + (size_t)which * DIN * D : ws + WS_WGU8) + (size_t)n * D;
        wq_row(src, dst, (float*)(ws + WS_SB) + r, lane); }
}

__device__ __forceinline__ unsigned short bf1(float v) { unsigned r; asm("v_cvt_pk_bf16_f32 %0, %1, %1" : "=v"(r) : "v"(v)); return (unsigned short)r; }
__device__ __forceinline__ float sigm_fast(float v) { return __builtin_amdgcn_rcpf(1.0f + __builtin_amdgcn_exp2f(-1.4426950408889634f * v)); }
__device__ __forceinline__ void lru_pass1(unsigned char* ws, LAS unsigned char* lds, int layer, int chunk) {
    int tid_ = threadIdx.x; asm volatile("" : "+v"(tid_)); const int tid = tid_, lane = tid & 63, wave = __builtin_amdgcn_readfirstlane(tid >> 6); (void)tid; (void)lane; (void)wave;
    typedef float f32x16 __attribute__((ext_vector_type(16)));
    const float* par = (const float*)(ws + WS_PAR);
    const int b = chunk >> 6, t0 = (chunk & 63) * 64; const size_t g0 = (size_t)b * SEQ + t0;
    LAS unsigned char* wl = lds + RING_OFF + wave * 16384;
    LAS bf16* U = (LAS bf16*)wl;
    LAS float* Gs = (LAS float*)(wl + 4608);
    const bf16* RIN = (const bf16*)(ws + WS_RIN); bf16* HL = (bf16*)(ws + WS_HL); bf16* LP = (bf16*)(ws + WS_LP);
    const int r32 = lane & 31, hi = lane >> 5;
    float h = 0.f, lpc = 0.f, xm3 = 0.f, xm2 = 0.f, xm1 = 0.f;
    v4u pre[4];
#define LRU_LOAD(nb_, tg_) do { _Pragma("unroll") for (int i = 0; i < 4; ++i) pre[i] = *(const v4u*)(RIN + (g0 + (tg_) * 32 + (lane >> 3) + 8 * i) * D + 64 * (2 * wave + (nb_)) + 8 * (lane & 7)); } while (0)
    LRU_LOAD(0, 0);
    for (int it = 0; it < 4; ++it) { const int nb = it >> 1, tg = it & 1;
        const int n = 2 * wave + nb, ch = 64 * n + lane;
        const float* cw = par + PO_CONVW + (size_t)layer * 4 * D;
        const float cw0 = cw[ch], cw1 = cw[D + ch], cw2 = cw[2 * D + ch], cw3 = cw[3 * D + ch], cb = par[PO_CONVB + layer * D + ch];
        const float ba = par[PO_LBA + layer * D + ch], bx = par[PO_LBX + layer * D + ch];
        const float lam = par[PO_LLAM + layer * D + ch];
        const float c8sp = -8.0f * 1.4426950408889634f * log1pf(__expf(-lam));
        const bf16* lw = (const bf16*)(ws + WS_LRUW) + (size_t)((layer * 16 + n) * 2) * 4096;
        if (tg == 0) { h = 0.f; lpc = 0.f; xm3 = 0.f; xm2 = 0.f; xm1 = 0.f;
            if (t0 > 0) { xm3 = bf2f(RIN[(g0 - 3) * D + ch]); xm2 = bf2f(RIN[(g0 - 2) * D + ch]); xm1 = bf2f(RIN[(g0 - 1) * D + ch]); } }
        const size_t gr = g0 + tg * 32;
        bf16x8 wf[2][2][4];
#pragma unroll
        for (int g = 0; g < 2; ++g)
#pragma unroll
            for (int dh = 0; dh < 2; ++dh)
#pragma unroll
                for (int ks = 0; ks < 4; ++ks) wf[g][dh][ks] = *(const bf16x8*)(lw + (size_t)g * 4096 + (32 * dh + r32) * 64 + 16 * ks + 8 * hi);
#pragma unroll
        for (int i = 0; i < 4; ++i) *(LAS v4u*)(U + ((lane >> 3) + 8 * i) * 72 + 8 * (lane & 7)) = pre[i];
        LDS_WAIT();
        if (it < 3) LRU_LOAD((it + 1) >> 1, (it + 1) & 1);
        float u[32];
#pragma unroll
        for (int t = 0; t < 32; ++t) { const float x = bf2f(U[t * 72 + lane]); u[t] = cb + cw0 * xm3 + cw1 * xm2 + cw2 * xm1 + cw3 * x; xm3 = xm2; xm2 = xm1; xm1 = x; U[t * 72 + lane] = bf1(u[t]); }
        LDS_WAIT();
        float gp[2][32];
#pragma unroll
        for (int g = 0; g < 2; ++g) {
            f32x16 c0 = {}, c1 = {};
#pragma unroll
            for (int ks = 0; ks < 4; ++ks) { const bf16x8 a = *(const LAS bf16x8*)(U + r32 * 72 + 16 * ks + 8 * hi);
                c0 = __builtin_amdgcn_mfma_f32_32x32x16_bf16(a, wf[g][0][ks], c0, 0, 0, 0); c1 = __builtin_amdgcn_mfma_f32_32x32x16_bf16(a, wf[g][1][ks], c1, 0, 0, 0); }
#pragma unroll
            for (int r = 0; r < 16; ++r) { const int row = (r & 3) + 8 * (r >> 2) + 4 * hi; Gs[row * 64 + r32] = c0[r]; Gs[row * 64 + 32 + r32] = c1[r]; }
            LDS_WAIT();
#pragma unroll
            for (int t = 0; t < 32; ++t) gp[g][t] = Gs[t * 64 + lane];
            LDS_WAIT();
        }
        LAS bf16* S2 = (LAS bf16*)Gs;
#pragma unroll
        for (int t = 0; t < 32; ++t) { const float rr = sigm_fast(gp[0][t] + ba), ii = sigm_fast(gp[1][t] + bx), la = c8sp * rr, a = __builtin_amdgcn_exp2f(la);
            const float bb = __builtin_amdgcn_sqrtf(fmaxf(0.f, 1.0f - a * a)) * ii * u[t];
            h = a * h + bb; lpc += la; U[t * 72 + lane] = bf1(h); S2[t * 72 + lane] = bf1(lpc); }
        LDS_WAIT();
#pragma unroll
        for (int i = 0; i < 4; ++i) { const int row = i * 8 + (lane >> 3), cc = lane & 7;
            const v4u a = *(const LAS v4u*)(U + row * 72 + cc * 8), c = *(const LAS v4u*)(S2 + row * 72 + cc * 8);
            *(v4u*)(HL + (gr + row) * D + 64 * n + cc * 8) = a; *(v4u*)(LP + (gr + row) * D + 64 * n + cc * 8) = c; }
        LDS_WAIT();
        if (tg == 1) { float* sum = (float*)(ws + WS_SUM) + (size_t)chunk * 2 * D; sum[ch] = lpc; sum[D + ch] = h; }
    }
#undef LRU_LOAD
}

__device__ __forceinline__ void tp_mix(unsigned char* ws, LAS unsigned char* lds, int layer, int chunk) {
    int tid_ = threadIdx.x; asm volatile("" : "+v"(tid_)); const int tid = tid_, lane = tid & 63, wave = __builtin_amdgcn_readfirstlane(tid >> 6); (void)tid; (void)lane; (void)wave;
    const float* par = (const float*)(ws + WS_PAR);
    LAS float* carry = (LAS float*)(lds + RING_OFF);
    { const float* sum = (const float*)(ws + WS_SUM);
      for (int ch = tid; ch < D; ch += NWAVES * 64) { float c = 0.f;
          const float* sp = sum + (size_t)(chunk & ~63) * 2 * D + ch; const int n = chunk & 63; int cc = 0;
          for (; cc + 8 <= n; cc += 8) { float la[8], bb[8];
#pragma unroll
              for (int k = 0; k < 8; ++k) { la[k] = sp[(size_t)(cc + k) * 2 * D]; bb[k] = sp[(size_t)(cc + k) * 2 * D + D]; }
#pragma unroll
              for (int k = 0; k < 8; ++k) c = __builtin_amdgcn_exp2f(la[k]) * c + bb[k]; }
          for (; cc < n; ++cc) c = __builtin_amdgcn_exp2f(sp[(size_t)cc * 2 * D]) * c + sp[(size_t)cc * 2 * D + D];
          carry[ch] = c; } }
    __syncthreads();
    const int b = chunk >> 6, t0 = (chunk & 63) * 64; const size_t g0 = (size_t)b * SEQ + t0;
    for (int rr = wave; rr < 64; rr += 2 * NWAVES) {
        v4u hl[2][2], lp[2][2], gg[2][2];
#pragma unroll
        for (int q = 0; q < 2; ++q) { const size_t ro = (g0 + rr + q * NWAVES) * D * 2;
#pragma unroll
            for (int j = 0; j < 2; ++j) { hl[q][j] = ((const v4u*)(ws + WS_HL + ro))[lane + 64 * j]; lp[q][j] = ((const v4u*)(ws + WS_LP + ro))[lane + 64 * j]; gg[q][j] = ((const v4u*)(ws + WS_GG + ro))[lane + 64 * j]; } }
#pragma unroll
        for (int q = 0; q < 2; ++q) { const size_t ro = (g0 + rr + q * NWAVES) * D * 2;
#pragma unroll
            for (int j = 0; j < 2; ++j) { const LAS f32x4* c4 = (const LAS f32x4*)carry + 128 * j + 2 * lane;
                const f32x4 l0 = bfl4(lp[q][j]), l1 = bfh4(lp[q][j]);
                const f32x4 e0 = {__builtin_amdgcn_exp2f(l0.x), __builtin_amdgcn_exp2f(l0.y), __builtin_amdgcn_exp2f(l0.z), __builtin_amdgcn_exp2f(l0.w)}, e1 = {__builtin_amdgcn_exp2f(l1.x), __builtin_amdgcn_exp2f(l1.y), __builtin_amdgcn_exp2f(l1.z), __builtin_amdgcn_exp2f(l1.w)};
                ((v4u*)(ws + WS_YA + ro))[lane + 64 * j] = pk8bf((bfl4(hl[q][j]) + e0 * c4[0]) * bfl4(gg[q][j]), (bfh4(hl[q][j]) + e1 * c4[1]) * bfh4(gg[q][j])); } }
    }
    __syncthreads();
}

template <bool DRY> __device__ __forceinline__ void route_row(unsigned char* ws, const LAS float* rwT, const f32x4 (&hn)[2][2], int m, int lane) {
    gu32* ctl = (gu32*)(ws + WS_CTL);
    float lg[NEXP];
#pragma unroll
    for (int e = 0; e < NEXP; ++e) { float s = 0.f;
#pragma unroll
        for (int j = 0; j < 2; ++j) { const LAS f32x4* r4 = (const LAS f32x4*)(rwT + e * D + 512 * j) + 2 * lane; s += dot4(hn[j][0], r4[0]) + dot4(hn[j][1], r4[1]); }
        lg[e] = wave_sum(s); }
    int e0 = 0; float v0 = lg[0];
#pragma unroll
    for (int e = 1; e < NEXP; ++e) if (lg[e] > v0) { v0 = lg[e]; e0 = e; }
    int e1 = -1; float v1 = -INFINITY;
#pragma unroll
    for (int e = 0; e < NEXP; ++e) if (e != e0 && lg[e] > v1) { v1 = lg[e]; e1 = e; }
    const float w1 = 1.0f / (1.0f + __expf(v0 - v1)), w0 = 1.0f - w1;
    if (DRY) { if (w0 + w1 + (float)e0 + (float)e1 == -12345.f) ((float*)(ws + WS_BIG))[m] = w0; }
    if (lane == 0 && !DRY) { const int p0 = (int)__hip_atomic_fetch_add(ctl + CW_CNT + 64 * e0, 1u, RLX_AGENT), p1 = (int)__hip_atomic_fetch_add(ctl + CW_CNT + 64 * e1, 1u, RLX_AGENT);
        int* lst = (int*)(ws + WS_LIST); lst[e0 * T + p0] = m; lst[e1 * T + p1] = m;
        int* ti = (int*)(ws + WS_TOK) + (size_t)m * 8; ti[0] = e0; ti[1] = p0; ti[2] = e1; ti[3] = p1; ti[4] = __float_as_int(w0); ti[5] = __float_as_int(w1); }
}
template <int SRC, bool ROUTE, bool DRY = false, bool H8 = false, bool FINAL = false, bool HQ = false> __device__ __forceinline__ void tp_post_pre(unsigned char* ws, float* xres, LAS unsigned char* lds, const float* gpost, const float* gpre, int vcu, int G) {
    int tid_ = threadIdx.x; asm volatile("" : "+v"(tid_)); const int tid = tid_, lane = tid & 63, wave = __builtin_amdgcn_readfirstlane(tid >> 6); (void)tid; (void)lane; (void)wave;
    gu32* ctl = (gu32*)(ws + WS_CTL);
    LAS float* rwT = (LAS float*)(lds + RING_OFF);
    int ps[NEXP];
    if (ROUTE) { const float* rw = (const float*)(ws + WS_PAR) + PO_RW; for (int i = tid; i < D * NEXP; i += NWAVES * 64) rwT[(i & 7) * D + (i >> 3)] = rw[i]; __syncthreads(); }
    if (SRC == 1) { int acc = 0;
#pragma unroll
        for (int e = 0; e < NEXP; ++e) { ps[e] = acc; acc += ((int)__hip_atomic_load(ctl + CW_CNT + 64 * e, RLX_AGENT) + 255) >> 8; } }
    const int gw = vcu * NWAVES + wave, ngw = G * NWAVES;
    f32x4 gp[2][2], gq[2][2];
#pragma unroll
    for (int j = 0; j < 2; ++j)
#pragma unroll
        for (int h = 0; h < 2; ++h) { gp[j][h] = ((const f32x4*)gpost)[128 * j + 2 * lane + h]; gq[j][h] = gpre ? ((const f32x4*)gpre)[128 * j + 2 * lane + h] : (f32x4){0.f, 0.f, 0.f, 0.f}; }
    unsigned char* xo = ws + (DRY ? WS_BIG : WS_XR); unsigned char* ho = ws + (DRY ? WS_BIG + 2 * SLOT : WS_H);
    constexpr int NR = (ROUTE || SRC == 1) ? 2 : 8;
    const bool xl = (ngw == 2048);
#define TP_ROW_OF(k) (xl ? ((gw >> 8) << 11) + (gw & 255) + ((k) << 8) : gw + (k) * ngw)
    for (int k0 = 0; TP_ROW_OF(k0) < T && k0 * ngw < T; k0 += NR) {
        v4u fa[NR][2], fc[NR][2], xr[NR][2]; float w0[NR], w1[NR];
#pragma unroll
        for (int r = 0; r < NR; ++r) { const int m = TP_ROW_OF(k0 + r); if ((k0 + r) * ngw < T && m < T) {
            if (SRC == 0) { const v4u* p = (const v4u*)(ws + WS_F + (size_t)m * D * 2) + lane; fa[r][0] = p[0]; fa[r][1] = p[64]; }
            else { const int* ti = (const int*)(ws + WS_TOK) + (size_t)m * 8; const int e0 = ti[0], p0 = ti[1], e1 = ti[2], p1 = ti[3]; w0[r] = __int_as_float(ti[4]); w1[r] = __int_as_float(ti[5]); int s0 = 0, s1 = 0;
#pragma unroll
                for (int e = 0; e < NEXP; ++e) { if (e == e0) s0 = ps[e]; if (e == e1) s1 = ps[e]; }
#define OE_ROW(dst, rw) do { const int rw_ = (rw); if (rw_ < MOE_MAINP * 256) { const v4u* q_ = (const v4u*)(ws + WS_OE + (size_t)rw_ * D * 2) + lane; dst[0] = q_[0]; dst[1] = q_[64]; } \
                    else { f32x4 a0_ = {0.f, 0.f, 0.f, 0.f}, a1_ = a0_, a2_ = a0_, a3_ = a0_; \
                        _Pragma("unroll") for (int ks_ = 0; ks_ < MOE_KS; ++ks_) { const v4u* q_ = (const v4u*)(ws + WS_OEP + ((size_t)ks_ * 8 * 256 + (rw_ - MOE_MAINP * 256)) * D * 2) + lane; const v4u x_ = q_[0], y_ = q_[64]; \
                            a0_ = a0_ + bfl4(x_); a1_ = a1_ + bfh4(x_); a2_ = a2_ + bfl4(y_); a3_ = a3_ + bfh4(y_); } \
                        dst[0] = pk8bf(a0_, a1_); dst[1] = pk8bf(a2_, a3_); } } while (0)
                OE_ROW(fa[r], s0 * 256 + p0); OE_ROW(fc[r], s1 * 256 + p1); }
#undef OE_ROW
            const v4u* xp = (const v4u*)(ws + WS_XR + (size_t)m * D * 2) + lane; xr[r][0] = xp[0]; xr[r][1] = xp[64]; } }
#pragma unroll
        for (int r = 0; r < NR; ++r) { const int m = TP_ROW_OF(k0 + r); if ((k0 + r) * ngw < T && m < T) {
            f32x4 f[2][2], xv[2][2]; float s = 0.f;
#pragma unroll
            for (int j = 0; j < 2; ++j) { f[j][0] = bfl4(fa[r][j]); f[j][1] = bfh4(fa[r][j]);
                if (SRC == 1) { f[j][0] = f[j][0] * w0[r] + bfl4(fc[r][j]) * w1[r]; f[j][1] = f[j][1] * w0[r] + bfh4(fc[r][j]) * w1[r]; }
                s += dot4(f[j][0], f[j][0]) + dot4(f[j][1], f[j][1]); }
            const float rs = rsqrtf(wave_sum(s) * (1.f / D) + EPS); float s2 = 0.f;
#pragma unroll
            for (int j = 0; j < 2; ++j) { xv[j][0] = bfl4(xr[r][j]) + f[j][0] * rs * gp[j][0]; xv[j][1] = bfh4(xr[r][j]) + f[j][1] * rs * gp[j][1];
                if (FINAL && !DRY) { f32x4* o = (f32x4*)(xres + (size_t)m * D) + 128 * j + 2 * lane; o[0] = xv[j][0]; o[1] = xv[j][1]; }
                else ((v4u*)(xo + (size_t)m * D * 2))[lane + 64 * j] = pk8bf(xv[j][0], xv[j][1]);
                s2 += dot4(xv[j][0], xv[j][0]) + dot4(xv[j][1], xv[j][1]); }
            if (gpre) { const float rs2 = rsqrtf(wave_sum(s2) * (1.f / D) + EPS);
#pragma unroll
                for (int j = 0; j < 2; ++j) { xv[j][0] = xv[j][0] * rs2 * gq[j][0]; xv[j][1] = xv[j][1] * rs2 * gq[j][1];
                    if (H8) { u32x2 w; w.x = pk4f8(xv[j][0].x * SC_H, xv[j][0].y * SC_H, xv[j][0].z * SC_H, xv[j][0].w * SC_H); w.y = pk4f8(xv[j][1].x * SC_H, xv[j][1].y * SC_H, xv[j][1].z * SC_H, xv[j][1].w * SC_H);
                        ((u32x2*)(ho + (size_t)m * D))[lane + 64 * j] = w; }
                    else if (!HQ) ((v4u*)(ho + (size_t)m * D * 2))[lane + 64 * j] = pk8bf(xv[j][0], xv[j][1]); }
                if (HQ) { const float mx = wave_max(fmaxf(fmaxf(amax4(xv[0][0]), amax4(xv[0][1])), fmaxf(amax4(xv[1][0]), amax4(xv[1][1])))); const float kq = 127.f / fmaxf(mx, 1e-30f);
#pragma unroll
                    for (int j = 0; j < 2; ++j) { u32x2 w; w.x = q4i8(xv[j][0], kq); w.y = q4i8(xv[j][1], kq); ((u32x2*)(ho + (size_t)m * D))[lane + 64 * j] = w; }
                    if (lane == 0 && !DRY) ((float*)(ws + WS_SA))[m] = mx * (1.f / 127.f); }
                if (ROUTE) route_row<DRY>(ws, rwT, xv, m, lane); } } }
    }
#undef TP_ROW_OF
    if (ROUTE) __syncthreads();
}

__device__ __forceinline__ void pm0_moe_setup(unsigned char* ws, const float* mg, const float* mu, const float* md, LAS unsigned char* lds, int vcu, int G) {
    int tid_ = threadIdx.x; asm volatile("" : "+v"(tid_)); const int tid = tid_, lane = tid & 63, wave = __builtin_amdgcn_readfirstlane(tid >> 6); (void)tid; (void)lane; (void)wave;
    gu32* ctl = (gu32*)(ws + WS_CTL);
    LAS float* scr = (LAS float*)(lds + RING_OFF + wave * 16384);
    const int gw = vcu * NWAVES + wave, ngw = G * NWAVES;
    int cs[NEXP + 1], ps[NEXP]; { int a = 0, p = 0;
#pragma unroll
        for (int e = 0; e < NEXP; ++e) { const int c = (int)__hip_atomic_load(ctl + CW_CNT + 64 * e, RLX_AGENT); cs[e] = a; ps[e] = p; a += c; p += (c + 255) >> 8; } cs[NEXP] = a; }
    const int* lst = (const int*)(ws + WS_LIST);
    for (int i = gw; i < cs[NEXP]; i += ngw) { int e = 0, base = 0, pst = 0;
#pragma unroll
        for (int k = 0; k < NEXP; ++k) if (i >= cs[k]) { e = k; base = cs[k]; pst = ps[k]; }
        const int pos = i - base, tok = lst[e * T + pos];
        ((v4u*)(ws + WS_HG + ((size_t)pst * 256 + pos) * D))[lane] = ((const v4u*)(ws + WS_H + (size_t)tok * D))[lane]; }
    { struct Dec { const float* mg; const float* mu; const float* md; unsigned char* ws;
          __device__ __forceinline__ TrItem operator()(int f) const {
              constexpr int I_FF = (D / 64) * (FF / 32);
              const int e = f / (3 * I_FF); int r = f - e * 3 * I_FF;
              if (r < I_FF) return tr_item<2>(mg + (size_t)e * D * FF, D, FF, (bf16*)(ws + WS_WMGU), e * 2 * FF, r, SC_WGU); r -= I_FF;
              if (r < I_FF) return tr_item<3>(mu + (size_t)e * D * FF, D, FF, (bf16*)(ws + WS_WMGU), e * 2 * FF, r, SC_WGU); r -= I_FF;
              return tr_item<0>(md + (size_t)e * FF * D, FF, D, (bf16*)(ws + WS_WMD), e * D, r, SC_WD); } };
      const Dec dec{mg, mu, md, ws}; tr_run<true>(dec, NEXP * 3 * (D / 64) * (FF / 32), scr, lane, gw, ngw); }
}
constexpr int NPH_L = 14, NPHASES = 1 + DEPTH * NPH_L;
__host__ __device__ constexpr bool phase_exists(int ph) { return ph == 0 || !((((ph - 1) % NPH_L) == 9 || ((ph - 1) % NPH_L) == 10) || (((ph - 1) / NPH_L) % 2 == 0 && ((ph - 1) % NPH_L) == 6)); }

__global__ void __launch_bounds__(NWAVES * 64, 2) mk_fwd(Args args) {
    extern __shared__ __attribute__((aligned(16))) unsigned char lds_raw[];
    LAS unsigned char* lds = (LAS unsigned char*)lds_raw;
    volatile LAS unsigned* MISC = (volatile LAS unsigned*)(lds + MISC_OFF);
    const int tid = threadIdx.x;
    const int Gk = gridDim.x; const int bxk = blockIdx.x; const int vcuk = (Gk % 8 == 0) ? (bxk % 8) * (Gk / 8) + bxk / 8 : bxk;
    for (int u = tid; u < (LDS_BYTES - LDSCTL_OFF) / 4; u += NWAVES * 64) ((LAS unsigned*)(lds + LDSCTL_OFF))[u] = 0u;
    __syncthreads();
    XcdBarrier bar; bar.bar = (unsigned*)(args.ws + WS_CTL) + CW_BAR; bar.x = 0; bar.st = nullptr;
    if (!MK_MULTI) bar = xcd_barrier_post((unsigned*)(args.ws + WS_CTL) + CW_BAR, MISC + 8);
    const int lo = args.ph_lo, hi = args.ph_hi;
#ifndef DIS
#define DIS 0
#endif
#ifndef REP
#define REP 0
#endif
#define EN(b) (!((DIS >> (b)) & 1))
#define IN(k) (lo <= (k) && (k) < hi)
#define PH_WS int z_ = 0, G = Gk, bx = bxk, vcu = vcuk; asm volatile("" : "+s"(z_), "+s"(G), "+s"(bx), "+s"(vcu)); unsigned char* ws = (unsigned char*)((GAS unsigned char*)args.ws + z_); (void)ws; (void)G; (void)bx; (void)vcu
#define XOUT ((float*)((GAS float*)args.out + z_))
#define GIN(k) ((const float*)((const GAS float*)args.in[k] + z_))
#define SEAM(k) do { if ((k) + 1 < hi) { if (MK_MULTI) { if (tid == 0) __hip_atomic_store((gu32*)(ws + WS_CTL) + CW_TMO, 0xBADBA0u, RLX_AGENT); } else xcd_barrier(bar); } } while (0)

    if (EN(0) && IN(0)) { PH_WS;
#if (REP >> 0) & 1
        { p0_prologue(args, lds, vcu, G); }
        __syncthreads();
#endif
        p0_prologue(args, lds, vcu, G);
        xcd_barrier(bar);
        p0_quant_weights(ws, vcu, G);
        SEAM(0); }

    for (int l = 0; l < DEPTH; ++l) {
        const int pb = 1 + NPH_L * l;
        if (EN(1) && IN(pb + 0)) { PH_WS;
#if (REP >> 1) & 1
            { unsigned char* wl = ws + WS_WSMALL + (size_t)l * WL_STRIDE;
            pg8::Gemm g{(const pg8::bf16_t*)(ws + WS_H), (const pg8::bf16_t*)(ws + WS_WIN8 + (size_t)l * DIN * D), T, DIN, D / 2}; pg8::StaticOrder S; S.init(T, DIN, G, bx); (void)wl;
            pg8::EpiInProjq E{(pg8::bf16_t*)(ws + WS_BIG), SLOT / 2, (const float*)(ws + WS_COS), attn_body::C2, (const float*)(ws + WS_SA), (const float*)(ws + WS_SB) + (size_t)l * DIN};
#ifdef STAGGER_US
            if (bx & 1) { const unsigned long long t0_ = __builtin_amdgcn_s_memrealtime(); while (__builtin_amdgcn_s_memrealtime() - t0_ < (unsigned long long)(STAGGER_US * 100)) __builtin_amdgcn_s_sleep(8); }
#endif
            pg8::gemm_phase<pg8::EpiInProjq, pg8::StaticOrder, true, true, 2>(lds + RING_OFF, g, S, E);
            }
            __syncthreads();
#endif
            unsigned char* wl = ws + WS_WSMALL + (size_t)l * WL_STRIDE;
            pg8::Gemm g{(const pg8::bf16_t*)(ws + WS_H), (const pg8::bf16_t*)(ws + WS_WIN8 + (size_t)l * DIN * D), T, DIN, D / 2}; pg8::StaticOrder S; S.init(T, DIN, G, bx); (void)wl;
            pg8::EpiInProjq E{(pg8::bf16_t*)(ws + WS_BIG), SLOT / 2, (const float*)(ws + WS_COS), attn_body::C2, (const float*)(ws + WS_SA), (const float*)(ws + WS_SB) + (size_t)l * DIN};
#ifdef STAGGER_US
            if (bx & 1) { const unsigned long long t0_ = __builtin_amdgcn_s_memrealtime(); while (__builtin_amdgcn_s_memrealtime() - t0_ < (unsigned long long)(STAGGER_US * 100)) __builtin_amdgcn_s_sleep(8); }
#endif
            pg8::gemm_phase<pg8::EpiInProjq, pg8::StaticOrder, true, true, 2>(lds + RING_OFF, g, S, E);

            SEAM(pb + 0);
        }
        if (EN(2) && IN(pb + 1)) { PH_WS;
#if (REP >> 2) & 1
            {
#if !defined(NO_LRU) && !defined(DUP_NO_LRU)
            for (int c = vcu; c < 256; c += G) lru_pass1(ws, lds, l, c);
            __syncthreads();
#endif
#if !defined(NO_ATT) && !defined(DUP_NO_ATT)
            const attn_body::AttnTensors AT{(const attn_body::bf16*)(ws + WS_Q), (const attn_body::bf16*)(ws + WS_K), (const attn_body::bf16*)(ws + WS_V), (attn_body::bf16*)(ws + WS_O2), (attn_body::bf16*)(ws + WS_YB)};
            { const float* par = (const float*)(ws + WS_PAR); const float* dl = par + PO_DLAM + l * 256; int t_ = threadIdx.x; asm volatile("" : "+v"(t_)); const int ln_ = t_ & 63;
              const float lamv = expf(wave_sum(dl[ln_] * dl[64 + ln_])) - expf(wave_sum(dl[128 + ln_] * dl[192 + ln_])) + (0.8f - 0.6f * expf(-0.3f * (float)l));
              attn_body::attn_phase<8>((char*)lds_raw + RING_OFF, AT, lamv, par + PO_SUBGS + l * 128, vcu, G); }
#endif
            }
            __syncthreads();
#endif

#ifndef NO_LRU
            for (int c = vcu; c < 256; c += G) lru_pass1(ws, lds, l, c);
            __syncthreads();
#endif
#ifndef NO_ATT
            const attn_body::AttnTensors AT{(const attn_body::bf16*)(ws + WS_Q), (const attn_body::bf16*)(ws + WS_K), (const attn_body::bf16*)(ws + WS_V), (attn_body::bf16*)(ws + WS_O2), (attn_body::bf16*)(ws + WS_YB)};
            { const float* par = (const float*)(ws + WS_PAR); const float* dl = par + PO_DLAM + l * 256; int t_ = threadIdx.x; asm volatile("" : "+v"(t_)); const int ln_ = t_ & 63;
              const float lamv = expf(wave_sum(dl[ln_] * dl[64 + ln_])) - expf(wave_sum(dl[128 + ln_] * dl[192 + ln_])) + (0.8f - 0.6f * expf(-0.3f * (float)l));
              attn_body::attn_phase<8>((char*)lds_raw + RING_OFF, AT, lamv, par + PO_SUBGS + l * 128, vcu, G); }
#endif

            SEAM(pb + 1);
        }
        if (EN(3) && IN(pb + 2)) { PH_WS;
#if (REP >> 3) & 1
            { for (int c = vcu; c < 256; c += G) tp_mix(ws, lds, l, c); }
            __syncthreads();
#endif
            for (int c = vcu; c < 256; c += G) tp_mix(ws, lds, l, c);
            SEAM(pb + 2); }
        if (EN(4) && IN(pb + 3)) { PH_WS;
#if (REP >> 4) & 1
            { unsigned char* wl = ws + WS_WSMALL + (size_t)l * WL_STRIDE;
            pg8::Gemm g{(const pg8::bf16_t*)(ws + WS_YA), (const pg8::bf16_t*)(wl + WL_WAB), T, D, D}; pg8::PairOrder S; S.base.init(T, D, G, bx);
            pg8::EpiMerge E{(const pg8::bf16_t*)(ws + WS_SGA), (const pg8::bf16_t*)(ws + WS_SGB), (pg8::bf16_t*)(ws + WS_T1), (pg8::bf16_t*)(ws + WS_MERGED), NPAN};
            pg8::gemm_phase<pg8::EpiMerge, pg8::PairOrder, true, true>(lds + RING_OFF, g, S, E);
            }
            __syncthreads();
#endif
            unsigned char* wl = ws + WS_WSMALL + (size_t)l * WL_STRIDE;
            pg8::Gemm g{(const pg8::bf16_t*)(ws + WS_YA), (const pg8::bf16_t*)(wl + WL_WAB), T, D, D}; pg8::PairOrder S; S.base.init(T, D, G, bx);
            pg8::EpiMerge E{(const pg8::bf16_t*)(ws + WS_SGA), (const pg8::bf16_t*)(ws + WS_SGB), (pg8::bf16_t*)(ws + WS_T1), (pg8::bf16_t*)(ws + WS_MERGED), NPAN};
            pg8::gemm_phase<pg8::EpiMerge, pg8::PairOrder, true, true>(lds + RING_OFF, g, S, E);

            SEAM(pb + 3);
        }
        if (EN(5) && IN(pb + 4)) { PH_WS;
#if (REP >> 5) & 1
            { unsigned char* wl = ws + WS_WSMALL + (size_t)l * WL_STRIDE;
            pg8::Gemm g{(const pg8::bf16_t*)(ws + WS_MERGED), (const pg8::bf16_t*)(wl + WL_WO), T, D, D}; pg8::StaticOrder S; S.init(T, D, G, bx);
            pg8::EpiPlainBf16 E{(pg8::bf16_t*)(ws + WS_F), D, 3};
            pg8::gemm_phase<pg8::EpiPlainBf16, pg8::StaticOrder, false, true>(lds + RING_OFF, g, S, E);
            }
            __syncthreads();
#endif
            unsigned char* wl = ws + WS_WSMALL + (size_t)l * WL_STRIDE;
            pg8::Gemm g{(const pg8::bf16_t*)(ws + WS_MERGED), (const pg8::bf16_t*)(wl + WL_WO), T, D, D}; pg8::StaticOrder S; S.init(T, D, G, bx);
            pg8::EpiPlainBf16 E{(pg8::bf16_t*)(ws + WS_F), D, 3};
            pg8::gemm_phase<pg8::EpiPlainBf16, pg8::StaticOrder, false, true>(lds + RING_OFF, g, S, E);

            SEAM(pb + 4);
        }
        if (EN(6) && IN(pb + 5)) { PH_WS;
#if (REP >> 6) & 1
            { const float* ng = (const float*)(ws + WS_PAR) + PO_NORMG + (size_t)l * 6 * D;
            if (l & 1) tp_post_pre<0, true, true, true>(ws, XOUT, lds, ng + 1 * D, ng + 2 * D, vcu, G);
            else tp_post_pre<0, false, true, false, false, true>(ws, XOUT, lds, ng + 1 * D, ng + 2 * D, vcu, G);
            }
            __syncthreads();
#endif
            const float* ng = (const float*)(ws + WS_PAR) + PO_NORMG + (size_t)l * 6 * D;
            if (l & 1) tp_post_pre<0, true, false, true>(ws, XOUT, lds, ng + 1 * D, ng + 2 * D, vcu, G);
            else tp_post_pre<0, false, false, false, false, true>(ws, XOUT, lds, ng + 1 * D, ng + 2 * D, vcu, G);

            SEAM(pb + 5);
        }
        if (!(l & 1)) {
            if (EN(7) && IN(pb + 7)) { PH_WS;
#if (REP >> 7) & 1
                {
                pg8::Gemm g{(const pg8::bf16_t*)(ws + WS_H), (const pg8::bf16_t*)(ws + WS_WGU8), T, 2 * FF, D / 2}; pg8::StaticOrder S; S.init(T, 2 * FF, G, bx);
                pg8::EpiSwiGLUq E{(pg8::bf16_t*)(ws + WS_ACT), FF, (const float*)(ws + WS_SA), (const float*)(ws + WS_SB) + 2 * DIN};
#ifdef STAGGER_US
            if (bx & 1) { const unsigned long long t0_ = __builtin_amdgcn_s_memrealtime(); while (__builtin_amdgcn_s_memrealtime() - t0_ < (unsigned long long)(STAGGER_US * 100)) __builtin_amdgcn_s_sleep(8); }
#endif
                pg8::gemm_phase<pg8::EpiSwiGLUq, pg8::StaticOrder, true, true, 2>(lds + RING_OFF, g, S, E);
                }
                __syncthreads();
#endif

                pg8::Gemm g{(const pg8::bf16_t*)(ws + WS_H), (const pg8::bf16_t*)(ws + WS_WGU8), T, 2 * FF, D / 2}; pg8::StaticOrder S; S.init(T, 2 * FF, G, bx);
                pg8::EpiSwiGLUq E{(pg8::bf16_t*)(ws + WS_ACT), FF, (const float*)(ws + WS_SA), (const float*)(ws + WS_SB) + 2 * DIN};
#ifdef STAGGER_US
            if (bx & 1) { const unsigned long long t0_ = __builtin_amdgcn_s_memrealtime(); while (__builtin_amdgcn_s_memrealtime() - t0_ < (unsigned long long)(STAGGER_US * 100)) __builtin_amdgcn_s_sleep(8); }
#endif
                pg8::gemm_phase<pg8::EpiSwiGLUq, pg8::StaticOrder, true, true, 2>(lds + RING_OFF, g, S, E);

                SEAM(pb + 7);
            }
            if (EN(8) && IN(pb + 8)) { PH_WS;
#if (REP >> 8) & 1
                {
                pg8::Gemm g{(const pg8::bf16_t*)(ws + WS_ACT), (const pg8::bf16_t*)(ws + WS_WD), T, D, FF}; pg8::StaticOrder S; S.init(T, D, G, bx);
                pg8::EpiPlainBf16 E{(pg8::bf16_t*)(ws + WS_F), D, 3};
                pg8::gemm_phase<pg8::EpiPlainBf16, pg8::StaticOrder, false, true>(lds + RING_OFF, g, S, E);
                }
                __syncthreads();
#endif

                pg8::Gemm g{(const pg8::bf16_t*)(ws + WS_ACT), (const pg8::bf16_t*)(ws + WS_WD), T, D, FF}; pg8::StaticOrder S; S.init(T, D, G, bx);
                pg8::EpiPlainBf16 E{(pg8::bf16_t*)(ws + WS_F), D, 3};
                pg8::gemm_phase<pg8::EpiPlainBf16, pg8::StaticOrder, false, true>(lds + RING_OFF, g, S, E);

                SEAM(pb + 8);
            }
            if (EN(9) && IN(pb + 11)) { PH_WS;
#if (REP >> 9) & 1
                { const float* ng = (const float*)(ws + WS_PAR) + PO_NORMG + (size_t)l * 6 * D;
                tp_post_pre<0, false, true, false, false, true>(ws, XOUT, lds, ng + 3 * D, ng + 4 * D, vcu, G); }
                __syncthreads();
#endif
                const float* ng = (const float*)(ws + WS_PAR) + PO_NORMG + (size_t)l * 6 * D;
                tp_post_pre<0, false, false, false, false, true>(ws, XOUT, lds, ng + 3 * D, ng + 4 * D, vcu, G);
                SEAM(pb + 11); }
        } else {
            if (EN(10) && IN(pb + 6)) { PH_WS;
#if (REP >> 10) & 1
                { pm0_moe_setup(ws, GIN(I_MG), GIN(I_MU), GIN(I_MD), lds, vcu, G); }
                __syncthreads();
#endif
                pm0_moe_setup(ws, GIN(I_MG), GIN(I_MU), GIN(I_MD), lds, vcu, G);
                SEAM(pb + 6); }
            if (EN(11) && IN(pb + 7)) { PH_WS; gu32* ctl = (gu32*)(ws + WS_CTL);
                int ps[NEXP + 1]; { int p = 0;
#pragma unroll
                    for (int e = 0; e < NEXP; ++e) { ps[e] = p; p += ((int)__hip_atomic_load(ctl + CW_CNT + 64 * e, RLX_AGENT) + 255) >> 8; } ps[NEXP] = p; }
#if (REP >> 11) & 1
                for (int rep_ = 0; rep_ < 2; ++rep_)
#endif
                {
                pg8::Gemm g{(const pg8::bf16_t*)(ws + WS_HG), (const pg8::bf16_t*)(ws + WS_WMGU), ps[NEXP] * 256, 2 * FF, D / 2, E8_H, E8_WGU};
                pg8::MoeOrder S; S.base.init(ps[NEXP] * 256, 2 * FF, G, bx); S.plo = 0; S.ps1 = ps[1]; S.ps2 = ps[2]; S.ps3 = ps[3]; S.ps4 = ps[4]; S.ps5 = ps[5]; S.ps6 = ps[6]; S.ps7 = ps[7];
                pg8::EpiSwiGLU8 E{ws + WS_ACT8, FF, 2 * FF / 256, 0, SC_ACT};
#ifdef STAGGER_US
            if (bx & 1) { const unsigned long long t0_ = __builtin_amdgcn_s_memrealtime(); while (__builtin_amdgcn_s_memrealtime() - t0_ < (unsigned long long)(STAGGER_US * 100)) __builtin_amdgcn_s_sleep(8); }
#endif
                pg8::gemm_phase<pg8::EpiSwiGLU8, pg8::MoeOrder, true, true, true>(lds + RING_OFF, g, S, E);
                }
                SEAM(pb + 7);
            }
            if (EN(12) && IN(pb + 8)) { PH_WS; gu32* ctl = (gu32*)(ws + WS_CTL);
                int ps[NEXP + 1]; { int p = 0;
#pragma unroll
                    for (int e = 0; e < NEXP; ++e) { ps[e] = p; p += ((int)__hip_atomic_load(ctl + CW_CNT + 64 * e, RLX_AGENT) + 255) >> 8; } ps[NEXP] = p; }
#if (REP >> 12) & 1
                for (int rep_ = 0; rep_ < 2; ++rep_)
#endif
                {
                const int npm = ps[NEXP] < MOE_MAINP ? ps[NEXP] : MOE_MAINP;
                pg8::Gemm g{(const pg8::bf16_t*)(ws + WS_ACT8), (const pg8::bf16_t*)(ws + WS_WMD), npm * 256, D, FF / 2, E8_ACT, E8_WD};
                pg8::MoeOrder S; S.base.init(npm * 256, D, G, bx); S.plo = 0; S.ps1 = ps[1]; S.ps2 = ps[2]; S.ps3 = ps[3]; S.ps4 = ps[4]; S.ps5 = ps[5]; S.ps6 = ps[6]; S.ps7 = ps[7];
                pg8::EpiPlainBf16 E{(pg8::bf16_t*)(ws + WS_OE), D, 3};
                pg8::gemm_phase<pg8::EpiPlainBf16, pg8::MoeOrder, true, true, true>(lds + RING_OFF, g, S, E);
                if (ps[NEXP] > MOE_MAINP) {
                    __syncthreads();
                    pg8::Gemm g2{(const pg8::bf16_t*)(ws + WS_ACT8), (const pg8::bf16_t*)(ws + WS_WMD), (ps[NEXP] - MOE_MAINP) * 256, D, MOE_KSB / 2, E8_ACT, E8_WD, FF / 2};
                    pg8::MoeKSplitOrder S2{G, bx, MOE_MAINP, ps[NEXP] - MOE_MAINP, D / 256, MOE_KS, MOE_KSB, ps[1], ps[2], ps[3], ps[4], ps[5], ps[6], ps[7]};
                    pg8::EpiSliceBf16 E2{(pg8::bf16_t*)(ws + WS_OEP), D, 3, MOE_MAINP, MOE_KSB, (size_t)8 * 256 * D};
                    pg8::gemm_phase<pg8::EpiSliceBf16, pg8::MoeKSplitOrder, true, true, true>(lds + RING_OFF, g2, S2, E2);
                }
                }
                SEAM(pb + 8);
            }
            if (EN(13) && IN(pb + 11)) { PH_WS;
#if (REP >> 13) & 1
                { const float* ng = (const float*)(ws + WS_PAR) + PO_NORMG + (size_t)l * 6 * D;
                tp_post_pre<1, false, true, false, false, true>(ws, XOUT, lds, ng + 3 * D, ng + 4 * D, vcu, G); }
                __syncthreads();
#endif
                const float* ng = (const float*)(ws + WS_PAR) + PO_NORMG + (size_t)l * 6 * D;
                tp_post_pre<1, false, false, false, false, true>(ws, XOUT, lds, ng + 3 * D, ng + 4 * D, vcu, G);
                SEAM(pb + 11); }
        }
        if (EN(14) && IN(pb + 12)) { PH_WS;
#if (REP >> 14) & 1
            { unsigned char* wl = ws + WS_WSMALL + (size_t)l * WL_STRIDE;
            { pg8::Gemm g{(const pg8::bf16_t*)(ws + WS_PB) + (size_t)l * T * PLE, (const pg8::bf16_t*)(wl + WL_WPP), T, D, PLE}; pg8::StaticOrder S; S.init(T, D, G, bx);
              pg8::EpiPlainBf16 E{(pg8::bf16_t*)(ws + WS_PP), D, 3};
              pg8::gemm_phase<pg8::EpiPlainBf16, pg8::StaticOrder, false, true>(lds + RING_OFF, g, S, E); }
            __syncthreads();
            { pg8::Gemm g{(const pg8::bf16_t*)(ws + WS_H), (const pg8::bf16_t*)(ws + WS_WPG8 + (size_t)l * D * D), T, D, D / 2}; pg8::StaticOrder S; S.init(T, D, G, bx);
              pg8::EpiPleGateq E{(pg8::bf16_t*)(ws + WS_F), (const pg8::bf16_t*)(ws + WS_PP), D, (const float*)(ws + WS_SA), (const float*)(ws + WS_SB) + 3 * DIN + (size_t)l * D};
              pg8::gemm_phase<pg8::EpiPleGateq, pg8::StaticOrder, false, true, 2>(lds + RING_OFF, g, S, E); }
            }
            __syncthreads();
#endif
            unsigned char* wl = ws + WS_WSMALL + (size_t)l * WL_STRIDE;
            { pg8::Gemm g{(const pg8::bf16_t*)(ws + WS_PB) + (size_t)l * T * PLE, (const pg8::bf16_t*)(wl + WL_WPP), T, D, PLE}; pg8::StaticOrder S; S.init(T, D, G, bx);
              pg8::EpiPlainBf16 E{(pg8::bf16_t*)(ws + WS_PP), D, 3};
              pg8::gemm_phase<pg8::EpiPlainBf16, pg8::StaticOrder, false, true>(lds + RING_OFF, g, S, E); }
            __syncthreads();
            { pg8::Gemm g{(const pg8::bf16_t*)(ws + WS_H), (const pg8::bf16_t*)(ws + WS_WPG8 + (size_t)l * D * D), T, D, D / 2}; pg8::StaticOrder S; S.init(T, D, G, bx);
              pg8::EpiPleGateq E{(pg8::bf16_t*)(ws + WS_F), (const pg8::bf16_t*)(ws + WS_PP), D, (const float*)(ws + WS_SA), (const float*)(ws + WS_SB) + 3 * DIN + (size_t)l * D};
              pg8::gemm_phase<pg8::EpiPleGateq, pg8::StaticOrder, false, true, 2>(lds + RING_OFF, g, S, E); }

            SEAM(pb + 12);
        }
        if (EN(15) && IN(pb + 13)) { PH_WS;
#if (REP >> 15) & 1
            { const float* ng = (const float*)(ws + WS_PAR) + PO_NORMG + (size_t)l * 6 * D;
            tp_post_pre<0, false, true>(ws, XOUT, lds, ng + 5 * D, (l + 1 < DEPTH) ? ng + 6 * D : nullptr, vcu, G); }
            __syncthreads();
#endif
            const float* ng = (const float*)(ws + WS_PAR) + PO_NORMG + (size_t)l * 6 * D;
            if (l + 1 < DEPTH) tp_post_pre<0, false, false, false, false, true>(ws, XOUT, lds, ng + 5 * D, ng + 6 * D, vcu, G);
            else tp_post_pre<0, false, false, false, true>(ws, XOUT, lds, ng + 5 * D, nullptr, vcu, G);
            SEAM(pb + 13); }
    }
#undef IN
#undef SEAM
#undef PH_WS
}

extern "C" void kernel_launch(void* const* d_in, const int* in_sizes, int n_in, void* d_out, int out_size, void* d_ws, size_t ws_size, hipStream_t stream) {
    static int grid = 0;
    if (grid == 0) {
        if (n_in != 26 || in_sizes[0] != T * D || out_size != T * D || ws_size < WS_END) { fprintf(stderr, "kernel_launch: unexpected shapes / workspace (n_in %d, in0 %d, out %d, ws %zu < %zu); nothing launched\n", n_in, n_in > 0 ? in_sizes[0] : -1, out_size, ws_size, (size_t)WS_END); grid = -1; return; }
        int dev = 0, cus = 0, per_cu = 0;
        if (hipGetDevice(&dev) != hipSuccess || hipDeviceGetAttribute(&cus, hipDeviceAttributeMultiprocessorCount, dev) != hipSuccess) { grid = -1; return; }
        if (hipFuncSetAttribute((const void*)mk_fwd, hipFuncAttributeMaxDynamicSharedMemorySize, LDS_BYTES) != hipSuccess) { fprintf(stderr, "kernel_launch: hipFuncSetAttribute failed\n"); grid = -1; return; }
        if (hipOccupancyMaxActiveBlocksPerMultiprocessor(&per_cu, (const void*)mk_fwd, NWAVES * 64, LDS_BYTES) != hipSuccess || per_cu < 1) { fprintf(stderr, "kernel_launch: occupancy query reports %d workgroups per CU\n", per_cu); (void)hipGetLastError(); grid = -1; return; }
        grid = cus;
    }
    if (grid < 0) return;
    if (hipMemsetAsync((char*)d_ws + WS_CTL, 0, CTL_ZERO_BYTES, stream) != hipSuccess) return;
    Args a{};
    for (int i = 0; i < 26; ++i) a.in[i] = d_in[i];
    a.out = (float*)d_out; a.ws = (unsigned char*)d_ws;
#if MK_MULTI
    for (int ph = 0; ph < NPHASES; ++ph) { if (!phase_exists(ph)) continue; a.ph_lo = ph; a.ph_hi = ph + 1; hipLaunchKernelGGL(mk_fwd, dim3(grid), dim3(NWAVES * 64), LDS_BYTES, stream, a); }
#else
    a.ph_lo = 0; a.ph_hi = NPHASES;
    hipLaunchKernelGGL(mk_fwd, dim3(grid), dim3(NWAVES * 64), LDS_BYTES, stream, a);
#endif
}
```

```cpp
#include <hip/hip_runtime.h>
#include <hip/hip_bf16.h>
#include <cstdio>
#include <cstdint>
#include <cmath>
namespace pg8 {
#define PG8_LAS __attribute__((address_space(3)))
typedef unsigned short bf16_t;
typedef short bf16x8 __attribute__((ext_vector_type(8)));
typedef float f32x4 __attribute__((ext_vector_type(4)));
typedef unsigned u32x4 __attribute__((ext_vector_type(4)));
constexpr int BM = 256, BK = 64, HALF = 128, HTB = HALF * BK * 2  , STAGE_BYTES = 8 * HTB, NXCD = 8, WGM = 8;

__host__ __device__ __forceinline__ int lds_byte(int r, int c) { const int st = (r >> 4) * 2 + (c >> 5), rr = r & 15, cc = c & 31, ob = rr * 64 + cc * 2; return st * 1024 + (ob ^ (((ob >> 9) & 1) << 5)); }
__host__ __device__ __forceinline__ void stage_rc(int b, int& R, int& C) { const int st = b / 1024, sb = b % 1024, swz = sb ^ (((sb >> 9) & 1) << 5); R = (st >> 1) * 16 + swz / 64; C = (st & 1) * 32 + (swz % 64) / 2; }
__host__ __device__ __forceinline__ int perm32(int rho) { const int n = rho >> 4, i = rho & 15; return 8 * (i >> 2) + 4 * n + (i & 3); }

struct Unit { int pm, pn; int ko = 0; };
typedef int v4i_t __attribute__((ext_vector_type(4)));
typedef int v8i_t __attribute__((ext_vector_type(8)));
struct Gemm { const bf16_t* A; const bf16_t* Bt; int M, N, K; int sa = 0x7f7f7f7f, sb = 0x7f7f7f7f; int ld = 0; };

struct StaticOrder {
    int nM, nN, nwg, G, c;
    __host__ __device__ void init(int M, int N, int G_, int c_) { nM = M / BM; nN = N / BM; nwg = nM * nN; G = G_; c = c_; }
    __host__ __device__ bool next(int i, Unit& u) const {
        const long L = (long)i * G + c; if (L >= nwg) return false;
        int wgid = (int)L; { const int q = nwg / NXCD, r = nwg % NXCD, xcd = wgid % NXCD, off = wgid / NXCD; wgid = (xcd < r ? xcd * (q + 1) : r * (q + 1) + (xcd - r) * q) + off; }
        const int nig = WGM * nN, gid = wgid / nig, fm = gid * WGM, gsz = (nM - fm) < WGM ? (nM - fm) : WGM;
        u.pm = fm + ((wgid % nig) % gsz); u.pn = (wgid % nig) / gsz; return true;
    }
    __device__ __forceinline__ void a_ready(const Unit&) const {}
    __device__ __forceinline__ void done(const Unit&) const {}
};

__device__ __forceinline__ unsigned cvt_pk_bf16(float lo, float hi) { unsigned r; asm volatile("v_cvt_pk_bf16_f32 %0, %1, %2" : "=v"(r) : "v"(lo), "v"(hi)); return r; }
typedef float f32x2 __attribute__((ext_vector_type(2)));
__device__ __forceinline__ f32x2 gelu_pk(f32x2 v) {
    const f32x2 av = __builtin_elementwise_abs(v), d = av * 0.2316418882f + 1.0f;
    f32x2 t; t.x = __builtin_amdgcn_rcpf(d.x); t.y = __builtin_amdgcn_rcpf(d.y);
    f32x2 q = t * 0.5307027145f + (-0.7265760135f); q = q * t + 0.7107068705f; q = q * t + (-0.142248368f); q = q * t + 0.127414796f; q = q * t;
    const f32x2 s = (v * v) * (-0.72134752044f);
    f32x2 e; e.x = __builtin_amdgcn_exp2f(s.x); e.y = __builtin_amdgcn_exp2f(s.y);
    const f32x2 m = v * (q * e), r = v - m;
    f32x2 o; o.x = v.x < 0.f ? m.x : r.x; o.y = v.y < 0.f ? m.y : r.y; return o;
}

typedef unsigned u32x2 __attribute__((ext_vector_type(2)));
#ifndef NT_EPI
#define NT_EPI 0
#endif
#if NT_EPI
#define ST16(p, v) __builtin_nontemporal_store((v), (u32x4*)(p))
#define ST8(p, v) __builtin_nontemporal_store((v), (u32x2*)(p))
#else
#define ST16(p, v) (*(u32x4*)(p) = (v))
#define ST8(p, v) (*(u32x2*)(p) = (v))
#endif
__device__ __forceinline__ float sigm(float v) { return __builtin_amdgcn_rcpf(1.0f + __builtin_amdgcn_exp2f(-1.4426950408889634f * v)); }
__device__ __forceinline__ f32x4 sigm4(f32x4 v) { return (f32x4){sigm(v[0]), sigm(v[1]), sigm(v[2]), sigm(v[3])}; }
__device__ __forceinline__ float gelu_tanh1(float v) { return v * sigm(1.5957691216057308f * v * (1.0f + 0.044715f * v * v)); }
__device__ __forceinline__ f32x4 gelu_tanh4(f32x4 v) { return (f32x4){gelu_tanh1(v[0]), gelu_tanh1(v[1]), gelu_tanh1(v[2]), gelu_tanh1(v[3])}; }
__device__ __forceinline__ u32x4 pack8(f32x4 a, f32x4 b) { u32x4 w; w.x = cvt_pk_bf16(a[0], a[1]); w.y = cvt_pk_bf16(a[2], a[3]); w.z = cvt_pk_bf16(b[0], b[1]); w.w = cvt_pk_bf16(b[2], b[3]); return w; }
__device__ __forceinline__ f32x4 bf_lo4(u32x4 w) { return (f32x4){__uint_as_float(w.x << 16), __uint_as_float(w.x & 0xffff0000u), __uint_as_float(w.y << 16), __uint_as_float(w.y & 0xffff0000u)}; }
__device__ __forceinline__ f32x4 bf_hi4(u32x4 w) { return (f32x4){__uint_as_float(w.z << 16), __uint_as_float(w.z & 0xffff0000u), __uint_as_float(w.w << 16), __uint_as_float(w.w & 0xffff0000u)}; }

struct EpiF32 {
    static constexpr bool PERM = false, AFTER_DRAIN = false;
    float* C; int ldc;
    __device__ __forceinline__ void operator()(const f32x4 (&acc)[2][2][4][2], const Unit& u, int wr, int wc, int fr, int fq) const {
        const int row0 = u.pm * BM + wr * 64 + fr, col0 = u.pn * BM + wc * 32 + 4 * fq;
#pragma unroll
        for (int ai = 0; ai < 2; ++ai)
#pragma unroll
            for (int m = 0; m < 4; ++m) { float* rowp = C + (size_t)(row0 + ai * HALF + m * 16) * ldc + col0;
#pragma unroll
                for (int bj = 0; bj < 2; ++bj)
#pragma unroll
                    for (int n = 0; n < 2; ++n) *(f32x4*)(rowp + bj * HALF + n * 16) = acc[ai][bj][m][n]; }
    }
};

__device__ const float ROPE_REV[32] = {
    0.15915494309f, 0.11934937021f, 0.089499401609f, 0.067115083005f, 0.050329212104f, 0.037741584717f, 0.028302195831f, 0.021223652765f,
    0.015915494309f, 0.011934937021f, 0.0089499401609f, 0.0067115083005f, 0.0050329212104f, 0.0037741584717f, 0.0028302195831f, 0.0021223652765f,
    0.0015915494309f, 0.0011934937021f, 0.00089499401609f, 0.00067115083005f, 0.00050329212104f, 0.00037741584717f, 0.00028302195831f, 0.00021223652765f,
    0.00015915494309f, 0.00011934937021f, 8.9499401609e-05f, 6.7115083005e-05f, 5.0329212104e-05f, 3.7741584717e-05f, 2.8302195831e-05f, 2.1223652765e-05f };
__device__ __forceinline__ f32x4 cos_rev4(f32x4 r) { return (f32x4){__builtin_amdgcn_cosf(__builtin_amdgcn_fractf(r[0])), __builtin_amdgcn_cosf(__builtin_amdgcn_fractf(r[1])), __builtin_amdgcn_cosf(__builtin_amdgcn_fractf(r[2])), __builtin_amdgcn_cosf(__builtin_amdgcn_fractf(r[3]))}; }
__device__ __forceinline__ f32x4 sin_rev4(f32x4 r) { return (f32x4){__builtin_amdgcn_sinf(__builtin_amdgcn_fractf(r[0])), __builtin_amdgcn_sinf(__builtin_amdgcn_fractf(r[1])), __builtin_amdgcn_sinf(__builtin_amdgcn_fractf(r[2])), __builtin_amdgcn_sinf(__builtin_amdgcn_fractf(r[3]))}; }
struct EpiInProj {
    static constexpr bool PERM = true, AFTER_DRAIN = false;
    bf16_t* out; size_t slot_stride; const float* posf; float qscale;
    __device__ __forceinline__ void operator()(const f32x4 (&acc)[2][2][4][2], const Unit& u, int wr, int wc, int fr, int fq) const {
        const int type = u.pn >> 2, sub = u.pn & 3;
        bf16_t* base = out + (size_t)type * slot_stride;
        const int row0 = u.pm * BM + wr * 64 + fr;
        if (type == 2 || type == 3) {
            const float sc = (type == 2) ? qscale : 1.0f;
            const int colb = sub * 256 + wc * 64 + 8 * fq;
            const f32x4 cf0 = *(const f32x4*)(ROPE_REV + 8 * fq), cf1 = *(const f32x4*)(ROPE_REV + 8 * fq + 4);
            float pv[2][4];
#pragma unroll
            for (int ai = 0; ai < 2; ++ai)
#pragma unroll
                for (int m = 0; m < 4; ++m) pv[ai][m] = posf[row0 + ai * HALF + m * 16];
#pragma unroll
            for (int ai = 0; ai < 2; ++ai)
#pragma unroll
                for (int m = 0; m < 4; ++m) { const int r = row0 + ai * HALF + m * 16;
                    const float p = pv[ai][m];
                    const f32x4 r0 = cf0 * p, r1 = cf1 * p;
                    const f32x4 c0 = cos_rev4(r0) * sc, c1 = cos_rev4(r1) * sc, s0 = sin_rev4(r0) * sc, s1 = sin_rev4(r1) * sc;
                    const f32x4 x0a = acc[ai][0][m][0], x0b = acc[ai][0][m][1], x1a = acc[ai][1][m][0], x1b = acc[ai][1][m][1];
                    const f32x4 y0a = x0a * c0 - x1a * s0, y0b = x0b * c1 - x1b * s1, y1a = x1a * c0 + x0a * s0, y1b = x1b * c1 + x0b * s1;
                    bf16_t* rowp = base + (size_t)r * 1024 + colb;
                    ST16(rowp, pack8(y0a, y0b)); ST16(rowp + 32, pack8(y1a, y1b)); }
        } else {
            const int colb = sub * 256 + wc * 64 + 8 * fq;
#pragma unroll
            for (int ai = 0; ai < 2; ++ai)
#pragma unroll
                for (int m = 0; m < 4; ++m) { bf16_t* rowp = base + (size_t)(row0 + ai * HALF + m * 16) * 1024 + colb;
#pragma unroll
                    for (int bj = 0; bj < 2; ++bj) { f32x4 v0 = acc[ai][bj][m][0], v1 = acc[ai][bj][m][1];
                        if (type == 0) { v0 = gelu_tanh4(v0); v1 = gelu_tanh4(v1); }
                        else if (type >= 5) { v0 = sigm4(v0); v1 = sigm4(v1); }
                        ST16(rowp + bj * 32, pack8(v0, v1)); } }
        }
    }
};

struct EpiMerge {
    static constexpr bool PERM = true, AFTER_DRAIN = false;
    const bf16_t* sga; const bf16_t* sgb; bf16_t* t1; bf16_t* merged; int nM;
    __device__ __forceinline__ void operator()(const f32x4 (&acc)[2][2][4][2], const Unit& u, int wr, int wc, int fr, int fq) const {
        const bool sel = u.pm >= nM; const int pm = sel ? u.pm - nM : u.pm, pn = u.pn & 3;
        const bf16_t* sg = sel ? sgb : sga;
        const int row0 = pm * BM + wr * 64 + fr, col0 = pn * BM + wc * 32 + 8 * fq;
#pragma unroll
        for (int ai = 0; ai < 2; ++ai) {
            u32x4 g[4][2], t[4][2];
#pragma unroll
            for (int m = 0; m < 4; ++m)
#pragma unroll
                for (int bj = 0; bj < 2; ++bj) { const size_t off = (size_t)(row0 + ai * HALF + m * 16) * 1024 + col0 + bj * HALF;
                    g[m][bj] = *(const u32x4*)(sg + off); if (sel) t[m][bj] = *(const u32x4*)(t1 + off); }
#pragma unroll
            for (int m = 0; m < 4; ++m)
#pragma unroll
                for (int bj = 0; bj < 2; ++bj) { const size_t off = (size_t)(row0 + ai * HALF + m * 16) * 1024 + col0 + bj * HALF;
                    f32x4 v0 = acc[ai][bj][m][0] * bf_lo4(g[m][bj]), v1 = acc[ai][bj][m][1] * bf_hi4(g[m][bj]);
                    if (!sel) *(u32x4*)(t1 + off) = pack8(v0, v1);
                    else { v0 = v0 + bf_lo4(t[m][bj]); v1 = v1 + bf_hi4(t[m][bj]); *(u32x4*)(merged + off) = pack8(v0, v1); } } }
    }
};

struct EpiSwiGLU {
    static constexpr bool PERM = true, AFTER_DRAIN = false;
    bf16_t* O; int ldc; int nper; int pm_sub;
    __device__ __forceinline__ void operator()(const f32x4 (&acc)[2][2][4][2], const Unit& u, int wr, int wc, int fr, int fq) const {
        const int pn = u.pn % nper;
        const int row0 = (u.pm - pm_sub) * BM + wr * 64 + fr, col0 = pn * HALF + wc * 32 + 8 * fq;
#pragma unroll
        for (int ai = 0; ai < 2; ++ai)
#pragma unroll
            for (int m = 0; m < 4; ++m) { const f32x4 g0 = acc[ai][0][m][0], g1 = acc[ai][0][m][1], u0 = acc[ai][1][m][0], u1 = acc[ai][1][m][1];
                const f32x4 a0 = g0 * sigm4(g0) * u0, a1 = g1 * sigm4(g1) * u1;
                ST16(O + (size_t)(row0 + ai * HALF + m * 16) * ldc + col0, pack8(a0, a1)); }
    }
};

__device__ __forceinline__ unsigned pk4_fp8(f32x4 v) { unsigned w = __builtin_amdgcn_cvt_pk_fp8_f32(v[0], v[1], 0u, false); return __builtin_amdgcn_cvt_pk_fp8_f32(v[2], v[3], w, true); }
__device__ __forceinline__ f32x4 clamp448(f32x4 v) { return (f32x4){__builtin_fminf(__builtin_fmaxf(v[0], -448.f), 448.f), __builtin_fminf(__builtin_fmaxf(v[1], -448.f), 448.f), __builtin_fminf(__builtin_fmaxf(v[2], -448.f), 448.f), __builtin_fminf(__builtin_fmaxf(v[3], -448.f), 448.f)}; }
struct EpiSwiGLU8 {
    static constexpr bool PERM = true, AFTER_DRAIN = false;
    unsigned char* O; int ldc; int nper; int pm_sub; float oscale;
    __device__ __forceinline__ void operator()(const f32x4 (&acc)[2][2][4][2], const Unit& u, int wr, int wc, int fr, int fq) const {
        const int pn = u.pn % nper;
        const int row0 = (u.pm - pm_sub) * BM + wr * 64 + fr, col0 = pn * HALF + wc * 32 + 8 * fq;
#pragma unroll
        for (int ai = 0; ai < 2; ++ai)
#pragma unroll
            for (int m = 0; m < 4; ++m) { const f32x4 g0 = acc[ai][0][m][0], g1 = acc[ai][0][m][1], u0 = acc[ai][1][m][0], u1 = acc[ai][1][m][1];
                const f32x4 a0 = clamp448(g0 * sigm4(g0) * u0 * oscale), a1 = clamp448(g1 * sigm4(g1) * u1 * oscale);
                u32x2 w; w.x = pk4_fp8(a0); w.y = pk4_fp8(a1);
                ST8(O + (size_t)(row0 + ai * HALF + m * 16) * ldc + col0, w); }
    }
};

typedef int i32x4 __attribute__((ext_vector_type(4)));
__device__ __forceinline__ f32x4 icvt(f32x4 a) { return __builtin_convertvector(__builtin_bit_cast(i32x4, a), f32x4); }
struct EpiSwiGLUq {
    static constexpr bool PERM = true, AFTER_DRAIN = false;
    bf16_t* O; int ldc; const float* sa; const float* sb;
    __device__ __forceinline__ void operator()(const f32x4 (&acc)[2][2][4][2], const Unit& u, int wr, int wc, int fr, int fq) const {
        const int row0 = u.pm * BM + wr * 64 + fr, col0 = u.pn * HALF + wc * 32 + 8 * fq, gc0 = u.pn * BM + wc * 32 + 8 * fq;
        const f32x4 bg0 = *(const f32x4*)(sb + gc0), bg1 = *(const f32x4*)(sb + gc0 + 4), bu0 = *(const f32x4*)(sb + gc0 + HALF), bu1 = *(const f32x4*)(sb + gc0 + HALF + 4);
        float sr[2][4];
#pragma unroll
        for (int ai = 0; ai < 2; ++ai)
#pragma unroll
            for (int m = 0; m < 4; ++m) sr[ai][m] = sa[row0 + ai * HALF + m * 16];
#pragma unroll
        for (int ai = 0; ai < 2; ++ai)
#pragma unroll
            for (int m = 0; m < 4; ++m) { const float s = sr[ai][m];
                const f32x4 g0 = icvt(acc[ai][0][m][0]) * (bg0 * s), g1 = icvt(acc[ai][0][m][1]) * (bg1 * s), u0 = icvt(acc[ai][1][m][0]) * (bu0 * s), u1 = icvt(acc[ai][1][m][1]) * (bu1 * s);
                const f32x4 a0 = g0 * sigm4(g0) * u0, a1 = g1 * sigm4(g1) * u1;
                ST16(O + (size_t)(row0 + ai * HALF + m * 16) * ldc + col0, pack8(a0, a1)); }
    }
};
struct EpiInProjq {
    static constexpr bool PERM = true, AFTER_DRAIN = false;
    bf16_t* out; size_t slot_stride; const float* posf; float qscale; const float* sa; const float* sb;
    __device__ __forceinline__ void operator()(const f32x4 (&acc)[2][2][4][2], const Unit& u, int wr, int wc, int fr, int fq) const {
        const int type = u.pn >> 2, sub = u.pn & 3;
        bf16_t* base = out + (size_t)type * slot_stride;
        const int row0 = u.pm * BM + wr * 64 + fr, gc0 = u.pn * BM + wc * 32 + 8 * fq;
        const f32x4 b00 = *(const f32x4*)(sb + gc0), b01 = *(const f32x4*)(sb + gc0 + 4), b10 = *(const f32x4*)(sb + gc0 + HALF), b11 = *(const f32x4*)(sb + gc0 + HALF + 4);
        const int colb = sub * 256 + wc * 64 + 8 * fq;
        if (type == 2 || type == 3) {
            const float sc = (type == 2) ? qscale : 1.0f;
            const f32x4 cf0 = *(const f32x4*)(ROPE_REV + 8 * fq), cf1 = *(const f32x4*)(ROPE_REV + 8 * fq + 4);
#pragma unroll
            for (int ai = 0; ai < 2; ++ai) {
                float sr[4], pv[4];
#pragma unroll
                for (int m = 0; m < 4; ++m) { sr[m] = sa[row0 + ai * HALF + m * 16]; pv[m] = posf[row0 + ai * HALF + m * 16]; }
#pragma unroll
                for (int m = 0; m < 4; ++m) { const int r = row0 + ai * HALF + m * 16; const float p = pv[m], s = sr[m] * sc;
                    bf16_t* rowp = base + (size_t)r * 1024 + colb;
                    { const f32x4 r0 = cf0 * p; const f32x4 c0 = cos_rev4(r0), s0 = sin_rev4(r0);
                      const f32x4 x0a = icvt(acc[ai][0][m][0]) * (b00 * s), x1a = icvt(acc[ai][1][m][0]) * (b10 * s);
                      const f32x4 y0a = x0a * c0 - x1a * s0, y1a = x1a * c0 + x0a * s0;
                      const f32x4 r1 = cf1 * p; const f32x4 c1 = cos_rev4(r1), s1 = sin_rev4(r1);
                      const f32x4 x0b = icvt(acc[ai][0][m][1]) * (b01 * s), x1b = icvt(acc[ai][1][m][1]) * (b11 * s);
                      const f32x4 y0b = x0b * c1 - x1b * s1, y1b = x1b * c1 + x0b * s1;
                      ST16(rowp, pack8(y0a, y0b)); ST16(rowp + 32, pack8(y1a, y1b)); } } }
        } else {
#pragma unroll
            for (int ai = 0; ai < 2; ++ai) {
                float sr[4];
#pragma unroll
                for (int m = 0; m < 4; ++m) sr[m] = sa[row0 + ai * HALF + m * 16];
#pragma unroll
                for (int m = 0; m < 4; ++m) { bf16_t* rowp = base + (size_t)(row0 + ai * HALF + m * 16) * 1024 + colb; const float s = sr[m];
#pragma unroll
                    for (int bj = 0; bj < 2; ++bj) { f32x4 v0 = icvt(acc[ai][bj][m][0]) * ((bj ? b10 : b00) * s), v1 = icvt(acc[ai][bj][m][1]) * ((bj ? b11 : b01) * s);
                        if (type == 0) { v0 = gelu_tanh4(v0); v1 = gelu_tanh4(v1); }
                        else if (type >= 5) { v0 = sigm4(v0); v1 = sigm4(v1); }
                        ST16(rowp + bj * 32, pack8(v0, v1)); } } }
        }
    }
};

struct EpiPleGateq {
    static constexpr bool PERM = true, AFTER_DRAIN = false;
    bf16_t* O; const bf16_t* PP; int ldc; const float* sa; const float* sb;
    __device__ __forceinline__ void operator()(const f32x4 (&acc)[2][2][4][2], const Unit& u, int wr, int wc, int fr, int fq) const {
        const int row0 = u.pm * BM + wr * 64 + fr, col0 = u.pn * BM + wc * 32 + 8 * fq;
        const f32x4 b00 = *(const f32x4*)(sb + col0), b01 = *(const f32x4*)(sb + col0 + 4), b10 = *(const f32x4*)(sb + col0 + HALF), b11 = *(const f32x4*)(sb + col0 + HALF + 4);
#pragma unroll
        for (int ai = 0; ai < 2; ++ai) {
            u32x4 p[4][2]; float sr[4];
#pragma unroll
            for (int m = 0; m < 4; ++m) { sr[m] = sa[row0 + ai * HALF + m * 16];
#pragma unroll
                for (int bj = 0; bj < 2; ++bj) p[m][bj] = *(const u32x4*)(PP + (size_t)(row0 + ai * HALF + m * 16) * ldc + col0 + bj * HALF); }
#pragma unroll
            for (int m = 0; m < 4; ++m)
#pragma unroll
                for (int bj = 0; bj < 2; ++bj) { const size_t ro = (size_t)(row0 + ai * HALF + m * 16) * ldc + col0 + bj * HALF;
                    *(u32x4*)(O + ro) = pack8(sigm4(icvt(acc[ai][bj][m][0]) * ((bj ? b10 : b00) * sr[m])) * bf_lo4(p[m][bj]), sigm4(icvt(acc[ai][bj][m][1]) * ((bj ? b11 : b01) * sr[m])) * bf_hi4(p[m][bj])); } }
    }
};
struct EpiPlainBf16 {
    static constexpr bool PERM = true, AFTER_DRAIN = false;
    bf16_t* O; int ldc; int pn_mask;
    __device__ __forceinline__ void operator()(const f32x4 (&acc)[2][2][4][2], const Unit& u, int wr, int wc, int fr, int fq) const {
        const int row0 = u.pm * BM + wr * 64 + fr, col0 = (u.pn & pn_mask) * BM + wc * 32 + 8 * fq;
#pragma unroll
        for (int ai = 0; ai < 2; ++ai)
#pragma unroll
            for (int m = 0; m < 4; ++m) { bf16_t* rowp = O + (size_t)(row0 + ai * HALF + m * 16) * ldc + col0;
#pragma unroll
                for (int bj = 0; bj < 2; ++bj) ST16(rowp + bj * HALF, pack8(acc[ai][bj][m][0], acc[ai][bj][m][1])); }
    }
};

struct EpiPleGate {
    static constexpr bool PERM = true, AFTER_DRAIN = false;
    bf16_t* O; const bf16_t* PP; int ldc;
    __device__ __forceinline__ void operator()(const f32x4 (&acc)[2][2][4][2], const Unit& u, int wr, int wc, int fr, int fq) const {
        const int row0 = u.pm * BM + wr * 64 + fr, col0 = u.pn * BM + wc * 32 + 8 * fq;
#pragma unroll
        for (int ai = 0; ai < 2; ++ai) {
            u32x4 p[4][2];
#pragma unroll
            for (int m = 0; m < 4; ++m)
#pragma unroll
                for (int bj = 0; bj < 2; ++bj) p[m][bj] = *(const u32x4*)(PP + (size_t)(row0 + ai * HALF + m * 16) * ldc + col0 + bj * HALF);
#pragma unroll
            for (int m = 0; m < 4; ++m)
#pragma unroll
                for (int bj = 0; bj < 2; ++bj) { const size_t ro = (size_t)(row0 + ai * HALF + m * 16) * ldc + col0 + bj * HALF;
                    *(u32x4*)(O + ro) = pack8(sigm4(acc[ai][bj][m][0]) * bf_lo4(p[m][bj]), sigm4(acc[ai][bj][m][1]) * bf_hi4(p[m][bj])); } }
    }
};

struct MoeKSplitOrder {
    int G, c, p0, npan, nN, S, kbytes; int ps1, ps2, ps3, ps4, ps5, ps6, ps7;
    __device__ __forceinline__ bool next(int i, Unit& u) const {
        const int L = i * G + c; if (L >= npan * nN * S) return false;
        const int ks = L % S, r = L / S, pn = r % nN, p = p0 + r / nN;
        const int e = (p >= ps1) + (p >= ps2) + (p >= ps3) + (p >= ps4) + (p >= ps5) + (p >= ps6) + (p >= ps7);
        u.pm = p; u.pn = e * nN + pn; u.ko = ks * kbytes; return true;
    }
    __device__ __forceinline__ void a_ready(const Unit&) const {}
    __device__ __forceinline__ void done(const Unit&) const {}
};
struct EpiSliceBf16 {
    static constexpr bool PERM = true, AFTER_DRAIN = false;
    bf16_t* O; int ldc; int pn_mask; int p0; int kbytes; size_t slice_stride;
    __device__ __forceinline__ void operator()(const f32x4 (&acc)[2][2][4][2], const Unit& u, int wr, int wc, int fr, int fq) const {
        bf16_t* Ob = O + (size_t)(u.ko / kbytes) * slice_stride;
        const int row0 = (u.pm - p0) * BM + wr * 64 + fr, col0 = (u.pn & pn_mask) * BM + wc * 32 + 8 * fq;
#pragma unroll
        for (int ai = 0; ai < 2; ++ai)
#pragma unroll
            for (int m = 0; m < 4; ++m) { bf16_t* rowp = Ob + (size_t)(row0 + ai * HALF + m * 16) * ldc + col0;
#pragma unroll
                for (int bj = 0; bj < 2; ++bj) ST16(rowp + bj * HALF, pack8(acc[ai][bj][m][0], acc[ai][bj][m][1])); }
    }
};
struct PairOrder {
    StaticOrder base;
    __device__ __forceinline__ bool next(int i, Unit& u) const { if (!base.next(i >> 1, u)) return false; if (i & 1) { u.pm += base.nM; u.pn += base.nN; } return true; }
    __device__ __forceinline__ void a_ready(const Unit&) const {}
    __device__ __forceinline__ void done(const Unit&) const {}
};
struct MoeOrder {
    StaticOrder base; int plo; int ps1, ps2, ps3, ps4, ps5, ps6, ps7;
    __device__ __forceinline__ bool next(int i, Unit& u) const {
        if (!base.next(i, u)) return false;
        const int p = u.pm + plo;
        const int e = (p >= ps1) + (p >= ps2) + (p >= ps3) + (p >= ps4) + (p >= ps5) + (p >= ps6) + (p >= ps7);
        u.pm = p; u.pn += e * base.nN; return true;
    }
    __device__ __forceinline__ void a_ready(const Unit&) const {}
    __device__ __forceinline__ void done(const Unit&) const {}
};
template <class Epi, class Sched, bool ALIGN_EPI = false, bool SP2 = false, int QM = 0>
__device__ __forceinline__ void gemm_phase(PG8_LAS unsigned char* lds, const Gemm g, const Sched& S, const Epi& E) {
    int tid_ = threadIdx.x; asm volatile("" : "+v"(tid_));
    const int tid = tid_, wid = __builtin_amdgcn_readfirstlane(tid >> 6), lane = tid & 63, wr = wid >> 2, wc = wid & 3, fr = lane & 15, fq = lane >> 4;
    const int K = g.K, nt = K / BK, LD = g.ld ? g.ld : K;
    unsigned voffA[2], voffB[2];
#pragma unroll
    for (int i = 0; i < 2; ++i) { int R, C; stage_rc(tid * 16 + i * 8192, R, C); const int Rb = Epi::PERM ? ((R & ~31) + perm32(R & 31)) : R;
        voffA[i] = (unsigned)(R * LD + C) * 2u; voffB[i] = (unsigned)(Rb * LD + C) * 2u; }
    const size_t kstep = (size_t)(BK * 2);
    const size_t hstep = (size_t)HALF * LD * 2;
    const size_t tstep = 2 * hstep;
    const unsigned ldsw = (unsigned)wid * 1024u;
    const int aoff = lds_byte(wr * 64 + fr, fq * 8), boff = lds_byte(wc * 32 + fr, fq * 8);
#define PG8_SA(b, h) (((b) * 2 + (h)) * HTB)
#define PG8_SB(b, h) ((4 + (b) * 2 + (h)) * HTB)
#define PG8_STAGE(bufoff, gbase, voff) do { _Pragma("unroll") for (int _i = 0; _i < 2; ++_i) \
        __builtin_amdgcn_global_load_lds((const unsigned*)((const char*)(gbase) + (voff)[_i]), (PG8_LAS unsigned*)(lds + (bufoff) + ldsw + _i * 8192), 16, 0, 0); } while (0)
#define PG8_CAT(a, b) __builtin_shufflevector(__builtin_bit_cast(v4i_t, a), __builtin_bit_cast(v4i_t, b), 0, 1, 2, 3, 4, 5, 6, 7)
#define PG8_LDA(dst, b, h) do { _Pragma("unroll") for (int m = 0; m < 4; ++m) { const bf16x8 r0_ = *(const PG8_LAS bf16x8*)(lds + PG8_SA(b, h) + aoff + m * 2048), r1_ = *(const PG8_LAS bf16x8*)(lds + PG8_SA(b, h) + aoff + m * 2048 + 1024); \
        if constexpr (QM == 1) dst##8[m] = PG8_CAT(r0_, r1_); else { dst[m][0] = r0_; dst[m][1] = r1_; } } } while (0)
#define PG8_LDB(dst, b, h) do { _Pragma("unroll") for (int n = 0; n < 2; ++n) { const bf16x8 r0_ = *(const PG8_LAS bf16x8*)(lds + PG8_SB(b, h) + boff + n * 2048), r1_ = *(const PG8_LAS bf16x8*)(lds + PG8_SB(b, h) + boff + n * 2048 + 1024); \
        if constexpr (QM == 1) dst##8[n] = PG8_CAT(r0_, r1_); else { dst[n][0] = r0_; dst[n][1] = r1_; } } } while (0)
#define PG8_MMA(ai, bj, At, Bt) do { __builtin_amdgcn_s_setprio(1); _Pragma("unroll") for (int m = 0; m < 4; ++m) _Pragma("unroll") for (int n = 0; n < 2; ++n) { \
        if constexpr (QM == 2) { _Pragma("unroll") for (int k = 0; k < 2; ++k) acc[ai][bj][m][n] = __builtin_bit_cast(f32x4, __builtin_amdgcn_mfma_i32_16x16x64_i8(__builtin_bit_cast(v4i_t, Bt[n][k]), __builtin_bit_cast(v4i_t, At[m][k]), __builtin_bit_cast(v4i_t, acc[ai][bj][m][n]), 0, 0, 0)); } \
        else if constexpr (QM == 1) asm volatile("v_mfma_scale_f32_16x16x128_f8f6f4 %0, %1, %2, %0, %3, %4 op_sel_hi:[0,0,0]" : "+v"(acc[ai][bj][m][n]) : "v"(Bt##8[n]), "v"(At##8[m]), "v"(sbv), "v"(sav));   \
        else { _Pragma("unroll") for (int k = 0; k < 2; ++k) acc[ai][bj][m][n] = __builtin_amdgcn_mfma_f32_16x16x32_bf16(Bt[n][k], At[m][k], acc[ai][bj][m][n], 0, 0, 0); } } \
        __builtin_amdgcn_s_setprio(0); } while (0)
#define PG8_WAIT_V(n) asm volatile("s_waitcnt vmcnt(" #n ")" ::: "memory")
#define PG8_WAIT_L(n) asm volatile("s_waitcnt lgkmcnt(" #n ")" ::: "memory")
#define PG8_BAR __builtin_amdgcn_s_barrier()
#define PG8_SCHED __builtin_amdgcn_sched_barrier(0)
    Unit cur, nxt; int ui = 0;
    if (!S.next(0, cur)) return;
    f32x4 acc[2][2][4][2];
#pragma unroll
    for (int a = 0; a < 2; ++a)
#pragma unroll
        for (int b = 0; b < 2; ++b)
#pragma unroll
            for (int m = 0; m < 4; ++m)
#pragma unroll
                for (int n = 0; n < 2; ++n) acc[a][b][m][n] = (f32x4){0.f, 0.f, 0.f, 0.f};
    bf16x8 At[4][2], B0[2][2], B1[2][2];
    v8i_t At8[4], B08[2], B18[2];
    (void)At; (void)B0; (void)B1; (void)At8; (void)B08; (void)B18;
    const int sav = g.sa, sbv = g.sb; (void)sav; (void)sbv;
    const char* cA = (const char*)g.A + (size_t)cur.pm * tstep + cur.ko; const char* cB = (const char*)g.Bt + (size_t)cur.pn * tstep + cur.ko;
    S.a_ready(cur);
    if constexpr (SP2) {
        PG8_STAGE(PG8_SB(0, 0), cB, voffB); PG8_STAGE(PG8_SB(0, 1), cB + hstep, voffB); PG8_STAGE(PG8_SA(0, 0), cA, voffA); PG8_STAGE(PG8_SA(0, 1), cA + hstep, voffA);
        if (wr == 1) PG8_BAR;
        PG8_WAIT_V(2); PG8_BAR;
        PG8_STAGE(PG8_SB(1, 0), cB + kstep, voffB); PG8_STAGE(PG8_SA(1, 0), cA + kstep, voffA); PG8_STAGE(PG8_SB(1, 1), cB + hstep + kstep, voffB);
        PG8_WAIT_V(6); PG8_BAR;
    } else {
        PG8_STAGE(PG8_SB(0, 0), cB, voffB); PG8_STAGE(PG8_SA(0, 0), cA, voffA); PG8_STAGE(PG8_SB(0, 1), cB + hstep, voffB); PG8_STAGE(PG8_SA(0, 1), cA + hstep, voffA);
        if (wr == 1) PG8_BAR;
        PG8_WAIT_V(4); PG8_BAR;
        PG8_STAGE(PG8_SB(1, 0), cB + kstep, voffB); PG8_STAGE(PG8_SA(1, 0), cA + kstep, voffA); PG8_STAGE(PG8_SB(1, 1), cB + hstep + kstep, voffB);
        PG8_WAIT_V(6); PG8_BAR;
    }
    for (;;) {
        const bool has_next = S.next(ui + 1, nxt);
        const char* nA = has_next ? (const char*)g.A + (size_t)nxt.pm * tstep + nxt.ko : cA; const char* nB = has_next ? (const char*)g.Bt + (size_t)nxt.pn * tstep + nxt.ko : cB;
        for (int t = 0; t < nt; t += 2) {
            const bool last = (t == nt - 2);
            const char* a1 = cA + (size_t)(t + 1) * kstep;
            const char* a2 = last ? nA : cA + (size_t)(t + 2) * kstep; const char* b2 = last ? nB : cB + (size_t)(t + 2) * kstep;
            const char* a3 = a2 + kstep; const char* b3 = b2 + kstep;
            if (last && has_next) S.a_ready(nxt);
            if constexpr (SP2) {
            PG8_LDB(B0, 0, 0); PG8_LDB(B1, 0, 1); PG8_SCHED; PG8_LDA(At, 0, 0); PG8_STAGE(PG8_SA(1, 1), a1 + hstep, voffA);
            PG8_WAIT_V(8); PG8_WAIT_L(0); PG8_BAR; PG8_MMA(0, 0, At, B0); PG8_MMA(0, 1, At, B1); PG8_BAR; PG8_SCHED;
            PG8_LDA(At, 0, 1); PG8_STAGE(PG8_SB(0, 0), b2, voffB); PG8_STAGE(PG8_SB(0, 1), b2 + hstep, voffB); PG8_STAGE(PG8_SA(0, 0), a2, voffA);
            PG8_WAIT_V(8); PG8_WAIT_L(0); PG8_BAR; PG8_MMA(1, 0, At, B0); PG8_MMA(1, 1, At, B1); PG8_BAR; PG8_SCHED;
            PG8_LDB(B0, 1, 0); PG8_LDB(B1, 1, 1); PG8_SCHED; PG8_LDA(At, 1, 0); PG8_STAGE(PG8_SA(0, 1), a2 + hstep, voffA);
            PG8_WAIT_V(8); PG8_WAIT_L(0); PG8_BAR; PG8_MMA(0, 0, At, B0); PG8_MMA(0, 1, At, B1); PG8_BAR; PG8_SCHED;
            PG8_LDA(At, 1, 1); PG8_STAGE(PG8_SB(1, 0), b3, voffB); PG8_STAGE(PG8_SB(1, 1), b3 + hstep, voffB); PG8_STAGE(PG8_SA(1, 0), a3, voffA);
            PG8_WAIT_V(8); PG8_WAIT_L(0); PG8_BAR; PG8_MMA(1, 0, At, B0); PG8_MMA(1, 1, At, B1); PG8_BAR; PG8_SCHED;
            } else {
            PG8_LDB(B0, 0, 0); PG8_SCHED; PG8_LDA(At, 0, 0); PG8_STAGE(PG8_SA(1, 1), a1 + hstep, voffA);
            PG8_WAIT_L(8); PG8_BAR; PG8_WAIT_L(0); PG8_MMA(0, 0, At, B0); PG8_BAR; PG8_SCHED;
            PG8_LDB(B1, 0, 1); PG8_STAGE(PG8_SB(0, 0), b2, voffB);
            PG8_BAR; PG8_WAIT_L(0); PG8_MMA(0, 1, At, B1); PG8_BAR;
            PG8_LDA(At, 0, 1); PG8_STAGE(PG8_SA(0, 0), a2, voffA);
            PG8_BAR; PG8_WAIT_L(0); PG8_MMA(1, 0, At, B0); PG8_BAR; PG8_SCHED;
            PG8_STAGE(PG8_SB(0, 1), b2 + hstep, voffB);
            PG8_WAIT_V(6); PG8_BAR; PG8_MMA(1, 1, At, B1); PG8_BAR;
            PG8_LDB(B0, 1, 0); PG8_SCHED; PG8_LDA(At, 1, 0); PG8_STAGE(PG8_SA(0, 1), a2 + hstep, voffA);
            PG8_WAIT_L(8); PG8_BAR; PG8_WAIT_L(0); PG8_MMA(0, 0, At, B0); PG8_BAR; PG8_SCHED;
            PG8_LDB(B1, 1, 1); PG8_STAGE(PG8_SB(1, 0), b3, voffB);
            PG8_BAR; PG8_WAIT_L(0); PG8_MMA(0, 1, At, B1); PG8_BAR;
            PG8_LDA(At, 1, 1); PG8_STAGE(PG8_SA(1, 0), a3, voffA);
            PG8_BAR; PG8_WAIT_L(0); PG8_MMA(1, 0, At, B0); PG8_BAR; PG8_SCHED;
            PG8_STAGE(PG8_SB(1, 1), b3 + hstep, voffB);
            PG8_WAIT_V(6); PG8_BAR; PG8_MMA(1, 1, At, B1); PG8_BAR;
            }
        }
        if constexpr (ALIGN_EPI) { if (wr == 0) PG8_BAR; }
        if constexpr (!Epi::AFTER_DRAIN) { E(acc, cur, wr, wc, fr, fq); S.done(cur); }
        if (!has_next) break;
#pragma unroll
        for (int a = 0; a < 2; ++a)
#pragma unroll
            for (int b = 0; b < 2; ++b)
#pragma unroll
                for (int m = 0; m < 4; ++m)
#pragma unroll
                    for (int n = 0; n < 2; ++n) acc[a][b][m][n] = (f32x4){0.f, 0.f, 0.f, 0.f};
        cur = nxt; cA = nA; cB = nB; ++ui;
        if constexpr (ALIGN_EPI) { if (wr == 1) PG8_BAR; }
    }
    PG8_WAIT_V(0);
    if constexpr (!ALIGN_EPI) { if (wr == 0) PG8_BAR; }
    PG8_BAR;
    if constexpr (Epi::AFTER_DRAIN) { E.fused(acc, cur, wr, wc, fr, fq, lds, wid, lane); S.done(cur); }
#undef PG8_SA
#undef PG8_SB
#undef PG8_STAGE
#undef PG8_LDA
#undef PG8_LDB
#undef PG8_MMA
#undef PG8_CAT
#undef PG8_WAIT_V
#undef PG8_WAIT_L
#undef PG8_BAR
#undef PG8_SCHED
}
}
#include <hip/hip_bf16.h>
#include <hip/hip_bf16.h>
#include <cmath>
namespace attn_body {
using bf16=__hip_bfloat16;
using bf16x8=__attribute__((ext_vector_type(8)))short;
using s16x4=__attribute__((ext_vector_type(4)))short;
using f32x16=__attribute__((ext_vector_type(16)))float;
using u32x4=__attribute__((ext_vector_type(4)))unsigned;
constexpr int BATCH=4,NHEAD=16,SEQ=4096,D=64,DM=NHEAD*D;
constexpr int NW=8,QBLK=32,QB=QBLK*NW,KVBLK=64,NQB=SEQ/QB;
constexpr int ATTN_PITCH=DM, ATTN_UNIT_ROWS=QB;
__device__ __forceinline__ int crow(int r,int hi){return (r&3)+8*(r>>2)+4*hi;}
#define SBAR() __builtin_amdgcn_sched_barrier(0)
__device__ __forceinline__ void cmask(f32x16&p0,f32x16&p1,int jb,int qrel,int hi){
  const float NEG=-INFINITY; int kb=64*jb+4*hi;
  #pragma unroll
  for(int r=0;r<16;++r){int kv=kb+(r&3)+8*(r>>2); if(kv>qrel)p0[r]=NEG; if(kv+32>qrel)p1[r]=NEG;}
}

constexpr int NSLOT=3, SLOTB=8192, SLOTV=16384;
constexpr int LDS_K=0, LDS_V=NSLOT*SLOTB, LDS_WS=LDS_V+NSLOT*SLOTV, LDS_OST=LDS_WS+NW*64*4, LDS_BYTES=LDS_OST;
constexpr float C2=0.125f*1.4426950408889634f;
__device__ __forceinline__ void glds16(const void*gsrc,unsigned lds_dst){unsigned keep;
  asm volatile("s_mov_b32 %0, m0\n\ts_mov_b32 m0, %2\n\ts_nop 0\n\tglobal_load_lds_dwordx4 %1, off\n\ts_mov_b32 m0, %0":"=&s"(keep):"v"(gsrc),"s"(lds_dst):"memory");}
__device__ __forceinline__ float max3f(float a,float b,float c){float r;asm("v_max3_f32 %0, %1, %2, %3":"=v"(r):"v"(a),"v"(b),"v"(c));return r;}
__device__ __forceinline__ float max2f(float a,float b){float r;asm("v_max_f32_e32 %0, %1, %2":"=v"(r):"v"(a),"v"(b));return r;}
__device__ __forceinline__ float fadd_s(float a,float b){float r;asm("v_add_f32_e32 %0, %1, %2":"=v"(r):"v"(a),"v"(b));return r;}
__device__ __forceinline__ float fsub_s(float a,float b){float r;asm("v_sub_f32_e32 %0, %1, %2":"=v"(r):"v"(a),"v"(b));return r;}
typedef float f32x2_t __attribute__((ext_vector_type(2))); typedef __bf16 bf16x2_t __attribute__((ext_vector_type(2)));
__device__ __forceinline__ unsigned cvtpk_s(float lo,float hi){f32x2_t v={lo,hi};bf16x2_t b=__builtin_convertvector(v,bf16x2_t);return __builtin_bit_cast(unsigned,b);}
#define WAIT_BAR(N) asm volatile("s_waitcnt vmcnt(" #N ") lgkmcnt(0)\n\ts_barrier":::"memory")

__device__ __forceinline__ void qkt(f32x16&p0,f32x16&p1,const char*Kslot,const bf16x8*qr,int r32,int hi){ const f32x16 negm=f32x16{};
  const char*kb=Kslot+hi*1024+r32*16;
  #pragma unroll
  for(int d0=0;d0<4;++d0){
    const bf16x8 b0=*reinterpret_cast<const bf16x8*>(kb+d0*2048);
    const bf16x8 b1=*reinterpret_cast<const bf16x8*>(kb+d0*2048+512);
    if(d0==0){p0=__builtin_amdgcn_mfma_f32_32x32x16_bf16(b0,qr[0],negm,0,0,0);p1=__builtin_amdgcn_mfma_f32_32x32x16_bf16(b1,qr[0],negm,0,0,0);}
    else{p0=__builtin_amdgcn_mfma_f32_32x32x16_bf16(b0,qr[d0],p0,0,0,0);p1=__builtin_amdgcn_mfma_f32_32x32x16_bf16(b1,qr[d0],p1,0,0,0);}}
}
typedef __attribute__((address_space(3))) const char* lds_cptr;
typedef short v4i16_t __attribute__((ext_vector_type(4)));
__device__ __forceinline__ void kload8(bf16x8*kf,lds_cptr kp){
  kf[0]=*(const __attribute__((address_space(3))) bf16x8*)(kp);      kf[1]=*(const __attribute__((address_space(3))) bf16x8*)(kp+512);
  kf[2]=*(const __attribute__((address_space(3))) bf16x8*)(kp+2048); kf[3]=*(const __attribute__((address_space(3))) bf16x8*)(kp+2560);
  kf[4]=*(const __attribute__((address_space(3))) bf16x8*)(kp+4096); kf[5]=*(const __attribute__((address_space(3))) bf16x8*)(kp+4608);
  kf[6]=*(const __attribute__((address_space(3))) bf16x8*)(kp+6144); kf[7]=*(const __attribute__((address_space(3))) bf16x8*)(kp+6656);
}
__device__ __forceinline__ void kload2(bf16x8*kf,lds_cptr kp,int j){ kf[2*j]=*(const __attribute__((address_space(3))) bf16x8*)(kp+j*2048); kf[2*j+1]=*(const __attribute__((address_space(3))) bf16x8*)(kp+j*2048+512); }
__device__ __forceinline__ s16x4 vtr(lds_cptr p){ return __builtin_bit_cast(s16x4,__builtin_amdgcn_ds_read_tr16_b64_v4i16((__attribute__((address_space(3))) v4i16_t*)p)); }
__device__ __forceinline__ float rowmax(const f32x16&p0,const f32x16&p1){
  float a=max3f(p0[0],p0[1],p1[0]),b=max3f(p0[2],p0[3],p1[1]);a=max3f(a,p1[2],p1[3]);
  #pragma unroll
  for(int r=4;r<16;r+=4){a=max3f(a,p0[r],p0[r+1]);b=max3f(b,p0[r+2],p0[r+3]);a=max3f(a,p1[r],p1[r+1]);b=max3f(b,p1[r+2],p1[r+3]);}
  const float m=max2f(a,b);
  auto rr=__builtin_amdgcn_permlane32_swap(__float_as_uint(m),__float_as_uint(m),false,false);
  return max2f(__uint_as_float(rr[0]),__uint_as_float(rr[1]));
}
__device__ __forceinline__ void pv(f32x16*o,int vb,bf16x8 pa0,bf16x8 pa1,bf16x8 pa2,bf16x8 pa3){
  #pragma unroll
  for(int d0=0;d0<4;++d0){s16x4 lo[4],hi[4];
    #pragma unroll
    for(int ks=0;ks<4;++ks){
      asm volatile("ds_read_b64_tr_b16 %0,%1 offset:%c2":"=&v"(lo[ks]):"v"(vb),"i"(d0*4096+ks*1024):"memory");
      asm volatile("ds_read_b64_tr_b16 %0,%1 offset:%c2":"=&v"(hi[ks]):"v"(vb),"i"(d0*4096+ks*1024+512):"memory");}
    asm volatile("s_waitcnt lgkmcnt(0)":::"memory");SBAR();
    #define PK(k) (bf16x8){lo[k][0],lo[k][1],lo[k][2],lo[k][3],hi[k][0],hi[k][1],hi[k][2],hi[k][3]}
    o[d0]=__builtin_amdgcn_mfma_f32_32x32x16_bf16(pa0,PK(0),o[d0],0,0,0);
    o[d0]=__builtin_amdgcn_mfma_f32_32x32x16_bf16(pa1,PK(1),o[d0],0,0,0);
    o[d0]=__builtin_amdgcn_mfma_f32_32x32x16_bf16(pa2,PK(2),o[d0],0,0,0);
    o[d0]=__builtin_amdgcn_mfma_f32_32x32x16_bf16(pa3,PK(3),o[d0],0,0,0);
    #undef PK
  }
}

#ifndef ATTN_STORE16
#define ATTN_STORE16(p,v) (*(u32x4*)(p)=(v))
#endif
template<int THRL> __device__ __forceinline__ void attn_unit(bool FUSE,int b,int h,int hv,int qb,const bf16*Q,const bf16*__restrict__ K,const bf16*__restrict__ V,bf16*O,const bf16*O2,float lam,const float*gsub,char*shm){
  int tid_=threadIdx.x; asm volatile("":"+v"(tid_)); const int tid=tid_,lane=tid&63,r32=lane&31,hi=lane>>5; const int wid=__builtin_amdgcn_readfirstlane(tid>>6);
  const long rowbase=(long)b*SEQ; const int q0=qb*QB;
  const bf16*Qw=Q+(rowbase+q0+wid*QBLK)*DM+h*D;
  const bf16*Kh=K+rowbase*DM+h*D,*Vh=V+rowbase*DM+hv*2*D;
  const unsigned lds0=(unsigned)(uintptr_t)shm;
  float*wsf=(float*)(shm+LDS_WS)+wid*64;
  const bf16*ksrc=Kh+(long)lane*DM+wid*8;
  const bf16*vsrc=Vh+(long)(16*(wid&3)+(lane>>2))*DM+(wid>>2)*32+(lane&3)*8;
  const unsigned kdst=lds0+LDS_K+wid*1024, vdst=lds0+LDS_V+wid*1024;
  #define DMA_K(t,slot) glds16(ksrc+(long)(t)*KVBLK*DM,(unsigned)__builtin_amdgcn_readfirstlane(kdst+(slot)))
  #define DMA_V(t,slot) do{ glds16(vsrc+(long)(t)*KVBLK*DM,(unsigned)__builtin_amdgcn_readfirstlane(vdst+2*(slot))); glds16(vsrc+(long)(t)*KVBLK*DM+64,(unsigned)__builtin_amdgcn_readfirstlane(vdst+2*(slot)+8192)); }while(0)
  const int vb0=(int)(lds0+LDS_V)+((lane>>4)&1)*32+(lane&3)*8+(4*hi+((lane&15)>>2))*64;
  const char*Kbase=shm+LDS_K; bf16x8 kf[8];
  const lds_cptr shm3=(lds_cptr)shm; const lds_cptr kp0=shm3+LDS_K+hi*1024+r32*16; const lds_cptr vp0=shm3+LDS_V+((lane>>4)&1)*32+(lane&3)*8+(4*hi+((lane&15)>>2))*64;
  const int NT=(q0+QB)/KVBLK;
  DMA_K(0,0);DMA_V(0,0);DMA_K(1,SLOTB);
  bf16x8 qr[4];
  #pragma unroll
  for(int d0=0;d0<4;++d0)qr[d0]=*reinterpret_cast<const bf16x8*>(&Qw[(long)r32*DM+d0*16+hi*8]);
  float mhat=0.f,l_reg=0.f;f32x16 o[4];o[0]=f32x16{};o[1]=f32x16{};o[2]=f32x16{};o[3]=f32x16{};const f32x16 ZERO16=f32x16{};
  const int qrel=wid*QBLK+r32;
  #define CMASK(P0,P1,t) do{int jb_=(t)-(NT-4); if(jb_>=0)cmask(P0,P1,jb_,qrel,hi);}while(0)
  bool resc=false;
  #define START(P0,P1) do{ const float rm=rowmax(P0,P1); resc=false; \
    { const float dl=rm; mhat=fadd_s(mhat,dl); \
      _Pragma("unroll") for(int r=0;r<16;++r){P0[r]=fsub_s(P0[r],dl);P1[r]=fsub_s(P1[r],dl);} \
      } \
    _Pragma("unroll") for(int r=0;r<16;++r)P0[r]=__builtin_amdgcn_exp2f(P0[r]); }while(0)
  #define RESC() do{ if(resc){ asm volatile("s_waitcnt lgkmcnt(0)":::"memory"); \
      _Pragma("unroll") for(int d_=0;d_<4;++d_) _Pragma("unroll") for(int r=0;r<16;++r)o[d_][r]*=wsf[crow(r,hi)]; } }while(0)
  f32x16 pA0,pA1,pB0,pB1;
  int sl_prev=0,sl_cur=0,sl_next=SLOTB;
  #define ROT() do{sl_prev=sl_cur;sl_cur=sl_next;sl_next=(sl_next==(NSLOT-1)*SLOTB)?0:sl_next+SLOTB;}while(0)
  DMA_K(2,2*SLOTB);
  WAIT_BAR(3);
  qkt(pA0,pA1,Kbase,qr,r32,hi);asm volatile("s_nop 15\n\ts_nop 7":"+v"(pA0),"+v"(pA1));CMASK(pA0,pA1,0);
  START(pA0,pA1);
  _Pragma("unroll") for(int r=0;r<16;++r)pA1[r]=__builtin_amdgcn_exp2f(pA1[r]);
  WAIT_BAR(0);
  DMA_K(3,0);DMA_V(1,SLOTB);
  ROT();
  kload8(kf,kp0+sl_cur);
  WAIT_BAR(3);
  s16x4 vlo[8],vhi[8]; u32x4 pw0,pw1,pw2,pw3;
  #define PKW(P,B) cvtpk_s(P[B],P[B+1])
  #define PAF(k) __builtin_bit_cast(bf16x8,pw##k)
  #define VFR(i) (bf16x8){vlo[i][0],vlo[i][1],vlo[i][2],vlo[i][3],vhi[i][0],vhi[i][1],vhi[i][2],vhi[i][3]}
  #define PIN(x) asm volatile("":"+v"(x))
  #define MX3(a,b,c) __builtin_fmaxf(__builtin_fmaxf((a),(b)),(c))
  #define GAPA(MF,A0,A1,A2,A3,W0,W1,PW) do{ MF; sacc+=A0; sacc+=A1; sacc+=A2; sacc+=A3; PIN(sacc); W0; W1; PIN(PW); SBAR(); }while(0)
  #define EX(v) __builtin_amdgcn_exp2f(v)
  #define GAPB(MF,RD,X,B) do{ MF; RD; X[B]=EX(X[B]-mhat); X[B+1]=EX(X[B+1]-mhat); PIN(X); SBAR(); }while(0)
  #define VRD(i) do{ vlo[i]=vtr(vp_+(((i)>>2)*4096+((i)&3)*1024)); vhi[i]=vtr(vp_+(((i)>>2)*4096+((i)&3)*1024+512)); }while(0)
  #define VRD2(i) do{ vlo[i]=vtr(vp_+(8192+((i)>>2)*4096+((i)&3)*1024)); vhi[i]=vtr(vp_+(8192+((i)>>2)*4096+((i)&3)*1024+512)); }while(0)
  #define KRD(G,j) do{ if(G){ kload2(kf,kp0+sl_next,j); SBAR(); } }while(0)
  #define STEP(C0,C1,P0,P1,t,GK,GV,GL) do{ SBAR(); \
    const lds_cptr vp_=vp0+2*sl_prev; \
    VRD(0); SBAR(); float sacc=(P0[0]+P0[1]); \
    GAPA(C0=__builtin_amdgcn_mfma_f32_32x32x16_bf16(kf[0],qr[0],ZERO16,0,0,0), P0[2],P0[3],P0[4],P0[5],     pw0[0]=PKW(P0,0), pw0[1]=PKW(P0,2), pw0); \
    VRD(4); SBAR(); GAPA(C1=__builtin_amdgcn_mfma_f32_32x32x16_bf16(kf[1],qr[0],ZERO16,0,0,0), P0[6],P0[7],P0[8],P0[9],     pw0[2]=PKW(P0,4), pw0[3]=PKW(P0,6), pw0); \
    VRD(1); SBAR(); GAPA(C0=__builtin_amdgcn_mfma_f32_32x32x16_bf16(kf[2],qr[1],C0,0,0,0),   P0[10],P0[11],P0[12],P0[13], pw1[0]=PKW(P0,8), pw1[1]=PKW(P0,10), pw1); \
    VRD(5); SBAR(); GAPA(C1=__builtin_amdgcn_mfma_f32_32x32x16_bf16(kf[3],qr[1],C1,0,0,0),   P0[14],P0[15],P1[0],P1[1],   pw1[2]=PKW(P0,12),pw1[3]=PKW(P0,14), pw1); \
    VRD(2); SBAR(); GAPA(C0=__builtin_amdgcn_mfma_f32_32x32x16_bf16(kf[4],qr[2],C0,0,0,0),   P1[2],P1[3],P1[4],P1[5],     pw2[0]=PKW(P1,0), pw2[1]=PKW(P1,2), pw2); \
    VRD(6); SBAR(); GAPA(C1=__builtin_amdgcn_mfma_f32_32x32x16_bf16(kf[5],qr[2],C1,0,0,0),   P1[6],P1[7],P1[8],P1[9],     pw2[2]=PKW(P1,4), pw2[3]=PKW(P1,6), pw2); \
    VRD(3); SBAR(); GAPA(C0=__builtin_amdgcn_mfma_f32_32x32x16_bf16(kf[6],qr[3],C0,0,0,0),   P1[10],P1[11],P1[12],P1[13], pw3[0]=PKW(P1,8), pw3[1]=PKW(P1,10), pw3); \
    VRD(7); SBAR(); GAPA(C1=__builtin_amdgcn_mfma_f32_32x32x16_bf16(kf[7],qr[3],C1,0,0,0),   P1[14],P1[15],0.f,0.f,       pw3[2]=PKW(P1,12),pw3[3]=PKW(P1,14), pw3); \
    l_reg+=sacc; \
    if(GK){DMA_K((t)+3,sl_cur);} if(GV){DMA_V((t)+1,sl_next);} \
    CMASK(C0,C1,t); \
    { float a=MX3(C0[0],C0[1],C1[0]),b=MX3(C0[2],C0[3],C1[1]); a=MX3(a,C1[2],C1[3]); \
      _Pragma("unroll") for(int r=4;r<16;r+=4){a=MX3(a,C0[r],C0[r+1]);b=MX3(b,C0[r+2],C0[r+3]);a=MX3(a,C1[r],C1[r+1]);b=MX3(b,C1[r+2],C1[r+3]);} \
      float rm=__builtin_fmaxf(a,b); { auto rr=__builtin_amdgcn_permlane32_swap(__float_as_uint(rm),__float_as_uint(rm),false,false); rm=__builtin_fmaxf(__uint_as_float(rr[0]),__uint_as_float(rr[1])); } \
      resc=false; rm-=mhat;   \
      if(__builtin_expect(__any(rm>(float)THRL),0)){ const float dl=__builtin_fmaxf(rm,0.f); mhat+=dl; \
        const float f=__builtin_amdgcn_exp2f(-dl); l_reg*=f; if(hi==0)wsf[r32]=f; resc=true; } } \
    SBAR(); \
    GAPB(o[0]=__builtin_amdgcn_mfma_f32_32x32x16_bf16(PAF(0),VFR(0),o[0],0,0,0), VRD2(0), C0,0); \
    GAPB(o[1]=__builtin_amdgcn_mfma_f32_32x32x16_bf16(PAF(0),VFR(4),o[1],0,0,0), VRD2(4), C0,2); \
    GAPB(o[0]=__builtin_amdgcn_mfma_f32_32x32x16_bf16(PAF(1),VFR(1),o[0],0,0,0), VRD2(1), C0,4); \
    GAPB(o[1]=__builtin_amdgcn_mfma_f32_32x32x16_bf16(PAF(1),VFR(5),o[1],0,0,0), VRD2(5), C0,6); \
    GAPB(o[0]=__builtin_amdgcn_mfma_f32_32x32x16_bf16(PAF(2),VFR(2),o[0],0,0,0), VRD2(2), C0,8); \
    GAPB(o[1]=__builtin_amdgcn_mfma_f32_32x32x16_bf16(PAF(2),VFR(6),o[1],0,0,0), VRD2(6), C0,10); \
    GAPB(o[0]=__builtin_amdgcn_mfma_f32_32x32x16_bf16(PAF(3),VFR(3),o[0],0,0,0), VRD2(3), C0,12); \
    GAPB(o[1]=__builtin_amdgcn_mfma_f32_32x32x16_bf16(PAF(3),VFR(7),o[1],0,0,0), VRD2(7), C0,14); \
    KRD(GL,0); GAPB(o[2]=__builtin_amdgcn_mfma_f32_32x32x16_bf16(PAF(0),VFR(0),o[2],0,0,0), (void)0, C1,0); \
    GAPB(o[3]=__builtin_amdgcn_mfma_f32_32x32x16_bf16(PAF(0),VFR(4),o[3],0,0,0), (void)0, C1,2); \
    KRD(GL,1); GAPB(o[2]=__builtin_amdgcn_mfma_f32_32x32x16_bf16(PAF(1),VFR(1),o[2],0,0,0), (void)0, C1,4); \
    GAPB(o[3]=__builtin_amdgcn_mfma_f32_32x32x16_bf16(PAF(1),VFR(5),o[3],0,0,0), (void)0, C1,6); \
    KRD(GL,2); GAPB(o[2]=__builtin_amdgcn_mfma_f32_32x32x16_bf16(PAF(2),VFR(2),o[2],0,0,0), (void)0, C1,8); \
    GAPB(o[3]=__builtin_amdgcn_mfma_f32_32x32x16_bf16(PAF(2),VFR(6),o[3],0,0,0), (void)0, C1,10); \
    KRD(GL,3); GAPB(o[2]=__builtin_amdgcn_mfma_f32_32x32x16_bf16(PAF(3),VFR(3),o[2],0,0,0), (void)0, C1,12); \
    GAPB(o[3]=__builtin_amdgcn_mfma_f32_32x32x16_bf16(PAF(3),VFR(7),o[3],0,0,0), (void)0, C1,14); \
    }while(0)
  int t=1;
  #undef CMASK
  #define CMASK(P0,P1,t) do{}while(0)
  for(;t+5<NT;t+=2){
    STEP(pB0,pB1,pA0,pA1,t,true,true,true);     WAIT_BAR(3); RESC(); ROT();
    STEP(pA0,pA1,pB0,pB1,t+1,true,true,true);   WAIT_BAR(3); RESC(); ROT();
  }
  #undef CMASK
  #define CMASK(P0,P1,t) do{int jb_=(t)-(NT-4); if(jb_>=0)cmask(P0,P1,jb_,qrel,hi);}while(0)
  #define ENDW(tt) do{ if((tt)+3<NT){WAIT_BAR(3);} else if((tt)+2<NT){WAIT_BAR(2);} else {WAIT_BAR(0);} }while(0)
  for(;t+1<NT;t+=2){
    STEP(pB0,pB1,pA0,pA1,t,(t+3<NT),(t+1<NT),(t+1<NT));       ENDW(t);   RESC(); ROT();
    STEP(pA0,pA1,pB0,pB1,t+1,(t+4<NT),(t+2<NT),(t+2<NT));     ENDW(t+1); RESC(); ROT();
  }
  STEP(pB0,pB1,pA0,pA1,NT-1,false,false,false); RESC();
  { float sacc=pB0[0]+pB0[1]; _Pragma("unroll") for(int r=2;r<16;++r)sacc+=pB0[r]; _Pragma("unroll") for(int r=0;r<16;++r)sacc+=pB1[r]; l_reg+=sacc;
    pw0=(u32x4){PKW(pB0,0),PKW(pB0,2),PKW(pB0,4),PKW(pB0,6)};pw1=(u32x4){PKW(pB0,8),PKW(pB0,10),PKW(pB0,12),PKW(pB0,14)};pw2=(u32x4){PKW(pB1,0),PKW(pB1,2),PKW(pB1,4),PKW(pB1,6)};pw3=(u32x4){PKW(pB1,8),PKW(pB1,10),PKW(pB1,12),PKW(pB1,14)};
    SBAR(); pv(o,vb0+2*sl_cur,PAF(0),PAF(1),PAF(2),PAF(3)); }
  #undef PKW
  #undef PAF
  #undef VFR
  #undef PIN
  #undef MX3
  #undef GAPA
  #undef GAPB
  #undef EX
  #undef VRD
  #undef VRD2
  #undef KRD
  #undef STEP
  #undef ENDW
  {auto rr=__builtin_amdgcn_permlane32_swap(__float_as_uint(l_reg),__float_as_uint(l_reg),false,false);l_reg=__uint_as_float(rr[0])+__uint_as_float(rr[1]);}
  if(hi==0)wsf[32+r32]=l_reg;asm volatile("s_waitcnt lgkmcnt(0)":::"memory");
  float rli[16];
  #pragma unroll
  for(int r=0;r<16;++r)rli[r]=__builtin_amdgcn_rcpf(wsf[32+crow(r,hi)]);
  bf16*Ow=O+(rowbase+q0+wid*QBLK)*DM+hv*2*D;
  asm volatile("s_waitcnt lgkmcnt(0)\n\ts_barrier":::"memory");
  { bf16*stg=(bf16*)(shm+LDS_K)+wid*4096;
    const bf16*O2w=O2+(rowbase+q0+wid*QBLK)*DM+hv*2*D;
    #pragma unroll
    for(int r=0;r<16;++r){const int orow=crow(r,hi);
      #pragma unroll
      for(int d0=0;d0<4;++d0)stg[orow*128+d0*32+r32]=__float2bfloat16(o[d0][r]*rli[r]);}
    asm volatile("s_waitcnt lgkmcnt(0)":::"memory");
    #pragma unroll
    for(int i=0;i<4;++i){const int row=i*8+(lane>>3),ch=lane&7;
      const u32x4 v0=*(const u32x4*)(stg+row*128+ch*8), v1=*(const u32x4*)(stg+row*128+64+ch*8);
      if(!FUSE){ ATTN_STORE16(Ow+(long)row*DM+ch*8,v0); ATTN_STORE16(Ow+(long)row*DM+64+ch*8,v1); }
      else{ const u32x4 t0=*(const u32x4*)(O2w+(long)row*DM+ch*8), t1=*(const u32x4*)(O2w+(long)row*DM+64+ch*8);
        float c[16]; float ss=0.f;
        #pragma unroll
        for(int k=0;k<4;++k){ c[2*k]=__uint_as_float(v0[k]<<16)-lam*__uint_as_float(t0[k]<<16); c[2*k+1]=__uint_as_float(v0[k]&0xffff0000u)-lam*__uint_as_float(t0[k]&0xffff0000u);
          c[8+2*k]=__uint_as_float(v1[k]<<16)-lam*__uint_as_float(t1[k]<<16); c[8+2*k+1]=__uint_as_float(v1[k]&0xffff0000u)-lam*__uint_as_float(t1[k]&0xffff0000u); }
        #pragma unroll
        for(int k=0;k<16;++k)ss+=c[k]*c[k];
        ss+=__int_as_float(__builtin_amdgcn_ds_swizzle(__float_as_int(ss),(1<<10)|0x1f)); ss+=__int_as_float(__builtin_amdgcn_ds_swizzle(__float_as_int(ss),(2<<10)|0x1f)); ss+=__int_as_float(__builtin_amdgcn_ds_swizzle(__float_as_int(ss),(4<<10)|0x1f));
        const float rs=__builtin_amdgcn_rsqf(ss*(1.f/128.f)+1e-6f);
        const float4 g0=*(const float4*)(gsub+ch*8), g1=*(const float4*)(gsub+ch*8+4), g2=*(const float4*)(gsub+64+ch*8), g3=*(const float4*)(gsub+64+ch*8+4);
        u32x4 w0,w1;
        w0[0]=cvtpk_s(c[0]*rs*g0.x,c[1]*rs*g0.y); w0[1]=cvtpk_s(c[2]*rs*g0.z,c[3]*rs*g0.w); w0[2]=cvtpk_s(c[4]*rs*g1.x,c[5]*rs*g1.y); w0[3]=cvtpk_s(c[6]*rs*g1.z,c[7]*rs*g1.w);
        w1[0]=cvtpk_s(c[8]*rs*g2.x,c[9]*rs*g2.y); w1[1]=cvtpk_s(c[10]*rs*g2.z,c[11]*rs*g2.w); w1[2]=cvtpk_s(c[12]*rs*g3.x,c[13]*rs*g3.y); w1[3]=cvtpk_s(c[14]*rs*g3.z,c[15]*rs*g3.w);
        ATTN_STORE16(Ow+(long)row*DM+ch*8,w0); ATTN_STORE16(Ow+(long)row*DM+64+ch*8,w1); } } }
  asm volatile("s_waitcnt lgkmcnt(0)\n\ts_barrier":::"memory");
  #undef DMA_K
  #undef DMA_V
  #undef CMASK
  #undef START
  #undef RESC
  #undef ROT
}
constexpr int ATTN_LDS_BYTES=LDS_BYTES;
struct AttnTensors { const bf16* Q; const bf16* K; const bf16* V; bf16* O2; bf16* YB; };
template<int THRL=8> __device__ __forceinline__ void attn_phase(char*lds,const AttnTensors&T,float lam,const float*gsub,int vcu,int ncu){
  const int bh=(vcu&255)>>3, s=vcu&7; const int b=bh>>3, h=bh&7;
  const float lam_u=__uint_as_float(__builtin_amdgcn_readfirstlane(__float_as_uint(lam)));
  for(int i=0;i<4;++i){ const int qb=(i&2)?15-s:s; const bool fuse=(i&1)!=0;
    attn_unit<THRL>(fuse,b,fuse?2*h:2*h+1,h,qb,T.Q,T.K,T.V,fuse?T.YB:T.O2,T.O2,lam_u,gsub,lds);
  }
}
#undef SBAR
#undef WAIT_BAR
}
constexpr int NWAVES = 8;
#ifndef MK_MULTI
#define MK_MULTI 0
#endif
constexpr int NB = 4, SEQ = 4096, T = NB * SEQ, D = 1024, DIN = 7168, FF = 3584, NEXP = 8, PLE = 256, DEPTH = 2;
constexpr int NPAN = T / 256;
constexpr float EPS = 1e-6f;
constexpr int MOE_ROWS = 2 * T + NEXP * 256;
constexpr int MOE_PANELS = MOE_ROWS / 256, MOE_HALF = MOE_PANELS / 2;
constexpr size_t MiB = 1u << 20;
constexpr size_t WS_CTL = 0, CTL_ZERO_BYTES = 1 * MiB;
constexpr size_t WS_LRUW = 1 * MiB;
constexpr size_t WS_PAR = 1 * MiB + 512 * 1024;
constexpr size_t WS_SUM = 2 * MiB;
constexpr size_t WS_TOK = 4 * MiB;
constexpr size_t WS_LIST = 5 * MiB;
constexpr size_t WS_COS = 6 * MiB;
constexpr size_t WS_WSMALL = 10 * MiB;
constexpr size_t WL_STRIDE = 45 * MiB / 2, WL_WIN = 0, WL_WAB = 14 * MiB, WL_WO = 18 * MiB, WL_WPG = 20 * MiB, WL_WPP = 22 * MiB;
constexpr size_t WS_WGU = WS_WSMALL + 45 * MiB, WS_WD = WS_WGU + 14 * MiB;
constexpr size_t WS_PB = 76 * MiB;
constexpr size_t WS_H = 92 * MiB;
constexpr size_t WS_BIG = 124 * MiB, SLOT = 32 * MiB;
constexpr size_t WS_GG = WS_BIG, WS_RIN = WS_BIG + SLOT, WS_Q = WS_BIG + 2 * SLOT, WS_K = WS_BIG + 3 * SLOT, WS_V = WS_BIG + 4 * SLOT, WS_SGA = WS_BIG + 5 * SLOT, WS_SGB = WS_BIG + 6 * SLOT;
constexpr size_t WS_HL = WS_BIG + 7 * SLOT, WS_LP = WS_BIG + 8 * SLOT, WS_O1 = WS_BIG + 9 * SLOT, WS_O2 = WS_BIG + 10 * SLOT;
constexpr size_t WS_YA = WS_RIN, WS_YB = WS_Q, WS_T1 = WS_K, WS_MERGED = WS_GG, WS_F = WS_SGA;
constexpr size_t WS_ACT = WS_BIG;
constexpr size_t WS_PP = WS_BIG;
constexpr size_t WS_WMGU = WS_BIG, WS_WMD = WS_BIG + 56 * MiB, WS_ACT8 = WS_BIG + 84 * MiB, WS_HG = WS_BIG + 204 * MiB, WS_OE = WS_BIG + 240 * MiB;
constexpr int MOE_MAINP = 128, MOE_KS = 7, MOE_KSB = FF / MOE_KS;
constexpr size_t WS_OEP = WS_OE + 68 * MiB;
constexpr size_t WS_XR = WS_O2 + SLOT;
constexpr size_t WS_WIN8 = WS_XR + SLOT;
constexpr size_t WS_WGU8 = WS_WIN8 + 14 * MiB;
constexpr size_t WS_SB = WS_WGU8 + 7 * MiB;
constexpr size_t WS_SA = WS_COS + 128 * 1024;
constexpr size_t WS_WPG8 = WS_SB + 1 * MiB;
constexpr size_t WS_END = WS_WPG8 + 2 * MiB;
constexpr float SC_H = 8.f, SC_WGU = 32.f, SC_ACT = 8.f, SC_WD = 64.f;
constexpr int E8_H = 0x7c7c7c7c, E8_WGU = 0x7a7a7a7a, E8_ACT = 0x7c7c7c7c, E8_WD = 0x79797979;
static_assert(WS_OEP + (size_t)MOE_KS * 8 * 256 * D * 2 <= WS_O2 + SLOT && MOE_KS * MOE_KSB == FF && MOE_KSB % 256 == 0 && WS_OE + (size_t)MOE_ROWS * D * 2 <= WS_END && WS_ACT8 + (size_t)MOE_ROWS * FF <= WS_HG && WS_HG + (size_t)MOE_ROWS * D <= WS_OE && WS_WMD + (size_t)NEXP * D * FF <= WS_ACT8, "d_ws map");
constexpr int CW_TMO = 0, CW_CODE = 1;
constexpr int CW_CNT = 64;
constexpr int CW_BAR = 4096;
constexpr int RING_OFF = 0, RING_BYTES = 131072;
constexpr int LDSCTL_OFF = RING_BYTES, MISC_OFF = LDSCTL_OFF + 320;
constexpr int LDS_BYTES = 147456;
static_assert(MISC_OFF + 128 <= LDS_BYTES, "LDS map");
#define GAS __attribute__((address_space(1)))
#define LAS __attribute__((address_space(3)))
typedef unsigned short bf16;
typedef unsigned v4u __attribute__((ext_vector_type(4)));
typedef float f32x4 __attribute__((ext_vector_type(4)));
typedef short bf16x8 __attribute__((ext_vector_type(8)));
typedef GAS unsigned gu32;
typedef GAS unsigned long long gu64;
#define RLX_AGENT __ATOMIC_RELAXED, __HIP_MEMORY_SCOPE_AGENT
#define LDS_WAIT() asm volatile("s_waitcnt lgkmcnt(0)" ::: "memory")
#define VM_WAIT() asm volatile("s_waitcnt vmcnt(0)" ::: "memory")
__device__ __forceinline__ unsigned long long rt() { return __builtin_amdgcn_s_memrealtime(); }
__device__ __forceinline__ unsigned f2bf(float f) { unsigned u = __builtin_bit_cast(unsigned, f); return (u + 0x7fffu + ((u >> 16) & 1u)) >> 16; }
__device__ __forceinline__ unsigned pk2(float lo, float hi) { return f2bf(lo) | (f2bf(hi) << 16); }

#define XB_TMO      128
#define XB_XCNT(j)  (256  + 64 * (j))
#define XB_XSUB(j)  (1280 + 64 * (j))
#define XB_XGEN(j)  (2304 + 64 * (j))
#define XB_TOP      3328
#define XB_TOPGEN   3392
#define XCD_BAR_WORDS 3456
#define XB_SPIN_CAP (1u << 18)

__device__ __forceinline__ unsigned xb_ld(unsigned* p)              { return __hip_atomic_load(p, __ATOMIC_RELAXED, __HIP_MEMORY_SCOPE_AGENT); }
__device__ __forceinline__ unsigned xb_add(unsigned* p, unsigned v) { return __hip_atomic_fetch_add(p, v, __ATOMIC_RELAXED, __HIP_MEMORY_SCOPE_AGENT); }
__device__ __forceinline__ unsigned xb_xcc_id() { return (unsigned)__builtin_amdgcn_s_getreg((3 << 11) | 20) & 0xFu; }
#define XB_SPIN(cond, bar) do { unsigned _sp = 0; while (cond) { __builtin_amdgcn_s_sleep(1); \
    if ((++_sp & 255u) == 0u) { if (xb_ld(&(bar)[XB_TMO])) break; if (_sp > XB_SPIN_CAP) { atomicAdd(&(bar)[XB_TMO], 1u); break; } } } } while (0)

struct XcdBarrier {
    unsigned* bar; unsigned x;
    volatile LAS unsigned* st;
};

__device__ __forceinline__ XcdBarrier xcd_barrier_post(unsigned* bar, volatile LAS unsigned* st) {
    XcdBarrier b; b.bar = bar; b.x = xb_xcc_id(); b.st = st;
    if (threadIdx.x == 0) (void)xb_add(&bar[XB_XCNT(b.x)], 1u);
    return b;
}
__device__ __forceinline__ void xcd_barrier_complete(unsigned* bar, unsigned x, unsigned& nloc, unsigned& nx) {
    const unsigned G = gridDim.x * gridDim.y * gridDim.z;
    unsigned sum, cnt, mine, sp = 0u;
    for (;;) {
        sum = 0u; cnt = 0u; mine = 0u;
#pragma unroll
        for (unsigned j = 0; j < 16; ++j) { const unsigned c = xb_ld(&bar[XB_XCNT(j)]); sum += c; cnt += (c > 0u) ? 1u : 0u; mine = (j == x) ? c : mine; }
        if (sum == G) break;
        __builtin_amdgcn_s_sleep(1);
        if ((++sp & 255u) == 0u) { if (xb_ld(&bar[XB_TMO])) break; if (sp > XB_SPIN_CAP) { atomicAdd(&bar[XB_TMO], 1u); break; } }
    }
    nloc = mine > 0u ? mine : 1u; nx = cnt > 0u ? cnt : 1u;
}

__device__ __forceinline__ void xcd_barrier(const XcdBarrier& b) {
    asm volatile("s_waitcnt vmcnt(0)" ::: "memory");
    __syncthreads();
    if (threadIdx.x == 0) {
        unsigned* bar = b.bar; unsigned bx_ = b.x;
        asm volatile("" : "+s"(bar), "+s"(bx_));
        __builtin_amdgcn_s_waitcnt(0);
        unsigned nloc = b.st[0], nx = b.st[1];
        if (nloc == 0u) { xcd_barrier_complete(bar, bx_, nloc, nx); b.st[0] = nloc; b.st[1] = nx; }
        const unsigned old = xb_add(&bar[XB_XSUB(bx_)], 1u);
        const unsigned gen = old / nloc;
        if (old + 1u == (gen + 1u) * nloc) {
            __builtin_amdgcn_fence(__ATOMIC_RELEASE, "agent");
            asm volatile("s_waitcnt vmcnt(0)" ::: "memory");
            const unsigned og = xb_add(&bar[XB_TOP], 1u);
            const unsigned tg = og / nx;
            if (og + 1u == (tg + 1u) * nx) xb_add(&bar[XB_TOPGEN], 1u);
            else XB_SPIN(xb_ld(&bar[XB_TOPGEN]) == tg, bar);
            __builtin_amdgcn_fence(__ATOMIC_ACQUIRE, "agent");
            xb_add(&bar[XB_XGEN(bx_)], 1u);
            asm volatile("s_waitcnt vmcnt(0)" ::: "memory");
        } else {
            XB_SPIN(xb_ld(&bar[XB_XGEN(bx_)]) == gen, bar);
            __builtin_amdgcn_fence(__ATOMIC_ACQUIRE, "agent");
            asm volatile("s_waitcnt vmcnt(0)" ::: "memory");
        }
    }
    __syncthreads();
}
__device__ const float INV_FREQ[32] = {
    1.0f, 0.74989420933f, 0.56234132519f, 0.42169650343f, 0.31622776602f, 0.23713737057f, 0.17782794100f, 0.13335214322f,
    0.1f, 0.074989420933f, 0.056234132519f, 0.042169650343f, 0.031622776602f, 0.023713737057f, 0.017782794100f, 0.013335214322f,
    0.01f, 0.0074989420933f, 0.0056234132519f, 0.0042169650343f, 0.0031622776602f, 0.0023713737057f, 0.0017782794100f, 0.0013335214322f,
    0.001f, 0.00074989420933f, 0.00056234132519f, 0.00042169650343f, 0.00031622776602f, 0.00023713737057f, 0.00017782794100f, 0.00013335214322f };

#define SWZ_XOR(v, o) __int_as_float(__builtin_amdgcn_ds_swizzle(__float_as_int(v), ((o) << 10) | 0x1f))
__device__ __forceinline__ float half_sum(float v) {
    v += SWZ_XOR(v, 1); v += SWZ_XOR(v, 2); v += SWZ_XOR(v, 4); v += SWZ_XOR(v, 8); v += SWZ_XOR(v, 16);
    return v;
}
__device__ __forceinline__ float wave_sum(float v) {
    v = half_sum(v);
    const auto rr = __builtin_amdgcn_permlane32_swap(__float_as_uint(v), __float_as_uint(v), false, false);
    return __uint_as_float(rr[0]) + __uint_as_float(rr[1]);
}
__device__ __forceinline__ float dot4(f32x4 a, f32x4 b) { return (a.x * b.x + a.y * b.y) + (a.z * b.z + a.w * b.w); }
__device__ __forceinline__ float bf2f(unsigned short v) { return __uint_as_float((unsigned)v << 16); }
typedef unsigned u32x2 __attribute__((ext_vector_type(2)));
__device__ __forceinline__ f32x4 bf4_to_f(u32x2 w) { return (f32x4){__uint_as_float(w.x << 16), __uint_as_float(w.x & 0xffff0000u), __uint_as_float(w.y << 16), __uint_as_float(w.y & 0xffff0000u)}; }
__device__ __forceinline__ u32x2 f_to_bf4(f32x4 v) { u32x2 w; w.x = pk2(v.x, v.y); w.y = pk2(v.z, v.w); return w; }
__device__ __forceinline__ float sigm_f(float v) { return 1.0f / (1.0f + __expf(-v)); }

__device__ __forceinline__ f32x4 bfl4(v4u w) { return (f32x4){__uint_as_float(w.x << 16), __uint_as_float(w.x & 0xffff0000u), __uint_as_float(w.y << 16), __uint_as_float(w.y & 0xffff0000u)}; }
__device__ __forceinline__ f32x4 bfh4(v4u w) { return (f32x4){__uint_as_float(w.z << 16), __uint_as_float(w.z & 0xffff0000u), __uint_as_float(w.w << 16), __uint_as_float(w.w & 0xffff0000u)}; }
__device__ __forceinline__ v4u pk8bf(f32x4 a, f32x4 b) { v4u w; w.x = pk2(a.x, a.y); w.y = pk2(a.z, a.w); w.z = pk2(b.x, b.y); w.w = pk2(b.z, b.w); return w; }
__device__ __forceinline__ float wave_max(float v) {
    v = fmaxf(v, SWZ_XOR(v, 1)); v = fmaxf(v, SWZ_XOR(v, 2)); v = fmaxf(v, SWZ_XOR(v, 4)); v = fmaxf(v, SWZ_XOR(v, 8)); v = fmaxf(v, SWZ_XOR(v, 16));
    const auto rr = __builtin_amdgcn_permlane32_swap(__float_as_uint(v), __float_as_uint(v), false, false);
    return fmaxf(__uint_as_float(rr[0]), __uint_as_float(rr[1]));
}
__device__ __forceinline__ float amax4(f32x4 v) { return fmaxf(fmaxf(fabsf(v.x), fabsf(v.y)), fmaxf(fabsf(v.z), fabsf(v.w))); }
__device__ __forceinline__ unsigned q4i8(f32x4 v, float k) {
    const int a = (int)rintf(v.x * k), b = (int)rintf(v.y * k), c = (int)rintf(v.z * k), d = (int)rintf(v.w * k);
    return (unsigned)(a & 255) | ((unsigned)(b & 255) << 8) | ((unsigned)(c & 255) << 16) | ((unsigned)d << 24);
}
__device__ __forceinline__ void wq_row(const bf16* src, unsigned char* dst, float* scale, int lane) {
    const v4u a = ((const v4u*)src)[2 * lane], b = ((const v4u*)src)[2 * lane + 1];
    const f32x4 v0 = bfl4(a), v1 = bfh4(a), v2 = bfl4(b), v3 = bfh4(b);
    const float mx = wave_max(fmaxf(fmaxf(amax4(v0), amax4(v1)), fmaxf(amax4(v2), amax4(v3))));
    const float k = 127.f / fmaxf(mx, 1e-30f);
    v4u o; o.x = q4i8(v0, k); o.y = q4i8(v1, k); o.z = q4i8(v2, k); o.w = q4i8(v3, k);
    ((v4u*)dst)[lane] = o;
    if (lane == 0) *scale = mx * (1.f / 127.f);
}
__device__ __forceinline__ void tr_load(float (&r)[32], const float* W, int N, int k0, int n0, int lane) {
#pragma unroll
    for (int i = 0; i < 32; ++i) r[i] = W[(size_t)(k0 + 2 * i + (lane >> 5)) * N + n0 + (lane & 31)];
}
__device__ __forceinline__ void tr_store(const float (&r)[32], int K, bf16* WT, int dest_row0, int k0, LAS float* scr, int lane) {
#pragma unroll
    for (int i = 0; i < 32; ++i) scr[(2 * i + (lane >> 5)) * 33 + (lane & 31)] = r[i];
    LDS_WAIT(); asm volatile("" ::: "memory");
    const int c = lane & 7;
#pragma unroll
    for (int j = 0; j < 4; ++j) { const int n = (lane >> 3) + 8 * j; const LAS float* s = scr + (8 * c) * 33 + n;
        v4u o; o.x = pk2(s[0 * 33], s[1 * 33]); o.y = pk2(s[2 * 33], s[3 * 33]); o.z = pk2(s[4 * 33], s[5 * 33]); o.w = pk2(s[6 * 33], s[7 * 33]);
        *(v4u*)(WT + (size_t)(dest_row0 + n) * K + k0 + 8 * c) = o; }
    LDS_WAIT(); asm volatile("" ::: "memory");
}
template <int MAP> __device__ __forceinline__ int dest_row(int n0) {
    if (MAP == 1) { const int tile = n0 >> 8, w = n0 & 255; return tile * 256 + ((w & 63) >> 5) * 128 + (w >> 6) * 32; }
    if (MAP == 2) return (n0 >> 7) * 256 + (n0 & 127);
    if (MAP == 3) return (n0 >> 7) * 256 + 128 + (n0 & 127);
    return n0;
}
__device__ __forceinline__ float clamp8(float v) { return __builtin_fminf(__builtin_fmaxf(v, -448.f), 448.f); }
__device__ __forceinline__ unsigned pk4f8(float a, float b, float c, float d) { unsigned w = __builtin_amdgcn_cvt_pk_fp8_f32(clamp8(a), clamp8(b), 0u, false); return __builtin_amdgcn_cvt_pk_fp8_f32(clamp8(c), clamp8(d), w, true); }
__device__ __forceinline__ void tr_store8(const float (&r)[32], int K, unsigned char* WT, int dest_row0, int k0, float scale, LAS float* scr, int lane) {
#pragma unroll
    for (int i = 0; i < 32; ++i) scr[(2 * i + (lane >> 5)) * 33 + (lane & 31)] = r[i] * scale;
    LDS_WAIT(); asm volatile("" ::: "memory");
    const int c = lane & 3;
#pragma unroll
    for (int j = 0; j < 2; ++j) { const int n = (lane >> 2) + 16 * j; const LAS float* s = scr + (16 * c) * 33 + n;
        v4u o; o.x = pk4f8(s[0 * 33], s[1 * 33], s[2 * 33], s[3 * 33]); o.y = pk4f8(s[4 * 33], s[5 * 33], s[6 * 33], s[7 * 33]);
        o.z = pk4f8(s[8 * 33], s[9 * 33], s[10 * 33], s[11 * 33]); o.w = pk4f8(s[12 * 33], s[13 * 33], s[14 * 33], s[15 * 33]);
        *(v4u*)(WT + (size_t)(dest_row0 + n) * K + k0 + 16 * c) = o; }
    LDS_WAIT(); asm volatile("" ::: "memory");
}
struct TrItem { const float* W; bf16* WT; int K, N, dest_row0, k0, n0; float s8; };
template <int MAP> __device__ __forceinline__ TrItem tr_item(const float* W, int K, int N, bf16* WT, int row_off, int q, float s8 = 0.f) {
    const int nblk = N / 32, kb = q / nblk, nb = q - kb * nblk; TrItem t; t.W = W; t.WT = WT; t.K = K; t.N = N; t.dest_row0 = row_off + dest_row<MAP>(32 * nb); t.k0 = 64 * kb; t.n0 = 32 * nb; t.s8 = s8; return t;
}
#define TR_STORE(r, t) do { if (F8 && t.s8 != 0.f) tr_store8(r, t.K, (unsigned char*)t.WT, t.dest_row0, t.k0, t.s8, scr, lane); else tr_store(r, t.K, t.WT, t.dest_row0, t.k0, scr, lane); } while (0)
template <bool F8, class Dec> __device__ __forceinline__ void tr_run(const Dec& DEC, int nitems, LAS float* scr, int lane, int gw, int ngw) {
    int it = gw; if (it >= nitems) return;
    float ra[32], rb[32];
    TrItem a = DEC(it), b = a;
    tr_load(ra, a.W, a.N, a.k0, a.n0, lane);
    for (;;) {
        const int it1 = it + ngw; const bool h1 = it1 < nitems;
        if (h1) { b = DEC(it1); tr_load(rb, b.W, b.N, b.k0, b.n0, lane); }
        TR_STORE(ra, a);
        if (!h1) break;
        const int it2 = it1 + ngw; const bool h2 = it2 < nitems;
        if (h2) { a = DEC(it2); tr_load(ra, a.W, a.N, a.k0, a.n0, lane); }
        TR_STORE(rb, b);
        if (!h2) break;
        it = it2;
    }
}

__device__ __forceinline__ void row_post_pre(const f32x4 (&f)[4], const float* xin, float* xout, const float* gpost, const float* gpre, bf16* hrow, int lane, f32x4 (&hn)[4]) {
    float s = 0.f;
#pragma unroll
    for (int j = 0; j < 4; ++j) s += dot4(f[j], f[j]);
    const float rs = rsqrtf(wave_sum(s) * (1.f / D) + EPS);
    f32x4 xv[4]; float s2 = 0.f;
#pragma unroll
    for (int j = 0; j < 4; ++j) { xv[j] = ((const f32x4*)xin)[lane + 64 * j] + f[j] * rs * ((const f32x4*)gpost)[lane + 64 * j]; ((f32x4*)xout)[lane + 64 * j] = xv[j]; s2 += dot4(xv[j], xv[j]); }
    if (gpre) {
        const float rs2 = rsqrtf(wave_sum(s2) * (1.f / D) + EPS);
#pragma unroll
        for (int j = 0; j < 4; ++j) { hn[j] = xv[j] * rs2 * ((const f32x4*)gpre)[lane + 64 * j]; ((u32x2*)hrow)[lane + 64 * j] = f_to_bf4(hn[j]); }
    }
}
struct Args { const void* in[26]; float* out; unsigned char* ws; int ph_lo, ph_hi; };
enum { I_X = 0, I_P, I_POS, I_NORMG, I_WIN, I_CONVW, I_CONVB, I_LWA, I_LBA, I_LWX, I_LBX, I_LLAM, I_DLAM, I_SUBG, I_WPA, I_WPB, I_WOUT, I_FG, I_FU, I_FD, I_RW, I_MG, I_MU, I_MD, I_PWP, I_PWG };

constexpr int PO_NORMG = 0, PO_CONVW = PO_NORMG + DEPTH * 6 * D, PO_CONVB = PO_CONVW + DEPTH * 4 * D, PO_LBA = PO_CONVB + DEPTH * D, PO_LBX = PO_LBA + DEPTH * D, PO_LLAM = PO_LBX + DEPTH * D,
              PO_DLAM = PO_LLAM + DEPTH * D, PO_SUBG = PO_DLAM + DEPTH * 256, PO_RW = PO_SUBG + DEPTH * 128, PO_SUBGS = PO_RW + D * NEXP, PO_END = PO_SUBGS + DEPTH * 128;
static_assert((size_t)PO_END * 4 <= 512 * 1024, "parameter block");
#define AIN(k) ((const void*)(const GAS void*)A.in[k])
struct QSlab { const float* W; unsigned char* dst; float* sc; int N, n0, drow; };
__device__ __forceinline__ void qs_load(float (&r)[2][32], const QSlab& s, int wave, int lane) {
#pragma unroll
    for (int it = 0; it < 2; ++it)
#pragma unroll
        for (int i = 0; i < 32; ++i) { const float* rowp = s.W + (size_t)(64 * (2 * wave + it) + 2 * i) * s.N + s.n0;
            r[it][i] = rowp[(unsigned)((lane >> 5) * s.N + (lane & 31))]; }
}
__device__ __forceinline__ void qs_store(const float (&r)[2][32], const QSlab& s, LAS float* ring, int par, int wave, int lane) {
    LAS float* scr = ring + wave * 4096;
    float m = 0.f;
#pragma unroll
    for (int i = 0; i < 32; ++i) m = fmaxf(m, fmaxf(fabsf(r[0][i]), fabsf(r[1][i])));
    { const auto rr = __builtin_amdgcn_permlane32_swap(__float_as_uint(m), __float_as_uint(m), false, false); m = fmaxf(__uint_as_float(rr[0]), __uint_as_float(rr[1])); }
    scr[2112 + par * 32 + (lane & 31)] = m;
    __syncthreads();
    float mx = 0.f;
#pragma unroll
    for (int w = 0; w < NWAVES; ++w) mx = fmaxf(mx, ring[w * 4096 + 2112 + par * 32 + (lane & 31)]);
    const float kq = 127.f / fmaxf(mx, 1e-30f);
    if (wave == 0 && lane < 32) s.sc[s.drow + lane] = mx * (1.f / 127.f);
#pragma unroll
    for (int it = 0; it < 2; ++it) { const int k0 = 64 * (2 * wave + it);
#pragma unroll
        for (int i = 0; i < 32; ++i) scr[(2 * i + (lane >> 5)) * 33 + (lane & 31)] = r[it][i] * kq;
        LDS_WAIT(); asm volatile("" ::: "memory");
        const int c = lane & 3;
#pragma unroll
        for (int j = 0; j < 2; ++j) { const int n = (lane >> 2) + 16 * j; const LAS float* q = scr + (16 * c) * 33 + n;
            v4u o; o.x = q4i8((f32x4){q[0 * 33], q[1 * 33], q[2 * 33], q[3 * 33]}, 1.f); o.y = q4i8((f32x4){q[4 * 33], q[5 * 33], q[6 * 33], q[7 * 33]}, 1.f);
            o.z = q4i8((f32x4){q[8 * 33], q[9 * 33], q[10 * 33], q[11 * 33]}, 1.f); o.w = q4i8((f32x4){q[12 * 33], q[13 * 33], q[14 * 33], q[15 * 33]}, 1.f);
            *(v4u*)(s.dst + (size_t)(s.drow + n) * D + k0 + 16 * c) = o; }
        LDS_WAIT(); asm volatile("" ::: "memory"); }
}
__device__ __forceinline__ void p0_quant_slabs(const Args& A, unsigned char* ws, LAS unsigned char* lds, int vcu, int G) {
    int tid_ = threadIdx.x; asm volatile("" : "+v"(tid_)); const int lane = tid_ & 63, wave = __builtin_amdgcn_readfirstlane(tid_ >> 6);
    LAS float* ring = (LAS float*)(lds + RING_OFF);
    constexpr int S_IN = DIN / 32, S_FF = FF / 32, S_PG = D / 32, NSLAB = DEPTH * S_IN + 2 * S_FF + DEPTH * S_PG;
    struct Dec { const Args& A; unsigned char* ws;
        __device__ __forceinline__ QSlab operator()(int f) const { QSlab s; float* sb = (float*)(ws + WS_SB);
            if (f < DEPTH * S_IN) { const int l = f / S_IN, nb = f - l * S_IN; s.W = (const float*)AIN(I_WIN) + (size_t)l * D * DIN; s.N = DIN; s.n0 = 32 * nb; s.drow = dest_row<1>(32 * nb);
                s.dst = ws + WS_WIN8 + (size_t)l * DIN * D; s.sc = sb + l * DIN; return s; }
            int r = f - DEPTH * S_IN;
            if (r < 2 * S_FF) { const int up = r >= S_FF, nb = r - up * S_FF; s.W = (const float*)(up ? AIN(I_FU) : AIN(I_FG)); s.N = FF; s.n0 = 32 * nb; s.drow = up ? dest_row<3>(32 * nb) : dest_row<2>(32 * nb);
                s.dst = ws + WS_WGU8; s.sc = sb + 2 * DIN; return s; }
            r -= 2 * S_FF; { const int l = r / S_PG, nb = r - l * S_PG; s.W = (const float*)AIN(I_PWG) + (size_t)l * D * D; s.N = D; s.n0 = 32 * nb; s.drow = 32 * nb;
                s.dst = ws + WS_WPG8 + (size_t)l * D * D; s.sc = sb + 3 * DIN + l * D; return s; } } };
    const Dec dec{A, ws};
    int f = vcu; if (f >= NSLAB) return;
    float ra[2][32], rb[2][32];
    QSlab a = dec(f), b = a;
    qs_load(ra, a, wave, lane);
    for (;;) {
        const int f1 = f + G; const bool h1 = f1 < NSLAB;
        if (h1) { b = dec(f1); qs_load(rb, b, wave, lane); }
        qs_store(ra, a, ring, 0, wave, lane);
        if (!h1) break;
        const int f2 = f1 + G; const bool h2 = f2 < NSLAB;
        if (h2) { a = dec(f2); qs_load(ra, a, wave, lane); }
        qs_store(rb, b, ring, 1, wave, lane);
        if (!h2) break;
        f = f2;
    }
    __syncthreads();
}
__device__ __forceinline__ void p0_prologue(const Args& A, LAS unsigned char* lds, int vcu, int G) {
    int tid_ = threadIdx.x; asm volatile("" : "+v"(tid_)); const int tid = tid_, lane = tid & 63, wave = __builtin_amdgcn_readfirstlane(tid >> 6); (void)tid; (void)lane; (void)wave;
    unsigned char* ws = (unsigned char*)(GAS unsigned char*)A.ws;
    LAS float* scr = (LAS float*)(lds + RING_OFF + wave * 16384);
    const int gw = vcu * NWAVES + wave, ngw = G * NWAVES;
    p0_quant_slabs(A, ws, lds, vcu, G);
    { struct Dec { const Args& A; unsigned char* ws;
          __device__ __forceinline__ TrItem operator()(int f) const {
              constexpr int I_SQ = (D / 64) * (D / 32), I_PP = (PLE / 64) * (D / 32), I_L = 3 * I_SQ + I_PP;
              if (f < DEPTH * I_L) { const int l = f / I_L; int r = f - l * I_L; unsigned char* wl = ws + WS_WSMALL + (size_t)l * WL_STRIDE;
                  if (r < I_SQ) return tr_item<0>((const float*)AIN(I_WPA) + (size_t)l * D * D, D, D, (bf16*)(wl + WL_WAB), 0, r); r -= I_SQ;
                  if (r < I_SQ) return tr_item<0>((const float*)AIN(I_WPB) + (size_t)l * D * D, D, D, (bf16*)(wl + WL_WAB), D, r); r -= I_SQ;
                  if (r < I_SQ) return tr_item<0>((const float*)AIN(I_WOUT) + (size_t)l * D * D, D, D, (bf16*)(wl + WL_WO), 0, r); r -= I_SQ;
                  return tr_item<0>((const float*)AIN(I_PWP) + (size_t)l * PLE * D, PLE, D, (bf16*)(wl + WL_WPP), 0, r); }
              const int r = f - DEPTH * I_L;
              return tr_item<0>((const float*)AIN(I_FD), FF, D, (bf16*)(ws + WS_WD), 0, r); } };
      constexpr int NIT = DEPTH * (3 * (D / 64) * (D / 32) + (PLE / 64) * (D / 32)) + (FF / 64) * (D / 32);
      const Dec dec{A, ws}; tr_run<true>(dec, NIT, scr, lane, gw, ngw); }
    const int gt = gw * 64 + lane, ngt = ngw * 64;
    { const int* pos = (const int*)AIN(I_POS); float* pf = (float*)(ws + WS_COS); for (int i = gt; i < T; i += ngt) pf[i] = (float)pos[i]; }
    { const f32x4* p = (const f32x4*)AIN(I_P); u32x2* pb = (u32x2*)(ws + WS_PB);
      for (int i = gt; i < DEPTH * T * PLE / 4; i += ngt) pb[i] = f_to_bf4(p[i]); }
    { bf16* lw = (bf16*)(ws + WS_LRUW);
      for (int i = gt; i < DEPTH * 16 * 2 * 4096; i += ngt) { const int c = i & 63, d = (i >> 6) & 63, g = (i >> 12) & 1, n = (i >> 13) & 15, l = i >> 17;
          const float* src = (const float*)AIN(g ? I_LWX : I_LWA); lw[i] = (bf16)f2bf(src[((size_t)(l * 16 + n) * 64 + c) * 64 + d]); } }
    { const float* g0 = (const float*)AIN(I_NORMG);
      for (int m = gw; m < T; m += ngw) { const f32x4* xr = (const f32x4*)((const float*)AIN(I_X) + (size_t)m * D); f32x4 v[4]; float s = 0.f;
#pragma unroll
          for (int j = 0; j < 4; ++j) { v[j] = xr[lane + 64 * j]; s += dot4(v[j], v[j]); }
          const float rs = rsqrtf(wave_sum(s) * (1.f / D) + EPS);
          float mx = 0.f;
#pragma unroll
          for (int j = 0; j < 4; ++j) { ((u32x2*)(ws + WS_XR + (size_t)m * D * 2))[lane + 64 * j] = f_to_bf4(v[j]); v[j] = v[j] * rs * ((const f32x4*)g0)[lane + 64 * j]; mx = fmaxf(mx, amax4(v[j])); }
          mx = wave_max(mx); const float kq = 127.f / fmaxf(mx, 1e-30f);
#pragma unroll
          for (int j = 0; j < 4; ++j) ((unsigned*)(ws + WS_H + (size_t)m * D))[lane + 64 * j] = q4i8(v[j], kq);
          if (lane == 0) ((float*)(ws + WS_SA))[m] = mx * (1.f / 127.f); } }
    { float* par = (float*)(ws + WS_PAR);
      const int srcs[9] = {I_NORMG, I_CONVW, I_CONVB, I_LBA, I_LBX, I_LLAM, I_DLAM, I_SUBG, I_RW};
      const int offs[10] = {PO_NORMG, PO_CONVW, PO_CONVB, PO_LBA, PO_LBX, PO_LLAM, PO_DLAM, PO_SUBG, PO_RW, PO_SUBGS};
#pragma unroll
      for (int k = 0; k < 9; ++k) { const float* src = (const float*)AIN(srcs[k]); const int n = offs[k + 1] - offs[k];
          for (int i = gt; i < n; i += ngt) par[offs[k] + i] = src[i]; }
      for (int i = gt; i < DEPTH * 128; i += ngt) par[PO_SUBGS + i] = ((const float*)AIN(I_SUBG))[i] * (1.0f - (0.8f - 0.6f * expf(-0.3f * (float)(i >> 7)))); }
}

__device__ __forceinline__ unsigned short bf1(float v) { unsigned r; asm("v_cvt_pk_bf16_f32 %0, %1, %1" : "=v"(r) : "v"(v)); return (unsigned short)r; }
__device__ __forceinline__ float sigm_fast(float v) { return __builtin_amdgcn_rcpf(1.0f + __builtin_amdgcn_exp2f(-1.4426950408889634f * v)); }
__device__ __forceinline__ void lru_pass1(unsigned char* ws, LAS unsigned char* lds, int layer, int chunk) {
    int tid_ = threadIdx.x; asm volatile("" : "+v"(tid_)); const int tid = tid_, lane = tid & 63, wave = __builtin_amdgcn_readfirstlane(tid >> 6); (void)tid; (void)lane; (void)wave;
    typedef float f32x16 __attribute__((ext_vector_type(16)));
    const float* par = (const float*)(ws + WS_PAR);
    const int b = chunk >> 6, t0 = (chunk & 63) * 64; const size_t g0 = (size_t)b * SEQ + t0;
    LAS unsigned char* wl = lds + RING_OFF + wave * 16384;
    LAS bf16* U = (LAS bf16*)wl;
    LAS float* Gs = (LAS float*)(wl + 4608);
    const bf16* RIN = (const bf16*)(ws + WS_RIN); bf16* HL = (bf16*)(ws + WS_HL); bf16* LP = (bf16*)(ws + WS_LP);
    const int r32 = lane & 31, hi = lane >> 5;
    float h = 0.f, lpc = 0.f, xm3 = 0.f, xm2 = 0.f, xm1 = 0.f;
    v4u pre[4];
#define LRU_LOAD(nb_, tg_) do { _Pragma("unroll") for (int i = 0; i < 4; ++i) pre[i] = *(const v4u*)(RIN + (g0 + (tg_) * 32 + (lane >> 3) + 8 * i) * D + 64 * (2 * wave + (nb_)) + 8 * (lane & 7)); } while (0)
    LRU_LOAD(0, 0);
    for (int it = 0; it < 4; ++it) { const int nb = it >> 1, tg = it & 1;
        const int n = 2 * wave + nb, ch = 64 * n + lane;
        const float* cw = par + PO_CONVW + (size_t)layer * 4 * D;
        const float cw0 = cw[ch], cw1 = cw[D + ch], cw2 = cw[2 * D + ch], cw3 = cw[3 * D + ch], cb = par[PO_CONVB + layer * D + ch];
        const float ba = par[PO_LBA + layer * D + ch], bx = par[PO_LBX + layer * D + ch];
        const float lam = par[PO_LLAM + layer * D + ch];
        const float c8sp = -8.0f * 1.4426950408889634f * log1pf(__expf(-lam));
        const bf16* lw = (const bf16*)(ws + WS_LRUW) + (size_t)((layer * 16 + n) * 2) * 4096;
        if (tg == 0) { h = 0.f; lpc = 0.f; xm3 = 0.f; xm2 = 0.f; xm1 = 0.f;
            if (t0 > 0) { xm3 = bf2f(RIN[(g0 - 3) * D + ch]); xm2 = bf2f(RIN[(g0 - 2) * D + ch]); xm1 = bf2f(RIN[(g0 - 1) * D + ch]); } }
        const size_t gr = g0 + tg * 32;
        bf16x8 wf[2][2][4];
#pragma unroll
        for (int g = 0; g < 2; ++g)
#pragma unroll
            for (int dh = 0; dh < 2; ++dh)
#pragma unroll
                for (int ks = 0; ks < 4; ++ks) wf[g][dh][ks] = *(const bf16x8*)(lw + (size_t)g * 4096 + (32 * dh + r32) * 64 + 16 * ks + 8 * hi);
#pragma unroll
        for (int i = 0; i < 4; ++i) *(LAS v4u*)(U + ((lane >> 3) + 8 * i) * 72 + 8 * (lane & 7)) = pre[i];
        LDS_WAIT();
        if (it < 3) LRU_LOAD((it + 1) >> 1, (it + 1) & 1);
        float u[32];
#pragma unroll
        for (int t = 0; t < 32; ++t) { const float x = bf2f(U[t * 72 + lane]); u[t] = cb + cw0 * xm3 + cw1 * xm2 + cw2 * xm1 + cw3 * x; xm3 = xm2; xm2 = xm1; xm1 = x; U[t * 72 + lane] = bf1(u[t]); }
        LDS_WAIT();
        float gp[2][32];
#pragma unroll
        for (int g = 0; g < 2; ++g) {
            f32x16 c0 = {}, c1 = {};
#pragma unroll
            for (int ks = 0; ks < 4; ++ks) { const bf16x8 a = *(const LAS bf16x8*)(U + r32 * 72 + 16 * ks + 8 * hi);
                c0 = __builtin_amdgcn_mfma_f32_32x32x16_bf16(a, wf[g][0][ks], c0, 0, 0, 0); c1 = __builtin_amdgcn_mfma_f32_32x32x16_bf16(a, wf[g][1][ks], c1, 0, 0, 0); }
#pragma unroll
            for (int r = 0; r < 16; ++r) { const int row = (r & 3) + 8 * (r >> 2) + 4 * hi; Gs[row * 64 + r32] = c0[r]; Gs[row * 64 + 32 + r32] = c1[r]; }
            LDS_WAIT();
#pragma unroll
            for (int t = 0; t < 32; ++t) gp[g][t] = Gs[t * 64 + lane];
            LDS_WAIT();
        }
        LAS bf16* S2 = (LAS bf16*)Gs;
#pragma unroll
        for (int t = 0; t < 32; ++t) { const float rr = sigm_fast(gp[0][t] + ba), ii = sigm_fast(gp[1][t] + bx), la = c8sp * rr, a = __builtin_amdgcn_exp2f(la);
            const float bb = __builtin_amdgcn_sqrtf(fmaxf(0.f, 1.0f - a * a)) * ii * u[t];
            h = a * h + bb; lpc += la; U[t * 72 + lane] = bf1(h); S2[t * 72 + lane] = bf1(lpc); }
        LDS_WAIT();
#pragma unroll
        for (int i = 0; i < 4; ++i) { const int row = i * 8 + (lane >> 3), cc = lane & 7;
            const v4u a = *(const LAS v4u*)(U + row * 72 + cc * 8), c = *(const LAS v4u*)(S2 + row * 72 + cc * 8);
            *(v4u*)(HL + (gr + row) * D + 64 * n + cc * 8) = a; *(v4u*)(LP + (gr + row) * D + 64 * n + cc * 8) = c; }
        LDS_WAIT();
        if (tg == 1) { float* sum = (float*)(ws + WS_SUM) + (size_t)chunk * 2 * D; sum[ch] = lpc; sum[D + ch] = h; }
    }
#undef LRU_LOAD
}

__device__ __forceinline__ void tp_mix(unsigned char* ws, LAS unsigned char* lds, int layer, int chunk) {
    int tid_ = threadIdx.x; asm volatile("" : "+v"(tid_)); const int tid = tid_, lane = tid & 63, wave = __builtin_amdgcn_readfirstlane(tid >> 6); (void)tid; (void)lane; (void)wave;
    const float* par = (const float*)(ws + WS_PAR);
    LAS float* carry = (LAS float*)(lds + RING_OFF);
    { const float* sum = (const float*)(ws + WS_SUM);
      for (int ch = tid; ch < D; ch += NWAVES * 64) { float c = 0.f;
          const float* sp = sum + (size_t)(chunk & ~63) * 2 * D + ch; const int n = chunk & 63; int cc = 0;
          for (; cc + 8 <= n; cc += 8) { float la[8], bb[8];
#pragma unroll
              for (int k = 0; k < 8; ++k) { la[k] = sp[(size_t)(cc + k) * 2 * D]; bb[k] = sp[(size_t)(cc + k) * 2 * D + D]; }
#pragma unroll
              for (int k = 0; k < 8; ++k) c = __builtin_amdgcn_exp2f(la[k]) * c + bb[k]; }
          for (; cc < n; ++cc) c = __builtin_amdgcn_exp2f(sp[(size_t)cc * 2 * D]) * c + sp[(size_t)cc * 2 * D + D];
          carry[ch] = c; } }
    __syncthreads();
    const int b = chunk >> 6, t0 = (chunk & 63) * 64; const size_t g0 = (size_t)b * SEQ + t0;
    for (int rr = wave; rr < 64; rr += 2 * NWAVES) {
        v4u hl[2][2], lp[2][2], gg[2][2];
#pragma unroll
        for (int q = 0; q < 2; ++q) { const size_t ro = (g0 + rr + q * NWAVES) * D * 2;
#pragma unroll
            for (int j = 0; j < 2; ++j) { hl[q][j] = ((const v4u*)(ws + WS_HL + ro))[lane + 64 * j]; lp[q][j] = ((const v4u*)(ws + WS_LP + ro))[lane + 64 * j]; gg[q][j] = ((const v4u*)(ws + WS_GG + ro))[lane + 64 * j]; } }
#pragma unroll
        for (int q = 0; q < 2; ++q) { const size_t ro = (g0 + rr + q * NWAVES) * D * 2;
#pragma unroll
            for (int j = 0; j < 2; ++j) { const LAS f32x4* c4 = (const LAS f32x4*)carry + 128 * j + 2 * lane;
                const f32x4 l0 = bfl4(lp[q][j]), l1 = bfh4(lp[q][j]);
                const f32x4 e0 = {__builtin_amdgcn_exp2f(l0.x), __builtin_amdgcn_exp2f(l0.y), __builtin_amdgcn_exp2f(l0.z), __builtin_amdgcn_exp2f(l0.w)}, e1 = {__builtin_amdgcn_exp2f(l1.x), __builtin_amdgcn_exp2f(l1.y), __builtin_amdgcn_exp2f(l1.z), __builtin_amdgcn_exp2f(l1.w)};
                ((v4u*)(ws + WS_YA + ro))[lane + 64 * j] = pk8bf((bfl4(hl[q][j]) + e0 * c4[0]) * bfl4(gg[q][j]), (bfh4(hl[q][j]) + e1 * c4[1]) * bfh4(gg[q][j])); } }
    }
    __syncthreads();
}

template <bool DRY> __device__ __forceinline__ void route_row(unsigned char* ws, const LAS float* rwT, const f32x4 (&hn)[2][2], int m, int lane) {
    gu32* ctl = (gu32*)(ws + WS_CTL);
    float lg[NEXP];
#pragma unroll
    for (int e = 0; e < NEXP; ++e) { float s = 0.f;
#pragma unroll
        for (int j = 0; j < 2; ++j) { const LAS f32x4* r4 = (const LAS f32x4*)(rwT + e * D + 512 * j) + 2 * lane; s += dot4(hn[j][0], r4[0]) + dot4(hn[j][1], r4[1]); }
        lg[e] = wave_sum(s); }
    int e0 = 0; float v0 = lg[0];
#pragma unroll
    for (int e = 1; e < NEXP; ++e) if (lg[e] > v0) { v0 = lg[e]; e0 = e; }
    int e1 = -1; float v1 = -INFINITY;
#pragma unroll
    for (int e = 0; e < NEXP; ++e) if (e != e0 && lg[e] > v1) { v1 = lg[e]; e1 = e; }
    const float w1 = 1.0f / (1.0f + __expf(v0 - v1)), w0 = 1.0f - w1;
    if (DRY) { if (w0 + w1 + (float)e0 + (float)e1 == -12345.f) ((float*)(ws + WS_BIG))[m] = w0; }
    if (lane == 0 && !DRY) { const int p0 = (int)__hip_atomic_fetch_add(ctl + CW_CNT + 64 * e0, 1u, RLX_AGENT), p1 = (int)__hip_atomic_fetch_add(ctl + CW_CNT + 64 * e1, 1u, RLX_AGENT);
        int* lst = (int*)(ws + WS_LIST); lst[e0 * T + p0] = m; lst[e1 * T + p1] = m;
        int* ti = (int*)(ws + WS_TOK) + (size_t)m * 8; ti[0] = e0; ti[1] = p0; ti[2] = e1; ti[3] = p1; ti[4] = __float_as_int(w0); ti[5] = __float_as_int(w1); }
}
template <int SRC, bool ROUTE, bool DRY = false, bool H8 = false, bool FINAL = false, bool HQ = false> __device__ __forceinline__ void tp_post_pre(unsigned char* ws, float* xres, LAS unsigned char* lds, const float* gpost, const float* gpre, int vcu, int G) {
    int tid_ = threadIdx.x; asm volatile("" : "+v"(tid_)); const int tid = tid_, lane = tid & 63, wave = __builtin_amdgcn_readfirstlane(tid >> 6); (void)tid; (void)lane; (void)wave;
    gu32* ctl = (gu32*)(ws + WS_CTL);
    LAS float* rwT = (LAS float*)(lds + RING_OFF);
    int ps[NEXP];
    if (ROUTE) { const float* rw = (const float*)(ws + WS_PAR) + PO_RW; for (int i = tid; i < D * NEXP; i += NWAVES * 64) rwT[(i & 7) * D + (i >> 3)] = rw[i]; __syncthreads(); }
    if (SRC == 1) { int acc = 0;
#pragma unroll
        for (int e = 0; e < NEXP; ++e) { ps[e] = acc; acc += ((int)__hip_atomic_load(ctl + CW_CNT + 64 * e, RLX_AGENT) + 255) >> 8; } }
    const int gw = vcu * NWAVES + wave, ngw = G * NWAVES;
    f32x4 gp[2][2], gq[2][2];
#pragma unroll
    for (int j = 0; j < 2; ++j)
#pragma unroll
        for (int h = 0; h < 2; ++h) { gp[j][h] = ((const f32x4*)gpost)[128 * j + 2 * lane + h]; gq[j][h] = gpre ? ((const f32x4*)gpre)[128 * j + 2 * lane + h] : (f32x4){0.f, 0.f, 0.f, 0.f}; }
    unsigned char* xo = ws + (DRY ? WS_BIG : WS_XR); unsigned char* ho = ws + (DRY ? WS_BIG + 2 * SLOT : WS_H);
    constexpr int NR = (ROUTE || SRC == 1) ? 2 : 8;
    const bool xl = (ngw == 2048);
#define TP_ROW_OF(k) (xl ? ((gw >> 8) << 11) + (gw & 255) + ((k) << 8) : gw + (k) * ngw)
    for (int k0 = 0; TP_ROW_OF(k0) < T && k0 * ngw < T; k0 += NR) {
        v4u fa[NR][2], fc[NR][2], xr[NR][2]; float w0[NR], w1[NR];
#pragma unroll
        for (int r = 0; r < NR; ++r) { const int m = TP_ROW_OF(k0 + r); if ((k0 + r) * ngw < T && m < T) {
            if (SRC == 0) { const v4u* p = (const v4u*)(ws + WS_F + (size_t)m * D * 2) + lane; fa[r][0] = p[0]; fa[r][1] = p[64]; }
            else { const int* ti = (const int*)(ws + WS_TOK) + (size_t)m * 8; const int e0 = ti[0], p0 = ti[1], e1 = ti[2], p1 = ti[3]; w0[r] = __int_as_float(ti[4]); w1[r] = __int_as_float(ti[5]); int s0 = 0, s1 = 0;
#pragma unroll
                for (int e = 0; e < NEXP; ++e) { if (e == e0) s0 = ps[e]; if (e == e1) s1 = ps[e]; }
#define OE_ROW(dst, rw) do { const int rw_ = (rw); if (rw_ < MOE_MAINP * 256) { const v4u* q_ = (const v4u*)(ws + WS_OE + (size_t)rw_ * D * 2) + lane; dst[0] = q_[0]; dst[1] = q_[64]; } \
                    else { f32x4 a0_ = {0.f, 0.f, 0.f, 0.f}, a1_ = a0_, a2_ = a0_, a3_ = a0_; \
                        _Pragma("unroll") for (int ks_ = 0; ks_ < MOE_KS; ++ks_) { const v4u* q_ = (const v4u*)(ws + WS_OEP + ((size_t)ks_ * 8 * 256 + (rw_ - MOE_MAINP * 256)) * D * 2) + lane; const v4u x_ = q_[0], y_ = q_[64]; \
                            a0_ = a0_ + bfl4(x_); a1_ = a1_ + bfh4(x_); a2_ = a2_ + bfl4(y_); a3_ = a3_ + bfh4(y_); } \
                        dst[0] = pk8bf(a0_, a1_); dst[1] = pk8bf(a2_, a3_); } } while (0)
                OE_ROW(fa[r], s0 * 256 + p0); OE_ROW(fc[r], s1 * 256 + p1); }
#undef OE_ROW
            const v4u* xp = (const v4u*)(ws + WS_XR + (size_t)m * D * 2) + lane; xr[r][0] = xp[0]; xr[r][1] = xp[64]; } }
#pragma unroll
        for (int r = 0; r < NR; ++r) { const int m = TP_ROW_OF(k0 + r); if ((k0 + r) * ngw < T && m < T) {
            f32x4 f[2][2], xv[2][2]; float s = 0.f;
#pragma unroll
            for (int j = 0; j < 2; ++j) { f[j][0] = bfl4(fa[r][j]); f[j][1] = bfh4(fa[r][j]);
                if (SRC == 1) { f[j][0] = f[j][0] * w0[r] + bfl4(fc[r][j]) * w1[r]; f[j][1] = f[j][1] * w0[r] + bfh4(fc[r][j]) * w1[r]; }
                s += dot4(f[j][0], f[j][0]) + dot4(f[j][1], f[j][1]); }
            const float rs = rsqrtf(wave_sum(s) * (1.f / D) + EPS); float s2 = 0.f;
#pragma unroll
            for (int j = 0; j < 2; ++j) { xv[j][0] = bfl4(xr[r][j]) + f[j][0] * rs * gp[j][0]; xv[j][1] = bfh4(xr[r][j]) + f[j][1] * rs * gp[j][1];
                if (FINAL && !DRY) { f32x4* o = (f32x4*)(xres + (size_t)m * D) + 128 * j + 2 * lane; o[0] = xv[j][0]; o[1] = xv[j][1]; }
                else ((v4u*)(xo + (size_t)m * D * 2))[lane + 64 * j] = pk8bf(xv[j][0], xv[j][1]);
                s2 += dot4(xv[j][0], xv[j][0]) + dot4(xv[j][1], xv[j][1]); }
            if (gpre) { const float rs2 = rsqrtf(wave_sum(s2) * (1.f / D) + EPS);
#pragma unroll
                for (int j = 0; j < 2; ++j) { xv[j][0] = xv[j][0] * rs2 * gq[j][0]; xv[j][1] = xv[j][1] * rs2 * gq[j][1];
                    if (H8) { u32x2 w; w.x = pk4f8(xv[j][0].x * SC_H, xv[j][0].y * SC_H, xv[j][0].z * SC_H, xv[j][0].w * SC_H); w.y = pk4f8(xv[j][1].x * SC_H, xv[j][1].y * SC_H, xv[j][1].z * SC_H, xv[j][1].w * SC_H);
                        ((u32x2*)(ho + (size_t)m * D))[lane + 64 * j] = w; }
                    else if (!HQ) ((v4u*)(ho + (size_t)m * D * 2))[lane + 64 * j] = pk8bf(xv[j][0], xv[j][1]); }
                if (HQ) { const float mx = wave_max(fmaxf(fmaxf(amax4(xv[0][0]), amax4(xv[0][1])), fmaxf(amax4(xv[1][0]), amax4(xv[1][1])))); const float kq = 127.f / fmaxf(mx, 1e-30f);
#pragma unroll
                    for (int j = 0; j < 2; ++j) { u32x2 w; w.x = q4i8(xv[j][0], kq); w.y = q4i8(xv[j][1], kq); ((u32x2*)(ho + (size_t)m * D))[lane + 64 * j] = w; }
                    if (lane == 0 && !DRY) ((float*)(ws + WS_SA))[m] = mx * (1.f / 127.f); }
                if (ROUTE) route_row<DRY>(ws, rwT, xv, m, lane); } } }
    }
#undef TP_ROW_OF
    if (ROUTE) __syncthreads();
}

__device__ __forceinline__ void pm0_moe_setup(unsigned char* ws, const float* mg, const float* mu, const float* md, LAS unsigned char* lds, int vcu, int G) {
    int tid_ = threadIdx.x; asm volatile("" : "+v"(tid_)); const int tid = tid_, lane = tid & 63, wave = __builtin_amdgcn_readfirstlane(tid >> 6); (void)tid; (void)lane; (void)wave;
    gu32* ctl = (gu32*)(ws + WS_CTL);
    LAS float* scr = (LAS float*)(lds + RING_OFF + wave * 16384);
    const int gw = vcu * NWAVES + wave, ngw = G * NWAVES;
    int cs[NEXP + 1], ps[NEXP]; { int a = 0, p = 0;
#pragma unroll
        for (int e = 0; e < NEXP; ++e) { const int c = (int)__hip_atomic_load(ctl + CW_CNT + 64 * e, RLX_AGENT); cs[e] = a; ps[e] = p; a += c; p += (c + 255) >> 8; } cs[NEXP] = a; }
    const int* lst = (const int*)(ws + WS_LIST);
    for (int i = gw; i < cs[NEXP]; i += ngw) { int e = 0, base = 0, pst = 0;
#pragma unroll
        for (int k = 0; k < NEXP; ++k) if (i >= cs[k]) { e = k; base = cs[k]; pst = ps[k]; }
        const int pos = i - base, tok = lst[e * T + pos];
        ((v4u*)(ws + WS_HG + ((size_t)pst * 256 + pos) * D))[lane] = ((const v4u*)(ws + WS_H + (size_t)tok * D))[lane]; }
    { struct Dec { const float* mg; const float* mu; const float* md; unsigned char* ws;
          __device__ __forceinline__ TrItem operator()(int f) const {
              constexpr int I_FF = (D / 64) * (FF / 32);
              const int e = f / (3 * I_FF); int r = f - e * 3 * I_FF;
              if (r < I_FF) return tr_item<2>(mg + (size_t)e * D * FF, D, FF, (bf16*)(ws + WS_WMGU), e * 2 * FF, r, SC_WGU); r -= I_FF;
              if (r < I_FF) return tr_item<3>(mu + (size_t)e * D * FF, D, FF, (bf16*)(ws + WS_WMGU), e * 2 * FF, r, SC_WGU); r -= I_FF;
              return tr_item<0>(md + (size_t)e * FF * D, FF, D, (bf16*)(ws + WS_WMD), e * D, r, SC_WD); } };
      const Dec dec{mg, mu, md, ws}; tr_run<true>(dec, NEXP * 3 * (D / 64) * (FF / 32), scr, lane, gw, ngw); }
}
constexpr int NPH_L = 14, NPHASES = 1 + DEPTH * NPH_L;
__host__ __device__ constexpr bool phase_exists(int ph) { return ph == 0 || !((((ph - 1) % NPH_L) == 9 || ((ph - 1) % NPH_L) == 10) || (((ph - 1) / NPH_L) % 2 == 0 && ((ph - 1) % NPH_L) == 6)); }

__global__ void __launch_bounds__(NWAVES * 64, 2) mk_fwd(Args args) {
    extern __shared__ __attribute__((aligned(16))) unsigned char lds_raw[];
    LAS unsigned char* lds = (LAS unsigned char*)lds_raw;
    volatile LAS unsigned* MISC = (volatile LAS unsigned*)(lds + MISC_OFF);
    const int tid = threadIdx.x;
    const int Gk = gridDim.x; const int bxk = blockIdx.x; const int vcuk = (Gk % 8 == 0) ? (bxk % 8) * (Gk / 8) + bxk / 8 : bxk;
    for (int u = tid; u < (LDS_BYTES - LDSCTL_OFF) / 4; u += NWAVES * 64) ((LAS unsigned*)(lds + LDSCTL_OFF))[u] = 0u;
    __syncthreads();
    XcdBarrier bar; bar.bar = (unsigned*)(args.ws + WS_CTL) + CW_BAR; bar.x = 0; bar.st = nullptr;
    if (!MK_MULTI) bar = xcd_barrier_post((unsigned*)(args.ws + WS_CTL) + CW_BAR, MISC + 8);
    const int lo = args.ph_lo, hi = args.ph_hi;
#ifndef DIS
#define DIS 0
#endif
#ifndef REP
#define REP 0
#endif
#define EN(b) (!((DIS >> (b)) & 1))
#define IN(k) (lo <= (k) && (k) < hi)
#define PH_WS int z_ = 0, G = Gk, bx = bxk, vcu = vcuk; asm volatile("" : "+s"(z_), "+s"(G), "+s"(bx), "+s"(vcu)); unsigned char* ws = (unsigned char*)((GAS unsigned char*)args.ws + z_); (void)ws; (void)G; (void)bx; (void)vcu
#define XOUT ((float*)((GAS float*)args.out + z_))
#define GIN(k) ((const float*)((const GAS float*)args.in[k] + z_))
#define SEAM(k) do { if ((k) + 1 < hi) { if (MK_MULTI) { if (tid == 0) __hip_atomic_store((gu32*)(ws + WS_CTL) + CW_TMO, 0xBADBA0u, RLX_AGENT); } else xcd_barrier(bar); } } while (0)

    if (EN(0) && IN(0)) { PH_WS;
#if (REP >> 0) & 1
        { p0_prologue(args, lds, vcu, G); }
        __syncthreads();
#endif
        p0_prologue(args, lds, vcu, G);
        SEAM(0); }

    for (int l = 0; l < DEPTH; ++l) {
        const int pb = 1 + NPH_L * l;
        if (EN(1) && IN(pb + 0)) { PH_WS;
#if (REP >> 1) & 1
            { unsigned char* wl = ws + WS_WSMALL + (size_t)l * WL_STRIDE;
            pg8::Gemm g{(const pg8::bf16_t*)(ws + WS_H), (const pg8::bf16_t*)(ws + WS_WIN8 + (size_t)l * DIN * D), T, DIN, D / 2}; pg8::StaticOrder S; S.init(T, DIN, G, bx); (void)wl;
            pg8::EpiInProjq E{(pg8::bf16_t*)(ws + WS_BIG), SLOT / 2, (const float*)(ws + WS_COS), attn_body::C2, (const float*)(ws + WS_SA), (const float*)(ws + WS_SB) + (size_t)l * DIN};
#ifdef STAGGER_US
            if (bx & 1) { const unsigned long long t0_ = __builtin_amdgcn_s_memrealtime(); while (__builtin_amdgcn_s_memrealtime() - t0_ < (unsigned long long)(STAGGER_US * 100)) __builtin_amdgcn_s_sleep(8); }
#endif
            pg8::gemm_phase<pg8::EpiInProjq, pg8::StaticOrder, true, true, 2>(lds + RING_OFF, g, S, E);
            }
            __syncthreads();
#endif
            unsigned char* wl = ws + WS_WSMALL + (size_t)l * WL_STRIDE;
            pg8::Gemm g{(const pg8::bf16_t*)(ws + WS_H), (const pg8::bf16_t*)(ws + WS_WIN8 + (size_t)l * DIN * D), T, DIN, D / 2}; pg8::StaticOrder S; S.init(T, DIN, G, bx); (void)wl;
            pg8::EpiInProjq E{(pg8::bf16_t*)(ws + WS_BIG), SLOT / 2, (const float*)(ws + WS_COS), attn_body::C2, (const float*)(ws + WS_SA), (const float*)(ws + WS_SB) + (size_t)l * DIN};
#ifdef STAGGER_US
            if (bx & 1) { const unsigned long long t0_ = __builtin_amdgcn_s_memrealtime(); while (__builtin_amdgcn_s_memrealtime() - t0_ < (unsigned long long)(STAGGER_US * 100)) __builtin_amdgcn_s_sleep(8); }
#endif
            pg8::gemm_phase<pg8::EpiInProjq, pg8::StaticOrder, true, true, 2>(lds + RING_OFF, g, S, E);

            SEAM(pb + 0);
        }
        if (EN(2) && IN(pb + 1)) { PH_WS;
#if (REP >> 2) & 1
            {
#if !defined(NO_LRU) && !defined(DUP_NO_LRU)
            for (int c = vcu; c < 256; c += G) lru_pass1(ws, lds, l, c);
            __syncthreads();
#endif
#if !defined(NO_ATT) && !defined(DUP_NO_ATT)
            const attn_body::AttnTensors AT{(const attn_body::bf16*)(ws + WS_Q), (const attn_body::bf16*)(ws + WS_K), (const attn_body::bf16*)(ws + WS_V), (attn_body::bf16*)(ws + WS_O2), (attn_body::bf16*)(ws + WS_YB)};
            { const float* par = (const float*)(ws + WS_PAR); const float* dl = par + PO_DLAM + l * 256; int t_ = threadIdx.x; asm volatile("" : "+v"(t_)); const int ln_ = t_ & 63;
              const float lamv = expf(wave_sum(dl[ln_] * dl[64 + ln_])) - expf(wave_sum(dl[128 + ln_] * dl[192 + ln_])) + (0.8f - 0.6f * expf(-0.3f * (float)l));
              attn_body::attn_phase<8>((char*)lds_raw + RING_OFF, AT, lamv, par + PO_SUBGS + l * 128, vcu, G); }
#endif
            }
            __syncthreads();
#endif

#ifndef NO_LRU
            for (int c = vcu; c < 256; c += G) lru_pass1(ws, lds, l, c);
            __syncthreads();
#endif
#ifndef NO_ATT
            const attn_body::AttnTensors AT{(const attn_body::bf16*)(ws + WS_Q), (const attn_body::bf16*)(ws + WS_K), (const attn_body::bf16*)(ws + WS_V), (attn_body::bf16*)(ws + WS_O2), (attn_body::bf16*)(ws + WS_YB)};
            { const float* par = (const float*)(ws + WS_PAR); const float* dl = par + PO_DLAM + l * 256; int t_ = threadIdx.x; asm volatile("" : "+v"(t_)); const int ln_ = t_ & 63;
              const float lamv = expf(wave_sum(dl[ln_] * dl[64 + ln_])) - expf(wave_sum(dl[128 + ln_] * dl[192 + ln_])) + (0.8f - 0.6f * expf(-0.3f * (float)l));
              attn_body::attn_phase<8>((char*)lds_raw + RING_OFF, AT, lamv, par + PO_SUBGS + l * 128, vcu, G); }
#endif

            SEAM(pb + 1);
        }
        if (EN(3) && IN(pb + 2)) { PH_WS;
#if (REP >> 3) & 1
            { for (int c = vcu; c < 256; c += G) tp_mix(ws, lds, l, c); }
            __syncthreads();
#endif
            for (int c = vcu; c < 256; c += G) tp_mix(ws, lds, l, c);
            SEAM(pb + 2); }
        if (EN(4) && IN(pb + 3)) { PH_WS;
#if (REP >> 4) & 1
            { unsigned char* wl = ws + WS_WSMALL + (size_t)l * WL_STRIDE;
            pg8::Gemm g{(const pg8::bf16_t*)(ws + WS_YA), (const pg8::bf16_t*)(wl + WL_WAB), T, D, D}; pg8::PairOrder S; S.base.init(T, D, G, bx);
            pg8::EpiMerge E{(const pg8::bf16_t*)(ws + WS_SGA), (const pg8::bf16_t*)(ws + WS_SGB), (pg8::bf16_t*)(ws + WS_T1), (pg8::bf16_t*)(ws + WS_MERGED), NPAN};
            pg8::gemm_phase<pg8::EpiMerge, pg8::PairOrder, true, true>(lds + RING_OFF, g, S, E);
            }
            __syncthreads();
#endif
            unsigned char* wl = ws + WS_WSMALL + (size_t)l * WL_STRIDE;
            pg8::Gemm g{(const pg8::bf16_t*)(ws + WS_YA), (const pg8::bf16_t*)(wl + WL_WAB), T, D, D}; pg8::PairOrder S; S.base.init(T, D, G, bx);
            pg8::EpiMerge E{(const pg8::bf16_t*)(ws + WS_SGA), (const pg8::bf16_t*)(ws + WS_SGB), (pg8::bf16_t*)(ws + WS_T1), (pg8::bf16_t*)(ws + WS_MERGED), NPAN};
            pg8::gemm_phase<pg8::EpiMerge, pg8::PairOrder, true, true>(lds + RING_OFF, g, S, E);

            SEAM(pb + 3);
        }
        if (EN(5) && IN(pb + 4)) { PH_WS;
#if (REP >> 5) & 1
            { unsigned char* wl = ws + WS_WSMALL + (size_t)l * WL_STRIDE;
            pg8::Gemm g{(const pg8::bf16_t*)(ws + WS_MERGED), (const pg8::bf16_t*)(wl + WL_WO), T, D, D}; pg8::StaticOrder S; S.init(T, D, G, bx);
            pg8::EpiPlainBf16 E{(pg8::bf16_t*)(ws + WS_F), D, 3};
            pg8::gemm_phase<pg8::EpiPlainBf16, pg8::StaticOrder, false, true>(lds + RING_OFF, g, S, E);
            }
            __syncthreads();
#endif
            unsigned char* wl = ws + WS_WSMALL + (size_t)l * WL_STRIDE;
            pg8::Gemm g{(const pg8::bf16_t*)(ws + WS_MERGED), (const pg8::bf16_t*)(wl + WL_WO), T, D, D}; pg8::StaticOrder S; S.init(T, D, G, bx);
            pg8::EpiPlainBf16 E{(pg8::bf16_t*)(ws + WS_F), D, 3};
            pg8::gemm_phase<pg8::EpiPlainBf16, pg8::StaticOrder, false, true>(lds + RING_OFF, g, S, E);

            SEAM(pb + 4);
        }
        if (EN(6) && IN(pb + 5)) { PH_WS;
#if (REP >> 6) & 1
            { const float* ng = (const float*)(ws + WS_PAR) + PO_NORMG + (size_t)l * 6 * D;
            if (l & 1) tp_post_pre<0, true, true, true>(ws, XOUT, lds, ng + 1 * D, ng + 2 * D, vcu, G);
            else tp_post_pre<0, false, true, false, false, true>(ws, XOUT, lds, ng + 1 * D, ng + 2 * D, vcu, G);
            }
            __syncthreads();
#endif
            const float* ng = (const float*)(ws + WS_PAR) + PO_NORMG + (size_t)l * 6 * D;
            if (l & 1) tp_post_pre<0, true, false, true>(ws, XOUT, lds, ng + 1 * D, ng + 2 * D, vcu, G);
            else tp_post_pre<0, false, false, false, false, true>(ws, XOUT, lds, ng + 1 * D, ng + 2 * D, vcu, G);

            SEAM(pb + 5);
        }
        if (!(l & 1)) {
            if (EN(7) && IN(pb + 7)) { PH_WS;
#if (REP >> 7) & 1
                {
                pg8::Gemm g{(const pg8::bf16_t*)(ws + WS_H), (const pg8::bf16_t*)(ws + WS_WGU8), T, 2 * FF, D / 2}; pg8::StaticOrder S; S.init(T, 2 * FF, G, bx);
                pg8::EpiSwiGLUq E{(pg8::bf16_t*)(ws + WS_ACT), FF, (const float*)(ws + WS_SA), (const float*)(ws + WS_SB) + 2 * DIN};
#ifdef STAGGER_US
            if (bx & 1) { const unsigned long long t0_ = __builtin_amdgcn_s_memrealtime(); while (__builtin_amdgcn_s_memrealtime() - t0_ < (unsigned long long)(STAGGER_US * 100)) __builtin_amdgcn_s_sleep(8); }
#endif
                pg8::gemm_phase<pg8::EpiSwiGLUq, pg8::StaticOrder, true, true, 2>(lds + RING_OFF, g, S, E);
                }
                __syncthreads();
#endif

                pg8::Gemm g{(const pg8::bf16_t*)(ws + WS_H), (const pg8::bf16_t*)(ws + WS_WGU8), T, 2 * FF, D / 2}; pg8::StaticOrder S; S.init(T, 2 * FF, G, bx);
                pg8::EpiSwiGLUq E{(pg8::bf16_t*)(ws + WS_ACT), FF, (const float*)(ws + WS_SA), (const float*)(ws + WS_SB) + 2 * DIN};
#ifdef STAGGER_US
            if (bx & 1) { const unsigned long long t0_ = __builtin_amdgcn_s_memrealtime(); while (__builtin_amdgcn_s_memrealtime() - t0_ < (unsigned long long)(STAGGER_US * 100)) __builtin_amdgcn_s_sleep(8); }
#endif
                pg8::gemm_phase<pg8::EpiSwiGLUq, pg8::StaticOrder, true, true, 2>(lds + RING_OFF, g, S, E);

                SEAM(pb + 7);
            }
            if (EN(8) && IN(pb + 8)) { PH_WS;
#if (REP >> 8) & 1
                {
                pg8::Gemm g{(const pg8::bf16_t*)(ws + WS_ACT), (const pg8::bf16_t*)(ws + WS_WD), T, D, FF}; pg8::StaticOrder S; S.init(T, D, G, bx);
                pg8::EpiPlainBf16 E{(pg8::bf16_t*)(ws + WS_F), D, 3};
                pg8::gemm_phase<pg8::EpiPlainBf16, pg8::StaticOrder, false, true>(lds + RING_OFF, g, S, E);
                }
                __syncthreads();
#endif

                pg8::Gemm g{(const pg8::bf16_t*)(ws + WS_ACT), (const pg8::bf16_t*)(ws + WS_WD), T, D, FF}; pg8::StaticOrder S; S.init(T, D, G, bx);
                pg8::EpiPlainBf16 E{(pg8::bf16_t*)(ws + WS_F), D, 3};
                pg8::gemm_phase<pg8::EpiPlainBf16, pg8::StaticOrder, false, true>(lds + RING_OFF, g, S, E);

                SEAM(pb + 8);
            }
            if (EN(9) && IN(pb + 11)) { PH_WS;
#if (REP >> 9) & 1
                { const float* ng = (const float*)(ws + WS_PAR) + PO_NORMG + (size_t)l * 6 * D;
                tp_post_pre<0, false, true, false, false, true>(ws, XOUT, lds, ng + 3 * D, ng + 4 * D, vcu, G); }
                __syncthreads();
#endif
                const float* ng = (const float*)(ws + WS_PAR) + PO_NORMG + (size_t)l * 6 * D;
                tp_post_pre<0, false, false, false, false, true>(ws, XOUT, lds, ng + 3 * D, ng + 4 * D, vcu, G);
                SEAM(pb + 11); }
        } else {
            if (EN(10) && IN(pb + 6)) { PH_WS;
#if (REP >> 10) & 1
                { pm0_moe_setup(ws, GIN(I_MG), GIN(I_MU), GIN(I_MD), lds, vcu, G); }
                __syncthreads();
#endif
                pm0_moe_setup(ws, GIN(I_MG), GIN(I_MU), GIN(I_MD), lds, vcu, G);
                SEAM(pb + 6); }
            if (EN(11) && IN(pb + 7)) { PH_WS; gu32* ctl = (gu32*)(ws + WS_CTL);
                int ps[NEXP + 1]; { int p = 0;
#pragma unroll
                    for (int e = 0; e < NEXP; ++e) { ps[e] = p; p += ((int)__hip_atomic_load(ctl + CW_CNT + 64 * e, RLX_AGENT) + 255) >> 8; } ps[NEXP] = p; }
#if (REP >> 11) & 1
                for (int rep_ = 0; rep_ < 2; ++rep_)
#endif
                {
                pg8::Gemm g{(const pg8::bf16_t*)(ws + WS_HG), (const pg8::bf16_t*)(ws + WS_WMGU), ps[NEXP] * 256, 2 * FF, D / 2, E8_H, E8_WGU};
                pg8::MoeOrder S; S.base.init(ps[NEXP] * 256, 2 * FF, G, bx); S.plo = 0; S.ps1 = ps[1]; S.ps2 = ps[2]; S.ps3 = ps[3]; S.ps4 = ps[4]; S.ps5 = ps[5]; S.ps6 = ps[6]; S.ps7 = ps[7];
                pg8::EpiSwiGLU8 E{ws + WS_ACT8, FF, 2 * FF / 256, 0, SC_ACT};
#ifdef STAGGER_US
            if (bx & 1) { const unsigned long long t0_ = __builtin_amdgcn_s_memrealtime(); while (__builtin_amdgcn_s_memrealtime() - t0_ < (unsigned long long)(STAGGER_US * 100)) __builtin_amdgcn_s_sleep(8); }
#endif
                pg8::gemm_phase<pg8::EpiSwiGLU8, pg8::MoeOrder, true, true, true>(lds + RING_OFF, g, S, E);
                }
                SEAM(pb + 7);
            }
            if (EN(12) && IN(pb + 8)) { PH_WS; gu32* ctl = (gu32*)(ws + WS_CTL);
                int ps[NEXP + 1]; { int p = 0;
#pragma unroll
                    for (int e = 0; e < NEXP; ++e) { ps[e] = p; p += ((int)__hip_atomic_load(ctl + CW_CNT + 64 * e, RLX_AGENT) + 255) >> 8; } ps[NEXP] = p; }
#if (REP >> 12) & 1
                for (int rep_ = 0; rep_ < 2; ++rep_)
#endif
                {
                const int npm = ps[NEXP] < MOE_MAINP ? ps[NEXP] : MOE_MAINP;
                pg8::Gemm g{(const pg8::bf16_t*)(ws + WS_ACT8), (const pg8::bf16_t*)(ws + WS_WMD), npm * 256, D, FF / 2, E8_ACT, E8_WD};
                pg8::MoeOrder S; S.base.init(npm * 256, D, G, bx); S.plo = 0; S.ps1 = ps[1]; S.ps2 = ps[2]; S.ps3 = ps[3]; S.ps4 = ps[4]; S.ps5 = ps[5]; S.ps6 = ps[6]; S.ps7 = ps[7];
                pg8::EpiPlainBf16 E{(pg8::bf16_t*)(ws + WS_OE), D, 3};
                pg8::gemm_phase<pg8::EpiPlainBf16, pg8::MoeOrder, true, true, true>(lds + RING_OFF, g, S, E);
                if (ps[NEXP] > MOE_MAINP) {
                    __syncthreads();
                    pg8::Gemm g2{(const pg8::bf16_t*)(ws + WS_ACT8), (const pg8::bf16_t*)(ws + WS_WMD), (ps[NEXP] - MOE_MAINP) * 256, D, MOE_KSB / 2, E8_ACT, E8_WD, FF / 2};
                    pg8::MoeKSplitOrder S2{G, bx, MOE_MAINP, ps[NEXP] - MOE_MAINP, D / 256, MOE_KS, MOE_KSB, ps[1], ps[2], ps[3], ps[4], ps[5], ps[6], ps[7]};
                    pg8::EpiSliceBf16 E2{(pg8::bf16_t*)(ws + WS_OEP), D, 3, MOE_MAINP, MOE_KSB, (size_t)8 * 256 * D};
                    pg8::gemm_phase<pg8::EpiSliceBf16, pg8::MoeKSplitOrder, true, true, true>(lds + RING_OFF, g2, S2, E2);
                }
                }
                SEAM(pb + 8);
            }
            if (EN(13) && IN(pb + 11)) { PH_WS;
#if (REP >> 13) & 1
                { const float* ng = (const float*)(ws + WS_PAR) + PO_NORMG + (size_t)l * 6 * D;
                tp_post_pre<1, false, true, false, false, true>(ws, XOUT, lds, ng + 3 * D, ng + 4 * D, vcu, G); }
                __syncthreads();
#endif
                const float* ng = (const float*)(ws + WS_PAR) + PO_NORMG + (size_t)l * 6 * D;
                tp_post_pre<1, false, false, false, false, true>(ws, XOUT, lds, ng + 3 * D, ng + 4 * D, vcu, G);
                SEAM(pb + 11); }
        }
        if (EN(14) && IN(pb + 12)) { PH_WS;
#if (REP >> 14) & 1
            { unsigned char* wl = ws + WS_WSMALL + (size_t)l * WL_STRIDE;
            { pg8::Gemm g{(const pg8::bf16_t*)(ws + WS_PB) + (size_t)l * T * PLE, (const pg8::bf16_t*)(wl + WL_WPP), T, D, PLE}; pg8::StaticOrder S; S.init(T, D, G, bx);
              pg8::EpiPlainBf16 E{(pg8::bf16_t*)(ws + WS_PP), D, 3};
              pg8::gemm_phase<pg8::EpiPlainBf16, pg8::StaticOrder, false, true>(lds + RING_OFF, g, S, E); }
            __syncthreads();
            { pg8::Gemm g{(const pg8::bf16_t*)(ws + WS_H), (const pg8::bf16_t*)(ws + WS_WPG8 + (size_t)l * D * D), T, D, D / 2}; pg8::StaticOrder S; S.init(T, D, G, bx);
              pg8::EpiPleGateq E{(pg8::bf16_t*)(ws + WS_F), (const pg8::bf16_t*)(ws + WS_PP), D, (const float*)(ws + WS_SA), (const float*)(ws + WS_SB) + 3 * DIN + (size_t)l * D};
              pg8::gemm_phase<pg8::EpiPleGateq, pg8::StaticOrder, false, true, 2>(lds + RING_OFF, g, S, E); }
            }
            __syncthreads();
#endif
            unsigned char* wl = ws + WS_WSMALL + (size_t)l * WL_STRIDE;
            { pg8::Gemm g{(const pg8::bf16_t*)(ws + WS_PB) + (size_t)l * T * PLE, (const pg8::bf16_t*)(wl + WL_WPP), T, D, PLE}; pg8::StaticOrder S; S.init(T, D, G, bx);
              pg8::EpiPlainBf16 E{(pg8::bf16_t*)(ws + WS_PP), D, 3};
              pg8::gemm_phase<pg8::EpiPlainBf16, pg8::StaticOrder, false, true>(lds + RING_OFF, g, S, E); }
            __syncthreads();
            { pg8::Gemm g{(const pg8::bf16_t*)(ws + WS_H), (const pg8::bf16_t*)(ws + WS_WPG8 + (size_t)l * D * D), T, D, D / 2}; pg8::StaticOrder S; S.init(T, D, G, bx);
              pg8::EpiPleGateq E{(pg8::bf16_t*)(ws + WS_F), (const pg8::bf16_t*)(ws + WS_PP), D, (const float*)(ws + WS_SA), (const float*)(ws + WS_SB) + 3 * DIN + (size_t)l * D};
              pg8::gemm_phase<pg8::EpiPleGateq, pg8::StaticOrder, false, true, 2>(lds + RING_OFF, g, S, E); }

            SEAM(pb + 12);
        }
        if (EN(15) && IN(pb + 13)) { PH_WS;
#if (REP >> 15) & 1
            { const float* ng = (const float*)(ws + WS_PAR) + PO_NORMG + (size_t)l * 6 * D;
            tp_post_pre<0, false, true>(ws, XOUT, lds, ng + 5 * D, (l + 1 < DEPTH) ? ng + 6 * D : nullptr, vcu, G); }
            __syncthreads();
#endif
            const float* ng = (const float*)(ws + WS_PAR) + PO_NORMG + (size_t)l * 6 * D;
            if (l + 1 < DEPTH) tp_post_pre<0, false, false, false, false, true>(ws, XOUT, lds, ng + 5 * D, ng + 6 * D, vcu, G);
            else tp_post_pre<0, false, false, false, true>(ws, XOUT, lds, ng + 5 * D, nullptr, vcu, G);
            SEAM(pb + 13); }
    }
#undef IN
#undef SEAM
#undef PH_WS
}

extern "C" void kernel_launch(void* const* d_in, const int* in_sizes, int n_in, void* d_out, int out_size, void* d_ws, size_t ws_size, hipStream_t stream) {
    static int grid = 0;
    if (grid == 0) {
        if (n_in != 26 || in_sizes[0] != T * D || out_size != T * D || ws_size < WS_END) { fprintf(stderr, "kernel_launch: unexpected shapes / workspace (n_in %d, in0 %d, out %d, ws %zu < %zu); nothing launched\n", n_in, n_in > 0 ? in_sizes[0] : -1, out_size, ws_size, (size_t)WS_END); grid = -1; return; }
        int dev = 0, cus = 0, per_cu = 0;
        if (hipGetDevice(&dev) != hipSuccess || hipDeviceGetAttribute(&cus, hipDeviceAttributeMultiprocessorCount, dev) != hipSuccess) { grid = -1; return; }
        if (hipFuncSetAttribute((const void*)mk_fwd, hipFuncAttributeMaxDynamicSharedMemorySize, LDS_BYTES) != hipSuccess) { fprintf(stderr, "kernel_launch: hipFuncSetAttribute failed\n"); grid = -1; return; }
        if (hipOccupancyMaxActiveBlocksPerMultiprocessor(&per_cu, (const void*)mk_fwd, NWAVES * 64, LDS_BYTES) != hipSuccess || per_cu < 1) { fprintf(stderr, "kernel_launch: occupancy query reports %d workgroups per CU\n", per_cu); (void)hipGetLastError(); grid = -1; return; }
        grid = cus;
    }
    if (grid < 0) return;
    if (hipMemsetAsync((char*)d_ws + WS_CTL, 0, CTL_ZERO_BYTES, stream) != hipSuccess) return;
    Args a{};
    for (int i = 0; i < 26; ++i) a.in[i] = d_in[i];
    a.out = (float*)d_out; a.ws = (unsigned char*)d_ws;
#if MK_MULTI
    for (int ph = 0; ph < NPHASES; ++ph) { if (!phase_exists(ph)) continue; a.ph_lo = ph; a.ph_hi = ph + 1; hipLaunchKernelGGL(mk_fwd, dim3(grid), dim3(NWAVES * 64), LDS_BYTES, stream, a); }
#else
    a.ph_lo = 0; a.ph_hi = NPHASES;
    hipLaunchKernelGGL(mk_fwd, dim3(grid), dim3(NWAVES * 64), LDS_BYTES, stream, a);
#endif
}
```

```cpp
#include <hip/hip_runtime.h>
#include <hip/hip_bf16.h>
#include <cstdio>
#include <cstdint>
#include <cmath>
namespace pg8 {
#define PG8_LAS __attribute__((address_space(3)))
typedef unsigned short bf16_t;
typedef short bf16x8 __attribute__((ext_vector_type(8)));
typedef float f32x4 __attribute__((ext_vector_type(4)));
typedef unsigned u32x4 __attribute__((ext_vector_type(4)));
constexpr int BM = 256, BK = 64, HALF = 128, HTB = HALF * BK * 2  , STAGE_BYTES = 8 * HTB, NXCD = 8, WGM = 8;

__host__ __device__ __forceinline__ int lds_byte(int r, int c) { const int st = (r >> 4) * 2 + (c >> 5), rr = r & 15, cc = c & 31, ob = rr * 64 + cc * 2; return st * 1024 + (ob ^ (((ob >> 9) & 1) << 5)); }
__host__ __device__ __forceinline__ void stage_rc(int b, int& R, int& C) { const int st = b / 1024, sb = b % 1024, swz = sb ^ (((sb >> 9) & 1) << 5); R = (st >> 1) * 16 + swz / 64; C = (st & 1) * 32 + (swz % 64) / 2; }
__host__ __device__ __forceinline__ int perm32(int rho) { const int n = rho >> 4, i = rho & 15; return 8 * (i >> 2) + 4 * n + (i & 3); }

struct Unit { int pm, pn; int ko = 0; };
typedef int v4i_t __attribute__((ext_vector_type(4)));
typedef int v8i_t __attribute__((ext_vector_type(8)));
struct Gemm { const bf16_t* A; const bf16_t* Bt; int M, N, K; int sa = 0x7f7f7f7f, sb = 0x7f7f7f7f; int ld = 0; };

struct StaticOrder {
    int nM, nN, nwg, G, c;
    __host__ __device__ void init(int M, int N, int G_, int c_) { nM = M / BM; nN = N / BM; nwg = nM * nN; G = G_; c = c_; }
    __host__ __device__ bool next(int i, Unit& u) const {
        const long L = (long)i * G + c; if (L >= nwg) return false;
        int wgid = (int)L; { const int q = nwg / NXCD, r = nwg % NXCD, xcd = wgid % NXCD, off = wgid / NXCD; wgid = (xcd < r ? xcd * (q + 1) : r * (q + 1) + (xcd - r) * q) + off; }
        const int nig = WGM * nN, gid = wgid / nig, fm = gid * WGM, gsz = (nM - fm) < WGM ? (nM - fm) : WGM;
        u.pm = fm + ((wgid % nig) % gsz); u.pn = (wgid % nig) / gsz; return true;
    }
    __device__ __forceinline__ void a_ready(const Unit&) const {}
    __device__ __forceinline__ void done(const Unit&) const {}
};

__device__ __forceinline__ unsigned cvt_pk_bf16(float lo, float hi) { unsigned r; asm volatile("v_cvt_pk_bf16_f32 %0, %1, %2" : "=v"(r) : "v"(lo), "v"(hi)); return r; }
typedef float f32x2 __attribute__((ext_vector_type(2)));
__device__ __forceinline__ f32x2 gelu_pk(f32x2 v) {
    const f32x2 av = __builtin_elementwise_abs(v), d = av * 0.2316418882f + 1.0f;
    f32x2 t; t.x = __builtin_amdgcn_rcpf(d.x); t.y = __builtin_amdgcn_rcpf(d.y);
    f32x2 q = t * 0.5307027145f + (-0.7265760135f); q = q * t + 0.7107068705f; q = q * t + (-0.142248368f); q = q * t + 0.127414796f; q = q * t;
    const f32x2 s = (v * v) * (-0.72134752044f);
    f32x2 e; e.x = __builtin_amdgcn_exp2f(s.x); e.y = __builtin_amdgcn_exp2f(s.y);
    const f32x2 m = v * (q * e), r = v - m;
    f32x2 o; o.x = v.x < 0.f ? m.x : r.x; o.y = v.y < 0.f ? m.y : r.y; return o;
}

typedef unsigned u32x2 __attribute__((ext_vector_type(2)));
#ifndef NT_EPI
#define NT_EPI 0
#endif
#if NT_EPI
#define ST16(p, v) __builtin_nontemporal_store((v), (u32x4*)(p))
#define ST8(p, v) __builtin_nontemporal_store((v), (u32x2*)(p))
#else
#define ST16(p, v) (*(u32x4*)(p) = (v))
#define ST8(p, v) (*(u32x2*)(p) = (v))
#endif
__device__ __forceinline__ float sigm(float v) { return __builtin_amdgcn_rcpf(1.0f + __builtin_amdgcn_exp2f(-1.4426950408889634f * v)); }
__device__ __forceinline__ f32x4 sigm4(f32x4 v) { return (f32x4){sigm(v[0]), sigm(v[1]), sigm(v[2]), sigm(v[3])}; }
__device__ __forceinline__ float gelu_tanh1(float v) { return v * sigm(1.5957691216057308f * v * (1.0f + 0.044715f * v * v)); }
__device__ __forceinline__ f32x4 gelu_tanh4(f32x4 v) { return (f32x4){gelu_tanh1(v[0]), gelu_tanh1(v[1]), gelu_tanh1(v[2]), gelu_tanh1(v[3])}; }
__device__ __forceinline__ u32x4 pack8(f32x4 a, f32x4 b) { u32x4 w; w.x = cvt_pk_bf16(a[0], a[1]); w.y = cvt_pk_bf16(a[2], a[3]); w.z = cvt_pk_bf16(b[0], b[1]); w.w = cvt_pk_bf16(b[2], b[3]); return w; }
__device__ __forceinline__ f32x4 bf_lo4(u32x4 w) { return (f32x4){__uint_as_float(w.x << 16), __uint_as_float(w.x & 0xffff0000u), __uint_as_float(w.y << 16), __uint_as_float(w.y & 0xffff0000u)}; }
__device__ __forceinline__ f32x4 bf_hi4(u32x4 w) { return (f32x4){__uint_as_float(w.z << 16), __uint_as_float(w.z & 0xffff0000u), __uint_as_float(w.w << 16), __uint_as_float(w.w & 0xffff0000u)}; }

struct EpiF32 {
    static constexpr bool PERM = false, AFTER_DRAIN = false;
    float* C; int ldc;
    __device__ __forceinline__ void operator()(const f32x4 (&acc)[2][2][4][2], const Unit& u, int wr, int wc, int fr, int fq) const {
        const int row0 = u.pm * BM + wr * 64 + fr, col0 = u.pn * BM + wc * 32 + 4 * fq;
#pragma unroll
        for (int ai = 0; ai < 2; ++ai)
#pragma unroll
            for (int m = 0; m < 4; ++m) { float* rowp = C + (size_t)(row0 + ai * HALF + m * 16) * ldc + col0;
#pragma unroll
                for (int bj = 0; bj < 2; ++bj)
#pragma unroll
                    for (int n = 0; n < 2; ++n) *(f32x4*)(rowp + bj * HALF + n * 16) = acc[ai][bj][m][n]; }
    }
};

__device__ const float ROPE_REV[32] = {
    0.15915494309f, 0.11934937021f, 0.089499401609f, 0.067115083005f, 0.050329212104f, 0.037741584717f, 0.028302195831f, 0.021223652765f,
    0.015915494309f, 0.011934937021f, 0.0089499401609f, 0.0067115083005f, 0.0050329212104f, 0.0037741584717f, 0.0028302195831f, 0.0021223652765f,
    0.0015915494309f, 0.0011934937021f, 0.00089499401609f, 0.00067115083005f, 0.00050329212104f, 0.00037741584717f, 0.00028302195831f, 0.00021223652765f,
    0.00015915494309f, 0.00011934937021f, 8.9499401609e-05f, 6.7115083005e-05f, 5.0329212104e-05f, 3.7741584717e-05f, 2.8302195831e-05f, 2.1223652765e-05f };
__device__ __forceinline__ f32x4 cos_rev4(f32x4 r) { return (f32x4){__builtin_amdgcn_cosf(__builtin_amdgcn_fractf(r[0])), __builtin_amdgcn_cosf(__builtin_amdgcn_fractf(r[1])), __builtin_amdgcn_cosf(__builtin_amdgcn_fractf(r[2])), __builtin_amdgcn_cosf(__builtin_amdgcn_fractf(r[3]))}; }
__device__ __forceinline__ f32x4 sin_rev4(f32x4 r) { return (f32x4){__builtin_amdgcn_sinf(__builtin_amdgcn_fractf(r[0])), __builtin_amdgcn_sinf(__builtin_amdgcn_fractf(r[1])), __builtin_amdgcn_sinf(__builtin_amdgcn_fractf(r[2])), __builtin_amdgcn_sinf(__builtin_amdgcn_fractf(r[3]))}; }
struct EpiInProj {
    static constexpr bool PERM = true, AFTER_DRAIN = false;
    bf16_t* out; size_t slot_stride; const float* posf; float qscale;
    __device__ __forceinline__ void operator()(const f32x4 (&acc)[2][2][4][2], const Unit& u, int wr, int wc, int fr, int fq) const {
        const int type = u.pn >> 2, sub = u.pn & 3;
        bf16_t* base = out + (size_t)type * slot_stride;
        const int row0 = u.pm * BM + wr * 64 + fr;
        if (type == 2 || type == 3) {
            const float sc = (type == 2) ? qscale : 1.0f;
            const int colb = sub * 256 + wc * 64 + 8 * fq;
            const f32x4 cf0 = *(const f32x4*)(ROPE_REV + 8 * fq), cf1 = *(const f32x4*)(ROPE_REV + 8 * fq + 4);
            float pv[2][4];
#pragma unroll
            for (int ai = 0; ai < 2; ++ai)
#pragma unroll
                for (int m = 0; m < 4; ++m) pv[ai][m] = posf[row0 + ai * HALF + m * 16];
#pragma unroll
            for (int ai = 0; ai < 2; ++ai)
#pragma unroll
                for (int m = 0; m < 4; ++m) { const int r = row0 + ai * HALF + m * 16;
                    const float p = pv[ai][m];
                    const f32x4 r0 = cf0 * p, r1 = cf1 * p;
                    const f32x4 c0 = cos_rev4(r0) * sc, c1 = cos_rev4(r1) * sc, s0 = sin_rev4(r0) * sc, s1 = sin_rev4(r1) * sc;
                    const f32x4 x0a = acc[ai][0][m][0], x0b = acc[ai][0][m][1], x1a = acc[ai][1][m][0], x1b = acc[ai][1][m][1];
                    const f32x4 y0a = x0a * c0 - x1a * s0, y0b = x0b * c1 - x1b * s1, y1a = x1a * c0 + x0a * s0, y1b = x1b * c1 + x0b * s1;
                    bf16_t* rowp = base + (size_t)r * 1024 + colb;
                    ST16(rowp, pack8(y0a, y0b)); ST16(rowp + 32, pack8(y1a, y1b)); }
        } else {
            const int colb = sub * 256 + wc * 64 + 8 * fq;
#pragma unroll
            for (int ai = 0; ai < 2; ++ai)
#pragma unroll
                for (int m = 0; m < 4; ++m) { bf16_t* rowp = base + (size_t)(row0 + ai * HALF + m * 16) * 1024 + colb;
#pragma unroll
                    for (int bj = 0; bj < 2; ++bj) { f32x4 v0 = acc[ai][bj][m][0], v1 = acc[ai][bj][m][1];
                        if (type == 0) { v0 = gelu_tanh4(v0); v1 = gelu_tanh4(v1); }
                        else if (type >= 5) { v0 = sigm4(v0); v1 = sigm4(v1); }
                        ST16(rowp + bj * 32, pack8(v0, v1)); } }
        }
    }
};

struct EpiMerge {
    static constexpr bool PERM = true, AFTER_DRAIN = false;
    const bf16_t* sga; const bf16_t* sgb; bf16_t* t1; bf16_t* merged; int nM;
    __device__ __forceinline__ void operator()(const f32x4 (&acc)[2][2][4][2], const Unit& u, int wr, int wc, int fr, int fq) const {
        const bool sel = u.pm >= nM; const int pm = sel ? u.pm - nM : u.pm, pn = u.pn & 3;
        const bf16_t* sg = sel ? sgb : sga;
        const int row0 = pm * BM + wr * 64 + fr, col0 = pn * BM + wc * 32 + 8 * fq;
#pragma unroll
        for (int ai = 0; ai < 2; ++ai) {
            u32x4 g[4][2], t[4][2];
#pragma unroll
            for (int m = 0; m < 4; ++m)
#pragma unroll
                for (int bj = 0; bj < 2; ++bj) { const size_t off = (size_t)(row0 + ai * HALF + m * 16) * 1024 + col0 + bj * HALF;
                    g[m][bj] = *(const u32x4*)(sg + off); if (sel) t[m][bj] = *(const u32x4*)(t1 + off); }
#pragma unroll
            for (int m = 0; m < 4; ++m)
#pragma unroll
                for (int bj = 0; bj < 2; ++bj) { const size_t off = (size_t)(row0 + ai * HALF + m * 16) * 1024 + col0 + bj * HALF;
                    f32x4 v0 = acc[ai][bj][m][0] * bf_lo4(g[m][bj]), v1 = acc[ai][bj][m][1] * bf_hi4(g[m][bj]);
                    if (!sel) *(u32x4*)(t1 + off) = pack8(v0, v1);
                    else { v0 = v0 + bf_lo4(t[m][bj]); v1 = v1 + bf_hi4(t[m][bj]); *(u32x4*)(merged + off) = pack8(v0, v1); } } }
    }
};

struct EpiSwiGLU {
    static constexpr bool PERM = true, AFTER_DRAIN = false;
    bf16_t* O; int ldc; int nper; int pm_sub;
    __device__ __forceinline__ void operator()(const f32x4 (&acc)[2][2][4][2], const Unit& u, int wr, int wc, int fr, int fq) const {
        const int pn = u.pn % nper;
        const int row0 = (u.pm - pm_sub) * BM + wr * 64 + fr, col0 = pn * HALF + wc * 32 + 8 * fq;
#pragma unroll
        for (int ai = 0; ai < 2; ++ai)
#pragma unroll
            for (int m = 0; m < 4; ++m) { const f32x4 g0 = acc[ai][0][m][0], g1 = acc[ai][0][m][1], u0 = acc[ai][1][m][0], u1 = acc[ai][1][m][1];
                const f32x4 a0 = g0 * sigm4(g0) * u0, a1 = g1 * sigm4(g1) * u1;
                ST16(O + (size_t)(row0 + ai * HALF + m * 16) * ldc + col0, pack8(a0, a1)); }
    }
};

__device__ __forceinline__ unsigned pk4_fp8(f32x4 v) { unsigned w = __builtin_amdgcn_cvt_pk_fp8_f32(v[0], v[1], 0u, false); return __builtin_amdgcn_cvt_pk_fp8_f32(v[2], v[3], w, true); }
__device__ __forceinline__ f32x4 clamp448(f32x4 v) { return (f32x4){__builtin_fminf(__builtin_fmaxf(v[0], -448.f), 448.f), __builtin_fminf(__builtin_fmaxf(v[1], -448.f), 448.f), __builtin_fminf(__builtin_fmaxf(v[2], -448.f), 448.f), __builtin_fminf(__builtin_fmaxf(v[3], -448.f), 448.f)}; }
struct EpiSwiGLU8 {
    static constexpr bool PERM = true, AFTER_DRAIN = false;
    unsigned char* O; int ldc; int nper; int pm_sub; float oscale;
    __device__ __forceinline__ void operator()(const f32x4 (&acc)[2][2][4][2], const Unit& u, int wr, int wc, int fr, int fq) const {
        const int pn = u.pn % nper;
        const int row0 = (u.pm - pm_sub) * BM + wr * 64 + fr, col0 = pn * HALF + wc * 32 + 8 * fq;
#pragma unroll
        for (int ai = 0; ai < 2; ++ai)
#pragma unroll
            for (int m = 0; m < 4; ++m) { const f32x4 g0 = acc[ai][0][m][0], g1 = acc[ai][0][m][1], u0 = acc[ai][1][m][0], u1 = acc[ai][1][m][1];
                const f32x4 a0 = clamp448(g0 * sigm4(g0) * u0 * oscale), a1 = clamp448(g1 * sigm4(g1) * u1 * oscale);
                u32x2 w; w.x = pk4_fp8(a0); w.y = pk4_fp8(a1);
                ST8(O + (size_t)(row0 + ai * HALF + m * 16) * ldc + col0, w); }
    }
};

typedef int i32x4 __attribute__((ext_vector_type(4)));
__device__ __forceinline__ f32x4 icvt(f32x4 a) { return __builtin_convertvector(__builtin_bit_cast(i32x4, a), f32x4); }
struct EpiSwiGLUq {
    static constexpr bool PERM = true, AFTER_DRAIN = false;
    bf16_t* O; int ldc; const float* sa; const float* sb;
    __device__ __forceinline__ void operator()(const f32x4 (&acc)[2][2][4][2], const Unit& u, int wr, int wc, int fr, int fq) const {
        const int row0 = u.pm * BM + wr * 64 + fr, col0 = u.pn * HALF + wc * 32 + 8 * fq, gc0 = u.pn * BM + wc * 32 + 8 * fq;
        const f32x4 bg0 = *(const f32x4*)(sb + gc0), bg1 = *(const f32x4*)(sb + gc0 + 4), bu0 = *(const f32x4*)(sb + gc0 + HALF), bu1 = *(const f32x4*)(sb + gc0 + HALF + 4);
        float sr[2][4];
#pragma unroll
        for (int ai = 0; ai < 2; ++ai)
#pragma unroll
            for (int m = 0; m < 4; ++m) sr[ai][m] = sa[row0 + ai * HALF + m * 16];
#pragma unroll
        for (int ai = 0; ai < 2; ++ai)
#pragma unroll
            for (int m = 0; m < 4; ++m) { const float s = sr[ai][m];
                const f32x4 g0 = icvt(acc[ai][0][m][0]) * (bg0 * s), g1 = icvt(acc[ai][0][m][1]) * (bg1 * s), u0 = icvt(acc[ai][1][m][0]) * (bu0 * s), u1 = icvt(acc[ai][1][m][1]) * (bu1 * s);
                const f32x4 a0 = g0 * sigm4(g0) * u0, a1 = g1 * sigm4(g1) * u1;
                ST16(O + (size_t)(row0 + ai * HALF + m * 16) * ldc + col0, pack8(a0, a1)); }
    }
};
struct EpiInProjq {
    static constexpr bool PERM = true, AFTER_DRAIN = false;
    bf16_t* out; size_t slot_stride; const float* posf; float qscale; const float* sa; const float* sb;
    __device__ __forceinline__ void operator()(const f32x4 (&acc)[2][2][4][2], const Unit& u, int wr, int wc, int fr, int fq) const {
        const int type = u.pn >> 2, sub = u.pn & 3;
        bf16_t* base = out + (size_t)type * slot_stride;
        const int row0 = u.pm * BM + wr * 64 + fr, gc0 = u.pn * BM + wc * 32 + 8 * fq;
        const f32x4 b00 = *(const f32x4*)(sb + gc0), b01 = *(const f32x4*)(sb + gc0 + 4), b10 = *(const f32x4*)(sb + gc0 + HALF), b11 = *(const f32x4*)(sb + gc0 + HALF + 4);
        const int colb = sub * 256 + wc * 64 + 8 * fq;
        if (type == 2 || type == 3) {
            const float sc = (type == 2) ? qscale : 1.0f;
            const f32x4 cf0 = *(const f32x4*)(ROPE_REV + 8 * fq), cf1 = *(const f32x4*)(ROPE_REV + 8 * fq + 4);
#pragma unroll
            for (int ai = 0; ai < 2; ++ai) {
                float sr[4], pv[4];
#pragma unroll
                for (int m = 0; m < 4; ++m) { sr[m] = sa[row0 + ai * HALF + m * 16]; pv[m] = posf[row0 + ai * HALF + m * 16]; }
#pragma unroll
                for (int m = 0; m < 4; ++m) { const int r = row0 + ai * HALF + m * 16; const float p = pv[m], s = sr[m] * sc;
                    bf16_t* rowp = base + (size_t)r * 1024 + colb;
                    { const f32x4 r0 = cf0 * p; const f32x4 c0 = cos_rev4(r0), s0 = sin_rev4(r0);
                      const f32x4 x0a = icvt(acc[ai][0][m][0]) * (b00 * s), x1a = icvt(acc[ai][1][m][0]) * (b10 * s);
                      const f32x4 y0a = x0a * c0 - x1a * s0, y1a = x1a * c0 + x0a * s0;
                      const f32x4 r1 = cf1 * p; const f32x4 c1 = cos_rev4(r1), s1 = sin_rev4(r1);
                      const f32x4 x0b = icvt(acc[ai][0][m][1]) * (b01 * s), x1b = icvt(acc[ai][1][m][1]) * (b11 * s);
                      const f32x4 y0b = x0b * c1 - x1b * s1, y1b = x1b * c1 + x0b * s1;
                      ST16(rowp, pack8(y0a, y0b)); ST16(rowp + 32, pack8(y1a, y1b)); } } }
        } else {
#pragma unroll
            for (int ai = 0; ai < 2; ++ai) {
                float sr[4];
#pragma unroll
                for (int m = 0; m < 4; ++m) sr[m] = sa[row0 + ai * HALF + m * 16];
#pragma unroll
                for (int m = 0; m < 4; ++m) { bf16_t* rowp = base + (size_t)(row0 + ai * HALF + m * 16) * 1024 + colb; const float s = sr[m];
#pragma unroll
                    for (int bj = 0; bj < 2; ++bj) { f32x4 v0 = icvt(acc[ai][bj][m][0]) * ((bj ? b10 : b00) * s), v1 = icvt(acc[ai][bj][m][1]) * ((bj ? b11 : b01) * s);
                        if (type == 0) { v0 = gelu_tanh4(v0); v1 = gelu_tanh4(v1); }
                        else if (type >= 5) { v0 = sigm4(v0); v1 = sigm4(v1); }
                        ST16(rowp + bj * 32, pack8(v0, v1)); } } }
        }
    }
};

struct EpiPleGateq {
    static constexpr bool PERM = true, AFTER_DRAIN = false;
    bf16_t* O; const bf16_t* PP; int ldc; const float* sa; const float* sb;
    __device__ __forceinline__ void operator()(const f32x4 (&acc)[2][2][4][2], const Unit& u, int wr, int wc, int fr, int fq) const {
        const int row0 = u.pm * BM + wr * 64 + fr, col0 = u.pn * BM + wc * 32 + 8 * fq;
        const f32x4 b00 = *(const f32x4*)(sb + col0), b01 = *(const f32x4*)(sb + col0 + 4), b10 = *(const f32x4*)(sb + col0 + HALF), b11 = *(const f32x4*)(sb + col0 + HALF + 4);
#pragma unroll
        for (int ai = 0; ai < 2; ++ai) {
            u32x4 p[4][2]; float sr[4];
#pragma unroll
            for (int m = 0; m < 4; ++m) { sr[m] = sa[row0 + ai * HALF + m * 16];
#pragma unroll
                for (int bj = 0; bj < 2; ++bj) p[m][bj] = *(const u32x4*)(PP + (size_t)(row0 + ai * HALF + m * 16) * ldc + col0 + bj * HALF); }
#pragma unroll
            for (int m = 0; m < 4; ++m)
#pragma unroll
                for (int bj = 0; bj < 2; ++bj) { const size_t ro = (size_t)(row0 + ai * HALF + m * 16) * ldc + col0 + bj * HALF;
                    *(u32x4*)(O + ro) = pack8(sigm4(icvt(acc[ai][bj][m][0]) * ((bj ? b10 : b00) * sr[m])) * bf_lo4(p[m][bj]), sigm4(icvt(acc[ai][bj][m][1]) * ((bj ? b11 : b01) * sr[m])) * bf_hi4(p[m][bj])); } }
    }
};
struct EpiPlainBf16 {
    static constexpr bool PERM = true, AFTER_DRAIN = false;
    bf16_t* O; int ldc; int pn_mask;
    __device__ __forceinline__ void operator()(const f32x4 (&acc)[2][2][4][2], const Unit& u, int wr, int wc, int fr, int fq) const {
        const int row0 = u.pm * BM + wr * 64 + fr, col0 = (u.pn & pn_mask) * BM + wc * 32 + 8 * fq;
#pragma unroll
        for (int ai = 0; ai < 2; ++ai)
#pragma unroll
            for (int m = 0; m < 4; ++m) { bf16_t* rowp = O + (size_t)(row0 + ai * HALF + m * 16) * ldc + col0;
#pragma unroll
                for (int bj = 0; bj < 2; ++bj) ST16(rowp + bj * HALF, pack8(acc[ai][bj][m][0], acc[ai][bj][m][1])); }
    }
};

struct EpiPleGate {
    static constexpr bool PERM = true, AFTER_DRAIN = false;
    bf16_t* O; const bf16_t* PP; int ldc;
    __device__ __forceinline__ void operator()(const f32x4 (&acc)[2][2][4][2], const Unit& u, int wr, int wc, int fr, int fq) const {
        const int row0 = u.pm * BM + wr * 64 + fr, col0 = u.pn * BM + wc * 32 + 8 * fq;
#pragma unroll
        for (int ai = 0; ai < 2; ++ai) {
            u32x4 p[4][2];
#pragma unroll
            for (int m = 0; m < 4; ++m)
#pragma unroll
                for (int bj = 0; bj < 2; ++bj) p[m][bj] = *(const u32x4*)(PP + (size_t)(row0 + ai * HALF + m * 16) * ldc + col0 + bj * HALF);
#pragma unroll
            for (int m = 0; m < 4; ++m)
#pragma unroll
                for (int bj = 0; bj < 2; ++bj) { const size_t ro = (size_t)(row0 + ai * HALF + m * 16) * ldc + col0 + bj * HALF;
                    *(u32x4*)(O + ro) = pack8(sigm4(acc[ai][bj][m][0]) * bf_lo4(p[m][bj]), sigm4(acc[ai][bj][m][1]) * bf_hi4(p[m][bj])); } }
    }
};

struct MoeKSplitOrder {
    int G, c, p0, npan, nN, S, kbytes; int ps1, ps2, ps3, ps4, ps5, ps6, ps7;
    __device__ __forceinline__ bool next(int i, Unit& u) const {
        const int L = i * G + c; if (L >= npan * nN * S) return false;
        const int ks = L % S, r = L / S, pn = r % nN, p = p0 + r / nN;
        const int e = (p >= ps1) + (p >= ps2) + (p >= ps3) + (p >= ps4) + (p >= ps5) + (p >= ps6) + (p >= ps7);
        u.pm = p; u.pn = e * nN + pn; u.ko = ks * kbytes; return true;
    }
    __device__ __forceinline__ void a_ready(const Unit&) const {}
    __device__ __forceinline__ void done(const Unit&) const {}
};
struct EpiSliceBf16 {
    static constexpr bool PERM = true, AFTER_DRAIN = false;
    bf16_t* O; int ldc; int pn_mask; int p0; int kbytes; size_t slice_stride;
    __device__ __forceinline__ void operator()(const f32x4 (&acc)[2][2][4][2], const Unit& u, int wr, int wc, int fr, int fq) const {
        bf16_t* Ob = O + (size_t)(u.ko / kbytes) * slice_stride;
        const int row0 = (u.pm - p0) * BM + wr * 64 + fr, col0 = (u.pn & pn_mask) * BM + wc * 32 + 8 * fq;
#pragma unroll
        for (int ai = 0; ai < 2; ++ai)
#pragma unroll
            for (int m = 0; m < 4; ++m) { bf16_t* rowp = Ob + (size_t)(row0 + ai * HALF + m * 16) * ldc + col0;
#pragma unroll
                for (int bj = 0; bj < 2; ++bj) ST16(rowp + bj * HALF, pack8(acc[ai][bj][m][0], acc[ai][bj][m][1])); }
    }
};
struct PairOrder {
    StaticOrder base;
    __device__ __forceinline__ bool next(int i, Unit& u) const { if (!base.next(i >> 1, u)) return false; if (i & 1) { u.pm += base.nM; u.pn += base.nN; } return true; }
    __device__ __forceinline__ void a_ready(const Unit&) const {}
    __device__ __forceinline__ void done(const Unit&) const {}
};
struct MoeOrder {
    StaticOrder base; int plo; int ps1, ps2, ps3, ps4, ps5, ps6, ps7;
    __device__ __forceinline__ bool next(int i, Unit& u) const {
        if (!base.next(i, u)) return false;
        const int p = u.pm + plo;
        const int e = (p >= ps1) + (p >= ps2) + (p >= ps3) + (p >= ps4) + (p >= ps5) + (p >= ps6) + (p >= ps7);
        u.pm = p; u.pn += e * base.nN; return true;
    }
    __device__ __forceinline__ void a_ready(const Unit&) const {}
    __device__ __forceinline__ void done(const Unit&) const {}
};
template <class Epi, class Sched, bool ALIGN_EPI = false, bool SP2 = false, int QM = 0>
__device__ __forceinline__ void gemm_phase(PG8_LAS unsigned char* lds, const Gemm g, const Sched& S, const Epi& E) {
    int tid_ = threadIdx.x; asm volatile("" : "+v"(tid_));
    const int tid = tid_, wid = __builtin_amdgcn_readfirstlane(tid >> 6), lane = tid & 63, wr = wid >> 2, wc = wid & 3, fr = lane & 15, fq = lane >> 4;
    const int K = g.K, nt = K / BK, LD = g.ld ? g.ld : K;
    unsigned voffA[2], voffB[2];
#pragma unroll
    for (int i = 0; i < 2; ++i) { int R, C; stage_rc(tid * 16 + i * 8192, R, C); const int Rb = Epi::PERM ? ((R & ~31) + perm32(R & 31)) : R;
        voffA[i] = (unsigned)(R * LD + C) * 2u; voffB[i] = (unsigned)(Rb * LD + C) * 2u; }
    const size_t kstep = (size_t)(BK * 2);
    const size_t hstep = (size_t)HALF * LD * 2;
    const size_t tstep = 2 * hstep;
    const unsigned ldsw = (unsigned)wid * 1024u;
    const int aoff = lds_byte(wr * 64 + fr, fq * 8), boff = lds_byte(wc * 32 + fr, fq * 8);
#define PG8_SA(b, h) (((b) * 2 + (h)) * HTB)
#define PG8_SB(b, h) ((4 + (b) * 2 + (h)) * HTB)
#define PG8_STAGE(bufoff, gbase, voff) do { _Pragma("unroll") for (int _i = 0; _i < 2; ++_i) \
        __builtin_amdgcn_global_load_lds((const unsigned*)((const char*)(gbase) + (voff)[_i]), (PG8_LAS unsigned*)(lds + (bufoff) + ldsw + _i * 8192), 16, 0, 0); } while (0)
#define PG8_CAT(a, b) __builtin_shufflevector(__builtin_bit_cast(v4i_t, a), __builtin_bit_cast(v4i_t, b), 0, 1, 2, 3, 4, 5, 6, 7)
#define PG8_LDA(dst, b, h) do { _Pragma("unroll") for (int m = 0; m < 4; ++m) { const bf16x8 r0_ = *(const PG8_LAS bf16x8*)(lds + PG8_SA(b, h) + aoff + m * 2048), r1_ = *(const PG8_LAS bf16x8*)(lds + PG8_SA(b, h) + aoff + m * 2048 + 1024); \
        if constexpr (QM == 1) dst##8[m] = PG8_CAT(r0_, r1_); else { dst[m][0] = r0_; dst[m][1] = r1_; } } } while (0)
#define PG8_LDB(dst, b, h) do { _Pragma("unroll") for (int n = 0; n < 2; ++n) { const bf16x8 r0_ = *(const PG8_LAS bf16x8*)(lds + PG8_SB(b, h) + boff + n * 2048), r1_ = *(const PG8_LAS bf16x8*)(lds + PG8_SB(b, h) + boff + n * 2048 + 1024); \
        if constexpr (QM == 1) dst##8[n] = PG8_CAT(r0_, r1_); else { dst[n][0] = r0_; dst[n][1] = r1_; } } } while (0)
#define PG8_MMA(ai, bj, At, Bt) do { __builtin_amdgcn_s_setprio(1); _Pragma("unroll") for (int m = 0; m < 4; ++m) _Pragma("unroll") for (int n = 0; n < 2; ++n) { \
        if constexpr (QM == 2) { _Pragma("unroll") for (int k = 0; k < 2; ++k) acc[ai][bj][m][n] = __builtin_bit_cast(f32x4, __builtin_amdgcn_mfma_i32_16x16x64_i8(__builtin_bit_cast(v4i_t, Bt[n][k]), __builtin_bit_cast(v4i_t, At[m][k]), __builtin_bit_cast(v4i_t, acc[ai][bj][m][n]), 0, 0, 0)); } \
        else if constexpr (QM == 1) asm volatile("v_mfma_scale_f32_16x16x128_f8f6f4 %0, %1, %2, %0, %3, %4 op_sel_hi:[0,0,0]" : "+v"(acc[ai][bj][m][n]) : "v"(Bt##8[n]), "v"(At##8[m]), "v"(sbv), "v"(sav));   \
        else { _Pragma("unroll") for (int k = 0; k < 2; ++k) acc[ai][bj][m][n] = __builtin_amdgcn_mfma_f32_16x16x32_bf16(Bt[n][k], At[m][k], acc[ai][bj][m][n], 0, 0, 0); } } \
        __builtin_amdgcn_s_setprio(0); } while (0)
#define PG8_WAIT_V(n) asm volatile("s_waitcnt vmcnt(" #n ")" ::: "memory")
#define PG8_WAIT_L(n) asm volatile("s_waitcnt lgkmcnt(" #n ")" ::: "memory")
#define PG8_BAR __builtin_amdgcn_s_barrier()
#define PG8_SCHED __builtin_amdgcn_sched_barrier(0)
    Unit cur, nxt; int ui = 0;
    if (!S.next(0, cur)) return;
    f32x4 acc[2][2][4][2];
#pragma unroll
    for (int a = 0; a < 2; ++a)
#pragma unroll
        for (int b = 0; b < 2; ++b)
#pragma unroll
            for (int m = 0; m < 4; ++m)
#pragma unroll
                for (int n = 0; n < 2; ++n) acc[a][b][m][n] = (f32x4){0.f, 0.f, 0.f, 0.f};
    bf16x8 At[4][2], B0[2][2], B1[2][2];
    v8i_t At8[4], B08[2], B18[2];
    (void)At; (void)B0; (void)B1; (void)At8; (void)B08; (void)B18;
    const int sav = g.sa, sbv = g.sb; (void)sav; (void)sbv;
    const char* cA = (const char*)g.A + (size_t)cur.pm * tstep + cur.ko; const char* cB = (const char*)g.Bt + (size_t)cur.pn * tstep + cur.ko;
    S.a_ready(cur);
    if constexpr (SP2) {
        PG8_STAGE(PG8_SB(0, 0), cB, voffB); PG8_STAGE(PG8_SB(0, 1), cB + hstep, voffB); PG8_STAGE(PG8_SA(0, 0), cA, voffA); PG8_STAGE(PG8_SA(0, 1), cA + hstep, voffA);
        if (wr == 1) PG8_BAR;
        PG8_WAIT_V(2); PG8_BAR;
        PG8_STAGE(PG8_SB(1, 0), cB + kstep, voffB); PG8_STAGE(PG8_SA(1, 0), cA + kstep, voffA); PG8_STAGE(PG8_SB(1, 1), cB + hstep + kstep, voffB);
        PG8_WAIT_V(6); PG8_BAR;
    } else {
        PG8_STAGE(PG8_SB(0, 0), cB, voffB); PG8_STAGE(PG8_SA(0, 0), cA, voffA); PG8_STAGE(PG8_SB(0, 1), cB + hstep, voffB); PG8_STAGE(PG8_SA(0, 1), cA + hstep, voffA);
        if (wr == 1) PG8_BAR;
        PG8_WAIT_V(4); PG8_BAR;
        PG8_STAGE(PG8_SB(1, 0), cB + kstep, voffB); PG8_STAGE(PG8_SA(1, 0), cA + kstep, voffA); PG8_STAGE(PG8_SB(1, 1), cB + hstep + kstep, voffB);
        PG8_WAIT_V(6); PG8_BAR;
    }
    for (;;) {
        const bool has_next = S.next(ui + 1, nxt);
        const char* nA = has_next ? (const char*)g.A + (size_t)nxt.pm * tstep + nxt.ko : cA; const char* nB = has_next ? (const char*)g.Bt + (size_t)nxt.pn * tstep + nxt.ko : cB;
        for (int t = 0; t < nt; t += 2) {
            const bool last = (t == nt - 2);
            const char* a1 = cA + (size_t)(t + 1) * kstep;
            const char* a2 = last ? nA : cA + (size_t)(t + 2) * kstep; const char* b2 = last ? nB : cB + (size_t)(t + 2) * kstep;
            const char* a3 = a2 + kstep; const char* b3 = b2 + kstep;
            if (last && has_next) S.a_ready(nxt);
            if constexpr (SP2) {
            PG8_LDB(B0, 0, 0); PG8_LDB(B1, 0, 1); PG8_SCHED; PG8_LDA(At, 0, 0); PG8_STAGE(PG8_SA(1, 1), a1 + hstep, voffA);
            PG8_WAIT_V(8); PG8_WAIT_L(0); PG8_BAR; PG8_MMA(0, 0, At, B0); PG8_MMA(0, 1, At, B1); PG8_BAR; PG8_SCHED;
            PG8_LDA(At, 0, 1); PG8_STAGE(PG8_SB(0, 0), b2, voffB); PG8_STAGE(PG8_SB(0, 1), b2 + hstep, voffB); PG8_STAGE(PG8_SA(0, 0), a2, voffA);
            PG8_WAIT_V(8); PG8_WAIT_L(0); PG8_BAR; PG8_MMA(1, 0, At, B0); PG8_MMA(1, 1, At, B1); PG8_BAR; PG8_SCHED;
            PG8_LDB(B0, 1, 0); PG8_LDB(B1, 1, 1); PG8_SCHED; PG8_LDA(At, 1, 0); PG8_STAGE(PG8_SA(0, 1), a2 + hstep, voffA);
            PG8_WAIT_V(8); PG8_WAIT_L(0); PG8_BAR; PG8_MMA(0, 0, At, B0); PG8_MMA(0, 1, At, B1); PG8_BAR; PG8_SCHED;
            PG8_LDA(At, 1, 1); PG8_STAGE(PG8_SB(1, 0), b3, voffB); PG8_STAGE(PG8_SB(1, 1), b3 + hstep, voffB); PG8_STAGE(PG8_SA(1, 0), a3, voffA);
            PG8_WAIT_V(8); PG8_WAIT_L(0); PG8_BAR; PG8_MMA(1, 0, At, B0); PG8_MMA(1, 1, At, B1); PG8_BAR; PG8_SCHED;
            } else {
            PG8_LDB(B0, 0, 0); PG8_SCHED; PG8_LDA(At, 0, 0); PG8_STAGE(PG8_SA(1, 1), a1 + hstep, voffA);
            PG8_WAIT_L(8); PG8_BAR; PG8_WAIT_L(0); PG8_MMA(0, 0, At, B0); PG8_BAR; PG8_SCHED;
            PG8_LDB(B1, 0, 1); PG8_STAGE(PG8_SB(0, 0), b2, voffB);
            PG8_BAR; PG8_WAIT_L(0); PG8_MMA(0, 1, At, B1); PG8_BAR;
            PG8_LDA(At, 0, 1); PG8_STAGE(PG8_SA(0, 0), a2, voffA);
            PG8_BAR; PG8_WAIT_L(0); PG8_MMA(1, 0, At, B0); PG8_BAR; PG8_SCHED;
            PG8_STAGE(PG8_SB(0, 1), b2 + hstep, voffB);
            PG8_WAIT_V(6); PG8_BAR; PG8_MMA(1, 1, At, B1); PG8_BAR;
            PG8_LDB(B0, 1, 0); PG8_SCHED; PG8_LDA(At, 1, 0); PG8_STAGE(PG8_SA(0, 1), a2 + hstep, voffA);
            PG8_WAIT_L(8); PG8_BAR; PG8_WAIT_L(0); PG8_MMA(0, 0, At, B0); PG8_BAR; PG8_SCHED;
            PG8_LDB(B1, 1, 1); PG8_STAGE(PG8_SB(1, 0), b3, voffB);
            PG8_BAR; PG8_WAIT_L(0); PG8_MMA(0, 1, At, B1); PG8_BAR;
            PG8_LDA(At, 1, 1); PG8_STAGE(PG8_SA(1, 0), a3, voffA);
            PG8_BAR; PG8_WAIT_L(0); PG8_MMA(1, 0, At, B0); PG8_BAR; PG8_SCHED;
            PG8_STAGE(PG8_SB(1, 1), b3 + hstep, voffB);
            PG8_WAIT_V(6); PG8_BAR; PG8_MMA(1, 1, At, B1); PG8_BAR;
            }
        }
        if constexpr (ALIGN_EPI) { if (wr == 0) PG8_BAR; }
        if constexpr (!Epi::AFTER_DRAIN) { E(acc, cur, wr, wc, fr, fq); S.done(cur); }
        if (!has_next) break;
#pragma unroll
        for (int a = 0; a < 2; ++a)
#pragma unroll
            for (int b = 0; b < 2; ++b)
#pragma unroll
                for (int m = 0; m < 4; ++m)
#pragma unroll
                    for (int n = 0; n < 2; ++n) acc[a][b][m][n] = (f32x4){0.f, 0.f, 0.f, 0.f};
        cur = nxt; cA = nA; cB = nB; ++ui;
        if constexpr (ALIGN_EPI) { if (wr == 1) PG8_BAR; }
    }
    PG8_WAIT_V(0);
    if constexpr (!ALIGN_EPI) { if (wr == 0) PG8_BAR; }
    PG8_BAR;
    if constexpr (Epi::AFTER_DRAIN) { E.fused(acc, cur, wr, wc, fr, fq, lds, wid, lane); S.done(cur); }
#undef PG8_SA
#undef PG8_SB
#undef PG8_STAGE
#undef PG8_LDA
#undef PG8_LDB
#undef PG8_MMA
#undef PG8_CAT
#undef PG8_WAIT_V
#undef PG8_WAIT_L
#undef PG8_BAR
#undef PG8_SCHED
}
}
#include <hip/hip_bf16.h>
#include <hip/hip_bf16.h>
#include <cmath>
namespace attn_body {
using bf16=__hip_bfloat16;
using bf16x8=__attribute__((ext_vector_type(8)))short;
using s16x4=__attribute__((ext_vector_type(4)))short;
using f32x16=__attribute__((ext_vector_type(16)))float;
using u32x4=__attribute__((ext_vector_type(4)))unsigned;
constexpr int BATCH=4,NHEAD=16,SEQ=4096,D=64,DM=NHEAD*D;
constexpr int NW=8,QBLK=32,QB=QBLK*NW,KVBLK=64,NQB=SEQ/QB;
constexpr int ATTN_PITCH=DM, ATTN_UNIT_ROWS=QB;
__device__ __forceinline__ int crow(int r,int hi){return (r&3)+8*(r>>2)+4*hi;}
#define SBAR() __builtin_amdgcn_sched_barrier(0)
__device__ __forceinline__ void cmask(f32x16&p0,f32x16&p1,int jb,int qrel,int hi){
  const float NEG=-INFINITY; int kb=64*jb+4*hi;
  #pragma unroll
  for(int r=0;r<16;++r){int kv=kb+(r&3)+8*(r>>2); if(kv>qrel)p0[r]=NEG; if(kv+32>qrel)p1[r]=NEG;}
}

constexpr int NSLOT=3, SLOTB=8192, SLOTV=16384;
constexpr int LDS_K=0, LDS_V=NSLOT*SLOTB, LDS_WS=LDS_V+NSLOT*SLOTV, LDS_OST=LDS_WS+NW*64*4, LDS_BYTES=LDS_OST;
constexpr float C2=0.125f*1.4426950408889634f;
__device__ __forceinline__ void glds16(const void*gsrc,unsigned lds_dst){unsigned keep;
  asm volatile("s_mov_b32 %0, m0\n\ts_mov_b32 m0, %2\n\ts_nop 0\n\tglobal_load_lds_dwordx4 %1, off\n\ts_mov_b32 m0, %0":"=&s"(keep):"v"(gsrc),"s"(lds_dst):"memory");}
__device__ __forceinline__ float max3f(float a,float b,float c){float r;asm("v_max3_f32 %0, %1, %2, %3":"=v"(r):"v"(a),"v"(b),"v"(c));return r;}
__device__ __forceinline__ float max2f(float a,float b){float r;asm("v_max_f32_e32 %0, %1, %2":"=v"(r):"v"(a),"v"(b));return r;}
__device__ __forceinline__ float fadd_s(float a,float b){float r;asm("v_add_f32_e32 %0, %1, %2":"=v"(r):"v"(a),"v"(b));return r;}
__device__ __forceinline__ float fsub_s(float a,float b){float r;asm("v_sub_f32_e32 %0, %1, %2":"=v"(r):"v"(a),"v"(b));return r;}
typedef float f32x2_t __attribute__((ext_vector_type(2))); typedef __bf16 bf16x2_t __attribute__((ext_vector_type(2)));
__device__ __forceinline__ unsigned cvtpk_s(float lo,float hi){f32x2_t v={lo,hi};bf16x2_t b=__builtin_convertvector(v,bf16x2_t);return __builtin_bit_cast(unsigned,b);}
#define WAIT_BAR(N) asm volatile("s_waitcnt vmcnt(" #N ") lgkmcnt(0)\n\ts_barrier":::"memory")

__device__ __forceinline__ void qkt(f32x16&p0,f32x16&p1,const char*Kslot,const bf16x8*qr,int r32,int hi){ const f32x16 negm=f32x16{};
  const char*kb=Kslot+hi*1024+r32*16;
  #pragma unroll
  for(int d0=0;d0<4;++d0){
    const bf16x8 b0=*reinterpret_cast<const bf16x8*>(kb+d0*2048);
    const bf16x8 b1=*reinterpret_cast<const bf16x8*>(kb+d0*2048+512);
    if(d0==0){p0=__builtin_amdgcn_mfma_f32_32x32x16_bf16(b0,qr[0],negm,0,0,0);p1=__builtin_amdgcn_mfma_f32_32x32x16_bf16(b1,qr[0],negm,0,0,0);}
    else{p0=__builtin_amdgcn_mfma_f32_32x32x16_bf16(b0,qr[d0],p0,0,0,0);p1=__builtin_amdgcn_mfma_f32_32x32x16_bf16(b1,qr[d0],p1,0,0,0);}}
}
typedef __attribute__((address_space(3))) const char* lds_cptr;
typedef short v4i16_t __attribute__((ext_vector_type(4)));
__device__ __forceinline__ void kload8(bf16x8*kf,lds_cptr kp){
  kf[0]=*(const __attribute__((address_space(3))) bf16x8*)(kp);      kf[1]=*(const __attribute__((address_space(3))) bf16x8*)(kp+512);
  kf[2]=*(const __attribute__((address_space(3))) bf16x8*)(kp+2048); kf[3]=*(const __attribute__((address_space(3))) bf16x8*)(kp+2560);
  kf[4]=*(const __attribute__((address_space(3))) bf16x8*)(kp+4096); kf[5]=*(const __attribute__((address_space(3))) bf16x8*)(kp+4608);
  kf[6]=*(const __attribute__((address_space(3))) bf16x8*)(kp+6144); kf[7]=*(const __attribute__((address_space(3))) bf16x8*)(kp+6656);
}
__device__ __forceinline__ void kload2(bf16x8*kf,lds_cptr kp,int j){ kf[2*j]=*(const __attribute__((address_space(3))) bf16x8*)(kp+j*2048); kf[2*j+1]=*(const __attribute__((address_space(3))) bf16x8*)(kp+j*2048+512); }
__device__ __forceinline__ s16x4 vtr(lds_cptr p){ return __builtin_bit_cast(s16x4,__builtin_amdgcn_ds_read_tr16_b64_v4i16((__attribute__((address_space(3))) v4i16_t*)p)); }
__device__ __forceinline__ float rowmax(const f32x16&p0,const f32x16&p1){
  float a=max3f(p0[0],p0[1],p1[0]),b=max3f(p0[2],p0[3],p1[1]);a=max3f(a,p1[2],p1[3]);
  #pragma unroll
  for(int r=4;r<16;r+=4){a=max3f(a,p0[r],p0[r+1]);b=max3f(b,p0[r+2],p0[r+3]);a=max3f(a,p1[r],p1[r+1]);b=max3f(b,p1[r+2],p1[r+3]);}
  const float m=max2f(a,b);
  auto rr=__builtin_amdgcn_permlane32_swap(__float_as_uint(m),__float_as_uint(m),false,false);
  return max2f(__uint_as_float(rr[0]),__uint_as_float(rr[1]));
}
__device__ __forceinline__ void pv(f32x16*o,int vb,bf16x8 pa0,bf16x8 pa1,bf16x8 pa2,bf16x8 pa3){
  #pragma unroll
  for(int d0=0;d0<4;++d0){s16x4 lo[4],hi[4];
    #pragma unroll
    for(int ks=0;ks<4;++ks){
      asm volatile("ds_read_b64_tr_b16 %0,%1 offset:%c2":"=&v"(lo[ks]):"v"(vb),"i"(d0*4096+ks*1024):"memory");
      asm volatile("ds_read_b64_tr_b16 %0,%1 offset:%c2":"=&v"(hi[ks]):"v"(vb),"i"(d0*4096+ks*1024+512):"memory");}
    asm volatile("s_waitcnt lgkmcnt(0)":::"memory");SBAR();
    #define PK(k) (bf16x8){lo[k][0],lo[k][1],lo[k][2],lo[k][3],hi[k][0],hi[k][1],hi[k][2],hi[k][3]}
    o[d0]=__builtin_amdgcn_mfma_f32_32x32x16_bf16(pa0,PK(0),o[d0],0,0,0);
    o[d0]=__builtin_amdgcn_mfma_f32_32x32x16_bf16(pa1,PK(1),o[d0],0,0,0);
    o[d0]=__builtin_amdgcn_mfma_f32_32x32x16_bf16(pa2,PK(2),o[d0],0,0,0);
    o[d0]=__builtin_amdgcn_mfma_f32_32x32x16_bf16(pa3,PK(3),o[d0],0,0,0);
    #undef PK
  }
}

#ifndef ATTN_STORE16
#define ATTN_STORE16(p,v) (*(u32x4*)(p)=(v))
#endif
template<int THRL> __device__ __forceinline__ void attn_unit(bool FUSE,int b,int h,int hv,int qb,const bf16*Q,const bf16*__restrict__ K,const bf16*__restrict__ V,bf16*O,const bf16*O2,float lam,const float*gsub,char*shm){
  int tid_=threadIdx.x; asm volatile("":"+v"(tid_)); const int tid=tid_,lane=tid&63,r32=lane&31,hi=lane>>5; const int wid=__builtin_amdgcn_readfirstlane(tid>>6);
  const long rowbase=(long)b*SEQ; const int q0=qb*QB;
  const bf16*Qw=Q+(rowbase+q0+wid*QBLK)*DM+h*D;
  const bf16*Kh=K+rowbase*DM+h*D,*Vh=V+rowbase*DM+hv*2*D;
  const unsigned lds0=(unsigned)(uintptr_t)shm;
  float*wsf=(float*)(shm+LDS_WS)+wid*64;
  const bf16*ksrc=Kh+(long)lane*DM+wid*8;
  const bf16*vsrc=Vh+(long)(16*(wid&3)+(lane>>2))*DM+(wid>>2)*32+(lane&3)*8;
  const unsigned kdst=lds0+LDS_K+wid*1024, vdst=lds0+LDS_V+wid*1024;
  #define DMA_K(t,slot) glds16(ksrc+(long)(t)*KVBLK*DM,(unsigned)__builtin_amdgcn_readfirstlane(kdst+(slot)))
  #define DMA_V(t,slot) do{ glds16(vsrc+(long)(t)*KVBLK*DM,(unsigned)__builtin_amdgcn_readfirstlane(vdst+2*(slot))); glds16(vsrc+(long)(t)*KVBLK*DM+64,(unsigned)__builtin_amdgcn_readfirstlane(vdst+2*(slot)+8192)); }while(0)
  const int vb0=(int)(lds0+LDS_V)+((lane>>4)&1)*32+(lane&3)*8+(4*hi+((lane&15)>>2))*64;
  const char*Kbase=shm+LDS_K; bf16x8 kf[8];
  const lds_cptr shm3=(lds_cptr)shm; const lds_cptr kp0=shm3+LDS_K+hi*1024+r32*16; const lds_cptr vp0=shm3+LDS_V+((lane>>4)&1)*32+(lane&3)*8+(4*hi+((lane&15)>>2))*64;
  const int NT=(q0+QB)/KVBLK;
  DMA_K(0,0);DMA_V(0,0);DMA_K(1,SLOTB);
  bf16x8 qr[4];
  #pragma unroll
  for(int d0=0;d0<4;++d0)qr[d0]=*reinterpret_cast<const bf16x8*>(&Qw[(long)r32*DM+d0*16+hi*8]);
  float mhat=0.f,l_reg=0.f;f32x16 o[4];o[0]=f32x16{};o[1]=f32x16{};o[2]=f32x16{};o[3]=f32x16{};const f32x16 ZERO16=f32x16{};
  const int qrel=wid*QBLK+r32;
  #define CMASK(P0,P1,t) do{int jb_=(t)-(NT-4); if(jb_>=0)cmask(P0,P1,jb_,qrel,hi);}while(0)
  bool resc=false;
  #define START(P0,P1) do{ const float rm=rowmax(P0,P1); resc=false; \
    { const float dl=rm; mhat=fadd_s(mhat,dl); \
      _Pragma("unroll") for(int r=0;r<16;++r){P0[r]=fsub_s(P0[r],dl);P1[r]=fsub_s(P1[r],dl);} \
      } \
    _Pragma("unroll") for(int r=0;r<16;++r)P0[r]=__builtin_amdgcn_exp2f(P0[r]); }while(0)
  #define RESC() do{ if(resc){ asm volatile("s_waitcnt lgkmcnt(0)":::"memory"); \
      _Pragma("unroll") for(int d_=0;d_<4;++d_) _Pragma("unroll") for(int r=0;r<16;++r)o[d_][r]*=wsf[crow(r,hi)]; } }while(0)
  f32x16 pA0,pA1,pB0,pB1;
  int sl_prev=0,sl_cur=0,sl_next=SLOTB;
  #define ROT() do{sl_prev=sl_cur;sl_cur=sl_next;sl_next=(sl_next==(NSLOT-1)*SLOTB)?0:sl_next+SLOTB;}while(0)
  DMA_K(2,2*SLOTB);
  WAIT_BAR(3);
  qkt(pA0,pA1,Kbase,qr,r32,hi);asm volatile("s_nop 15\n\ts_nop 7":"+v"(pA0),"+v"(pA1));CMASK(pA0,pA1,0);
  START(pA0,pA1);
  _Pragma("unroll") for(int r=0;r<16;++r)pA1[r]=__builtin_amdgcn_exp2f(pA1[r]);
  WAIT_BAR(0);
  DMA_K(3,0);DMA_V(1,SLOTB);
  ROT();
  kload8(kf,kp0+sl_cur);
  WAIT_BAR(3);
  s16x4 vlo[8],vhi[8]; u32x4 pw0,pw1,pw2,pw3;
  #define PKW(P,B) cvtpk_s(P[B],P[B+1])
  #define PAF(k) __builtin_bit_cast(bf16x8,pw##k)
  #define VFR(i) (bf16x8){vlo[i][0],vlo[i][1],vlo[i][2],vlo[i][3],vhi[i][0],vhi[i][1],vhi[i][2],vhi[i][3]}
  #define PIN(x) asm volatile("":"+v"(x))
  #define MX3(a,b,c) __builtin_fmaxf(__builtin_fmaxf((a),(b)),(c))
  #define GAPA(MF,A0,A1,A2,A3,W0,W1,PW) do{ MF; sacc+=A0; sacc+=A1; sacc+=A2; sacc+=A3; PIN(sacc); W0; W1; PIN(PW); SBAR(); }while(0)
  #define EX(v) __builtin_amdgcn_exp2f(v)
  #define GAPB(MF,RD,X,B) do{ MF; RD; X[B]=EX(X[B]-mhat); X[B+1]=EX(X[B+1]-mhat); PIN(X); SBAR(); }while(0)
  #define VRD(i) do{ vlo[i]=vtr(vp_+(((i)>>2)*4096+((i)&3)*1024)); vhi[i]=vtr(vp_+(((i)>>2)*4096+((i)&3)*1024+512)); }while(0)
  #define VRD2(i) do{ vlo[i]=vtr(vp_+(8192+((i)>>2)*4096+((i)&3)*1024)); vhi[i]=vtr(vp_+(8192+((i)>>2)*4096+((i)&3)*1024+512)); }while(0)
  #define KRD(G,j) do{ if(G){ kload2(kf,kp0+sl_next,j); SBAR(); } }while(0)
  #define STEP(C0,C1,P0,P1,t,GK,GV,GL) do{ SBAR(); \
    const lds_cptr vp_=vp0+2*sl_prev; \
    VRD(0); SBAR(); float sacc=(P0[0]+P0[1]); \
    GAPA(C0=__builtin_amdgcn_mfma_f32_32x32x16_bf16(kf[0],qr[0],ZERO16,0,0,0), P0[2],P0[3],P0[4],P0[5],     pw0[0]=PKW(P0,0), pw0[1]=PKW(P0,2), pw0); \
    VRD(4); SBAR(); GAPA(C1=__builtin_amdgcn_mfma_f32_32x32x16_bf16(kf[1],qr[0],ZERO16,0,0,0), P0[6],P0[7],P0[8],P0[9],     pw0[2]=PKW(P0,4), pw0[3]=PKW(P0,6), pw0); \
    VRD(1); SBAR(); GAPA(C0=__builtin_amdgcn_mfma_f32_32x32x16_bf16(kf[2],qr[1],C0,0,0,0),   P0[10],P0[11],P0[12],P0[13], pw1[0]=PKW(P0,8), pw1[1]=PKW(P0,10), pw1); \
    VRD(5); SBAR(); GAPA(C1=__builtin_amdgcn_mfma_f32_32x32x16_bf16(kf[3],qr[1],C1,0,0,0),   P0[14],P0[15],P1[0],P1[1],   pw1[2]=PKW(P0,12),pw1[3]=PKW(P0,14), pw1); \
    VRD(2); SBAR(); GAPA(C0=__builtin_amdgcn_mfma_f32_32x32x16_bf16(kf[4],qr[2],C0,0,0,0),   P1[2],P1[3],P1[4],P1[5],     pw2[0]=PKW(P1,0), pw2[1]=PKW(P1,2), pw2); \
    VRD(6); SBAR(); GAPA(C1=__builtin_amdgcn_mfma_f32_32x32x16_bf16(kf[5],qr[2],C1,0,0,0),   P1[6],P1[7],P1[8],P1[9],     pw2[2]=PKW(P1,4), pw2[3]=PKW(P1,6), pw2); \
    VRD(3); SBAR(); GAPA(C0=__builtin_amdgcn_mfma_f32_32x32x16_bf16(kf[6],qr[3],C0,0,0,0),   P1[10],P1[11],P1[12],P1[13], pw3[0]=PKW(P1,8), pw3[1]=PKW(P1,10), pw3); \
    VRD(7); SBAR(); GAPA(C1=__builtin_amdgcn_mfma_f32_32x32x16_bf16(kf[7],qr[3],C1,0,0,0),   P1[14],P1[15],0.f,0.f,       pw3[2]=PKW(P1,12),pw3[3]=PKW(P1,14), pw3); \
    l_reg+=sacc; \
    if(GK){DMA_K((t)+3,sl_cur);} if(GV){DMA_V((t)+1,sl_next);} \
    CMASK(C0,C1,t); \
    { float a=MX3(C0[0],C0[1],C1[0]),b=MX3(C0[2],C0[3],C1[1]); a=MX3(a,C1[2],C1[3]); \
      _Pragma("unroll") for(int r=4;r<16;r+=4){a=MX3(a,C0[r],C0[r+1]);b=MX3(b,C0[r+2],C0[r+3]);a=MX3(a,C1[r],C1[r+1]);b=MX3(b,C1[r+2],C1[r+3]);} \
      float rm=__builtin_fmaxf(a,b); { auto rr=__builtin_amdgcn_permlane32_swap(__float_as_uint(rm),__float_as_uint(rm),false,false); rm=__builtin_fmaxf(__uint_as_float(rr[0]),__uint_as_float(rr[1])); } \
      resc=false; rm-=mhat;   \
      if(__builtin_expect(__any(rm>(float)THRL),0)){ const float dl=__builtin_fmaxf(rm,0.f); mhat+=dl; \
        const float f=__builtin_amdgcn_exp2f(-dl); l_reg*=f; if(hi==0)wsf[r32]=f; resc=true; } } \
    SBAR(); \
    GAPB(o[0]=__builtin_amdgcn_mfma_f32_32x32x16_bf16(PAF(0),VFR(0),o[0],0,0,0), VRD2(0), C0,0); \
    GAPB(o[1]=__builtin_amdgcn_mfma_f32_32x32x16_bf16(PAF(0),VFR(4),o[1],0,0,0), VRD2(4), C0,2); \
    GAPB(o[0]=__builtin_amdgcn_mfma_f32_32x32x16_bf16(PAF(1),VFR(1),o[0],0,0,0), VRD2(1), C0,4); \
    GAPB(o[1]=__builtin_amdgcn_mfma_f32_32x32x16_bf16(PAF(1),VFR(5),o[1],0,0,0), VRD2(5), C0,6); \
    GAPB(o[0]=__builtin_amdgcn_mfma_f32_32x32x16_bf16(PAF(2),VFR(2),o[0],0,0,0), VRD2(2), C0,8); \
    GAPB(o[1]=__builtin_amdgcn_mfma_f32_32x32x16_bf16(PAF(2),VFR(6),o[1],0,0,0), VRD2(6), C0,10); \
    GAPB(o[0]=__builtin_amdgcn_mfma_f32_32x32x16_bf16(PAF(3),VFR(3),o[0],0,0,0), VRD2(3), C0,12); \
    GAPB(o[1]=__builtin_amdgcn_mfma_f32_32x32x16_bf16(PAF(3),VFR(7),o[1],0,0,0), VRD2(7), C0,14); \
    KRD(GL,0); GAPB(o[2]=__builtin_amdgcn_mfma_f32_32x32x16_bf16(PAF(0),VFR(0),o[2],0,0,0), (void)0, C1,0); \
    GAPB(o[3]=__builtin_amdgcn_mfma_f32_32x32x16_bf16(PAF(0),VFR(4),o[3],0,0,0), (void)0, C1,2); \
    KRD(GL,1); GAPB(o[2]=__builtin_amdgcn_mfma_f32_32x32x16_bf16(PAF(1),VFR(1),o[2],0,0,0), (void)0, C1,4); \
    GAPB(o[3]=__builtin_amdgcn_mfma_f32_32x32x16_bf16(PAF(1),VFR(5),o[3],0,0,0), (void)0, C1,6); \
    KRD(GL,2); GAPB(o[2]=__builtin_amdgcn_mfma_f32_32x32x16_bf16(PAF(2),VFR(2),o[2],0,0,0), (void)0, C1,8); \
    GAPB(o[3]=__builtin_amdgcn_mfma_f32_32x32x16_bf16(PAF(2),VFR(6),o[3],0,0,0), (void)0, C1,10); \
    KRD(GL,3); GAPB(o[2]=__builtin_amdgcn_mfma_f32_32x32x16_bf16(PAF(3),VFR(3),o[2],0,0,0), (void)0, C1,12); \
    GAPB(o[3]=__builtin_amdgcn_mfma_f32_32x32x16_bf16(PAF(3),VFR(7),o[3],0,0,0), (void)0, C1,14); \
    }while(0)
  int t=1;
  #undef CMASK
  #define CMASK(P0,P1,t) do{}while(0)
  for(;t+5<NT;t+=2){
    STEP(pB0,pB1,pA0,pA1,t,true,true,true);     WAIT_BAR(3); RESC(); ROT();
    STEP(pA0,pA1,pB0,pB1,t+1,true,true,true);   WAIT_BAR(3); RESC(); ROT();
  }
  #undef CMASK
  #define CMASK(P0,P1,t) do{int jb_=(t)-(NT-4); if(jb_>=0)cmask(P0,P1,jb_,qrel,hi);}while(0)
  #define ENDW(tt) do{ if((tt)+3<NT){WAIT_BAR(3);} else if((tt)+2<NT){WAIT_BAR(2);} else {WAIT_BAR(0);} }while(0)
  for(;t+1<NT;t+=2){
    STEP(pB0,pB1,pA0,pA1,t,(t+3<NT),(t+1<NT),(t+1<NT));       ENDW(t);   RESC(); ROT();
    STEP(pA0,pA1,pB0,pB1,t+1,(t+4<NT),(t+2<NT),(t+2<NT));     ENDW(t+1); RESC(); ROT();
  }
  STEP(pB0,pB1,pA0,pA1,NT-1,false,false,false); RESC();
  { float sacc=pB0[0]+pB0[1]; _Pragma("unroll") for(int r=2;r<16;++r)sacc+=pB0[r]; _Pragma("unroll") for(int r=0;r<16;++r)sacc+=pB1[r]; l_reg+=sacc;
    pw0=(u32x4){PKW(pB0,0),PKW(pB0,2),PKW(pB0,4),PKW(pB0,6)};pw1=(u32x4){PKW(pB0,8),PKW(pB0,10),PKW(pB0,12),PKW(pB0,14)};pw2=(u32x4){PKW(pB1,0),PKW(pB1,2),PKW(pB1,4),PKW(pB1,6)};pw3=(u32x4){PKW(pB1,8),PKW(pB1,10),PKW(pB1,12),PKW(pB1,14)};
    SBAR(); pv(o,vb0+2*sl_cur,PAF(0),PAF(1),PAF(2),PAF(3)); }
  #undef PKW
  #undef PAF
  #undef VFR
  #undef PIN
  #undef MX3
  #undef GAPA
  #undef GAPB
  #undef EX
  #undef VRD
  #undef VRD2
  #undef KRD
  #undef STEP
  #undef ENDW
  {auto rr=__builtin_amdgcn_permlane32_swap(__float_as_uint(l_reg),__float_as_uint(l_reg),false,false);l_reg=__uint_as_float(rr[0])+__uint_as_float(rr[1]);}
  if(hi==0)wsf[32+r32]=l_reg;asm volatile("s_waitcnt lgkmcnt(0)":::"memory");
  float rli[16];
  #pragma unroll
  for(int r=0;r<16;++r)rli[r]=__builtin_amdgcn_rcpf(wsf[32+crow(r,hi)]);
  bf16*Ow=O+(rowbase+q0+wid*QBLK)*DM+hv*2*D;
  asm volatile("s_waitcnt lgkmcnt(0)\n\ts_barrier":::"memory");
  { bf16*stg=(bf16*)(shm+LDS_K)+wid*4096;
    const bf16*O2w=O2+(rowbase+q0+wid*QBLK)*DM+hv*2*D;
    #pragma unroll
    for(int r=0;r<16;++r){const int orow=crow(r,hi);
      #pragma unroll
      for(int d0=0;d0<4;++d0)stg[orow*128+d0*32+r32]=__float2bfloat16(o[d0][r]*rli[r]);}
    asm volatile("s_waitcnt lgkmcnt(0)":::"memory");
    #pragma unroll
    for(int i=0;i<4;++i){const int row=i*8+(lane>>3),ch=lane&7;
      const u32x4 v0=*(const u32x4*)(stg+row*128+ch*8), v1=*(const u32x4*)(stg+row*128+64+ch*8);
      if(!FUSE){ ATTN_STORE16(Ow+(long)row*DM+ch*8,v0); ATTN_STORE16(Ow+(long)row*DM+64+ch*8,v1); }
      else{ const u32x4 t0=*(const u32x4*)(O2w+(long)row*DM+ch*8), t1=*(const u32x4*)(O2w+(long)row*DM+64+ch*8);
        float c[16]; float ss=0.f;
        #pragma unroll
        for(int k=0;k<4;++k){ c[2*k]=__uint_as_float(v0[k]<<16)-lam*__uint_as_float(t0[k]<<16); c[2*k+1]=__uint_as_float(v0[k]&0xffff0000u)-lam*__uint_as_float(t0[k]&0xffff0000u);
          c[8+2*k]=__uint_as_float(v1[k]<<16)-lam*__uint_as_float(t1[k]<<16); c[8+2*k+1]=__uint_as_float(v1[k]&0xffff0000u)-lam*__uint_as_float(t1[k]&0xffff0000u); }
        #pragma unroll
        for(int k=0;k<16;++k)ss+=c[k]*c[k];
        ss+=__int_as_float(__builtin_amdgcn_ds_swizzle(__float_as_int(ss),(1<<10)|0x1f)); ss+=__int_as_float(__builtin_amdgcn_ds_swizzle(__float_as_int(ss),(2<<10)|0x1f)); ss+=__int_as_float(__builtin_amdgcn_ds_swizzle(__float_as_int(ss),(4<<10)|0x1f));
        const float rs=__builtin_amdgcn_rsqf(ss*(1.f/128.f)+1e-6f);
        const float4 g0=*(const float4*)(gsub+ch*8), g1=*(const float4*)(gsub+ch*8+4), g2=*(const float4*)(gsub+64+ch*8), g3=*(const float4*)(gsub+64+ch*8+4);
        u32x4 w0,w1;
        w0[0]=cvtpk_s(c[0]*rs*g0.x,c[1]*rs*g0.y); w0[1]=cvtpk_s(c[2]*rs*g0.z,c[3]*rs*g0.w); w0[2]=cvtpk_s(c[4]*rs*g1.x,c[5]*rs*g1.y); w0[3]=cvtpk_s(c[6]*rs*g1.z,c[7]*rs*g1.w);
        w1[0]=cvtpk_s(c[8]*rs*g2.x,c[9]*rs*g2.y); w1[1]=cvtpk_s(c[10]*rs*g2.z,c[11]*rs*g2.w); w1[2]=cvtpk_s(c[12]*rs*g3.x,c[13]*rs*g3.y); w1[3]=cvtpk_s(c[14]*rs*g3.z,c[15]*rs*g3.w);
        ATTN_STORE16(Ow+(long)row*DM+ch*8,w0); ATTN_STORE16(Ow+(long)row*DM+64+ch*8,w1); } } }
  asm volatile("s_waitcnt lgkmcnt(0)\n\ts_barrier":::"memory");
  #undef DMA_K
  #undef DMA_V
  #undef CMASK
  #undef START
  #undef RESC
  #undef ROT
}
constexpr int ATTN_LDS_BYTES=LDS_BYTES;
struct AttnTensors { const bf16* Q; const bf16* K; const bf16* V; bf16* O2; bf16* YB; };
template<int THRL=8> __device__ __forceinline__ void attn_phase(char*lds,const AttnTensors&T,float lam,const float*gsub,int vcu,int ncu){
  const int bh=(vcu&255)>>3, s=vcu&7; const int b=bh>>3, h=bh&7;
  const float lam_u=__uint_as_float(__builtin_amdgcn_readfirstlane(__float_as_uint(lam)));
  for(int i=0;i<4;++i){ const int qb=(i&2)?15-s:s; const bool fuse=(i&1)!=0;
    attn_unit<THRL>(fuse,b,fuse?2*h:2*h+1,h,qb,T.Q,T.K,T.V,fuse?T.YB:T.O2,T.O2,lam_u,gsub,lds);
  }
}
#undef SBAR
#undef WAIT_BAR
}
constexpr int NWAVES = 8;
#ifndef MK_MULTI
#define MK_MULTI 0
#endif
constexpr int NB = 4, SEQ = 4096, T = NB * SEQ, D = 1024, DIN = 7168, FF = 3584, NEXP = 8, PLE = 256, DEPTH = 2;
constexpr int NPAN = T / 256;
constexpr float EPS = 1e-6f;
constexpr int MOE_ROWS = 2 * T + NEXP * 256;
constexpr int MOE_PANELS = MOE_ROWS / 256, MOE_HALF = MOE_PANELS / 2;
constexpr size_t MiB = 1u << 20;
constexpr size_t WS_CTL = 0, CTL_ZERO_BYTES = 1 * MiB;
constexpr size_t WS_LRUW = 1 * MiB;
constexpr size_t WS_PAR = 1 * MiB + 512 * 1024;
constexpr size_t WS_SUM = 2 * MiB;
constexpr size_t WS_TOK = 4 * MiB;
constexpr size_t WS_LIST = 5 * MiB;
constexpr size_t WS_COS = 6 * MiB;
constexpr size_t WS_WSMALL = 10 * MiB;
constexpr size_t WL_STRIDE = 45 * MiB / 2, WL_WIN = 0, WL_WAB = 14 * MiB, WL_WO = 18 * MiB, WL_WPG = 20 * MiB, WL_WPP = 22 * MiB;
constexpr size_t WS_WGU = WS_WSMALL + 45 * MiB, WS_WD = WS_WGU + 14 * MiB;
constexpr size_t WS_PB = 76 * MiB;
constexpr size_t WS_H = 92 * MiB;
constexpr size_t WS_BIG = 124 * MiB, SLOT = 32 * MiB;
constexpr size_t WS_GG = WS_BIG, WS_RIN = WS_BIG + SLOT, WS_Q = WS_BIG + 2 * SLOT, WS_K = WS_BIG + 3 * SLOT, WS_V = WS_BIG + 4 * SLOT, WS_SGA = WS_BIG + 5 * SLOT, WS_SGB = WS_BIG + 6 * SLOT;
constexpr size_t WS_HL = WS_BIG + 7 * SLOT, WS_LP = WS_BIG + 8 * SLOT, WS_O1 = WS_BIG + 9 * SLOT, WS_O2 = WS_BIG + 10 * SLOT;
constexpr size_t WS_YA = WS_RIN, WS_YB = WS_Q, WS_T1 = WS_K, WS_MERGED = WS_GG, WS_F = WS_SGA;
constexpr size_t WS_ACT = WS_BIG;
constexpr size_t WS_PP = WS_BIG;
constexpr size_t WS_WMGU = WS_BIG, WS_WMD = WS_BIG + 56 * MiB, WS_ACT8 = WS_BIG + 84 * MiB, WS_HG = WS_BIG + 204 * MiB, WS_OE = WS_BIG + 240 * MiB;
constexpr int MOE_MAINP = 128, MOE_KS = 7, MOE_KSB = FF / MOE_KS;
constexpr size_t WS_OEP = WS_OE + 68 * MiB;
constexpr size_t WS_XR = WS_O2 + SLOT;
constexpr size_t WS_WIN8 = WS_XR + SLOT;
constexpr size_t WS_WGU8 = WS_WIN8 + 14 * MiB;
constexpr size_t WS_SB = WS_WGU8 + 7 * MiB;
constexpr size_t WS_SA = WS_COS + 128 * 1024;
constexpr size_t WS_WPG8 = WS_SB + 1 * MiB;
constexpr size_t WS_END = WS_WPG8 + 2 * MiB;
constexpr float SC_H = 8.f, SC_WGU = 32.f, SC_ACT = 8.f, SC_WD = 64.f;
constexpr int E8_H = 0x7c7c7c7c, E8_WGU = 0x7a7a7a7a, E8_ACT = 0x7c7c7c7c, E8_WD = 0x79797979;
static_assert(WS_OEP + (size_t)MOE_KS * 8 * 256 * D * 2 <= WS_O2 + SLOT && MOE_KS * MOE_KSB == FF && MOE_KSB % 256 == 0 && WS_OE + (size_t)MOE_ROWS * D * 2 <= WS_END && WS_ACT8 + (size_t)MOE_ROWS * FF <= WS_HG && WS_HG + (size_t)MOE_ROWS * D <= WS_OE && WS_WMD + (size_t)NEXP * D * FF <= WS_ACT8, "d_ws map");
constexpr int CW_TMO = 0, CW_CODE = 1;
constexpr int CW_CNT = 64;
constexpr int CW_LRU = 8192;
constexpr int CW_BAR = 4096;
constexpr int RING_OFF = 0, RING_BYTES = 131072;
constexpr int LDSCTL_OFF = RING_BYTES, MISC_OFF = LDSCTL_OFF + 320;
constexpr int LDS_BYTES = 147456;
static_assert(MISC_OFF + 128 <= LDS_BYTES, "LDS map");
#define GAS __attribute__((address_space(1)))
#define LAS __attribute__((address_space(3)))
typedef unsigned short bf16;
typedef unsigned v4u __attribute__((ext_vector_type(4)));
typedef float f32x4 __attribute__((ext_vector_type(4)));
typedef short bf16x8 __attribute__((ext_vector_type(8)));
typedef GAS unsigned gu32;
typedef GAS unsigned long long gu64;
#define RLX_AGENT __ATOMIC_RELAXED, __HIP_MEMORY_SCOPE_AGENT
#define LDS_WAIT() asm volatile("s_waitcnt lgkmcnt(0)" ::: "memory")
#define VM_WAIT() asm volatile("s_waitcnt vmcnt(0)" ::: "memory")
__device__ __forceinline__ unsigned long long rt() { return __builtin_amdgcn_s_memrealtime(); }
__device__ __forceinline__ unsigned f2bf(float f) { unsigned u = __builtin_bit_cast(unsigned, f); return (u + 0x7fffu + ((u >> 16) & 1u)) >> 16; }
__device__ __forceinline__ unsigned pk2(float lo, float hi) { return f2bf(lo) | (f2bf(hi) << 16); }

#define XB_TMO      128
#define XB_XCNT(j)  (256  + 64 * (j))
#define XB_XSUB(j)  (1280 + 64 * (j))
#define XB_XGEN(j)  (2304 + 64 * (j))
#define XB_TOP      3328
#define XB_TOPGEN   3392
#define XCD_BAR_WORDS 3456
#define XB_SPIN_CAP (1u << 18)

__device__ __forceinline__ unsigned xb_ld(unsigned* p)              { return __hip_atomic_load(p, __ATOMIC_RELAXED, __HIP_MEMORY_SCOPE_AGENT); }
__device__ __forceinline__ unsigned xb_add(unsigned* p, unsigned v) { return __hip_atomic_fetch_add(p, v, __ATOMIC_RELAXED, __HIP_MEMORY_SCOPE_AGENT); }
__device__ __forceinline__ unsigned xb_xcc_id() { return (unsigned)__builtin_amdgcn_s_getreg((3 << 11) | 20) & 0xFu; }
#define XB_SPIN(cond, bar) do { unsigned _sp = 0; while (cond) { __builtin_amdgcn_s_sleep(1); \
    if ((++_sp & 255u) == 0u) { if (xb_ld(&(bar)[XB_TMO])) break; if (_sp > XB_SPIN_CAP) { atomicAdd(&(bar)[XB_TMO], 1u); break; } } } } while (0)

struct XcdBarrier {
    unsigned* bar; unsigned x;
    volatile LAS unsigned* st;
};

__device__ __forceinline__ XcdBarrier xcd_barrier_post(unsigned* bar, volatile LAS unsigned* st) {
    XcdBarrier b; b.bar = bar; b.x = xb_xcc_id(); b.st = st;
    if (threadIdx.x == 0) (void)xb_add(&bar[XB_XCNT(b.x)], 1u);
    return b;
}
__device__ __forceinline__ void xcd_barrier_complete(unsigned* bar, unsigned x, unsigned& nloc, unsigned& nx) {
    const unsigned G = gridDim.x * gridDim.y * gridDim.z;
    unsigned sum, cnt, mine, sp = 0u;
    for (;;) {
        sum = 0u; cnt = 0u; mine = 0u;
#pragma unroll
        for (unsigned j = 0; j < 16; ++j) { const unsigned c = xb_ld(&bar[XB_XCNT(j)]); sum += c; cnt += (c > 0u) ? 1u : 0u; mine = (j == x) ? c : mine; }
        if (sum == G) break;
        __builtin_amdgcn_s_sleep(1);
        if ((++sp & 255u) == 0u) { if (xb_ld(&bar[XB_TMO])) break; if (sp > XB_SPIN_CAP) { atomicAdd(&bar[XB_TMO], 1u); break; } }
    }
    nloc = mine > 0u ? mine : 1u; nx = cnt > 0u ? cnt : 1u;
}

__device__ __forceinline__ void xcd_barrier(const XcdBarrier& b) {
    asm volatile("s_waitcnt vmcnt(0)" ::: "memory");
    __syncthreads();
    if (threadIdx.x == 0) {
        unsigned* bar = b.bar; unsigned bx_ = b.x;
        asm volatile("" : "+s"(bar), "+s"(bx_));
        __builtin_amdgcn_s_waitcnt(0);
        unsigned nloc = b.st[0], nx = b.st[1];
        if (nloc == 0u) { xcd_barrier_complete(bar, bx_, nloc, nx); b.st[0] = nloc; b.st[1] = nx; }
        const unsigned old = xb_add(&bar[XB_XSUB(bx_)], 1u);
        const unsigned gen = old / nloc;
        if (old + 1u == (gen + 1u) * nloc) {
            __builtin_amdgcn_fence(__ATOMIC_RELEASE, "agent");
            asm volatile("s_waitcnt vmcnt(0)" ::: "memory");
            const unsigned og = xb_add(&bar[XB_TOP], 1u);
            const unsigned tg = og / nx;
            if (og + 1u == (tg + 1u) * nx) xb_add(&bar[XB_TOPGEN], 1u);
            else XB_SPIN(xb_ld(&bar[XB_TOPGEN]) == tg, bar);
            __builtin_amdgcn_fence(__ATOMIC_ACQUIRE, "agent");
            xb_add(&bar[XB_XGEN(bx_)], 1u);
            asm volatile("s_waitcnt vmcnt(0)" ::: "memory");
        } else {
            XB_SPIN(xb_ld(&bar[XB_XGEN(bx_)]) == gen, bar);
            __builtin_amdgcn_fence(__ATOMIC_ACQUIRE, "agent");
            asm volatile("s_waitcnt vmcnt(0)" ::: "memory");
        }
    }
    __syncthreads();
}
__device__ const float INV_FREQ[32] = {
    1.0f, 0.74989420933f, 0.56234132519f, 0.42169650343f, 0.31622776602f, 0.23713737057f, 0.17782794100f, 0.13335214322f,
    0.1f, 0.074989420933f, 0.056234132519f, 0.042169650343f, 0.031622776602f, 0.023713737057f, 0.017782794100f, 0.013335214322f,
    0.01f, 0.0074989420933f, 0.0056234132519f, 0.0042169650343f, 0.0031622776602f, 0.0023713737057f, 0.0017782794100f, 0.0013335214322f,
    0.001f, 0.00074989420933f, 0.00056234132519f, 0.00042169650343f, 0.00031622776602f, 0.00023713737057f, 0.00017782794100f, 0.00013335214322f };

#define SWZ_XOR(v, o) __int_as_float(__builtin_amdgcn_ds_swizzle(__float_as_int(v), ((o) << 10) | 0x1f))
__device__ __forceinline__ float half_sum(float v) {
    v += SWZ_XOR(v, 1); v += SWZ_XOR(v, 2); v += SWZ_XOR(v, 4); v += SWZ_XOR(v, 8); v += SWZ_XOR(v, 16);
    return v;
}
__device__ __forceinline__ float wave_sum(float v) {
    v = half_sum(v);
    const auto rr = __builtin_amdgcn_permlane32_swap(__float_as_uint(v), __float_as_uint(v), false, false);
    return __uint_as_float(rr[0]) + __uint_as_float(rr[1]);
}
__device__ __forceinline__ float dot4(f32x4 a, f32x4 b) { return (a.x * b.x + a.y * b.y) + (a.z * b.z + a.w * b.w); }
__device__ __forceinline__ float bf2f(unsigned short v) { return __uint_as_float((unsigned)v << 16); }
typedef unsigned u32x2 __attribute__((ext_vector_type(2)));
__device__ __forceinline__ f32x4 bf4_to_f(u32x2 w) { return (f32x4){__uint_as_float(w.x << 16), __uint_as_float(w.x & 0xffff0000u), __uint_as_float(w.y << 16), __uint_as_float(w.y & 0xffff0000u)}; }
__device__ __forceinline__ u32x2 f_to_bf4(f32x4 v) { u32x2 w; w.x = pk2(v.x, v.y); w.y = pk2(v.z, v.w); return w; }
__device__ __forceinline__ float sigm_f(float v) { return 1.0f / (1.0f + __expf(-v)); }

__device__ __forceinline__ f32x4 bfl4(v4u w) { return (f32x4){__uint_as_float(w.x << 16), __uint_as_float(w.x & 0xffff0000u), __uint_as_float(w.y << 16), __uint_as_float(w.y & 0xffff0000u)}; }
__device__ __forceinline__ f32x4 bfh4(v4u w) { return (f32x4){__uint_as_float(w.z << 16), __uint_as_float(w.z & 0xffff0000u), __uint_as_float(w.w << 16), __uint_as_float(w.w & 0xffff0000u)}; }
__device__ __forceinline__ v4u pk8bf(f32x4 a, f32x4 b) { v4u w; w.x = pk2(a.x, a.y); w.y = pk2(a.z, a.w); w.z = pk2(b.x, b.y); w.w = pk2(b.z, b.w); return w; }
__device__ __forceinline__ float wave_max(float v) {
    v = fmaxf(v, SWZ_XOR(v, 1)); v = fmaxf(v, SWZ_XOR(v, 2)); v = fmaxf(v, SWZ_XOR(v, 4)); v = fmaxf(v, SWZ_XOR(v, 8)); v = fmaxf(v, SWZ_XOR(v, 16));
    const auto rr = __builtin_amdgcn_permlane32_swap(__float_as_uint(v), __float_as_uint(v), false, false);
    return fmaxf(__uint_as_float(rr[0]), __uint_as_float(rr[1]));
}
__device__ __forceinline__ float amax4(f32x4 v) { return fmaxf(fmaxf(fabsf(v.x), fabsf(v.y)), fmaxf(fabsf(v.z), fabsf(v.w))); }
__device__ __forceinline__ unsigned q4i8(f32x4 v, float k) {
    const int a = (int)rintf(v.x * k), b = (int)rintf(v.y * k), c = (int)rintf(v.z * k), d = (int)rintf(v.w * k);
    return (unsigned)(a & 255) | ((unsigned)(b & 255) << 8) | ((unsigned)(c & 255) << 16) | ((unsigned)d << 24);
}
__device__ __forceinline__ void wq_row(const bf16* src, unsigned char* dst, float* scale, int lane) {
    const v4u a = ((const v4u*)src)[2 * lane], b = ((const v4u*)src)[2 * lane + 1];
    const f32x4 v0 = bfl4(a), v1 = bfh4(a), v2 = bfl4(b), v3 = bfh4(b);
    const float mx = wave_max(fmaxf(fmaxf(amax4(v0), amax4(v1)), fmaxf(amax4(v2), amax4(v3))));
    const float k = 127.f / fmaxf(mx, 1e-30f);
    v4u o; o.x = q4i8(v0, k); o.y = q4i8(v1, k); o.z = q4i8(v2, k); o.w = q4i8(v3, k);
    ((v4u*)dst)[lane] = o;
    if (lane == 0) *scale = mx * (1.f / 127.f);
}
__device__ __forceinline__ void tr_load(float (&r)[32], const float* W, int N, int k0, int n0, int lane) {
#pragma unroll
    for (int i = 0; i < 32; ++i) r[i] = W[(size_t)(k0 + 2 * i + (lane >> 5)) * N + n0 + (lane & 31)];
}
__device__ __forceinline__ void tr_store(const float (&r)[32], int K, bf16* WT, int dest_row0, int k0, LAS float* scr, int lane) {
#pragma unroll
    for (int i = 0; i < 32; ++i) scr[(2 * i + (lane >> 5)) * 33 + (lane & 31)] = r[i];
    LDS_WAIT(); asm volatile("" ::: "memory");
    const int c = lane & 7;
#pragma unroll
    for (int j = 0; j < 4; ++j) { const int n = (lane >> 3) + 8 * j; const LAS float* s = scr + (8 * c) * 33 + n;
        v4u o; o.x = pk2(s[0 * 33], s[1 * 33]); o.y = pk2(s[2 * 33], s[3 * 33]); o.z = pk2(s[4 * 33], s[5 * 33]); o.w = pk2(s[6 * 33], s[7 * 33]);
        *(v4u*)(WT + (size_t)(dest_row0 + n) * K + k0 + 8 * c) = o; }
    LDS_WAIT(); asm volatile("" ::: "memory");
}
template <int MAP> __device__ __forceinline__ int dest_row(int n0) {
    if (MAP == 1) { const int tile = n0 >> 8, w = n0 & 255; return tile * 256 + ((w & 63) >> 5) * 128 + (w >> 6) * 32; }
    if (MAP == 2) return (n0 >> 7) * 256 + (n0 & 127);
    if (MAP == 3) return (n0 >> 7) * 256 + 128 + (n0 & 127);
    return n0;
}
__device__ __forceinline__ float clamp8(float v) { return __builtin_fminf(__builtin_fmaxf(v, -448.f), 448.f); }
__device__ __forceinline__ unsigned pk4f8(float a, float b, float c, float d) { unsigned w = __builtin_amdgcn_cvt_pk_fp8_f32(clamp8(a), clamp8(b), 0u, false); return __builtin_amdgcn_cvt_pk_fp8_f32(clamp8(c), clamp8(d), w, true); }
__device__ __forceinline__ void tr_store8(const float (&r)[32], int K, unsigned char* WT, int dest_row0, int k0, float scale, LAS float* scr, int lane) {
#pragma unroll
    for (int i = 0; i < 32; ++i) scr[(2 * i + (lane >> 5)) * 33 + (lane & 31)] = r[i] * scale;
    LDS_WAIT(); asm volatile("" ::: "memory");
    const int c = lane & 3;
#pragma unroll
    for (int j = 0; j < 2; ++j) { const int n = (lane >> 2) + 16 * j; const LAS float* s = scr + (16 * c) * 33 + n;
        v4u o; o.x = pk4f8(s[0 * 33], s[1 * 33], s[2 * 33], s[3 * 33]); o.y = pk4f8(s[4 * 33], s[5 * 33], s[6 * 33], s[7 * 33]);
        o.z = pk4f8(s[8 * 33], s[9 * 33], s[10 * 33], s[11 * 33]); o.w = pk4f8(s[12 * 33], s[13 * 33], s[14 * 33], s[15 * 33]);
        *(v4u*)(WT + (size_t)(dest_row0 + n) * K + k0 + 16 * c) = o; }
    LDS_WAIT(); asm volatile("" ::: "memory");
}
struct TrItem { const float* W; bf16* WT; int K, N, dest_row0, k0, n0; float s8; };
template <int MAP> __device__ __forceinline__ TrItem tr_item(const float* W, int K, int N, bf16* WT, int row_off, int q, float s8 = 0.f) {
    const int nblk = N / 32, kb = q / nblk, nb = q - kb * nblk; TrItem t; t.W = W; t.WT = WT; t.K = K; t.N = N; t.dest_row0 = row_off + dest_row<MAP>(32 * nb); t.k0 = 64 * kb; t.n0 = 32 * nb; t.s8 = s8; return t;
}
#define TR_STORE(r, t) do { if (F8 && t.s8 != 0.f) tr_store8(r, t.K, (unsigned char*)t.WT, t.dest_row0, t.k0, t.s8, scr, lane); else tr_store(r, t.K, t.WT, t.dest_row0, t.k0, scr, lane); } while (0)
template <bool F8, class Dec> __device__ __forceinline__ void tr_run(const Dec& DEC, int nitems, LAS float* scr, int lane, int gw, int ngw) {
    int it = gw; if (it >= nitems) return;
    float ra[32], rb[32];
    TrItem a = DEC(it), b = a;
    tr_load(ra, a.W, a.N, a.k0, a.n0, lane);
    for (;;) {
        const int it1 = it + ngw; const bool h1 = it1 < nitems;
        if (h1) { b = DEC(it1); tr_load(rb, b.W, b.N, b.k0, b.n0, lane); }
        TR_STORE(ra, a);
        if (!h1) break;
        const int it2 = it1 + ngw; const bool h2 = it2 < nitems;
        if (h2) { a = DEC(it2); tr_load(ra, a.W, a.N, a.k0, a.n0, lane); }
        TR_STORE(rb, b);
        if (!h2) break;
        it = it2;
    }
}

__device__ __forceinline__ void row_post_pre(const f32x4 (&f)[4], const float* xin, float* xout, const float* gpost, const float* gpre, bf16* hrow, int lane, f32x4 (&hn)[4]) {
    float s = 0.f;
#pragma unroll
    for (int j = 0; j < 4; ++j) s += dot4(f[j], f[j]);
    const float rs = rsqrtf(wave_sum(s) * (1.f / D) + EPS);
    f32x4 xv[4]; float s2 = 0.f;
#pragma unroll
    for (int j = 0; j < 4; ++j) { xv[j] = ((const f32x4*)xin)[lane + 64 * j] + f[j] * rs * ((const f32x4*)gpost)[lane + 64 * j]; ((f32x4*)xout)[lane + 64 * j] = xv[j]; s2 += dot4(xv[j], xv[j]); }
    if (gpre) {
        const float rs2 = rsqrtf(wave_sum(s2) * (1.f / D) + EPS);
#pragma unroll
        for (int j = 0; j < 4; ++j) { hn[j] = xv[j] * rs2 * ((const f32x4*)gpre)[lane + 64 * j]; ((u32x2*)hrow)[lane + 64 * j] = f_to_bf4(hn[j]); }
    }
}
struct Args { const void* in[26]; float* out; unsigned char* ws; int ph_lo, ph_hi; };
enum { I_X = 0, I_P, I_POS, I_NORMG, I_WIN, I_CONVW, I_CONVB, I_LWA, I_LBA, I_LWX, I_LBX, I_LLAM, I_DLAM, I_SUBG, I_WPA, I_WPB, I_WOUT, I_FG, I_FU, I_FD, I_RW, I_MG, I_MU, I_MD, I_PWP, I_PWG };

constexpr int PO_NORMG = 0, PO_CONVW = PO_NORMG + DEPTH * 6 * D, PO_CONVB = PO_CONVW + DEPTH * 4 * D, PO_LBA = PO_CONVB + DEPTH * D, PO_LBX = PO_LBA + DEPTH * D, PO_LLAM = PO_LBX + DEPTH * D,
              PO_DLAM = PO_LLAM + DEPTH * D, PO_SUBG = PO_DLAM + DEPTH * 256, PO_RW = PO_SUBG + DEPTH * 128, PO_SUBGS = PO_RW + D * NEXP, PO_END = PO_SUBGS + DEPTH * 128;
static_assert((size_t)PO_END * 4 <= 512 * 1024, "parameter block");
#define AIN(k) ((const void*)(const GAS void*)A.in[k])
struct QSlab { const float* W; unsigned char* dst; float* sc; int N, n0, drow; };
__device__ __forceinline__ void qs_load(float (&r)[2][32], const QSlab& s, int wave, int lane) {
#pragma unroll
    for (int it = 0; it < 2; ++it)
#pragma unroll
        for (int i = 0; i < 32; ++i) { const float* rowp = s.W + (size_t)(64 * (2 * wave + it) + 2 * i) * s.N + s.n0;
            r[it][i] = rowp[(unsigned)((lane >> 5) * s.N + (lane & 31))]; }
}
__device__ __forceinline__ void qs_store(const float (&r)[2][32], const QSlab& s, LAS float* ring, int par, int wave, int lane) {
    LAS float* scr = ring + wave * 4096;
    float m = 0.f;
#pragma unroll
    for (int i = 0; i < 32; ++i) m = fmaxf(m, fmaxf(fabsf(r[0][i]), fabsf(r[1][i])));
    { const auto rr = __builtin_amdgcn_permlane32_swap(__float_as_uint(m), __float_as_uint(m), false, false); m = fmaxf(__uint_as_float(rr[0]), __uint_as_float(rr[1])); }
    scr[2112 + par * 32 + (lane & 31)] = m;
    __syncthreads();
    float mx = 0.f;
#pragma unroll
    for (int w = 0; w < NWAVES; ++w) mx = fmaxf(mx, ring[w * 4096 + 2112 + par * 32 + (lane & 31)]);
    const float kq = 127.f / fmaxf(mx, 1e-30f);
    if (wave == 0 && lane < 32) s.sc[s.drow + lane] = mx * (1.f / 127.f);
#pragma unroll
    for (int it = 0; it < 2; ++it) { const int k0 = 64 * (2 * wave + it);
#pragma unroll
        for (int i = 0; i < 32; ++i) scr[(2 * i + (lane >> 5)) * 33 + (lane & 31)] = r[it][i] * kq;
        LDS_WAIT(); asm volatile("" ::: "memory");
        const int c = lane & 3;
#pragma unroll
        for (int j = 0; j < 2; ++j) { const int n = (lane >> 2) + 16 * j; const LAS float* q = scr + (16 * c) * 33 + n;
            v4u o; o.x = q4i8((f32x4){q[0 * 33], q[1 * 33], q[2 * 33], q[3 * 33]}, 1.f); o.y = q4i8((f32x4){q[4 * 33], q[5 * 33], q[6 * 33], q[7 * 33]}, 1.f);
            o.z = q4i8((f32x4){q[8 * 33], q[9 * 33], q[10 * 33], q[11 * 33]}, 1.f); o.w = q4i8((f32x4){q[12 * 33], q[13 * 33], q[14 * 33], q[15 * 33]}, 1.f);
            *(v4u*)(s.dst + (size_t)(s.drow + n) * D + k0 + 16 * c) = o; }
        LDS_WAIT(); asm volatile("" ::: "memory"); }
}
__device__ __forceinline__ void p0_quant_slabs(const Args& A, unsigned char* ws, LAS unsigned char* lds, int vcu, int G) {
    int tid_ = threadIdx.x; asm volatile("" : "+v"(tid_)); const int lane = tid_ & 63, wave = __builtin_amdgcn_readfirstlane(tid_ >> 6);
    LAS float* ring = (LAS float*)(lds + RING_OFF);
    constexpr int S_IN = DIN / 32, S_FF = FF / 32, S_PG = D / 32, NSLAB = DEPTH * S_IN + 2 * S_FF + DEPTH * S_PG;
    struct Dec { const Args& A; unsigned char* ws;
        __device__ __forceinline__ QSlab operator()(int f) const { QSlab s; float* sb = (float*)(ws + WS_SB);
            if (f < DEPTH * S_IN) { const int l = f / S_IN, nb = f - l * S_IN; s.W = (const float*)AIN(I_WIN) + (size_t)l * D * DIN; s.N = DIN; s.n0 = 32 * nb; s.drow = dest_row<1>(32 * nb);
                s.dst = ws + WS_WIN8 + (size_t)l * DIN * D; s.sc = sb + l * DIN; return s; }
            int r = f - DEPTH * S_IN;
            if (r < 2 * S_FF) { const int up = r >= S_FF, nb = r - up * S_FF; s.W = (const float*)(up ? AIN(I_FU) : AIN(I_FG)); s.N = FF; s.n0 = 32 * nb; s.drow = up ? dest_row<3>(32 * nb) : dest_row<2>(32 * nb);
                s.dst = ws + WS_WGU8; s.sc = sb + 2 * DIN; return s; }
            r -= 2 * S_FF; { const int l = r / S_PG, nb = r - l * S_PG; s.W = (const float*)AIN(I_PWG) + (size_t)l * D * D; s.N = D; s.n0 = 32 * nb; s.drow = 32 * nb;
                s.dst = ws + WS_WPG8 + (size_t)l * D * D; s.sc = sb + 3 * DIN + l * D; return s; } } };
    const Dec dec{A, ws};
    int f = vcu; if (f >= NSLAB) return;
    float ra[2][32], rb[2][32];
    QSlab a = dec(f), b = a;
    qs_load(ra, a, wave, lane);
    for (;;) {
        const int f1 = f + G; const bool h1 = f1 < NSLAB;
        if (h1) { b = dec(f1); qs_load(rb, b, wave, lane); }
        qs_store(ra, a, ring, 0, wave, lane);
        if (!h1) break;
        const int f2 = f1 + G; const bool h2 = f2 < NSLAB;
        if (h2) { a = dec(f2); qs_load(ra, a, wave, lane); }
        qs_store(rb, b, ring, 1, wave, lane);
        if (!h2) break;
        f = f2;
    }
    __syncthreads();
}
__device__ __forceinline__ void p0_prologue(const Args& A, LAS unsigned char* lds, int vcu, int G) {
    int tid_ = threadIdx.x; asm volatile("" : "+v"(tid_)); const int tid = tid_, lane = tid & 63, wave = __builtin_amdgcn_readfirstlane(tid >> 6); (void)tid; (void)lane; (void)wave;
    unsigned char* ws = (unsigned char*)(GAS unsigned char*)A.ws;
    LAS float* scr = (LAS float*)(lds + RING_OFF + wave * 16384);
    const int gw = vcu * NWAVES + wave, ngw = G * NWAVES;
    p0_quant_slabs(A, ws, lds, vcu, G);
    { struct Dec { const Args& A; unsigned char* ws;
          __device__ __forceinline__ TrItem operator()(int f) const {
              constexpr int I_SQ = (D / 64) * (D / 32), I_PP = (PLE / 64) * (D / 32), I_L = 3 * I_SQ + I_PP;
              if (f < DEPTH * I_L) { const int l = f / I_L; int r = f - l * I_L; unsigned char* wl = ws + WS_WSMALL + (size_t)l * WL_STRIDE;
                  if (r < I_SQ) return tr_item<0>((const float*)AIN(I_WPA) + (size_t)l * D * D, D, D, (bf16*)(wl + WL_WAB), 0, r); r -= I_SQ;
                  if (r < I_SQ) return tr_item<0>((const float*)AIN(I_WPB) + (size_t)l * D * D, D, D, (bf16*)(wl + WL_WAB), D, r); r -= I_SQ;
                  if (r < I_SQ) return tr_item<0>((const float*)AIN(I_WOUT) + (size_t)l * D * D, D, D, (bf16*)(wl + WL_WO), 0, r); r -= I_SQ;
                  return tr_item<0>((const float*)AIN(I_PWP) + (size_t)l * PLE * D, PLE, D, (bf16*)(wl + WL_WPP), 0, r); }
              const int r = f - DEPTH * I_L;
              return tr_item<0>((const float*)AIN(I_FD), FF, D, (bf16*)(ws + WS_WD), 0, r); } };
      constexpr int NIT = DEPTH * (3 * (D / 64) * (D / 32) + (PLE / 64) * (D / 32)) + (FF / 64) * (D / 32);
      const Dec dec{A, ws}; tr_run<true>(dec, NIT, scr, lane, gw, ngw); }
    const int gt = gw * 64 + lane, ngt = ngw * 64;
    { const int* pos = (const int*)AIN(I_POS); float* pf = (float*)(ws + WS_COS); for (int i = gt; i < T; i += ngt) pf[i] = (float)pos[i]; }
    { const f32x4* p = (const f32x4*)AIN(I_P); u32x2* pb = (u32x2*)(ws + WS_PB);
      for (int i = gt; i < DEPTH * T * PLE / 4; i += ngt) pb[i] = f_to_bf4(p[i]); }
    { bf16* lw = (bf16*)(ws + WS_LRUW);
      for (int i = gt; i < DEPTH * 16 * 2 * 4096; i += ngt) { const int c = i & 63, d = (i >> 6) & 63, g = (i >> 12) & 1, n = (i >> 13) & 15, l = i >> 17;
          const float* src = (const float*)AIN(g ? I_LWX : I_LWA); lw[i] = (bf16)f2bf(src[((size_t)(l * 16 + n) * 64 + c) * 64 + d]); } }
    { const float* g0 = (const float*)AIN(I_NORMG);
      for (int m = gw; m < T; m += ngw) { const f32x4* xr = (const f32x4*)((const float*)AIN(I_X) + (size_t)m * D); f32x4 v[4]; float s = 0.f;
#pragma unroll
          for (int j = 0; j < 4; ++j) { v[j] = xr[lane + 64 * j]; s += dot4(v[j], v[j]); }
          const float rs = rsqrtf(wave_sum(s) * (1.f / D) + EPS);
          float mx = 0.f;
#pragma unroll
          for (int j = 0; j < 4; ++j) { ((u32x2*)(ws + WS_XR + (size_t)m * D * 2))[lane + 64 * j] = f_to_bf4(v[j]); v[j] = v[j] * rs * ((const f32x4*)g0)[lane + 64 * j]; mx = fmaxf(mx, amax4(v[j])); }
          mx = wave_max(mx); const float kq = 127.f / fmaxf(mx, 1e-30f);
#pragma unroll
          for (int j = 0; j < 4; ++j) ((unsigned*)(ws + WS_H + (size_t)m * D))[lane + 64 * j] = q4i8(v[j], kq);
          if (lane == 0) ((float*)(ws + WS_SA))[m] = mx * (1.f / 127.f); } }
    { float* par = (float*)(ws + WS_PAR);
      const int srcs[9] = {I_NORMG, I_CONVW, I_CONVB, I_LBA, I_LBX, I_LLAM, I_DLAM, I_SUBG, I_RW};
      const int offs[10] = {PO_NORMG, PO_CONVW, PO_CONVB, PO_LBA, PO_LBX, PO_LLAM, PO_DLAM, PO_SUBG, PO_RW, PO_SUBGS};
#pragma unroll
      for (int k = 0; k < 9; ++k) { const float* src = (const float*)AIN(srcs[k]); const int n = offs[k + 1] - offs[k];
          for (int i = gt; i < n; i += ngt) par[offs[k] + i] = src[i]; }
      for (int i = gt; i < DEPTH * 128; i += ngt) par[PO_SUBGS + i] = ((const float*)AIN(I_SUBG))[i] * (1.0f - (0.8f - 0.6f * expf(-0.3f * (float)(i >> 7)))); }
}

__device__ __forceinline__ unsigned short bf1(float v) { unsigned r; asm("v_cvt_pk_bf16_f32 %0, %1, %1" : "=v"(r) : "v"(v)); return (unsigned short)r; }
__device__ __forceinline__ float sigm_fast(float v) { return __builtin_amdgcn_rcpf(1.0f + __builtin_amdgcn_exp2f(-1.4426950408889634f * v)); }
__device__ __forceinline__ void lru_pass1(unsigned char* ws, LAS unsigned char* lds, int layer, int chunk) {
    int tid_ = threadIdx.x; asm volatile("" : "+v"(tid_)); const int tid = tid_, lane = tid & 63, wave = __builtin_amdgcn_readfirstlane(tid >> 6); (void)tid; (void)lane; (void)wave;
    typedef float f32x16 __attribute__((ext_vector_type(16)));
    const float* par = (const float*)(ws + WS_PAR);
    const int b = chunk >> 6, t0 = (chunk & 63) * 64; const size_t g0 = (size_t)b * SEQ + t0;
    LAS unsigned char* wl = lds + RING_OFF + wave * 16384;
    LAS bf16* U = (LAS bf16*)wl;
    LAS float* Gs = (LAS float*)(wl + 4608);
    const bf16* RIN = (const bf16*)(ws + WS_RIN); bf16* HL = (bf16*)(ws + WS_HL); bf16* LP = (bf16*)(ws + WS_LP);
    const int r32 = lane & 31, hi = lane >> 5;
    float h = 0.f, lpc = 0.f, xm3 = 0.f, xm2 = 0.f, xm1 = 0.f;
    v4u pre[4];
#define LRU_LOAD(nb_, tg_) do { _Pragma("unroll") for (int i = 0; i < 4; ++i) pre[i] = *(const v4u*)(RIN + (g0 + (tg_) * 32 + (lane >> 3) + 8 * i) * D + 64 * (2 * wave + (nb_)) + 8 * (lane & 7)); } while (0)
    LRU_LOAD(0, 0);
    for (int it = 0; it < 4; ++it) { const int nb = it >> 1, tg = it & 1;
        const int n = 2 * wave + nb, ch = 64 * n + lane;
        const float* cw = par + PO_CONVW + (size_t)layer * 4 * D;
        const float cw0 = cw[ch], cw1 = cw[D + ch], cw2 = cw[2 * D + ch], cw3 = cw[3 * D + ch], cb = par[PO_CONVB + layer * D + ch];
        const float ba = par[PO_LBA + layer * D + ch], bx = par[PO_LBX + layer * D + ch];
        const float lam = par[PO_LLAM + layer * D + ch];
        const float c8sp = -8.0f * 1.4426950408889634f * log1pf(__expf(-lam));
        const bf16* lw = (const bf16*)(ws + WS_LRUW) + (size_t)((layer * 16 + n) * 2) * 4096;
        if (tg == 0) { h = 0.f; lpc = 0.f; xm3 = 0.f; xm2 = 0.f; xm1 = 0.f;
            if (t0 > 0) { xm3 = bf2f(RIN[(g0 - 3) * D + ch]); xm2 = bf2f(RIN[(g0 - 2) * D + ch]); xm1 = bf2f(RIN[(g0 - 1) * D + ch]); } }
        const size_t gr = g0 + tg * 32;
        bf16x8 wf[2][2][4];
#pragma unroll
        for (int g = 0; g < 2; ++g)
#pragma unroll
            for (int dh = 0; dh < 2; ++dh)
#pragma unroll
                for (int ks = 0; ks < 4; ++ks) wf[g][dh][ks] = *(const bf16x8*)(lw + (size_t)g * 4096 + (32 * dh + r32) * 64 + 16 * ks + 8 * hi);
#pragma unroll
        for (int i = 0; i < 4; ++i) *(LAS v4u*)(U + ((lane >> 3) + 8 * i) * 72 + 8 * (lane & 7)) = pre[i];
        LDS_WAIT();
        if (it < 3) LRU_LOAD((it + 1) >> 1, (it + 1) & 1);
        float u[32];
#pragma unroll
        for (int t = 0; t < 32; ++t) { const float x = bf2f(U[t * 72 + lane]); u[t] = cb + cw0 * xm3 + cw1 * xm2 + cw2 * xm1 + cw3 * x; xm3 = xm2; xm2 = xm1; xm1 = x; U[t * 72 + lane] = bf1(u[t]); }
        LDS_WAIT();
        float gp[2][32];
#pragma unroll
        for (int g = 0; g < 2; ++g) {
            f32x16 c0 = {}, c1 = {};
#pragma unroll
            for (int ks = 0; ks < 4; ++ks) { const bf16x8 a = *(const LAS bf16x8*)(U + r32 * 72 + 16 * ks + 8 * hi);
                c0 = __builtin_amdgcn_mfma_f32_32x32x16_bf16(a, wf[g][0][ks], c0, 0, 0, 0); c1 = __builtin_amdgcn_mfma_f32_32x32x16_bf16(a, wf[g][1][ks], c1, 0, 0, 0); }
#pragma unroll
            for (int r = 0; r < 16; ++r) { const int row = (r & 3) + 8 * (r >> 2) + 4 * hi; Gs[row * 64 + r32] = c0[r]; Gs[row * 64 + 32 + r32] = c1[r]; }
            LDS_WAIT();
#pragma unroll
            for (int t = 0; t < 32; ++t) gp[g][t] = Gs[t * 64 + lane];
            LDS_WAIT();
        }
        LAS bf16* S2 = (LAS bf16*)Gs;
#pragma unroll
        for (int t = 0; t < 32; ++t) { const float rr = sigm_fast(gp[0][t] + ba), ii = sigm_fast(gp[1][t] + bx), la = c8sp * rr, a = __builtin_amdgcn_exp2f(la);
            const float bb = __builtin_amdgcn_sqrtf(fmaxf(0.f, 1.0f - a * a)) * ii * u[t];
            h = a * h + bb; lpc += la; U[t * 72 + lane] = bf1(h); S2[t * 72 + lane] = bf1(lpc); }
        LDS_WAIT();
#pragma unroll
        for (int i = 0; i < 4; ++i) { const int row = i * 8 + (lane >> 3), cc = lane & 7;
            const v4u a = *(const LAS v4u*)(U + row * 72 + cc * 8), c = *(const LAS v4u*)(S2 + row * 72 + cc * 8);
            *(v4u*)(HL + (gr + row) * D + 64 * n + cc * 8) = a; *(v4u*)(LP + (gr + row) * D + 64 * n + cc * 8) = c; }
        LDS_WAIT();
        if (tg == 1) { float* sum = (float*)(ws + WS_SUM) + (size_t)chunk * 2 * D; __hip_atomic_store(sum + ch, lpc, RLX_AGENT); __hip_atomic_store(sum + D + ch, h, RLX_AGENT); }
    }
#undef LRU_LOAD
}

__device__ __forceinline__ void tp_mix(unsigned char* ws, LAS unsigned char* lds, int layer, int chunk) {
    int tid_ = threadIdx.x; asm volatile("" : "+v"(tid_)); const int tid = tid_, lane = tid & 63, wave = __builtin_amdgcn_readfirstlane(tid >> 6); (void)tid; (void)lane; (void)wave;
    const float* par = (const float*)(ws + WS_PAR);
    LAS float* carry = (LAS float*)(lds + RING_OFF);
    { const float* sum = (const float*)(ws + WS_SUM);
      for (int ch = tid; ch < D; ch += NWAVES * 64) { float c = 0.f;
          const float* sp = sum + (size_t)(chunk & ~63) * 2 * D + ch; const int n = chunk & 63; int cc = 0;
          for (; cc + 8 <= n; cc += 8) { float la[8], bb[8];
#pragma unroll
              for (int k = 0; k < 8; ++k) { la[k] = sp[(size_t)(cc + k) * 2 * D]; bb[k] = sp[(size_t)(cc + k) * 2 * D + D]; }
#pragma unroll
              for (int k = 0; k < 8; ++k) c = __builtin_amdgcn_exp2f(la[k]) * c + bb[k]; }
          for (; cc < n; ++cc) c = __builtin_amdgcn_exp2f(sp[(size_t)cc * 2 * D]) * c + sp[(size_t)cc * 2 * D + D];
          carry[ch] = c; } }
    __syncthreads();
    const int b = chunk >> 6, t0 = (chunk & 63) * 64; const size_t g0 = (size_t)b * SEQ + t0;
    for (int rr = wave; rr < 64; rr += 2 * NWAVES) {
        v4u hl[2][2], lp[2][2], gg[2][2];
#pragma unroll
        for (int q = 0; q < 2; ++q) { const size_t ro = (g0 + rr + q * NWAVES) * D * 2;
#pragma unroll
            for (int j = 0; j < 2; ++j) { hl[q][j] = ((const v4u*)(ws + WS_HL + ro))[lane + 64 * j]; lp[q][j] = ((const v4u*)(ws + WS_LP + ro))[lane + 64 * j]; gg[q][j] = ((const v4u*)(ws + WS_GG + ro))[lane + 64 * j]; } }
#pragma unroll
        for (int q = 0; q < 2; ++q) { const size_t ro = (g0 + rr + q * NWAVES) * D * 2;
#pragma unroll
            for (int j = 0; j < 2; ++j) { const LAS f32x4* c4 = (const LAS f32x4*)carry + 128 * j + 2 * lane;
                const f32x4 l0 = bfl4(lp[q][j]), l1 = bfh4(lp[q][j]);
                const f32x4 e0 = {__builtin_amdgcn_exp2f(l0.x), __builtin_amdgcn_exp2f(l0.y), __builtin_amdgcn_exp2f(l0.z), __builtin_amdgcn_exp2f(l0.w)}, e1 = {__builtin_amdgcn_exp2f(l1.x), __builtin_amdgcn_exp2f(l1.y), __builtin_amdgcn_exp2f(l1.z), __builtin_amdgcn_exp2f(l1.w)};
                ((v4u*)(ws + WS_YA + ro))[lane + 64 * j] = pk8bf((bfl4(hl[q][j]) + e0 * c4[0]) * bfl4(gg[q][j]), (bfh4(hl[q][j]) + e1 * c4[1]) * bfh4(gg[q][j])); } }
    }
    __syncthreads();
}

template <bool DRY> __device__ __forceinline__ void route_row(unsigned char* ws, const LAS float* rwT, const f32x4 (&hn)[2][2], int m, int lane) {
    gu32* ctl = (gu32*)(ws + WS_CTL);
    float lg[NEXP];
#pragma unroll
    for (int e = 0; e < NEXP; ++e) { float s = 0.f;
#pragma unroll
        for (int j = 0; j < 2; ++j) { const LAS f32x4* r4 = (const LAS f32x4*)(rwT + e * D + 512 * j) + 2 * lane; s += dot4(hn[j][0], r4[0]) + dot4(hn[j][1], r4[1]); }
        lg[e] = wave_sum(s); }
    int e0 = 0; float v0 = lg[0];
#pragma unroll
    for (int e = 1; e < NEXP; ++e) if (lg[e] > v0) { v0 = lg[e]; e0 = e; }
    int e1 = -1; float v1 = -INFINITY;
#pragma unroll
    for (int e = 0; e < NEXP; ++e) if (e != e0 && lg[e] > v1) { v1 = lg[e]; e1 = e; }
    const float w1 = 1.0f / (1.0f + __expf(v0 - v1)), w0 = 1.0f - w1;
    if (DRY) { if (w0 + w1 + (float)e0 + (float)e1 == -12345.f) ((float*)(ws + WS_BIG))[m] = w0; }
    if (lane == 0 && !DRY) { const int p0 = (int)__hip_atomic_fetch_add(ctl + CW_CNT + 64 * e0, 1u, RLX_AGENT), p1 = (int)__hip_atomic_fetch_add(ctl + CW_CNT + 64 * e1, 1u, RLX_AGENT);
        int* lst = (int*)(ws + WS_LIST); lst[e0 * T + p0] = m; lst[e1 * T + p1] = m;
        int* ti = (int*)(ws + WS_TOK) + (size_t)m * 8; ti[0] = e0; ti[1] = p0; ti[2] = e1; ti[3] = p1; ti[4] = __float_as_int(w0); ti[5] = __float_as_int(w1); }
}
template <int SRC, bool ROUTE, bool DRY = false, bool H8 = false, bool FINAL = false, bool HQ = false> __device__ __forceinline__ void tp_post_pre(unsigned char* ws, float* xres, LAS unsigned char* lds, const float* gpost, const float* gpre, int vcu, int G) {
    int tid_ = threadIdx.x; asm volatile("" : "+v"(tid_)); const int tid = tid_, lane = tid & 63, wave = __builtin_amdgcn_readfirstlane(tid >> 6); (void)tid; (void)lane; (void)wave;
    gu32* ctl = (gu32*)(ws + WS_CTL);
    LAS float* rwT = (LAS float*)(lds + RING_OFF);
    int ps[NEXP];
    if (ROUTE) { const float* rw = (const float*)(ws + WS_PAR) + PO_RW; for (int i = tid; i < D * NEXP; i += NWAVES * 64) rwT[(i & 7) * D + (i >> 3)] = rw[i]; __syncthreads(); }
    if (SRC == 1) { int acc = 0;
#pragma unroll
        for (int e = 0; e < NEXP; ++e) { ps[e] = acc; acc += ((int)__hip_atomic_load(ctl + CW_CNT + 64 * e, RLX_AGENT) + 255) >> 8; } }
    const int gw = vcu * NWAVES + wave, ngw = G * NWAVES;
    f32x4 gp[2][2], gq[2][2];
#pragma unroll
    for (int j = 0; j < 2; ++j)
#pragma unroll
        for (int h = 0; h < 2; ++h) { gp[j][h] = ((const f32x4*)gpost)[128 * j + 2 * lane + h]; gq[j][h] = gpre ? ((const f32x4*)gpre)[128 * j + 2 * lane + h] : (f32x4){0.f, 0.f, 0.f, 0.f}; }
    unsigned char* xo = ws + (DRY ? WS_BIG : WS_XR); unsigned char* ho = ws + (DRY ? WS_BIG + 2 * SLOT : WS_H);
    constexpr int NR = (ROUTE || SRC == 1) ? 2 : 8;
    const bool xl = (ngw == 2048);
#define TP_ROW_OF(k) (xl ? ((gw >> 8) << 11) + (gw & 255) + ((k) << 8) : gw + (k) * ngw)
    for (int k0 = 0; TP_ROW_OF(k0) < T && k0 * ngw < T; k0 += NR) {
        v4u fa[NR][2], fc[NR][2], xr[NR][2]; float w0[NR], w1[NR];
#pragma unroll
        for (int r = 0; r < NR; ++r) { const int m = TP_ROW_OF(k0 + r); if ((k0 + r) * ngw < T && m < T) {
            if (SRC == 0) { const v4u* p = (const v4u*)(ws + WS_F + (size_t)m * D * 2) + lane; fa[r][0] = p[0]; fa[r][1] = p[64]; }
            else { const int* ti = (const int*)(ws + WS_TOK) + (size_t)m * 8; const int e0 = ti[0], p0 = ti[1], e1 = ti[2], p1 = ti[3]; w0[r] = __int_as_float(ti[4]); w1[r] = __int_as_float(ti[5]); int s0 = 0, s1 = 0;
#pragma unroll
                for (int e = 0; e < NEXP; ++e) { if (e == e0) s0 = ps[e]; if (e == e1) s1 = ps[e]; }
#define OE_ROW(dst, rw) do { const int rw_ = (rw); if (rw_ < MOE_MAINP * 256) { const v4u* q_ = (const v4u*)(ws + WS_OE + (size_t)rw_ * D * 2) + lane; dst[0] = q_[0]; dst[1] = q_[64]; } \
                    else { f32x4 a0_ = {0.f, 0.f, 0.f, 0.f}, a1_ = a0_, a2_ = a0_, a3_ = a0_; \
                        _Pragma("unroll") for (int ks_ = 0; ks_ < MOE_KS; ++ks_) { const v4u* q_ = (const v4u*)(ws + WS_OEP + ((size_t)ks_ * 8 * 256 + (rw_ - MOE_MAINP * 256)) * D * 2) + lane; const v4u x_ = q_[0], y_ = q_[64]; \
                            a0_ = a0_ + bfl4(x_); a1_ = a1_ + bfh4(x_); a2_ = a2_ + bfl4(y_); a3_ = a3_ + bfh4(y_); } \
                        dst[0] = pk8bf(a0_, a1_); dst[1] = pk8bf(a2_, a3_); } } while (0)
                OE_ROW(fa[r], s0 * 256 + p0); OE_ROW(fc[r], s1 * 256 + p1); }
#undef OE_ROW
            const v4u* xp = (const v4u*)(ws + WS_XR + (size_t)m * D * 2) + lane; xr[r][0] = xp[0]; xr[r][1] = xp[64]; } }
#pragma unroll
        for (int r = 0; r < NR; ++r) { const int m = TP_ROW_OF(k0 + r); if ((k0 + r) * ngw < T && m < T) {
            f32x4 f[2][2], xv[2][2]; float s = 0.f;
#pragma unroll
            for (int j = 0; j < 2; ++j) { f[j][0] = bfl4(fa[r][j]); f[j][1] = bfh4(fa[r][j]);
                if (SRC == 1) { f[j][0] = f[j][0] * w0[r] + bfl4(fc[r][j]) * w1[r]; f[j][1] = f[j][1] * w0[r] + bfh4(fc[r][j]) * w1[r]; }
                s += dot4(f[j][0], f[j][0]) + dot4(f[j][1], f[j][1]); }
            const float rs = rsqrtf(wave_sum(s) * (1.f / D) + EPS); float s2 = 0.f;
#pragma unroll
            for (int j = 0; j < 2; ++j) { xv[j][0] = bfl4(xr[r][j]) + f[j][0] * rs * gp[j][0]; xv[j][1] = bfh4(xr[r][j]) + f[j][1] * rs * gp[j][1];
                if (FINAL && !DRY) { f32x4* o = (f32x4*)(xres + (size_t)m * D) + 128 * j + 2 * lane; o[0] = xv[j][0]; o[1] = xv[j][1]; }
                else ((v4u*)(xo + (size_t)m * D * 2))[lane + 64 * j] = pk8bf(xv[j][0], xv[j][1]);
                s2 += dot4(xv[j][0], xv[j][0]) + dot4(xv[j][1], xv[j][1]); }
            if (gpre) { const float rs2 = rsqrtf(wave_sum(s2) * (1.f / D) + EPS);
#pragma unroll
                for (int j = 0; j < 2; ++j) { xv[j][0] = xv[j][0] * rs2 * gq[j][0]; xv[j][1] = xv[j][1] * rs2 * gq[j][1];
                    if (H8) { u32x2 w; w.x = pk4f8(xv[j][0].x * SC_H, xv[j][0].y * SC_H, xv[j][0].z * SC_H, xv[j][0].w * SC_H); w.y = pk4f8(xv[j][1].x * SC_H, xv[j][1].y * SC_H, xv[j][1].z * SC_H, xv[j][1].w * SC_H);
                        ((u32x2*)(ho + (size_t)m * D))[lane + 64 * j] = w; }
                    else if (!HQ) ((v4u*)(ho + (size_t)m * D * 2))[lane + 64 * j] = pk8bf(xv[j][0], xv[j][1]); }
                if (HQ) { const float mx = wave_max(fmaxf(fmaxf(amax4(xv[0][0]), amax4(xv[0][1])), fmaxf(amax4(xv[1][0]), amax4(xv[1][1])))); const float kq = 127.f / fmaxf(mx, 1e-30f);
#pragma unroll
                    for (int j = 0; j < 2; ++j) { u32x2 w; w.x = q4i8(xv[j][0], kq); w.y = q4i8(xv[j][1], kq); ((u32x2*)(ho + (size_t)m * D))[lane + 64 * j] = w; }
                    if (lane == 0 && !DRY) ((float*)(ws + WS_SA))[m] = mx * (1.f / 127.f); }
                if (ROUTE) route_row<DRY>(ws, rwT, xv, m, lane); } } }
    }
#undef TP_ROW_OF
    if (ROUTE) __syncthreads();
}

__device__ __forceinline__ void pm0_moe_setup(unsigned char* ws, const float* mg, const float* mu, const float* md, LAS unsigned char* lds, int vcu, int G) {
    int tid_ = threadIdx.x; asm volatile("" : "+v"(tid_)); const int tid = tid_, lane = tid & 63, wave = __builtin_amdgcn_readfirstlane(tid >> 6); (void)tid; (void)lane; (void)wave;
    gu32* ctl = (gu32*)(ws + WS_CTL);
    LAS float* scr = (LAS float*)(lds + RING_OFF + wave * 16384);
    const int gw = vcu * NWAVES + wave, ngw = G * NWAVES;
    int cs[NEXP + 1], ps[NEXP]; { int a = 0, p = 0;
#pragma unroll
        for (int e = 0; e < NEXP; ++e) { const int c = (int)__hip_atomic_load(ctl + CW_CNT + 64 * e, RLX_AGENT); cs[e] = a; ps[e] = p; a += c; p += (c + 255) >> 8; } cs[NEXP] = a; }
    const int* lst = (const int*)(ws + WS_LIST);
    for (int i = gw; i < cs[NEXP]; i += ngw) { int e = 0, base = 0, pst = 0;
#pragma unroll
        for (int k = 0; k < NEXP; ++k) if (i >= cs[k]) { e = k; base = cs[k]; pst = ps[k]; }
        const int pos = i - base, tok = lst[e * T + pos];
        ((v4u*)(ws + WS_HG + ((size_t)pst * 256 + pos) * D))[lane] = ((const v4u*)(ws + WS_H + (size_t)tok * D))[lane]; }
    { struct Dec { const float* mg; const float* mu; const float* md; unsigned char* ws;
          __device__ __forceinline__ TrItem operator()(int f) const {
              constexpr int I_FF = (D / 64) * (FF / 32);
              const int e = f / (3 * I_FF); int r = f - e * 3 * I_FF;
              if (r < I_FF) return tr_item<2>(mg + (size_t)e * D * FF, D, FF, (bf16*)(ws + WS_WMGU), e * 2 * FF, r, SC_WGU); r -= I_FF;
              if (r < I_FF) return tr_item<3>(mu + (size_t)e * D * FF, D, FF, (bf16*)(ws + WS_WMGU), e * 2 * FF, r, SC_WGU); r -= I_FF;
              return tr_item<0>(md + (size_t)e * FF * D, FF, D, (bf16*)(ws + WS_WMD), e * D, r, SC_WD); } };
      const Dec dec{mg, mu, md, ws}; tr_run<true>(dec, NEXP * 3 * (D / 64) * (FF / 32), scr, lane, gw, ngw); }
}
constexpr int NPH_L = 14, NPHASES = 1 + DEPTH * NPH_L;
__host__ __device__ constexpr bool phase_exists(int ph) { return ph == 0 || !(((ph - 1) % NPH_L) == 2 || (((ph - 1) % NPH_L) == 9 || ((ph - 1) % NPH_L) == 10) || (((ph - 1) / NPH_L) % 2 == 0 && ((ph - 1) % NPH_L) == 6)); }

__global__ void __launch_bounds__(NWAVES * 64, 2) mk_fwd(Args args) {
    extern __shared__ __attribute__((aligned(16))) unsigned char lds_raw[];
    LAS unsigned char* lds = (LAS unsigned char*)lds_raw;
    volatile LAS unsigned* MISC = (volatile LAS unsigned*)(lds + MISC_OFF);
    const int tid = threadIdx.x;
    const int Gk = gridDim.x; const int bxk = blockIdx.x; const int vcuk = (Gk % 8 == 0) ? (bxk % 8) * (Gk / 8) + bxk / 8 : bxk;
    for (int u = tid; u < (LDS_BYTES - LDSCTL_OFF) / 4; u += NWAVES * 64) ((LAS unsigned*)(lds + LDSCTL_OFF))[u] = 0u;
    __syncthreads();
    XcdBarrier bar; bar.bar = (unsigned*)(args.ws + WS_CTL) + CW_BAR; bar.x = 0; bar.st = nullptr;
    if (!MK_MULTI) bar = xcd_barrier_post((unsigned*)(args.ws + WS_CTL) + CW_BAR, MISC + 8);
    const int lo = args.ph_lo, hi = args.ph_hi;
#ifndef DIS
#define DIS 0
#endif
#ifndef REP
#define REP 0
#endif
#define EN(b) (!((DIS >> (b)) & 1))
#define IN(k) (lo <= (k) && (k) < hi)
#define PH_WS int z_ = 0, G = Gk, bx = bxk, vcu = vcuk; asm volatile("" : "+s"(z_), "+s"(G), "+s"(bx), "+s"(vcu)); unsigned char* ws = (unsigned char*)((GAS unsigned char*)args.ws + z_); (void)ws; (void)G; (void)bx; (void)vcu
#define XOUT ((float*)((GAS float*)args.out + z_))
#define GIN(k) ((const float*)((const GAS float*)args.in[k] + z_))
#define SEAM(k) do { if ((k) + 1 < hi) { if (MK_MULTI) { if (tid == 0) __hip_atomic_store((gu32*)(ws + WS_CTL) + CW_TMO, 0xBADBA0u, RLX_AGENT); } else xcd_barrier(bar); } } while (0)

    if (EN(0) && IN(0)) { PH_WS;
#if (REP >> 0) & 1
        { p0_prologue(args, lds, vcu, G); }
        __syncthreads();
#endif
        p0_prologue(args, lds, vcu, G);
        SEAM(0); }

    for (int l = 0; l < DEPTH; ++l) {
        const int pb = 1 + NPH_L * l;
        if (EN(1) && IN(pb + 0)) { PH_WS;
#if (REP >> 1) & 1
            { unsigned char* wl = ws + WS_WSMALL + (size_t)l * WL_STRIDE;
            pg8::Gemm g{(const pg8::bf16_t*)(ws + WS_H), (const pg8::bf16_t*)(ws + WS_WIN8 + (size_t)l * DIN * D), T, DIN, D / 2}; pg8::StaticOrder S; S.init(T, DIN, G, bx); (void)wl;
            pg8::EpiInProjq E{(pg8::bf16_t*)(ws + WS_BIG), SLOT / 2, (const float*)(ws + WS_COS), attn_body::C2, (const float*)(ws + WS_SA), (const float*)(ws + WS_SB) + (size_t)l * DIN};
#ifdef STAGGER_US
            if (bx & 1) { const unsigned long long t0_ = __builtin_amdgcn_s_memrealtime(); while (__builtin_amdgcn_s_memrealtime() - t0_ < (unsigned long long)(STAGGER_US * 100)) __builtin_amdgcn_s_sleep(8); }
#endif
            pg8::gemm_phase<pg8::EpiInProjq, pg8::StaticOrder, true, true, 2>(lds + RING_OFF, g, S, E);
            }
            __syncthreads();
#endif
            unsigned char* wl = ws + WS_WSMALL + (size_t)l * WL_STRIDE;
            pg8::Gemm g{(const pg8::bf16_t*)(ws + WS_H), (const pg8::bf16_t*)(ws + WS_WIN8 + (size_t)l * DIN * D), T, DIN, D / 2}; pg8::StaticOrder S; S.init(T, DIN, G, bx); (void)wl;
            pg8::EpiInProjq E{(pg8::bf16_t*)(ws + WS_BIG), SLOT / 2, (const float*)(ws + WS_COS), attn_body::C2, (const float*)(ws + WS_SA), (const float*)(ws + WS_SB) + (size_t)l * DIN};
#ifdef STAGGER_US
            if (bx & 1) { const unsigned long long t0_ = __builtin_amdgcn_s_memrealtime(); while (__builtin_amdgcn_s_memrealtime() - t0_ < (unsigned long long)(STAGGER_US * 100)) __builtin_amdgcn_s_sleep(8); }
#endif
            pg8::gemm_phase<pg8::EpiInProjq, pg8::StaticOrder, true, true, 2>(lds + RING_OFF, g, S, E);

            SEAM(pb + 0);
        }
        if (EN(2) && IN(pb + 1)) { PH_WS;

#ifndef NO_LRU
            for (int c = vcu; c < 256; c += G) lru_pass1(ws, lds, l, c);
            VM_WAIT(); __syncthreads();
            if (tid == 0) { unsigned* cb = (unsigned*)(ws + WS_CTL) + CW_LRU + 2048 * l; unsigned* bw = (unsigned*)(ws + WS_CTL) + CW_BAR; unsigned bx_ = bar.x; asm volatile("" : "+s"(cb), "+s"(bw), "+s"(bx_));
                const unsigned nloc = bar.st[0], nx = bar.st[1];
                if (xb_add(cb + 64 * bx_, 1u) + 1u == nloc) (void)xb_add(cb + 64 * 16, 1u);
                XB_SPIN(xb_ld(cb + 64 * 16) < nx, bw);
                __builtin_amdgcn_fence(__ATOMIC_ACQUIRE, "agent"); VM_WAIT(); }
            __syncthreads();
            for (int c = vcu; c < 256; c += G) tp_mix(ws, lds, l, c);
#endif
#ifndef NO_ATT
            const attn_body::AttnTensors AT{(const attn_body::bf16*)(ws + WS_Q), (const attn_body::bf16*)(ws + WS_K), (const attn_body::bf16*)(ws + WS_V), (attn_body::bf16*)(ws + WS_O2), (attn_body::bf16*)(ws + WS_YB)};
            { const float* par = (const float*)(ws + WS_PAR); const float* dl = par + PO_DLAM + l * 256; int t_ = threadIdx.x; asm volatile("" : "+v"(t_)); const int ln_ = t_ & 63;
              const float lamv = expf(wave_sum(dl[ln_] * dl[64 + ln_])) - expf(wave_sum(dl[128 + ln_] * dl[192 + ln_])) + (0.8f - 0.6f * expf(-0.3f * (float)l));
              attn_body::attn_phase<8>((char*)lds_raw + RING_OFF, AT, lamv, par + PO_SUBGS + l * 128, vcu, G); }
#endif

            SEAM(pb + 1);
        }
        if (EN(4) && IN(pb + 3)) { PH_WS;
#if (REP >> 4) & 1
            { unsigned char* wl = ws + WS_WSMALL + (size_t)l * WL_STRIDE;
            pg8::Gemm g{(const pg8::bf16_t*)(ws + WS_YA), (const pg8::bf16_t*)(wl + WL_WAB), T, D, D}; pg8::PairOrder S; S.base.init(T, D, G, bx);
            pg8::EpiMerge E{(const pg8::bf16_t*)(ws + WS_SGA), (const pg8::bf16_t*)(ws + WS_SGB), (pg8::bf16_t*)(ws + WS_T1), (pg8::bf16_t*)(ws + WS_MERGED), NPAN};
            pg8::gemm_phase<pg8::EpiMerge, pg8::PairOrder, true, true>(lds + RING_OFF, g, S, E);
            }
            __syncthreads();
#endif
            unsigned char* wl = ws + WS_WSMALL + (size_t)l * WL_STRIDE;
            pg8::Gemm g{(const pg8::bf16_t*)(ws + WS_YA), (const pg8::bf16_t*)(wl + WL_WAB), T, D, D}; pg8::PairOrder S; S.base.init(T, D, G, bx);
            pg8::EpiMerge E{(const pg8::bf16_t*)(ws + WS_SGA), (const pg8::bf16_t*)(ws + WS_SGB), (pg8::bf16_t*)(ws + WS_T1), (pg8::bf16_t*)(ws + WS_MERGED), NPAN};
            pg8::gemm_phase<pg8::EpiMerge, pg8::PairOrder, true, true>(lds + RING_OFF, g, S, E);

            SEAM(pb + 3);
        }
        if (EN(5) && IN(pb + 4)) { PH_WS;
#if (REP >> 5) & 1
            { unsigned char* wl = ws + WS_WSMALL + (size_t)l * WL_STRIDE;
            pg8::Gemm g{(const pg8::bf16_t*)(ws + WS_MERGED), (const pg8::bf16_t*)(wl + WL_WO), T, D, D}; pg8::StaticOrder S; S.init(T, D, G, bx);
            pg8::EpiPlainBf16 E{(pg8::bf16_t*)(ws + WS_F), D, 3};
            pg8::gemm_phase<pg8::EpiPlainBf16, pg8::StaticOrder, false, true>(lds + RING_OFF, g, S, E);
            }
            __syncthreads();
#endif
            unsigned char* wl = ws + WS_WSMALL + (size_t)l * WL_STRIDE;
            pg8::Gemm g{(const pg8::bf16_t*)(ws + WS_MERGED), (const pg8::bf16_t*)(wl + WL_WO), T, D, D}; pg8::StaticOrder S; S.init(T, D, G, bx);
            pg8::EpiPlainBf16 E{(pg8::bf16_t*)(ws + WS_F), D, 3};
            pg8::gemm_phase<pg8::EpiPlainBf16, pg8::StaticOrder, false, true>(lds + RING_OFF, g, S, E);

            SEAM(pb + 4);
        }
        if (EN(6) && IN(pb + 5)) { PH_WS;
#if (REP >> 6) & 1
            { const float* ng = (const float*)(ws + WS_PAR) + PO_NORMG + (size_t)l * 6 * D;
            if (l & 1) tp_post_pre<0, true, true, true>(ws, XOUT, lds, ng + 1 * D, ng + 2 * D, vcu, G);
            else tp_post_pre<0, false, true, false, false, true>(ws, XOUT, lds, ng + 1 * D, ng + 2 * D, vcu, G);
            }
            __syncthreads();
#endif
            const float* ng = (const float*)(ws + WS_PAR) + PO_NORMG + (size_t)l * 6 * D;
            if (l & 1) tp_post_pre<0, true, false, true>(ws, XOUT, lds, ng + 1 * D, ng + 2 * D, vcu, G);
            else tp_post_pre<0, false, false, false, false, true>(ws, XOUT, lds, ng + 1 * D, ng + 2 * D, vcu, G);

            SEAM(pb + 5);
        }
        if (!(l & 1)) {
            if (EN(7) && IN(pb + 7)) { PH_WS;
#if (REP >> 7) & 1
                {
                pg8::Gemm g{(const pg8::bf16_t*)(ws + WS_H), (const pg8::bf16_t*)(ws + WS_WGU8), T, 2 * FF, D / 2}; pg8::StaticOrder S; S.init(T, 2 * FF, G, bx);
                pg8::EpiSwiGLUq E{(pg8::bf16_t*)(ws + WS_ACT), FF, (const float*)(ws + WS_SA), (const float*)(ws + WS_SB) + 2 * DIN};
#ifdef STAGGER_US
            if (bx & 1) { const unsigned long long t0_ = __builtin_amdgcn_s_memrealtime(); while (__builtin_amdgcn_s_memrealtime() - t0_ < (unsigned long long)(STAGGER_US * 100)) __builtin_amdgcn_s_sleep(8); }
#endif
                pg8::gemm_phase<pg8::EpiSwiGLUq, pg8::StaticOrder, true, true, 2>(lds + RING_OFF, g, S, E);
                }
                __syncthreads();
#endif

                pg8::Gemm g{(const pg8::bf16_t*)(ws + WS_H), (const pg8::bf16_t*)(ws + WS_WGU8), T, 2 * FF, D / 2}; pg8::StaticOrder S; S.init(T, 2 * FF, G, bx);
                pg8::EpiSwiGLUq E{(pg8::bf16_t*)(ws + WS_ACT), FF, (const float*)(ws + WS_SA), (const float*)(ws + WS_SB) + 2 * DIN};
#ifdef STAGGER_US
            if (bx & 1) { const unsigned long long t0_ = __builtin_amdgcn_s_memrealtime(); while (__builtin_amdgcn_s_memrealtime() - t0_ < (unsigned long long)(STAGGER_US * 100)) __builtin_amdgcn_s_sleep(8); }
#endif
                pg8::gemm_phase<pg8::EpiSwiGLUq, pg8::StaticOrder, true, true, 2>(lds + RING_OFF, g, S, E);

                SEAM(pb + 7);
            }
            if (EN(8) && IN(pb + 8)) { PH_WS;
#if (REP >> 8) & 1
                {
                pg8::Gemm g{(const pg8::bf16_t*)(ws + WS_ACT), (const pg8::bf16_t*)(ws + WS_WD), T, D, FF}; pg8::StaticOrder S; S.init(T, D, G, bx);
                pg8::EpiPlainBf16 E{(pg8::bf16_t*)(ws + WS_F), D, 3};
                pg8::gemm_phase<pg8::EpiPlainBf16, pg8::StaticOrder, false, true>(lds + RING_OFF, g, S, E);
                }
                __syncthreads();
#endif

                pg8::Gemm g{(const pg8::bf16_t*)(ws + WS_ACT), (const pg8::bf16_t*)(ws + WS_WD), T, D, FF}; pg8::StaticOrder S; S.init(T, D, G, bx);
                pg8::EpiPlainBf16 E{(pg8::bf16_t*)(ws + WS_F), D, 3};
                pg8::gemm_phase<pg8::EpiPlainBf16, pg8::StaticOrder, false, true>(lds + RING_OFF, g, S, E);

                SEAM(pb + 8);
            }
            if (EN(9) && IN(pb + 11)) { PH_WS;
#if (REP >> 9) & 1
                { const float* ng = (const float*)(ws + WS_PAR) + PO_NORMG + (size_t)l * 6 * D;
                tp_post_pre<0, false, true, false, false, true>(ws, XOUT, lds, ng + 3 * D, ng + 4 * D, vcu, G); }
                __syncthreads();
#endif
                const float* ng = (const float*)(ws + WS_PAR) + PO_NORMG + (size_t)l * 6 * D;
                tp_post_pre<0, false, false, false, false, true>(ws, XOUT, lds, ng + 3 * D, ng + 4 * D, vcu, G);
                SEAM(pb + 11); }
        } else {
            if (EN(10) && IN(pb + 6)) { PH_WS;
#if (REP >> 10) & 1
                { pm0_moe_setup(ws, GIN(I_MG), GIN(I_MU), GIN(I_MD), lds, vcu, G); }
                __syncthreads();
#endif
                pm0_moe_setup(ws, GIN(I_MG), GIN(I_MU), GIN(I_MD), lds, vcu, G);
                SEAM(pb + 6); }
            if (EN(11) && IN(pb + 7)) { PH_WS; gu32* ctl = (gu32*)(ws + WS_CTL);
                int ps[NEXP + 1]; { int p = 0;
#pragma unroll
                    for (int e = 0; e < NEXP; ++e) { ps[e] = p; p += ((int)__hip_atomic_load(ctl + CW_CNT + 64 * e, RLX_AGENT) + 255) >> 8; } ps[NEXP] = p; }
#if (REP >> 11) & 1
                for (int rep_ = 0; rep_ < 2; ++rep_)
#endif
                {
                pg8::Gemm g{(const pg8::bf16_t*)(ws + WS_HG), (const pg8::bf16_t*)(ws + WS_WMGU), ps[NEXP] * 256, 2 * FF, D / 2, E8_H, E8_WGU};
                pg8::MoeOrder S; S.base.init(ps[NEXP] * 256, 2 * FF, G, bx); S.plo = 0; S.ps1 = ps[1]; S.ps2 = ps[2]; S.ps3 = ps[3]; S.ps4 = ps[4]; S.ps5 = ps[5]; S.ps6 = ps[6]; S.ps7 = ps[7];
                pg8::EpiSwiGLU8 E{ws + WS_ACT8, FF, 2 * FF / 256, 0, SC_ACT};
#ifdef STAGGER_US
            if (bx & 1) { const unsigned long long t0_ = __builtin_amdgcn_s_memrealtime(); while (__builtin_amdgcn_s_memrealtime() - t0_ < (unsigned long long)(STAGGER_US * 100)) __builtin_amdgcn_s_sleep(8); }
#endif
                pg8::gemm_phase<pg8::EpiSwiGLU8, pg8::MoeOrder, true, true, true>(lds + RING_OFF, g, S, E);
                }
                SEAM(pb + 7);
            }
            if (EN(12) && IN(pb + 8)) { PH_WS; gu32* ctl = (gu32*)(ws + WS_CTL);
                int ps[NEXP + 1]; { int p = 0;
#pragma unroll
                    for (int e = 0; e < NEXP; ++e) { ps[e] = p; p += ((int)__hip_atomic_load(ctl + CW_CNT + 64 * e, RLX_AGENT) + 255) >> 8; } ps[NEXP] = p; }
#if (REP >> 12) & 1
                for (int rep_ = 0; rep_ < 2; ++rep_)
#endif
                {
                const int npm = ps[NEXP] < MOE_MAINP ? ps[NEXP] : MOE_MAINP;
                pg8::Gemm g{(const pg8::bf16_t*)(ws + WS_ACT8), (const pg8::bf16_t*)(ws + WS_WMD), npm * 256, D, FF / 2, E8_ACT, E8_WD};
                pg8::MoeOrder S; S.base.init(npm * 256, D, G, bx); S.plo = 0; S.ps1 = ps[1]; S.ps2 = ps[2]; S.ps3 = ps[3]; S.ps4 = ps[4]; S.ps5 = ps[5]; S.ps6 = ps[6]; S.ps7 = ps[7];
                pg8::EpiPlainBf16 E{(pg8::bf16_t*)(ws + WS_OE), D, 3};
                pg8::gemm_phase<pg8::EpiPlainBf16, pg8::MoeOrder, true, true, true>(lds + RING_OFF, g, S, E);
                if (ps[NEXP] > MOE_MAINP) {
                    __syncthreads();
                    pg8::Gemm g2{(const pg8::bf16_t*)(ws + WS_ACT8), (const pg8::bf16_t*)(ws + WS_WMD), (ps[NEXP] - MOE_MAINP) * 256, D, MOE_KSB / 2, E8_ACT, E8_WD, FF / 2};
                    pg8::MoeKSplitOrder S2{G, bx, MOE_MAINP, ps[NEXP] - MOE_MAINP, D / 256, MOE_KS, MOE_KSB, ps[1], ps[2], ps[3], ps[4], ps[5], ps[6], ps[7]};
                    pg8::EpiSliceBf16 E2{(pg8::bf16_t*)(ws + WS_OEP), D, 3, MOE_MAINP, MOE_KSB, (size_t)8 * 256 * D};
                    pg8::gemm_phase<pg8::EpiSliceBf16, pg8::MoeKSplitOrder, true, true, true>(lds + RING_OFF, g2, S2, E2);
                }
                }
                SEAM(pb + 8);
            }
            if (EN(13) && IN(pb + 11)) { PH_WS;
#if (REP >> 13) & 1
                { const float* ng = (const float*)(ws + WS_PAR) + PO_NORMG + (size_t)l * 6 * D;
                tp_post_pre<1, false, true, false, false, true>(ws, XOUT, lds, ng + 3 * D, ng + 4 * D, vcu, G); }
                __syncthreads();
#endif
                const float* ng = (const float*)(ws + WS_PAR) + PO_NORMG + (size_t)l * 6 * D;
                tp_post_pre<1, false, false, false, false, true>(ws, XOUT, lds, ng + 3 * D, ng + 4 * D, vcu, G);
                SEAM(pb + 11); }
        }
        if (EN(14) && IN(pb + 12)) { PH_WS;
#if (REP >> 14) & 1
            { unsigned char* wl = ws + WS_WSMALL + (size_t)l * WL_STRIDE;
            { pg8::Gemm g{(const pg8::bf16_t*)(ws + WS_PB) + (size_t)l * T * PLE, (const pg8::bf16_t*)(wl + WL_WPP), T, D, PLE}; pg8::StaticOrder S; S.init(T, D, G, bx);
              pg8::EpiPlainBf16 E{(pg8::bf16_t*)(ws + WS_PP), D, 3};
              pg8::gemm_phase<pg8::EpiPlainBf16, pg8::StaticOrder, false, true>(lds + RING_OFF, g, S, E); }
            __syncthreads();
            { pg8::Gemm g{(const pg8::bf16_t*)(ws + WS_H), (const pg8::bf16_t*)(ws + WS_WPG8 + (size_t)l * D * D), T, D, D / 2}; pg8::StaticOrder S; S.init(T, D, G, bx);
              pg8::EpiPleGateq E{(pg8::bf16_t*)(ws + WS_F), (const pg8::bf16_t*)(ws + WS_PP), D, (const float*)(ws + WS_SA), (const float*)(ws + WS_SB) + 3 * DIN + (size_t)l * D};
              pg8::gemm_phase<pg8::EpiPleGateq, pg8::StaticOrder, false, true, 2>(lds + RING_OFF, g, S, E); }
            }
            __syncthreads();
#endif
            unsigned char* wl = ws + WS_WSMALL + (size_t)l * WL_STRIDE;
            { pg8::Gemm g{(const pg8::bf16_t*)(ws + WS_PB) + (size_t)l * T * PLE, (const pg8::bf16_t*)(wl + WL_WPP), T, D, PLE}; pg8::StaticOrder S; S.init(T, D, G, bx);
              pg8::EpiPlainBf16 E{(pg8::bf16_t*)(ws + WS_PP), D, 3};
              pg8::gemm_phase<pg8::EpiPlainBf16, pg8::StaticOrder, false, true>(lds + RING_OFF, g, S, E); }
            __syncthreads();
            { pg8::Gemm g{(const pg8::bf16_t*)(ws + WS_H), (const pg8::bf16_t*)(ws + WS_WPG8 + (size_t)l * D * D), T, D, D / 2}; pg8::StaticOrder S; S.init(T, D, G, bx);
              pg8::EpiPleGateq E{(pg8::bf16_t*)(ws + WS_F), (const pg8::bf16_t*)(ws + WS_PP), D, (const float*)(ws + WS_SA), (const float*)(ws + WS_SB) + 3 * DIN + (size_t)l * D};
              pg8::gemm_phase<pg8::EpiPleGateq, pg8::StaticOrder, false, true, 2>(lds + RING_OFF, g, S, E); }

            SEAM(pb + 12);
        }
        if (EN(15) && IN(pb + 13)) { PH_WS;
#if (REP >> 15) & 1
            { const float* ng = (const float*)(ws + WS_PAR) + PO_NORMG + (size_t)l * 6 * D;
            tp_post_pre<0, false, true>(ws, XOUT, lds, ng + 5 * D, (l + 1 < DEPTH) ? ng + 6 * D : nullptr, vcu, G); }
            __syncthreads();
#endif
            const float* ng = (const float*)(ws + WS_PAR) + PO_NORMG + (size_t)l * 6 * D;
            if (l + 1 < DEPTH) tp_post_pre<0, false, false, false, false, true>(ws, XOUT, lds, ng + 5 * D, ng + 6 * D, vcu, G);
            else tp_post_pre<0, false, false, false, true>(ws, XOUT, lds, ng + 5 * D, nullptr, vcu, G);
            SEAM(pb + 13); }
    }
#undef IN
#undef SEAM
#undef PH_WS
}

extern "C" void kernel_launch(void* const* d_in, const int* in_sizes, int n_in, void* d_out, int out_size, void* d_ws, size_t ws_size, hipStream_t stream) {
    static int grid = 0;
    if (grid == 0) {
        if (n_in != 26 || in_sizes[0] != T * D || out_size != T * D || ws_size < WS_END) { fprintf(stderr, "kernel_launch: unexpected shapes / workspace (n_in %d, in0 %d, out %d, ws %zu < %zu); nothing launched\n", n_in, n_in > 0 ? in_sizes[0] : -1, out_size, ws_size, (size_t)WS_END); grid = -1; return; }
        int dev = 0, cus = 0, per_cu = 0;
        if (hipGetDevice(&dev) != hipSuccess || hipDeviceGetAttribute(&cus, hipDeviceAttributeMultiprocessorCount, dev) != hipSuccess) { grid = -1; return; }
        if (hipFuncSetAttribute((const void*)mk_fwd, hipFuncAttributeMaxDynamicSharedMemorySize, LDS_BYTES) != hipSuccess) { fprintf(stderr, "kernel_launch: hipFuncSetAttribute failed\n"); grid = -1; return; }
        if (hipOccupancyMaxActiveBlocksPerMultiprocessor(&per_cu, (const void*)mk_fwd, NWAVES * 64, LDS_BYTES) != hipSuccess || per_cu < 1) { fprintf(stderr, "kernel_launch: occupancy query reports %d workgroups per CU\n", per_cu); (void)hipGetLastError(); grid = -1; return; }
        grid = cus;
    }
    if (grid < 0) return;
    if (hipMemsetAsync((char*)d_ws + WS_CTL, 0, CTL_ZERO_BYTES, stream) != hipSuccess) return;
    Args a{};
    for (int i = 0; i < 26; ++i) a.in[i] = d_in[i];
    a.out = (float*)d_out; a.ws = (unsigned char*)d_ws;
#if MK_MULTI
    for (int ph = 0; ph < NPHASES; ++ph) { if (!phase_exists(ph)) continue; a.ph_lo = ph; a.ph_hi = ph + 1; hipLaunchKernelGGL(mk_fwd, dim3(grid), dim3(NWAVES * 64), LDS_BYTES, stream, a); }
#else
    a.ph_lo = 0; a.ph_hi = NPHASES;
    hipLaunchKernelGGL(mk_fwd, dim3(grid), dim3(NWAVES * 64), LDS_BYTES, stream, a);
#endif
}
```
